# Optimizing an MI355X kernel written in HIP

```python
import jax, jax.numpy as jnp
from jax import lax
import numpy as np

D_MODEL = 4096
BATCH = 2
SEQ = 4096
DEPTH = 2

CHUNK = 64
Q_BLOCK = 128
HEAD_DIM = 128
N_MIX_HEADS = D_MODEL // HEAD_DIM
A_HEADS = N_MIX_HEADS // 2
LEFT_CHUNKS = 8
BAND = (LEFT_CHUNKS + 1) * CHUNK
REL_CLIP = 256
B_HEADS = N_MIX_HEADS // 2
MLA_Q_LORA = 1536
MLA_KV_LORA = 512
MLA_NOPE = 128
MLA_ROPE = 64
MLA_V = 128
C_HEADS = N_MIX_HEADS // 2
C_KV_HEADS = 4
IDX_HEADS = 32
IDX_HD = 64
DSA_TOPK_MAX = 256
D_HEADS = N_MIX_HEADS // 2
FOX_FORGET_BIAS = 2.0
MEM_TOKENS = 256
MEM_HEADS = 4
MEM_HD = 128
PEER_HEADS = 8
PEER_DKEY = 256
N_KEYS = 128
N_EXPERTS = N_KEYS * N_KEYS
PEER_TOPK = 16
PEER_BLOCK = 64
ROPE_THETA = 10000.0
LN_EPS = 1e-5
RMS_EPS = 1e-6
DEEPNORM_ALPHA = (2 * DEPTH) ** 0.25
DEEPNORM_BETA = (8 * DEPTH) ** -0.25
N_EVEN = (DEPTH + 1) // 2
N_ODD = DEPTH // 2

A_W = A_HEADS * HEAD_DIM
AB_SPLITS = [A_W, A_W, A_W, MLA_Q_LORA, MLA_KV_LORA, MLA_ROPE]
AB_IN_COLS = sum(AB_SPLITS)
AB_MIX = A_HEADS * HEAD_DIM + B_HEADS * MLA_V
C_QW = C_HEADS * HEAD_DIM
C_KW = C_KV_HEADS * HEAD_DIM
D_W = D_HEADS * HEAD_DIM
CD_SPLITS = [C_QW, C_KW, C_KW, IDX_HEADS * IDX_HD, IDX_HD, IDX_HEADS, D_W, D_W, D_W, D_HEADS]
CD_IN_COLS = sum(CD_SPLITS)
CD_MIX = C_QW + D_W
MEM_W = MEM_HEADS * MEM_HD

kernel_name = 'hybrid_chunk_streaming_encoder'


def split_cols(h, sizes):
    offs = [int(o) for o in np.cumsum(sizes)[:-1]]
    return jnp.split(h, offs, axis=-1)


def layer_norm(x, g, b):
    xf = x.astype(jnp.float32)
    xc = xf - jnp.mean(xf, -1, keepdims=True)
    var = jnp.mean(xc * xc, -1, keepdims=True)
    return (xc * lax.rsqrt(var + LN_EPS) * g + b).astype(x.dtype)


def rms_norm(x, g):
    xf = x.astype(jnp.float32)
    return (xf * lax.rsqrt(jnp.mean(xf * xf, -1, keepdims=True) + RMS_EPS) * g).astype(x.dtype)


def rope(x):
    S, dim = x.shape[1], x.shape[-1]
    half = dim // 2
    inv = ROPE_THETA ** (-jnp.arange(half, dtype=jnp.float32) * 2.0 / dim)
    ang = jnp.arange(S, dtype=jnp.float32)[:, None] * inv[None, :]
    cos = jnp.cos(ang)[None, :, None, :]
    sin = jnp.sin(ang)[None, :, None, :]
    xf = x.astype(jnp.float32)
    x1, x2 = xf[..., :half], xf[..., half:]
    return jnp.concatenate([x1 * cos - x2 * sin, x2 * cos + x1 * sin], -1).astype(x.dtype)


def swept_attention(q, k, v, frame_causal, log_decay_cum=None):
    B, S, H, dk = q.shape
    scale = dk ** -0.5
    kpos = jnp.arange(S)
    ct = None if log_decay_cum is None else jnp.swapaxes(log_decay_cum, 1, 2)

    def block(i):
        start = i * Q_BLOCK
        qb = lax.dynamic_slice_in_dim(q, start, Q_BLOCK, axis=1)
        qpos = start + jnp.arange(Q_BLOCK)
        s = jnp.einsum('bqhd,bkhd->bhqk', qb, k, preferred_element_type=jnp.float32) * scale
        if frame_causal:
            mask = kpos[None, :] <= qpos[:, None]
        else:
            mask = (kpos[None, :] // CHUNK) <= (qpos[:, None] // CHUNK)
        if ct is not None:
            cq = lax.dynamic_slice_in_dim(ct, start, Q_BLOCK, axis=2)
            s = s + cq[..., :, None] - ct[:, :, None, :]
        p = jax.nn.softmax(jnp.where(mask, s, -jnp.inf), axis=-1)
        return jnp.einsum('bhqk,bkhd->bqhd', p.astype(v.dtype), v)

    out = lax.map(block, jnp.arange(S // Q_BLOCK))
    return jnp.swapaxes(out, 0, 1).reshape(B, S, H, v.shape[-1])


def chunk_band_attention(q, k, v, rel_bias):
    B, S, H, d = q.shape
    pad = LEFT_CHUNKS * CHUNK
    kp = jnp.pad(k, ((0, 0), (pad, 0), (0, 0), (0, 0)))
    vp = jnp.pad(v, ((0, 0), (pad, 0), (0, 0), (0, 0)))
    rel = jnp.arange(CHUNK)[:, None] + pad - jnp.arange(BAND)[None, :]
    bias = rel_bias[:, jnp.clip(rel, -REL_CLIP, REL_CLIP) + REL_CLIP].astype(jnp.float32)
    scale = d ** -0.5

    def block(c):
        qb = lax.dynamic_slice_in_dim(q, c * CHUNK, CHUNK, axis=1)
        kb = lax.dynamic_slice_in_dim(kp, c * CHUNK, BAND, axis=1)
        vb = lax.dynamic_slice_in_dim(vp, c * CHUNK, BAND, axis=1)
        s = jnp.einsum('bqhd,bkhd->bhqk', qb, kb, preferred_element_type=jnp.float32) * scale + bias
        valid = (c * CHUNK - pad + jnp.arange(BAND)) >= 0
        p = jax.nn.softmax(jnp.where(valid, s, -jnp.inf), axis=-1)
        return jnp.einsum('bhqk,bkhd->bqhd', p.astype(vb.dtype), vb)

    out = lax.map(block, jnp.arange(S // CHUNK))
    return jnp.swapaxes(out, 0, 1).reshape(B, S, H, d)


def dsa_attention(q, k, v, qi, ki, wi):
    B, S, H, d = q.shape
    G = k.shape[2]
    R = H // G
    topk = min(DSA_TOPK_MAX, S // 4)
    scale = d ** -0.5
    kchunk = jnp.arange(S) // CHUNK
    wi = wi.astype(jnp.float32) * IDX_HEADS ** -0.5
    gather = jax.vmap(lambda t, ii: t[ii])

    def block(i):
        start = i * Q_BLOCK
        qb = lax.dynamic_slice_in_dim(q, start, Q_BLOCK, axis=1)
        qib = lax.dynamic_slice_in_dim(qi, start, Q_BLOCK, axis=1)
        wib = lax.dynamic_slice_in_dim(wi, start, Q_BLOCK, axis=1)
        qchunk = (start + jnp.arange(Q_BLOCK)) // CHUNK
        idx_logit = jnp.einsum('bqhd,bkd->bqhk', qib, ki, preferred_element_type=jnp.float32) * IDX_HD ** -0.5
        score = jnp.einsum('bqh,bqhk->bqk', wib, jax.nn.relu(idx_logit))
        admissible = kchunk[None, :] <= qchunk[:, None]
        _, sel = lax.top_k(jnp.where(admissible, score, -jnp.inf), topk)
        sel_ok = kchunk[sel] <= qchunk[None, :, None]
        k_sel = gather(k, sel)
        v_sel = gather(v, sel)
        s = jnp.einsum('bqgrd,bqkgd->bqgrk', qb.reshape(B, Q_BLOCK, G, R, d), k_sel,
                       preferred_element_type=jnp.float32) * scale
        p = jax.nn.softmax(jnp.where(sel_ok[:, :, None, None, :], s, -jnp.inf), axis=-1)
        o = jnp.einsum('bqgrk,bqkgd->bqgrd', p.astype(v.dtype), v_sel)
        return o.reshape(B, Q_BLOCK, H, d)

    out = lax.map(block, jnp.arange(S // Q_BLOCK))
    return jnp.swapaxes(out, 0, 1).reshape(B, S, H, d)


def mixer_ab(x, w_in, rel_bias, q_norm, w_uq, kv_norm, w_ukv, w_out):
    B, S, _ = x.shape
    qa, ka, va, cq, ckv, kr = split_cols(x @ w_in, AB_SPLITS)
    oa = chunk_band_attention(qa.reshape(B, S, A_HEADS, HEAD_DIM), ka.reshape(B, S, A_HEADS, HEAD_DIM),
                              va.reshape(B, S, A_HEADS, HEAD_DIM), rel_bias)
    qb = (rms_norm(cq, q_norm) @ w_uq).reshape(B, S, B_HEADS, MLA_NOPE + MLA_ROPE)
    qb = jnp.concatenate([qb[..., :MLA_NOPE], rope(qb[..., MLA_NOPE:])], -1)
    kv = (rms_norm(ckv, kv_norm) @ w_ukv).reshape(B, S, B_HEADS, MLA_NOPE + MLA_V)
    k_rope = jnp.broadcast_to(rope(kr[:, :, None, :]), (B, S, B_HEADS, MLA_ROPE))
    kb = jnp.concatenate([kv[..., :MLA_NOPE], k_rope], -1)
    ob = swept_attention(qb, kb, kv[..., MLA_NOPE:], frame_causal=False)
    o = jnp.concatenate([oa.reshape(B, S, -1), ob.reshape(B, S, -1)], -1)
    return o @ w_out


def mixer_cd(x, w_in, forget_bias, w_out):
    B, S, _ = x.shape
    qc, kc, vc, qi, ki, wi, qd, kd, vd, fd = split_cols(x @ w_in, CD_SPLITS)
    oc = dsa_attention(rope(qc.reshape(B, S, C_HEADS, HEAD_DIM)),
                       rope(kc.reshape(B, S, C_KV_HEADS, HEAD_DIM)),
                       vc.reshape(B, S, C_KV_HEADS, HEAD_DIM),
                       rope(qi.reshape(B, S, IDX_HEADS, IDX_HD)),
                       rope(ki[:, :, None, :])[:, :, 0, :],
                       wi)
    log_f = jax.nn.log_sigmoid(fd.astype(jnp.float32) + forget_bias.astype(jnp.float32))
    cum = lax.cumsum(log_f, axis=1)
    od = swept_attention(qd.reshape(B, S, D_HEADS, HEAD_DIM), kd.reshape(B, S, D_HEADS, HEAD_DIM),
                         vd.reshape(B, S, D_HEADS, HEAD_DIM), frame_causal=True, log_decay_cum=cum)
    o = jnp.concatenate([oc.reshape(B, S, -1), od.reshape(B, S, -1)], -1)
    return o @ w_out


def memory_cross_attention(x, mem, w_q, w_kv, w_o):
    B, S, _ = x.shape
    M = mem.shape[1]
    q = (x @ w_q).reshape(B, S, MEM_HEADS, MEM_HD)
    kv = (mem @ w_kv).reshape(B, M, 2, MEM_HEADS, MEM_HD)
    s = jnp.einsum('bshd,bmhd->bhsm', q, kv[:, :, 0], preferred_element_type=jnp.float32) * MEM_HD ** -0.5
    p = jax.nn.softmax(s, axis=-1)
    o = jnp.einsum('bhsm,bmhd->bshd', p.astype(kv.dtype), kv[:, :, 1])
    return o.reshape(B, S, MEM_W) @ w_o


def peer_ffn(x, w_q, sub_keys, u_tab, v_tab):
    B, S, D = x.shape
    q = (x @ w_q).reshape(B, S, PEER_HEADS, 2, PEER_DKEY // 2)
    s = jnp.einsum('bshpd,hpnd->bshpn', q, sub_keys, preferred_element_type=jnp.float32)
    top_s, top_i = lax.top_k(s, PEER_TOPK)
    cand_s = (top_s[..., 0, :, None] + top_s[..., 1, None, :]).reshape(B, S, PEER_HEADS, PEER_TOPK * PEER_TOPK)
    cand_i = (top_i[..., 0, :, None] * N_KEYS + top_i[..., 1, None, :]).reshape(B, S, PEER_HEADS, PEER_TOPK * PEER_TOPK)
    best_s, best_j = lax.top_k(cand_s, PEER_TOPK)
    idx = jnp.take_along_axis(cand_i, best_j, axis=-1)
    gate = jax.nn.softmax(best_s, axis=-1)
    nb = (B * S) // PEER_BLOCK
    hk = PEER_HEADS * PEER_TOPK
    xs = (x.reshape(nb, PEER_BLOCK, D), idx.reshape(nb, PEER_BLOCK, hk), gate.reshape(nb, PEER_BLOCK, hk))

    def block(args):
        xb, ib, gb = args
        act = jax.nn.gelu(jnp.einsum('tkd,td->tk', u_tab[ib], xb, preferred_element_type=jnp.float32),
                          approximate=False)
        return jnp.einsum('tk,tkd->td', (gb * act).astype(v_tab.dtype), v_tab[ib])

    return lax.map(block, xs).reshape(B, S, D)


def setup_inputs(seed: int = 0) -> dict:
    key = jax.random.key(seed)
    ks = iter(jax.random.split(key, 24))

    def nrm(shape, scale):
        return jax.random.normal(next(ks), shape, jnp.float32) * scale

    L = DEPTH
    return {
        'x': nrm((BATCH, SEQ, D_MODEL), 1.0),
        'mem': nrm((BATCH, MEM_TOKENS, D_MODEL), 1.0),
        'ab_w_in': nrm((N_EVEN, D_MODEL, AB_IN_COLS), D_MODEL ** -0.5),
        'a_rel_bias': nrm((N_EVEN, A_HEADS, 2 * REL_CLIP + 1), 0.5),
        'b_q_norm': 1.0 + nrm((N_EVEN, MLA_Q_LORA), 0.02),
        'b_w_uq': nrm((N_EVEN, MLA_Q_LORA, B_HEADS * (MLA_NOPE + MLA_ROPE)), MLA_Q_LORA ** -0.5),
        'b_kv_norm': 1.0 + nrm((N_EVEN, MLA_KV_LORA), 0.02),
        'b_w_ukv': nrm((N_EVEN, MLA_KV_LORA, B_HEADS * (MLA_NOPE + MLA_V)), MLA_KV_LORA ** -0.5),
        'ab_w_out': nrm((N_EVEN, AB_MIX, D_MODEL), AB_MIX ** -0.5 * DEEPNORM_BETA),
        'cd_w_in': nrm((N_ODD, D_MODEL, CD_IN_COLS), D_MODEL ** -0.5),
        'd_forget_bias': FOX_FORGET_BIAS + nrm((N_ODD, D_HEADS), 0.1),
        'cd_w_out': nrm((N_ODD, CD_MIX, D_MODEL), CD_MIX ** -0.5 * DEEPNORM_BETA),
        'mem_w_q': nrm((L, D_MODEL, MEM_W), D_MODEL ** -0.5),
        'mem_w_kv': nrm((L, D_MODEL, 2 * MEM_W), D_MODEL ** -0.5),
        'mem_w_o': nrm((L, MEM_W, D_MODEL), MEM_W ** -0.5 * DEEPNORM_BETA),
        'peer_w_q': nrm((L, D_MODEL, PEER_HEADS * PEER_DKEY), D_MODEL ** -0.5),
        'peer_sub_keys': nrm((L, PEER_HEADS, 2, N_KEYS, PEER_DKEY // 2), (PEER_DKEY // 2) ** -0.5),
        'peer_u': nrm((L, N_EXPERTS, D_MODEL), D_MODEL ** -0.5),
        'peer_v': nrm((L, N_EXPERTS, D_MODEL), DEEPNORM_BETA * PEER_HEADS ** -0.5),
        'ln_g': 1.0 + nrm((L, 3, D_MODEL), 0.02),
        'ln_b': nrm((L, 3, D_MODEL), 0.02),
    }


def reference(x, mem, ab_w_in, a_rel_bias, b_q_norm, b_w_uq, b_kv_norm, b_w_ukv, ab_w_out,
              cd_w_in, d_forget_bias, cd_w_out, mem_w_q, mem_w_kv, mem_w_o,
              peer_w_q, peer_sub_keys, peer_u, peer_v, ln_g, ln_b):
    h = x
    for layer in range(DEPTH):
        j = layer // 2
        if layer % 2 == 0:
            y = mixer_ab(h, ab_w_in[j], a_rel_bias[j], b_q_norm[j], b_w_uq[j], b_kv_norm[j], b_w_ukv[j], ab_w_out[j])
        else:
            y = mixer_cd(h, cd_w_in[j], d_forget_bias[j], cd_w_out[j])
        h = layer_norm(DEEPNORM_ALPHA * h + y, ln_g[layer, 0], ln_b[layer, 0])
        y = memory_cross_attention(h, mem, mem_w_q[layer], mem_w_kv[layer], mem_w_o[layer])
        h = layer_norm(DEEPNORM_ALPHA * h + y, ln_g[layer, 1], ln_b[layer, 1])
        y = peer_ffn(h, peer_w_q[layer], peer_sub_keys[layer], peer_u[layer], peer_v[layer])
        h = layer_norm(DEEPNORM_ALPHA * h + y, ln_g[layer, 2], ln_b[layer, 2])
    return h
```

```cpp
#include <hip/hip_runtime.h>
#include <cstdio>
#include <cstdint>

#define GAS __attribute__((address_space(1)))
#define LAS __attribute__((address_space(3)))
typedef unsigned short bf16_t;
typedef short bf16x8 __attribute__((ext_vector_type(8)));
typedef float f32x4 __attribute__((ext_vector_type(4)));
typedef float f32x16 __attribute__((ext_vector_type(16)));
typedef unsigned u32x4 __attribute__((ext_vector_type(4)));
typedef unsigned u32x2 __attribute__((ext_vector_type(2)));

#ifndef MK_PER_PHASE
#define MK_PER_PHASE 0
#endif

constexpr int NB = 2, SEQ = 4096, T = NB * SEQ, DM = 4096;
constexpr int AB_COLS = 8256, AB_MAIN = 8192, AB_PAD = 8448;
constexpr int CD_COLS = 11376, CD_MAIN = 11264, CD_PAD = 11520;
constexpr float ALPHA = 1.4142135623730951f;
constexpr float LN_EPS = 1e-5f, RMS_EPS = 1e-6f;
constexpr int NPHASE = 29;

constexpr size_t MiB = 1ull << 20;
constexpr size_t WS_CTL = 0, CTL_BYTES = 1 * MiB;
constexpr size_t WS_ROPE128 = 1 * MiB;
constexpr size_t WS_ROPE64 = 3 * MiB;
constexpr size_t WS_RSQ = 4 * MiB;
constexpr size_t WS_RSKV = 4 * MiB + 65536;
constexpr size_t WS_CUM = 5 * MiB;
constexpr size_t WS_LOGF = 5 * MiB + 524288;
constexpr size_t WS_KR = 6 * MiB;
constexpr size_t WS_KI = 7 * MiB;
constexpr size_t WS_WI = 8 * MiB;
constexpr size_t WS_KVM = 9 * MiB;
constexpr size_t WS_MEMB = 11 * MiB;
constexpr size_t WS_MASK = 15 * MiB;
constexpr size_t WS_PIDX = 19 * MiB;
constexpr size_t WS_PGATE = 23 * MiB;
constexpr size_t WS_MEMQ = 27 * MiB;
constexpr size_t WS_MEMO = 35 * MiB;
constexpr size_t WS_SMALL = 43 * MiB;
constexpr size_t WS_W_AB_IN = 64 * MiB;
constexpr size_t WS_W_UQ = 130 * MiB;
constexpr size_t WS_W_UKV = 139 * MiB;
constexpr size_t WS_W_AB_OUT = 143 * MiB;
constexpr size_t WS_W_CD_IN = 175 * MiB;
constexpr size_t WS_W_CD_OUT = 265 * MiB;
constexpr size_t WS_W_MEM_Q = 297 * MiB;
constexpr size_t WS_W_MEM_KV = 305 * MiB;
constexpr size_t WS_W_MEM_O = 321 * MiB;
constexpr size_t WS_W_PEER = 329 * MiB;
constexpr size_t WS_U16 = 361 * MiB;
constexpr size_t WS_V16 = 617 * MiB;
constexpr size_t WS_XB = 873 * MiB;
constexpr size_t WS_HF = 937 * MiB;
constexpr size_t WS_RES = 1065 * MiB;
constexpr size_t WS_PROJ = 1193 * MiB;
constexpr size_t WS_PSCORE = WS_PROJ;
constexpr size_t WS_ATT = 1369 * MiB;
constexpr size_t WS_QB = 1433 * MiB;
constexpr size_t WS_KVB = 1481 * MiB;
constexpr size_t WS_SCORE = 1433 * MiB;
constexpr size_t WS_END = 1561 * MiB;

constexpr int LDS_BYTES = 147456;
constexpr int LDS_MISC = 140 * 1024;

#define LDS_WAIT() asm volatile("s_waitcnt lgkmcnt(0)" ::: "memory")
__device__ __forceinline__ float bf2f(bf16_t b) { return __uint_as_float(((unsigned)b) << 16); }
__device__ __forceinline__ unsigned f2bf(float f) { unsigned u = __float_as_uint(f); return (u + 0x7fffu + ((u >> 16) & 1u)) >> 16; }
__device__ __forceinline__ unsigned pk2(float lo, float hi) { return f2bf(lo) | (f2bf(hi) << 16); }
__device__ __forceinline__ float wave_sum(float v) {
#pragma unroll
    for (int o = 1; o < 64; o <<= 1) v += __shfl_xor(v, o);
    return v;
}
__device__ __forceinline__ float wave_max(float v) {
#pragma unroll
    for (int o = 1; o < 64; o <<= 1) v = fmaxf(v, __shfl_xor(v, o));
    return v;
}
__device__ __forceinline__ int wave_sum_i(int v) {
#pragma unroll
    for (int o = 1; o < 64; o <<= 1) v += __shfl_xor(v, o);
    return v;
}

#define XB_TMO      128
#define XB_XCNT(j)  (256  + 64 * (j))
#define XB_XSUB(j)  (1280 + 64 * (j))
#define XB_XGEN(j)  (2304 + 64 * (j))
#define XB_TOP      3328
#define XB_TOPGEN   3392
#define XCD_BAR_WORDS 3456
#define XB_SPIN_CAP (1u << 22)

__device__ __forceinline__ unsigned xb_ld(unsigned* p)              { return __hip_atomic_load(p, __ATOMIC_RELAXED, __HIP_MEMORY_SCOPE_AGENT); }
__device__ __forceinline__ unsigned xb_add(unsigned* p, unsigned v) { return __hip_atomic_fetch_add(p, v, __ATOMIC_RELAXED, __HIP_MEMORY_SCOPE_AGENT); }
__device__ __forceinline__ unsigned xb_xcc_id() { return (unsigned)__builtin_amdgcn_s_getreg((3 << 11) | 20) & 0xFu; }
#define XB_SPIN(cond, bar) do { unsigned _sp = 0; while (cond) { __builtin_amdgcn_s_sleep(1); \
    if ((++_sp & 255u) == 0u) { if (xb_ld(&(bar)[XB_TMO])) break; if (_sp > XB_SPIN_CAP) { atomicAdd(&(bar)[XB_TMO], 1u); break; } } } } while (0)

struct XcdBarrier { unsigned* bar; unsigned x; volatile LAS unsigned* st; };

__device__ __forceinline__ XcdBarrier xcd_barrier_post(unsigned* bar, volatile LAS unsigned* st) {
    XcdBarrier b; b.bar = bar; b.x = xb_xcc_id(); b.st = st;
    if (threadIdx.x == 0) (void)xb_add(&bar[XB_XCNT(b.x)], 1u);
    return b;
}
__device__ __forceinline__ void xcd_barrier_complete(unsigned* bar, unsigned x, unsigned& nloc, unsigned& nx) {
    const unsigned G = gridDim.x * gridDim.y * gridDim.z;
    unsigned sum, cnt, mine, sp = 0u;
    for (;;) {
        sum = 0u; cnt = 0u; mine = 0u;
#pragma unroll
        for (unsigned j = 0; j < 16; ++j) { const unsigned c = xb_ld(&bar[XB_XCNT(j)]); sum += c; cnt += (c > 0u) ? 1u : 0u; mine = (j == x) ? c : mine; }
        if (sum == G) break;
        __builtin_amdgcn_s_sleep(1);
        if ((++sp & 255u) == 0u) { if (xb_ld(&bar[XB_TMO])) break; if (sp > XB_SPIN_CAP) { atomicAdd(&bar[XB_TMO], 1u); break; } }
    }
    nloc = mine > 0u ? mine : 1u; nx = cnt > 0u ? cnt : 1u;
}
__device__ __forceinline__ void xcd_barrier(const XcdBarrier& b) {
    asm volatile("s_waitcnt vmcnt(0)" ::: "memory");
    __syncthreads();
    if (threadIdx.x == 0) {
        unsigned* bar = b.bar;
        __builtin_amdgcn_s_waitcnt(0);
        unsigned nloc = b.st[0], nx = b.st[1];
        if (nloc == 0u) { xcd_barrier_complete(bar, b.x, nloc, nx); b.st[0] = nloc; b.st[1] = nx; }
        const unsigned old = xb_add(&bar[XB_XSUB(b.x)], 1u);
        const unsigned gen = old / nloc;
        if (old + 1u == (gen + 1u) * nloc) {
            __builtin_amdgcn_fence(__ATOMIC_RELEASE, "agent");
            asm volatile("s_waitcnt vmcnt(0)" ::: "memory");
            const unsigned og = xb_add(&bar[XB_TOP], 1u);
            const unsigned tg = og / nx;
            if (og + 1u == (tg + 1u) * nx) xb_add(&bar[XB_TOPGEN], 1u);
            else XB_SPIN(xb_ld(&bar[XB_TOPGEN]) == tg, bar);
            __builtin_amdgcn_fence(__ATOMIC_ACQUIRE, "agent");
            xb_add(&bar[XB_XGEN(b.x)], 1u);
            asm volatile("s_waitcnt vmcnt(0)" ::: "memory");
        } else {
            XB_SPIN(xb_ld(&bar[XB_XGEN(b.x)]) == gen, bar);
            __builtin_amdgcn_fence(__ATOMIC_ACQUIRE, "agent");
            asm volatile("s_waitcnt vmcnt(0)" ::: "memory");
        }
    }
    __syncthreads();
}

struct Args { const float* in[21]; float* out; unsigned char* ws; int ph_lo, ph_hi; };
enum { I_X = 0, I_MEM, I_AB_W_IN, I_A_REL_BIAS, I_B_Q_NORM, I_B_W_UQ, I_B_KV_NORM, I_B_W_UKV, I_AB_W_OUT, I_CD_W_IN, I_D_FORGET_BIAS, I_CD_W_OUT,
       I_MEM_W_Q, I_MEM_W_KV, I_MEM_W_O, I_PEER_W_Q, I_PEER_SUB_KEYS, I_PEER_U, I_PEER_V, I_LN_G, I_LN_B };

struct WI { int tid, lane, wave, gw, ngw, bid, nblk; };

__device__ __forceinline__ void tr_item(const float* W, int K, int ld, int c0, int nc, bf16_t* WT, int r0, const float* scale, LAS float* scr, int item, int lane) {
    const int nblk = (nc + 31) >> 5, kb = item / nblk, nb = item - kb * nblk, k0 = 64 * kb, n0 = 32 * nb;
    const int nn = n0 + (lane & 31); const bool ok = nn < nc;
#pragma unroll 8
    for (int i = 0; i < 32; ++i) { const int kk = 2 * i + (lane >> 5); float v = ok ? W[(size_t)(k0 + kk) * ld + c0 + nn] : 0.f; if (scale) v *= scale[k0 + kk]; scr[kk * 33 + (lane & 31)] = v; }
    LDS_WAIT();
    const int c = lane & 7;
#pragma unroll
    for (int j = 0; j < 4; ++j) { const int n = (lane >> 3) + 8 * j; const LAS float* s = scr + (8 * c) * 33 + n;
        u32x4 o; o.x = pk2(s[0 * 33], s[1 * 33]); o.y = pk2(s[2 * 33], s[3 * 33]); o.z = pk2(s[4 * 33], s[5 * 33]); o.w = pk2(s[6 * 33], s[7 * 33]);
        if (n0 + n < nc) *(u32x4*)(WT + (size_t)(r0 + n0 + n) * K + k0 + 8 * c) = o; }
    LDS_WAIT();
}
__device__ __forceinline__ void cvt_rows(const float* src, bf16_t* dst, size_t n, size_t i0, size_t stride) {
    for (size_t i = i0 * 8; i < n; i += stride * 8) {
        const f32x4 a = *(const f32x4*)(src + i), b = *(const f32x4*)(src + i + 4);
        u32x4 o; o.x = pk2(a.x, a.y); o.y = pk2(a.z, a.w); o.z = pk2(b.x, b.y); o.w = pk2(b.z, b.w);
        *(u32x4*)(dst + i) = o;
    }
}
__device__ __forceinline__ void ph_convert(const Args& a, LAS unsigned char* lds, const WI& w) {
    unsigned char* ws = a.ws;
    LAS float* scr = (LAS float*)(lds + w.wave * 16384);
    constexpr int J1 = 64 * 258, J2 = 24 * 96, J3 = 8 * 128, J4 = 64 * 128, J5 = 64 * 160, J6 = 64 * 192, J7 = 64 * 3, J8 = 64 * 1, J9 = 64 * 128,
                  J10 = 64 * 16, J12 = 64 * 32, J14 = 8 * 128;
    constexpr int NJ = J1 + J2 + J3 + J4 + J5 + J6 + J7 + J8 + J9 + 2 * J10 + 2 * J12 + 2 * J14;
    for (int it = w.gw; it < NJ; it += w.ngw) {
        int r = it; const float* src; int K, ld, c0 = 0, nc, r0 = 0; bf16_t* dst; const float* sc = nullptr;
        if (r < J1) { src = a.in[I_AB_W_IN]; K = 4096; ld = AB_COLS; nc = AB_COLS; dst = (bf16_t*)(ws + WS_W_AB_IN); }
        else if ((r -= J1) < J2) { src = a.in[I_B_W_UQ]; K = 1536; ld = 3072; nc = 3072; dst = (bf16_t*)(ws + WS_W_UQ); sc = a.in[I_B_Q_NORM]; }
        else if ((r -= J2) < J3) { src = a.in[I_B_W_UKV]; K = 512; ld = 4096; nc = 4096; dst = (bf16_t*)(ws + WS_W_UKV); sc = a.in[I_B_KV_NORM]; }
        else if ((r -= J3) < J4) { src = a.in[I_AB_W_OUT]; K = 4096; ld = 4096; nc = 4096; dst = (bf16_t*)(ws + WS_W_AB_OUT); }
        else if ((r -= J4) < J5) { src = a.in[I_CD_W_IN]; K = 4096; ld = CD_COLS; c0 = 0; nc = 5120; r0 = 0; dst = (bf16_t*)(ws + WS_W_CD_IN); }
        else if ((r -= J5) < J6) { src = a.in[I_CD_W_IN]; K = 4096; ld = CD_COLS; c0 = 5216; nc = 6144; r0 = 5120; dst = (bf16_t*)(ws + WS_W_CD_IN); }
        else if ((r -= J6) < J7) { src = a.in[I_CD_W_IN]; K = 4096; ld = CD_COLS; c0 = 5120; nc = 96; r0 = 11264; dst = (bf16_t*)(ws + WS_W_CD_IN); }
        else if ((r -= J7) < J8) { src = a.in[I_CD_W_IN]; K = 4096; ld = CD_COLS; c0 = 11360; nc = 16; r0 = 11360; dst = (bf16_t*)(ws + WS_W_CD_IN); }
        else if ((r -= J8) < J9) { src = a.in[I_CD_W_OUT]; K = 4096; ld = 4096; nc = 4096; dst = (bf16_t*)(ws + WS_W_CD_OUT); }
        else if ((r -= J9) < 2 * J10) { const int l = r / J10; r -= l * J10; src = a.in[I_MEM_W_Q] + (size_t)l * 4096 * 512; K = 4096; ld = 512; nc = 512; dst = (bf16_t*)(ws + WS_W_MEM_Q) + (size_t)l * 512 * 4096; }
        else if ((r -= 2 * J10) < 2 * J12) { const int l = r / J12; r -= l * J12; src = a.in[I_MEM_W_KV] + (size_t)l * 4096 * 1024; K = 4096; ld = 1024; nc = 1024; dst = (bf16_t*)(ws + WS_W_MEM_KV) + (size_t)l * 1024 * 4096; }
        else { r -= 2 * J12; const int l = r / J14; r -= l * J14; src = a.in[I_MEM_W_O] + (size_t)l * 512 * 4096; K = 512; ld = 4096; nc = 4096; dst = (bf16_t*)(ws + WS_W_MEM_O) + (size_t)l * 4096 * 512; }
        tr_item(src, K, ld, c0, nc, dst, r0, sc, scr, r, w.lane);
    }
    { const size_t gt = (size_t)w.gw * 64 + w.lane, ng = (size_t)w.ngw * 64;
      bf16_t* p1 = (bf16_t*)(ws + WS_W_AB_IN) + (size_t)AB_COLS * 4096; const size_t n1 = (size_t)(AB_PAD - AB_COLS) * 4096;
      for (size_t i = gt * 8; i < n1; i += ng * 8) *(u32x4*)(p1 + i) = (u32x4){0u, 0u, 0u, 0u};
      bf16_t* p2 = (bf16_t*)(ws + WS_W_CD_IN) + (size_t)CD_COLS * 4096; const size_t n2 = (size_t)(CD_PAD - CD_COLS) * 4096;
      for (size_t i = gt * 8; i < n2; i += ng * 8) *(u32x4*)(p2 + i) = (u32x4){0u, 0u, 0u, 0u};
      cvt_rows(a.in[I_X], (bf16_t*)(ws + WS_XB), (size_t)T * DM, gt, ng);
      cvt_rows(a.in[I_MEM], (bf16_t*)(ws + WS_MEMB), (size_t)512 * DM, gt, ng);
      cvt_rows(a.in[I_PEER_U], (bf16_t*)(ws + WS_U16), (size_t)2 * 16384 * DM, gt, ng);
      cvt_rows(a.in[I_PEER_V], (bf16_t*)(ws + WS_V16), (size_t)2 * 16384 * DM, gt, ng);
      float* r128 = (float*)(ws + WS_ROPE128); float* r64 = (float*)(ws + WS_ROPE64);
      for (size_t i = gt; i < (size_t)SEQ * 96; i += ng) {
          const int s = (int)(i / 96), j = (int)(i % 96); const bool big = j < 64; const int ii = big ? j : j - 64;
          const double rr = big ? 0.8659643233600653 : 0.7498942093324559; double inv = 1.0;
          for (int q = 0; q < ii; ++q) inv *= rr;
          const double rev = (double)s * inv * 0.15915494309189535; const float fr = (float)(rev - rint(rev));
          const float cs = __builtin_amdgcn_cosf(fr), sn = __builtin_amdgcn_sinf(fr);
          float* o = big ? (r128 + ((size_t)s * 64 + ii) * 2) : (r64 + ((size_t)s * 32 + ii) * 2);
          o[0] = cs; o[1] = sn; }
    }
    {
        LAS float* Ks = (LAS float*)lds; LAS float* Ws = Ks + 128 * 129;
        const int tk = w.tid & 31, tn = w.tid >> 5;
        for (int it = w.bid; it < 2 * 16 * 32; it += w.nblk) {
            const int l = it >> 9, hp = (it >> 5) & 15, kb = it & 31;
            __syncthreads();
            const float* keys = a.in[I_PEER_SUB_KEYS] + ((size_t)(l * 16 + hp) * 128) * 128;
            const float* wq = a.in[I_PEER_W_Q] + ((size_t)l * 4096 + (size_t)kb * 128) * 2048 + hp * 128;
            for (int e = w.tid; e < 128 * 128; e += 512) { const int rrow = e >> 7, d = e & 127; Ks[rrow * 129 + d] = keys[(size_t)rrow * 128 + d]; Ws[rrow * 129 + d] = wq[(size_t)rrow * 2048 + d]; }
            __syncthreads();
            float acc[8][4];
#pragma unroll
            for (int x = 0; x < 8; ++x)
#pragma unroll
                for (int y = 0; y < 4; ++y) acc[x][y] = 0.f;
            for (int d = 0; d < 128; ++d) {
                float kv[8], wv[4];
#pragma unroll
                for (int x = 0; x < 8; ++x) kv[x] = Ks[(tn + 16 * x) * 129 + d];
#pragma unroll
                for (int y = 0; y < 4; ++y) wv[y] = Ws[(tk + 32 * y) * 129 + d];
#pragma unroll
                for (int x = 0; x < 8; ++x)
#pragma unroll
                    for (int y = 0; y < 4; ++y) acc[x][y] += kv[x] * wv[y];
            }
            bf16_t* dst = (bf16_t*)(ws + WS_W_PEER) + ((size_t)l * 2048 + hp * 128) * 4096 + kb * 128;
#pragma unroll
            for (int x = 0; x < 8; ++x)
#pragma unroll
                for (int y = 0; y < 4; ++y) dst[(size_t)(tn + 16 * x) * 4096 + tk + 32 * y] = (bf16_t)f2bf(acc[x][y]);
        }
        __syncthreads();
    }
}

__device__ __forceinline__ int crow(int r, int hi) { return (r & 3) + 8 * (r >> 2) + 4 * hi; }
template <class F>
__device__ __forceinline__ void naive_gemm(const bf16_t* A, int lda, const bf16_t* Bt, int ldb, int M, int N, int K, const WI& w, F epi) {
    const int tm = M >> 5, tn = (N + 31) >> 5;
    const int i = w.lane & 31, g = w.lane >> 5;
    for (int tile = w.gw; tile < tm * tn; tile += w.ngw) {
        const int bn = tile / tm, bm = tile - bn * tm;
        const bf16_t* ap = A + (size_t)(bm * 32 + i) * lda + 8 * g;
        const int nrow = bn * 32 + i; const bool nv = nrow < N;
        const bf16_t* bp = Bt + (size_t)(nv ? nrow : 0) * ldb + 8 * g;
        f32x16 acc = {};
#pragma unroll 4
        for (int k = 0; k < K; k += 16) {
            const bf16x8 av = *(const bf16x8*)(ap + k);
            bf16x8 bv = *(const bf16x8*)(bp + k);
            if (!nv) bv = (bf16x8){0, 0, 0, 0, 0, 0, 0, 0};
            acc = __builtin_amdgcn_mfma_f32_32x32x16_bf16(av, bv, acc, 0, 0, 0);
        }
#pragma unroll
        for (int r = 0; r < 16; ++r) { const int row = bm * 32 + crow(r, g), col = bn * 32 + i; if (col < N) epi(row, col, acc[r]); }
    }
}

__device__ __forceinline__ void ln_rows(const float* src, const float* g, const float* b, float* dstf, bf16_t* dstb, const WI& w) {
    for (int m = w.gw; m < T; m += w.ngw) {
        const f32x4* xr = (const f32x4*)(src + (size_t)m * DM) + w.lane;
        f32x4 v[16]; float s = 0.f;
#pragma unroll
        for (int j = 0; j < 16; ++j) { v[j] = xr[64 * j]; s += (v[j].x + v[j].y) + (v[j].z + v[j].w); }
        const float mean = wave_sum(s) * (1.f / DM); float s2 = 0.f;
#pragma unroll
        for (int j = 0; j < 16; ++j) { v[j] = v[j] - mean; s2 += (v[j].x * v[j].x + v[j].y * v[j].y) + (v[j].z * v[j].z + v[j].w * v[j].w); }
        const float rstd = 1.f / sqrtf(wave_sum(s2) * (1.f / DM) + LN_EPS);
#pragma unroll
        for (int j = 0; j < 16; ++j) {
            const int c = 4 * w.lane + 256 * j;
            const f32x4 gg = *(const f32x4*)(g + c), bb = *(const f32x4*)(b + c);
            const f32x4 o = v[j] * rstd * gg + bb;
            *(f32x4*)(dstf + (size_t)m * DM + c) = o;
            if (dstb) { u32x2 p; p.x = pk2(o.x, o.y); p.y = pk2(o.z, o.w); *(u32x2*)(dstb + (size_t)m * DM + c) = p; }
        }
    }
}

template <int MODE>
__device__ __forceinline__ void attn_naive(const Args& a, int layer, LAS float* qs, const WI& w) {
    constexpr int H = (MODE == 4) ? 4 : 16, DK = (MODE == 1) ? 192 : 128;
    const float scale = (MODE == 1) ? 0.07216878364870322f : 0.08838834764831845f;
    unsigned char* ws = a.ws;
    const float NEG = -__builtin_inff();
    for (int it = w.gw; it < T * H; it += w.ngw) {
        const int h = it / T, t = it - h * T, b = t / SEQ, sp = t - b * SEQ, c = sp >> 6;
        const bf16_t* qp; const bf16_t* kbase; const bf16_t* vbase; int ldk, ldv; bf16_t* op;
        int s_lo = 0, s_hi;
        if (MODE == 0) { const bf16_t* P = (const bf16_t*)(ws + WS_PROJ); qp = P + (size_t)t * AB_MAIN + h * 128; kbase = P + (size_t)b * SEQ * AB_MAIN + 2048 + h * 128; vbase = kbase + 2048; ldk = ldv = AB_MAIN;
            op = (bf16_t*)(ws + WS_ATT) + (size_t)t * DM + h * 128; s_lo = (c - 8) * 64; if (s_lo < 0) s_lo = 0; s_hi = (c + 1) * 64; }
        else if (MODE == 1) { qp = (const bf16_t*)(ws + WS_QB) + (size_t)t * 3072 + h * 192; kbase = (const bf16_t*)(ws + WS_KVB) + (size_t)b * SEQ * 4096 + h * 256; vbase = kbase + 128; ldk = ldv = 4096;
            op = (bf16_t*)(ws + WS_ATT) + (size_t)t * DM + 2048 + h * 128; s_hi = (c + 1) * 64; }
        else if (MODE == 2) { const bf16_t* P = (const bf16_t*)(ws + WS_PROJ); qp = P + (size_t)t * CD_MAIN + h * 128; kbase = P + (size_t)b * SEQ * CD_MAIN + 2048 + (h >> 2) * 128; vbase = kbase + 512; ldk = ldv = CD_MAIN;
            op = (bf16_t*)(ws + WS_ATT) + (size_t)t * DM + h * 128; s_hi = (c + 1) * 64; }
        else if (MODE == 3) { const bf16_t* P = (const bf16_t*)(ws + WS_PROJ); qp = P + (size_t)t * CD_MAIN + 5120 + h * 128; kbase = P + (size_t)b * SEQ * CD_MAIN + 7168 + h * 128; vbase = kbase + 2048; ldk = ldv = CD_MAIN;
            op = (bf16_t*)(ws + WS_ATT) + (size_t)t * DM + 2048 + h * 128; s_hi = sp + 1; }
        else { qp = (const bf16_t*)(ws + WS_MEMQ) + (size_t)t * 512 + h * 128; kbase = (const bf16_t*)(ws + WS_KVM) + ((size_t)layer * 512 + b * 256) * 1024 + h * 128; vbase = kbase + 512; ldk = ldv = 1024;
            op = (bf16_t*)(ws + WS_MEMO) + (size_t)t * 512 + h * 128; s_hi = 256; }
        LDS_WAIT();
        for (int d = w.lane; d < DK; d += 64) qs[d] = bf2f(qp[d]);
        LDS_WAIT();
        const float* cum = (const float*)(ws + WS_CUM) + ((size_t)b * 16 + h) * SEQ;
        const float ct = (MODE == 3) ? cum[sp] : 0.f;
        const float* relb = a.in[I_A_REL_BIAS] + h * 513;
        const unsigned* mrow = (const unsigned*)(ws + WS_MASK) + (size_t)t * 128;
        float m = NEG, l = 0.f, o0 = 0.f, o1 = 0.f;
        for (int s0 = s_lo; s0 < s_hi; s0 += 64) {
            const int s = s0 + w.lane; bool valid = s < s_hi;
            if (MODE == 2) { if (valid) valid = (mrow[s >> 5] >> (s & 31)) & 1u; }
            float x = NEG;
            if (valid) {
                const bf16_t* kp = kbase + (size_t)s * ldk; float acc = 0.f;
#pragma unroll 4
                for (int d0 = 0; d0 < 128; d0 += 8) { const bf16x8 kv = *(const bf16x8*)(kp + d0);
#pragma unroll
                    for (int e = 0; e < 8; ++e) acc += qs[d0 + e] * bf2f((bf16_t)kv[e]); }
                if (MODE == 1) { const bf16_t* kr = (const bf16_t*)(ws + WS_KR) + ((size_t)b * SEQ + s) * 64;
#pragma unroll 4
                    for (int d0 = 0; d0 < 64; d0 += 8) { const bf16x8 kv = *(const bf16x8*)(kr + d0);
#pragma unroll
                        for (int e = 0; e < 8; ++e) acc += qs[128 + d0 + e] * bf2f((bf16_t)kv[e]); } }
                x = acc * scale;
                if (MODE == 0) { int rel = sp - s; rel = rel < -256 ? -256 : (rel > 256 ? 256 : rel); x += relb[rel + 256]; }
                if (MODE == 3) x += ct - cum[s];
            }
            const float mx = wave_max(x);
            if (mx == NEG) continue;
            const float mn = fmaxf(m, mx); const float p = valid ? __expf(x - mn) : 0.f; const float al = __expf(m - mn);
            l = l * al + wave_sum(p); o0 *= al; o1 *= al; m = mn;
            for (int j = 0; j < 64; ++j) { const float pj = __shfl(p, j);
                if (pj != 0.f) { const bf16_t* vp = vbase + (size_t)(s0 + j) * ldv; o0 += pj * bf2f(vp[w.lane]); o1 += pj * bf2f(vp[w.lane + 64]); } }
        }
        const float rl = 1.f / l;
        op[w.lane] = (bf16_t)f2bf(o0 * rl); op[w.lane + 64] = (bf16_t)f2bf(o1 * rl);
    }
}

__device__ __forceinline__ void rope_pair(float& x1, float& x2, float cs, float sn) { const float a = x1 * cs - x2 * sn, b = x2 * cs + x1 * sn; x1 = a; x2 = b; }
__device__ __forceinline__ void ph_l0_stats(const Args& a, const WI& w) {
    unsigned char* ws = a.ws; const bf16_t* P = (const bf16_t*)(ws + WS_PROJ);
    const float* r64 = (const float*)(ws + WS_ROPE64);
    for (int t = w.gw; t < T; t += w.ngw) {
        const bf16_t* row = P + (size_t)t * AB_MAIN;
        float s = 0.f;
        for (int j = 0; j < 3; ++j) { const bf16x8 v = *(const bf16x8*)(row + 6144 + (j * 64 + w.lane) * 8);
#pragma unroll
            for (int e = 0; e < 8; ++e) { const float f = bf2f((bf16_t)v[e]); s += f * f; } }
        s = wave_sum(s);
        float s2 = 0.f; { const bf16x8 v = *(const bf16x8*)(row + 7680 + w.lane * 8);
#pragma unroll
            for (int e = 0; e < 8; ++e) { const float f = bf2f((bf16_t)v[e]); s2 += f * f; } }
        s2 = wave_sum(s2);
        if (w.lane == 0) { ((float*)(ws + WS_RSQ))[t] = 1.f / sqrtf(s * (1.f / 1536.f) + RMS_EPS); ((float*)(ws + WS_RSKV))[t] = 1.f / sqrtf(s2 * (1.f / 512.f) + RMS_EPS); }
        if (w.lane < 32) { const float* sm = (const float*)(ws + WS_SMALL) + (size_t)t * 128; const int sp = t & (SEQ - 1);
            float x1 = sm[w.lane], x2 = sm[w.lane + 32]; const float cs = r64[((size_t)sp * 32 + w.lane) * 2], sn = r64[((size_t)sp * 32 + w.lane) * 2 + 1];
            rope_pair(x1, x2, cs, sn);
            bf16_t* kr = (bf16_t*)(ws + WS_KR) + (size_t)t * 64; kr[w.lane] = (bf16_t)f2bf(x1); kr[w.lane + 32] = (bf16_t)f2bf(x2); }
    }
}
__device__ __forceinline__ void ph_l0_qrope(const Args& a, const WI& w) {
    unsigned char* ws = a.ws; bf16_t* Q = (bf16_t*)(ws + WS_QB); const float* r64 = (const float*)(ws + WS_ROPE64);
    for (int t = w.gw; t < T; t += w.ngw) {
        const int sp = t & (SEQ - 1);
        for (int e = w.lane; e < 16 * 32; e += 64) { const int h = e >> 5, i = e & 31; bf16_t* q = Q + (size_t)t * 3072 + h * 192 + 128;
            float x1 = bf2f(q[i]), x2 = bf2f(q[i + 32]); rope_pair(x1, x2, r64[((size_t)sp * 32 + i) * 2], r64[((size_t)sp * 32 + i) * 2 + 1]);
            q[i] = (bf16_t)f2bf(x1); q[i + 32] = (bf16_t)f2bf(x2); }
    }
}
__device__ __forceinline__ void ph_l1_elem(const Args& a, const WI& w) {
    unsigned char* ws = a.ws; bf16_t* P = (bf16_t*)(ws + WS_PROJ);
    const float* r128 = (const float*)(ws + WS_ROPE128); const float* r64 = (const float*)(ws + WS_ROPE64);
    for (int t = w.gw; t < T; t += w.ngw) {
        const int b = t / SEQ, sp = t - b * SEQ; bf16_t* row = P + (size_t)t * CD_MAIN;
        for (int e = w.lane; e < 20 * 64; e += 64) { const int h = e >> 6, i = e & 63; bf16_t* q = row + h * 128;
            float x1 = bf2f(q[i]), x2 = bf2f(q[i + 64]); rope_pair(x1, x2, r128[((size_t)sp * 64 + i) * 2], r128[((size_t)sp * 64 + i) * 2 + 1]);
            q[i] = (bf16_t)f2bf(x1); q[i + 64] = (bf16_t)f2bf(x2); }
        for (int e = w.lane; e < 32 * 32; e += 64) { const int h = e >> 5, i = e & 31; bf16_t* q = row + 3072 + h * 64;
            float x1 = bf2f(q[i]), x2 = bf2f(q[i + 32]); rope_pair(x1, x2, r64[((size_t)sp * 32 + i) * 2], r64[((size_t)sp * 32 + i) * 2 + 1]);
            q[i] = (bf16_t)f2bf(x1); q[i + 32] = (bf16_t)f2bf(x2); }
        const float* sm = (const float*)(ws + WS_SMALL) + (size_t)t * 128;
        if (w.lane < 32) { float x1 = sm[w.lane], x2 = sm[w.lane + 32]; rope_pair(x1, x2, r64[((size_t)sp * 32 + w.lane) * 2], r64[((size_t)sp * 32 + w.lane) * 2 + 1]);
            bf16_t* ki = (bf16_t*)(ws + WS_KI) + (size_t)t * 64; ki[w.lane] = (bf16_t)f2bf(x1); ki[w.lane + 32] = (bf16_t)f2bf(x2);
            ((float*)(ws + WS_WI))[(size_t)t * 32 + w.lane] = sm[64 + w.lane] * 0.17677669529663687f; }
        if (w.lane < 16) { const float z = sm[96 + w.lane] + a.in[I_D_FORGET_BIAS][w.lane];
            const float lf = fminf(z, 0.f) - log1pf(__expf(-fabsf(z)));
            ((float*)(ws + WS_LOGF))[((size_t)b * 16 + w.lane) * SEQ + sp] = lf; }
    }
}
__device__ __forceinline__ void ph_l1_scan(const Args& a, const WI& w) {
    unsigned char* ws = a.ws;
    for (int it = w.gw; it < NB * 16; it += w.ngw) {
        const float* src = (const float*)(ws + WS_LOGF) + (size_t)it * SEQ + w.lane * 64; float* dst = (float*)(ws + WS_CUM) + (size_t)it * SEQ + w.lane * 64;
        float tot = 0.f; for (int j = 0; j < 64; ++j) tot += src[j];
        float inc = tot;
#pragma unroll
        for (int o = 1; o < 64; o <<= 1) { const float v = __shfl_up(inc, o); if (w.lane >= o) inc += v; }
        float run = inc - tot;
        for (int j = 0; j < 64; ++j) { run += src[j]; dst[j] = run; }
    }
}
__device__ __forceinline__ void ph_l1_index_naive(const Args& a, LAS float* qs  , const WI& w) {
    unsigned char* ws = a.ws; const bf16_t* P = (const bf16_t*)(ws + WS_PROJ); const bf16_t* KI = (const bf16_t*)(ws + WS_KI);
    const float* WIp = (const float*)(ws + WS_WI); float* SC = (float*)(ws + WS_SCORE);
    for (int t = w.gw; t < T; t += w.ngw) {
        const int b = t / SEQ, sp = t - b * SEQ, nadm = ((sp >> 6) + 1) * 64;
        LDS_WAIT();
        for (int e = w.lane; e < 2048; e += 64) qs[e] = bf2f(P[(size_t)t * CD_MAIN + 3072 + e]);
        if (w.lane < 32) qs[2048 + w.lane] = WIp[(size_t)t * 32 + w.lane];
        LDS_WAIT();
        for (int s0 = 0; s0 < nadm; s0 += 64) {
            const int s = s0 + w.lane; const bf16_t* kp = KI + ((size_t)b * SEQ + s) * 64;
            float k[64];
#pragma unroll
            for (int d0 = 0; d0 < 64; d0 += 8) { const bf16x8 kv = *(const bf16x8*)(kp + d0);
#pragma unroll
                for (int e = 0; e < 8; ++e) k[d0 + e] = bf2f((bf16_t)kv[e]); }
            float sc = 0.f;
            for (int h = 0; h < 32; ++h) { float dot = 0.f;
#pragma unroll
                for (int d = 0; d < 64; ++d) dot += qs[h * 64 + d] * k[d];
                sc += qs[2048 + h] * fmaxf(dot * 0.125f, 0.f); }
            SC[((size_t)b * SEQ + sp) * SEQ + s] = sc;
        }
    }
}
__device__ __forceinline__ void ph_l1_select(const Args& a, const WI& w) {
    unsigned char* ws = a.ws; const float* SC = (const float*)(ws + WS_SCORE); unsigned* MK = (unsigned*)(ws + WS_MASK);
    for (int t = w.gw; t < T; t += w.ngw) {
        const int b = t / SEQ, sp = t - b * SEQ, nblk = (sp >> 6) + 1;
        const float* row = SC + ((size_t)b * SEQ + sp) * SEQ;
        unsigned key[64];
#pragma unroll
        for (int j = 0; j < 64; ++j) { unsigned u = 0u; if (j < nblk) { u = __float_as_uint(row[j * 64 + w.lane]); u ^= (u >> 31) ? 0xFFFFFFFFu : 0x80000000u; } key[j] = u; }
        unsigned thr = 0u;
        if (nblk > 4) {
            for (int bit = 31; bit >= 0; --bit) { const unsigned cand = thr | (1u << bit); int cnt = 0;
#pragma unroll
                for (int j = 0; j < 64; ++j) cnt += (key[j] >= cand) ? 1 : 0;
                cnt = wave_sum_i(cnt); if (cnt >= 256) thr = cand; }
        }
        unsigned lo = 0u, hi = 0u;
#pragma unroll
        for (int j = 0; j < 64; ++j) { const bool sel = (j < nblk) && (key[j] >= thr); const unsigned long long bal = __ballot(sel); if (w.lane == j) { lo = (unsigned)bal; hi = (unsigned)(bal >> 32); } }
        *(u32x2*)(MK + (size_t)t * 128 + 2 * w.lane) = (u32x2){lo, hi};
    }
}

__device__ __forceinline__ void ph_peer_topk(const Args& a, const WI& w) {
    unsigned char* ws = a.ws; const float* PS = (const float*)(ws + WS_PSCORE); int* PIDX = (int*)(ws + WS_PIDX); float* PG = (float*)(ws + WS_PGATE);
    const float NEG = -__builtin_inff();
    for (int t = w.gw; t < T; t += w.ngw) {
        for (int h = 0; h < 8; ++h) {
            const float* s = PS + (size_t)t * 2048 + h * 256;
            float ts[2]; int ti[2];
#pragma unroll
            for (int p = 0; p < 2; ++p) {
                float v0 = s[p * 128 + w.lane], v1 = s[p * 128 + 64 + w.lane]; float mys = NEG; int myi = 0;
                for (int k = 0; k < 16; ++k) {
                    const float m = wave_max(fmaxf(v0, v1));
                    const unsigned long long b0 = __ballot(v0 == m); int idx;
                    if (b0) { const int src = __ffsll((long long)b0) - 1; idx = src; if (w.lane == src) v0 = NEG; }
                    else { const unsigned long long b1 = __ballot(v1 == m); const int src = __ffsll((long long)b1) - 1; idx = src + 64; if (w.lane == src) v1 = NEG; }
                    if (w.lane == k) { mys = m; myi = idx; }
                }
                ts[p] = mys; ti[p] = myi;
            }
            float cv[4];
#pragma unroll
            for (int q = 0; q < 4; ++q) { const int c = w.lane + 64 * q; cv[q] = __shfl(ts[0], c >> 4) + __shfl(ts[1], c & 15); }
            float bs = NEG; int bc = 0;
            for (int k = 0; k < 16; ++k) {
                const float m = wave_max(fmaxf(fmaxf(cv[0], cv[1]), fmaxf(cv[2], cv[3])));
                int cidx = -1;
#pragma unroll
                for (int q = 0; q < 4; ++q) { if (cidx < 0) { const unsigned long long bb = __ballot(cv[q] == m); if (bb) { const int src = __ffsll((long long)bb) - 1; cidx = src + 64 * q; if (w.lane == src) cv[q] = NEG; } } }
                if (w.lane == k) { bs = m; bc = cidx; }
            }
            const int e0 = __shfl(ti[0], bc >> 4), e1 = __shfl(ti[1], bc & 15);
            const float top = __shfl(bs, 0);
            const float ex = (w.lane < 16) ? __expf(bs - top) : 0.f;
            const float den = wave_sum(ex);
            if (w.lane < 16) { PIDX[(size_t)t * 128 + h * 16 + w.lane] = e0 * 128 + e1; PG[(size_t)t * 128 + h * 16 + w.lane] = ex / den; }
        }
    }
}
__device__ __forceinline__ void ph_peer_experts(const Args& a, int layer, float* outf, bf16_t* outb, const float* g, const float* bta, LAS float* wsm  , const WI& w) {
    unsigned char* ws = a.ws; const bf16_t* XB = (const bf16_t*)(ws + WS_XB); const float* HF = (const float*)(ws + WS_HF);
    const bf16_t* U = (const bf16_t*)(ws + WS_U16) + (size_t)layer * 16384 * DM; const bf16_t* V = (const bf16_t*)(ws + WS_V16) + (size_t)layer * 16384 * DM;
    const int* PIDX = (const int*)(ws + WS_PIDX); const float* PG = (const float*)(ws + WS_PGATE);
    for (int t = w.gw; t < T; t += w.ngw) {
        u32x4 xr[8];
#pragma unroll
        for (int j = 0; j < 8; ++j) xr[j] = *(const u32x4*)(XB + (size_t)t * DM + 512 * j + 8 * w.lane);
        LDS_WAIT();
        for (int k0 = 0; k0 < 128; k0 += 4) {
            float z[4];
#pragma unroll
            for (int q = 0; q < 4; ++q) {
                const int e = __builtin_amdgcn_readfirstlane(PIDX[(size_t)t * 128 + k0 + q]);
                const bf16_t* ur = U + (size_t)e * DM + 8 * w.lane; float acc = 0.f;
#pragma unroll
                for (int j = 0; j < 8; ++j) { const u32x4 uv = *(const u32x4*)(ur + 512 * j);
                    acc += __uint_as_float(uv.x << 16) * __uint_as_float(xr[j].x << 16) + __uint_as_float(uv.x & 0xffff0000u) * __uint_as_float(xr[j].x & 0xffff0000u);
                    acc += __uint_as_float(uv.y << 16) * __uint_as_float(xr[j].y << 16) + __uint_as_float(uv.y & 0xffff0000u) * __uint_as_float(xr[j].y & 0xffff0000u);
                    acc += __uint_as_float(uv.z << 16) * __uint_as_float(xr[j].z << 16) + __uint_as_float(uv.z & 0xffff0000u) * __uint_as_float(xr[j].z & 0xffff0000u);
                    acc += __uint_as_float(uv.w << 16) * __uint_as_float(xr[j].w << 16) + __uint_as_float(uv.w & 0xffff0000u) * __uint_as_float(xr[j].w & 0xffff0000u); }
                z[q] = acc;
            }
#pragma unroll
            for (int q = 0; q < 4; ++q) z[q] = wave_sum(z[q]);
            if (w.lane < 4) { const float zz = (w.lane == 0) ? z[0] : (w.lane == 1) ? z[1] : (w.lane == 2) ? z[2] : z[3];
                const float act = 0.5f * zz * (1.f + erff(zz * 0.70710678118654752f));
                wsm[k0 + w.lane] = act * PG[(size_t)t * 128 + k0 + w.lane]; }
        }
        LDS_WAIT();
        float y[64];
#pragma unroll
        for (int i = 0; i < 64; ++i) y[i] = 0.f;
        for (int k0 = 0; k0 < 128; k0 += 2) {
#pragma unroll
            for (int q = 0; q < 2; ++q) {
                const int e = __builtin_amdgcn_readfirstlane(PIDX[(size_t)t * 128 + k0 + q]); const float wt = wsm[k0 + q];
                const bf16_t* vr = V + (size_t)e * DM + 8 * w.lane;
#pragma unroll
                for (int j = 0; j < 8; ++j) { const u32x4 vv = *(const u32x4*)(vr + 512 * j);
                    y[8 * j + 0] += wt * __uint_as_float(vv.x << 16); y[8 * j + 1] += wt * __uint_as_float(vv.x & 0xffff0000u);
                    y[8 * j + 2] += wt * __uint_as_float(vv.y << 16); y[8 * j + 3] += wt * __uint_as_float(vv.y & 0xffff0000u);
                    y[8 * j + 4] += wt * __uint_as_float(vv.z << 16); y[8 * j + 5] += wt * __uint_as_float(vv.z & 0xffff0000u);
                    y[8 * j + 6] += wt * __uint_as_float(vv.w << 16); y[8 * j + 7] += wt * __uint_as_float(vv.w & 0xffff0000u); }
            }
        }
        float s = 0.f;
#pragma unroll
        for (int j = 0; j < 8; ++j) { const float* hp = HF + (size_t)t * DM + 512 * j + 8 * w.lane; const f32x4 h0 = *(const f32x4*)hp, h1 = *(const f32x4*)(hp + 4);
            y[8 * j + 0] += ALPHA * h0.x; y[8 * j + 1] += ALPHA * h0.y; y[8 * j + 2] += ALPHA * h0.z; y[8 * j + 3] += ALPHA * h0.w;
            y[8 * j + 4] += ALPHA * h1.x; y[8 * j + 5] += ALPHA * h1.y; y[8 * j + 6] += ALPHA * h1.z; y[8 * j + 7] += ALPHA * h1.w; }
#pragma unroll
        for (int i = 0; i < 64; ++i) s += y[i];
        const float mean = wave_sum(s) * (1.f / DM); float s2 = 0.f;
#pragma unroll
        for (int i = 0; i < 64; ++i) { y[i] -= mean; s2 += y[i] * y[i]; }
        const float rstd = 1.f / sqrtf(wave_sum(s2) * (1.f / DM) + LN_EPS);
#pragma unroll
        for (int j = 0; j < 8; ++j) { const int c = 512 * j + 8 * w.lane;
            const f32x4 g0 = *(const f32x4*)(g + c), g1 = *(const f32x4*)(g + c + 4), b0 = *(const f32x4*)(bta + c), b1 = *(const f32x4*)(bta + c + 4);
            f32x4 o0, o1;
            o0.x = y[8 * j + 0] * rstd * g0.x + b0.x; o0.y = y[8 * j + 1] * rstd * g0.y + b0.y; o0.z = y[8 * j + 2] * rstd * g0.z + b0.z; o0.w = y[8 * j + 3] * rstd * g0.w + b0.w;
            o1.x = y[8 * j + 4] * rstd * g1.x + b1.x; o1.y = y[8 * j + 5] * rstd * g1.y + b1.y; o1.z = y[8 * j + 6] * rstd * g1.z + b1.z; o1.w = y[8 * j + 7] * rstd * g1.w + b1.w;
            *(f32x4*)(outf + (size_t)t * DM + c) = o0; *(f32x4*)(outf + (size_t)t * DM + c + 4) = o1;
            if (outb) { u32x4 p; p.x = pk2(o0.x, o0.y); p.y = pk2(o0.z, o0.w); p.z = pk2(o1.x, o1.y); p.w = pk2(o1.z, o1.w); *(u32x4*)(outb + (size_t)t * DM + c) = p; } }
    }
}

__global__ void __launch_bounds__(512, 2) mega(Args a) {
    extern __shared__ __attribute__((aligned(16))) unsigned char lds_raw[];
    LAS unsigned char* lds = (LAS unsigned char*)lds_raw;
    WI w; w.tid = threadIdx.x; w.lane = w.tid & 63; w.wave = __builtin_amdgcn_readfirstlane(w.tid >> 6);
    w.bid = blockIdx.x; w.nblk = gridDim.x; w.gw = w.bid * 8 + w.wave; w.ngw = w.nblk * 8;
    unsigned char* ws = a.ws;
    volatile LAS unsigned* misc = (volatile LAS unsigned*)(lds + LDS_MISC);
    if (w.tid < 4) misc[w.tid] = 0u;
    __syncthreads();
    XcdBarrier bar; bar.bar = (unsigned*)(ws + WS_CTL) + 4096; bar.x = 0; bar.st = misc;
#if !MK_PER_PHASE
    bar = xcd_barrier_post((unsigned*)(ws + WS_CTL) + 4096, misc);
#endif
    const int lo = a.ph_lo, hi = a.ph_hi;
#define IN(k) (lo <= (k) && (k) < hi)
#if MK_PER_PHASE
#define SEAM(k) do { } while (0)
#else
#define SEAM(k) do { if (IN(k) && IN((k) + 1)) xcd_barrier(bar); } while (0)
#endif
    LAS float* wlds = (LAS float*)(lds + w.wave * 16384);
    bf16_t* XB = (bf16_t*)(ws + WS_XB); float* HF = (float*)(ws + WS_HF); float* RES = (float*)(ws + WS_RES); bf16_t* PROJ = (bf16_t*)(ws + WS_PROJ);
    bf16_t* ATT = (bf16_t*)(ws + WS_ATT); float* SMALL = (float*)(ws + WS_SMALL);

    if (IN(0)) ph_convert(a, lds, w);
    SEAM(0);
    if (IN(1)) {
        naive_gemm(XB, DM, (const bf16_t*)(ws + WS_W_AB_IN), DM, T, AB_MAIN, DM, w, [=](int m, int n, float v) { PROJ[(size_t)m * AB_MAIN + n] = (bf16_t)f2bf(v); });
        naive_gemm(XB, DM, (const bf16_t*)(ws + WS_W_AB_IN) + (size_t)AB_MAIN * DM, DM, T, 64, DM, w, [=](int m, int n, float v) { SMALL[(size_t)m * 128 + n] = v; });
        bf16_t* KVM = (bf16_t*)(ws + WS_KVM);
        naive_gemm((const bf16_t*)(ws + WS_MEMB), DM, (const bf16_t*)(ws + WS_W_MEM_KV), DM, 512, 2048, DM, w,
                   [=](int m, int n, float v) { KVM[((size_t)(n >> 10) * 512 + m) * 1024 + (n & 1023)] = (bf16_t)f2bf(v); });
    }
    SEAM(1);
    if (IN(2)) ph_l0_stats(a, w);
    SEAM(2);
    if (IN(3)) {
        const float* rsq = (const float*)(ws + WS_RSQ); const float* rskv = (const float*)(ws + WS_RSKV);
        bf16_t* QB = (bf16_t*)(ws + WS_QB); bf16_t* KVB = (bf16_t*)(ws + WS_KVB);
        naive_gemm(PROJ + 6144, AB_MAIN, (const bf16_t*)(ws + WS_W_UQ), 1536, T, 3072, 1536, w, [=](int m, int n, float v) { QB[(size_t)m * 3072 + n] = (bf16_t)f2bf(v * rsq[m]); });
        naive_gemm(PROJ + 7680, AB_MAIN, (const bf16_t*)(ws + WS_W_UKV), 512, T, 4096, 512, w, [=](int m, int n, float v) { KVB[(size_t)m * 4096 + n] = (bf16_t)f2bf(v * rskv[m]); });
    }
    SEAM(3);
    if (IN(4)) ph_l0_qrope(a, w);
    SEAM(4);
    if (IN(5)) { attn_naive<0>(a, 0, wlds, w); attn_naive<1>(a, 0, wlds, w); }
    SEAM(5);
    if (IN(6)) { const float* X = a.in[I_X];
        naive_gemm(ATT, DM, (const bf16_t*)(ws + WS_W_AB_OUT), DM, T, DM, DM, w, [=](int m, int n, float v) { RES[(size_t)m * DM + n] = ALPHA * X[(size_t)m * DM + n] + v; }); }
    SEAM(6);
    if (IN(7)) ln_rows(RES, a.in[I_LN_G] + 0 * DM, a.in[I_LN_B] + 0 * DM, HF, XB, w);
    SEAM(7);

#define MEM_PEER_PHASES(L, P0_, LAST)                                                                                                                         \
    if (IN(P0_)) { bf16_t* MQ = (bf16_t*)(ws + WS_MEMQ);                                                                                                        \
        naive_gemm(XB, DM, (const bf16_t*)(ws + WS_W_MEM_Q) + (size_t)(L) * 512 * DM, DM, T, 512, DM, w, [=](int m, int n, float v) { MQ[(size_t)m * 512 + n] = (bf16_t)f2bf(v); }); } \
    SEAM(P0_);                                                                                                                                                  \
    if (IN(P0_ + 1)) attn_naive<4>(a, (L), wlds, w);                                                                                                            \
    SEAM(P0_ + 1);                                                                                                                                              \
    if (IN(P0_ + 2)) { naive_gemm((const bf16_t*)(ws + WS_MEMO), 512, (const bf16_t*)(ws + WS_W_MEM_O) + (size_t)(L) * DM * 512, 512, T, DM, 512, w,            \
                                  [=](int m, int n, float v) { RES[(size_t)m * DM + n] = ALPHA * HF[(size_t)m * DM + n] + v; }); }                              \
    SEAM(P0_ + 2);                                                                                                                                              \
    if (IN(P0_ + 3)) ln_rows(RES, a.in[I_LN_G] + ((L) * 3 + 1) * DM, a.in[I_LN_B] + ((L) * 3 + 1) * DM, HF, XB, w);                                             \
    SEAM(P0_ + 3);                                                                                                                                              \
    if (IN(P0_ + 4)) { float* PS = (float*)(ws + WS_PSCORE);                                                                                                    \
        naive_gemm(XB, DM, (const bf16_t*)(ws + WS_W_PEER) + (size_t)(L) * 2048 * DM, DM, T, 2048, DM, w, [=](int m, int n, float v) { PS[(size_t)m * 2048 + n] = v; }); } \
    SEAM(P0_ + 4);                                                                                                                                              \
    if (IN(P0_ + 5)) ph_peer_topk(a, w);                                                                                                                        \
    SEAM(P0_ + 5);                                                                                                                                              \
    if (IN(P0_ + 6)) ph_peer_experts(a, (L), (LAST) ? a.out : HF, (LAST) ? (bf16_t*)nullptr : XB, a.in[I_LN_G] + ((L) * 3 + 2) * DM, a.in[I_LN_B] + ((L) * 3 + 2) * DM, wlds, w); \
    if (!(LAST)) SEAM(P0_ + 6);

    MEM_PEER_PHASES(0, 8, false)

    if (IN(15)) {
        naive_gemm(XB, DM, (const bf16_t*)(ws + WS_W_CD_IN), DM, T, CD_MAIN, DM, w, [=](int m, int n, float v) { PROJ[(size_t)m * CD_MAIN + n] = (bf16_t)f2bf(v); });
        naive_gemm(XB, DM, (const bf16_t*)(ws + WS_W_CD_IN) + (size_t)CD_MAIN * DM, DM, T, 112, DM, w, [=](int m, int n, float v) { SMALL[(size_t)m * 128 + n] = v; });
    }
    SEAM(15);
    if (IN(16)) ph_l1_elem(a, w);
    SEAM(16);
    if (IN(17)) { ph_l1_scan(a, w); ph_l1_index_naive(a, wlds, w); }
    SEAM(17);
    if (IN(18)) ph_l1_select(a, w);
    SEAM(18);
    if (IN(19)) { attn_naive<2>(a, 1, wlds, w); attn_naive<3>(a, 1, wlds, w); }
    SEAM(19);
    if (IN(20)) { naive_gemm(ATT, DM, (const bf16_t*)(ws + WS_W_CD_OUT), DM, T, DM, DM, w, [=](int m, int n, float v) { RES[(size_t)m * DM + n] = ALPHA * HF[(size_t)m * DM + n] + v; }); }
    SEAM(20);
    if (IN(21)) ln_rows(RES, a.in[I_LN_G] + 3 * DM, a.in[I_LN_B] + 3 * DM, HF, XB, w);
    SEAM(21);
    MEM_PEER_PHASES(1, 22, true)
#undef IN
#undef SEAM
}

extern "C" void kernel_launch(void* const* d_in, const int* in_sizes, int n_in, void* d_out, int out_size, void* d_ws, size_t ws_size, hipStream_t stream) {
    static int grid = 0;
    if (grid == 0) {
        if (n_in != 21 || out_size != T * DM || ws_size < WS_END) { fprintf(stderr, "kernel_launch: unexpected shapes (n_in %d out %d ws %zu need %zu)\n", n_in, out_size, ws_size, (size_t)WS_END); grid = -1; return; }
        int dev = 0, cus = 0, per_cu = 0;
        if (hipGetDevice(&dev) != hipSuccess || hipDeviceGetAttribute(&cus, hipDeviceAttributeMultiprocessorCount, dev) != hipSuccess) { grid = -1; return; }
        if (hipFuncSetAttribute((const void*)mega, hipFuncAttributeMaxDynamicSharedMemorySize, LDS_BYTES) != hipSuccess) { fprintf(stderr, "kernel_launch: hipFuncSetAttribute failed\n"); grid = -1; return; }
        if (hipOccupancyMaxActiveBlocksPerMultiprocessor(&per_cu, (const void*)mega, 512, LDS_BYTES) != hipSuccess || per_cu < 1) { fprintf(stderr, "kernel_launch: occupancy query says %d\n", per_cu); }
        (void)hipGetLastError();
        grid = cus;
    }
    if (grid < 0) return;
    (void)hipMemsetAsync((char*)d_ws + WS_CTL, 0, CTL_BYTES, stream);
    Args a{};
    for (int i = 0; i < 21; ++i) a.in[i] = (const float*)d_in[i];
    a.out = (float*)d_out; a.ws = (unsigned char*)d_ws;
#if MK_PER_PHASE
    for (int p = 0; p < NPHASE; ++p) { a.ph_lo = p; a.ph_hi = p + 1; hipLaunchKernelGGL(mega, dim3(grid), dim3(512), LDS_BYTES, stream, a); }
#else
    a.ph_lo = 0; a.ph_hi = NPHASE;
    hipLaunchKernelGGL(mega, dim3(grid), dim3(512), LDS_BYTES, stream, a);
#endif
}
```

```cpp
#include <hip/hip_runtime.h>
#include <cstdio>
#include <cstdint>

#define GAS __attribute__((address_space(1)))
#define LAS __attribute__((address_space(3)))
typedef unsigned short bf16_t;
typedef short bf16x8 __attribute__((ext_vector_type(8)));
typedef float f32x4 __attribute__((ext_vector_type(4)));
typedef float f32x16 __attribute__((ext_vector_type(16)));
typedef unsigned u32x4 __attribute__((ext_vector_type(4)));
typedef unsigned u32x2 __attribute__((ext_vector_type(2)));

#ifndef MK_PER_PHASE
#define MK_PER_PHASE 0
#endif

constexpr int NB = 2, SEQ = 4096, T = NB * SEQ, DM = 4096;
constexpr int AB_COLS = 8256, AB_MAIN = 8192, AB_PAD = 8448;
constexpr int CD_COLS = 11376, CD_MAIN = 11264, CD_PAD = 11520;
constexpr float ALPHA = 1.4142135623730951f;
constexpr float LN_EPS = 1e-5f, RMS_EPS = 1e-6f;
constexpr int NPHASE = 29;

constexpr size_t MiB = 1ull << 20;
constexpr size_t WS_CTL = 0, CTL_BYTES = 1 * MiB;
constexpr size_t WS_ROPE128 = 1 * MiB;
constexpr size_t WS_ROPE64 = 3 * MiB;
constexpr size_t WS_RSQ = 4 * MiB;
constexpr size_t WS_RSKV = 4 * MiB + 65536;
constexpr size_t WS_CUM = 5 * MiB;
constexpr size_t WS_LOGF = 5 * MiB + 524288;
constexpr size_t WS_KR = 6 * MiB;
constexpr size_t WS_KI = 7 * MiB;
constexpr size_t WS_WI = 8 * MiB;
constexpr size_t WS_KVM = 9 * MiB;
constexpr size_t WS_MEMB = 11 * MiB;
constexpr size_t WS_MASK = 15 * MiB;
constexpr size_t WS_PIDX = 19 * MiB;
constexpr size_t WS_PGATE = 23 * MiB;
constexpr size_t WS_MEMQ = 27 * MiB;
constexpr size_t WS_MEMO = 35 * MiB;
constexpr size_t WS_SMALL = 43 * MiB;
constexpr size_t WS_W_AB_IN = 64 * MiB;
constexpr size_t WS_W_UQ = 130 * MiB;
constexpr size_t WS_W_UKV = 139 * MiB;
constexpr size_t WS_W_AB_OUT = 143 * MiB;
constexpr size_t WS_W_CD_IN = 175 * MiB;
constexpr size_t WS_W_CD_OUT = 265 * MiB;
constexpr size_t WS_W_MEM_Q = 297 * MiB;
constexpr size_t WS_W_MEM_KV = 305 * MiB;
constexpr size_t WS_W_MEM_O = 321 * MiB;
constexpr size_t WS_W_PEER = 329 * MiB;
constexpr size_t WS_U16 = 361 * MiB;
constexpr size_t WS_V16 = 617 * MiB;
constexpr size_t WS_XB = 873 * MiB;
constexpr size_t WS_HF = 937 * MiB;
constexpr size_t WS_RES = 1065 * MiB;
constexpr size_t WS_PROJ = 1193 * MiB;
constexpr size_t WS_PSCORE = WS_PROJ;
constexpr size_t WS_ATT = 1369 * MiB;
constexpr size_t WS_QB = 1433 * MiB;
constexpr size_t WS_KVB = 1481 * MiB;
constexpr size_t WS_SCORE = 1433 * MiB;
constexpr size_t WS_MQP = 1561 * MiB;
constexpr size_t WS_END = 1625 * MiB;

constexpr int LDS_BYTES = 147456;
constexpr int LDS_MISC = 140 * 1024;

#define LDS_WAIT() asm volatile("s_waitcnt lgkmcnt(0)" ::: "memory")
__device__ __forceinline__ float bf2f(bf16_t b) { return __uint_as_float(((unsigned)b) << 16); }
__device__ __forceinline__ unsigned f2bf(float f) { unsigned u = __float_as_uint(f); return (u + 0x7fffu + ((u >> 16) & 1u)) >> 16; }
__device__ __forceinline__ unsigned pk2(float lo, float hi) { return f2bf(lo) | (f2bf(hi) << 16); }
__device__ __forceinline__ float wave_sum(float v) {
#pragma unroll
    for (int o = 1; o < 64; o <<= 1) v += __shfl_xor(v, o);
    return v;
}
__device__ __forceinline__ float wave_max(float v) {
#pragma unroll
    for (int o = 1; o < 64; o <<= 1) v = fmaxf(v, __shfl_xor(v, o));
    return v;
}
__device__ __forceinline__ int wave_sum_i(int v) {
#pragma unroll
    for (int o = 1; o < 64; o <<= 1) v += __shfl_xor(v, o);
    return v;
}

#define XB_TMO      128
#define XB_XCNT(j)  (256  + 64 * (j))
#define XB_XSUB(j)  (1280 + 64 * (j))
#define XB_XGEN(j)  (2304 + 64 * (j))
#define XB_TOP      3328
#define XB_TOPGEN   3392
#define XCD_BAR_WORDS 3456
#define XB_SPIN_CAP (1u << 22)

__device__ __forceinline__ unsigned xb_ld(unsigned* p)              { return __hip_atomic_load(p, __ATOMIC_RELAXED, __HIP_MEMORY_SCOPE_AGENT); }
__device__ __forceinline__ unsigned xb_add(unsigned* p, unsigned v) { return __hip_atomic_fetch_add(p, v, __ATOMIC_RELAXED, __HIP_MEMORY_SCOPE_AGENT); }
__device__ __forceinline__ unsigned xb_xcc_id() { return (unsigned)__builtin_amdgcn_s_getreg((3 << 11) | 20) & 0xFu; }
#define XB_SPIN(cond, bar) do { unsigned _sp = 0; while (cond) { __builtin_amdgcn_s_sleep(1); \
    if ((++_sp & 255u) == 0u) { if (xb_ld(&(bar)[XB_TMO])) break; if (_sp > XB_SPIN_CAP) { atomicAdd(&(bar)[XB_TMO], 1u); break; } } } } while (0)

struct XcdBarrier { unsigned* bar; unsigned x; volatile LAS unsigned* st; };

__device__ __forceinline__ XcdBarrier xcd_barrier_post(unsigned* bar, volatile LAS unsigned* st) {
    XcdBarrier b; b.bar = bar; b.x = xb_xcc_id(); b.st = st;
    if (threadIdx.x == 0) (void)xb_add(&bar[XB_XCNT(b.x)], 1u);
    return b;
}
__device__ __forceinline__ void xcd_barrier_complete(unsigned* bar, unsigned x, unsigned& nloc, unsigned& nx) {
    const unsigned G = gridDim.x * gridDim.y * gridDim.z;
    unsigned sum, cnt, mine, sp = 0u;
    for (;;) {
        sum = 0u; cnt = 0u; mine = 0u;
#pragma unroll
        for (unsigned j = 0; j < 16; ++j) { const unsigned c = xb_ld(&bar[XB_XCNT(j)]); sum += c; cnt += (c > 0u) ? 1u : 0u; mine = (j == x) ? c : mine; }
        if (sum == G) break;
        __builtin_amdgcn_s_sleep(1);
        if ((++sp & 255u) == 0u) { if (xb_ld(&bar[XB_TMO])) break; if (sp > XB_SPIN_CAP) { atomicAdd(&bar[XB_TMO], 1u); break; } }
    }
    nloc = mine > 0u ? mine : 1u; nx = cnt > 0u ? cnt : 1u;
}
__device__ __forceinline__ void xcd_barrier(const XcdBarrier& b) {
    asm volatile("s_waitcnt vmcnt(0)" ::: "memory");
    __syncthreads();
    if (threadIdx.x == 0) {
        unsigned* bar = b.bar;
        __builtin_amdgcn_s_waitcnt(0);
        unsigned nloc = b.st[0], nx = b.st[1];
        if (nloc == 0u) { xcd_barrier_complete(bar, b.x, nloc, nx); b.st[0] = nloc; b.st[1] = nx; }
        const unsigned old = xb_add(&bar[XB_XSUB(b.x)], 1u);
        const unsigned gen = old / nloc;
        if (old + 1u == (gen + 1u) * nloc) {
            __builtin_amdgcn_fence(__ATOMIC_RELEASE, "agent");
            asm volatile("s_waitcnt vmcnt(0)" ::: "memory");
            const unsigned og = xb_add(&bar[XB_TOP], 1u);
            const unsigned tg = og / nx;
            if (og + 1u == (tg + 1u) * nx) xb_add(&bar[XB_TOPGEN], 1u);
            else XB_SPIN(xb_ld(&bar[XB_TOPGEN]) == tg, bar);
            __builtin_amdgcn_fence(__ATOMIC_ACQUIRE, "agent");
            xb_add(&bar[XB_XGEN(b.x)], 1u);
            asm volatile("s_waitcnt vmcnt(0)" ::: "memory");
        } else {
            XB_SPIN(xb_ld(&bar[XB_XGEN(b.x)]) == gen, bar);
            __builtin_amdgcn_fence(__ATOMIC_ACQUIRE, "agent");
            asm volatile("s_waitcnt vmcnt(0)" ::: "memory");
        }
    }
    __syncthreads();
}

namespace pg8 {
constexpr int BM = 256, BK = 64, HALF = 128, HTB = HALF * BK * 2, STAGE_BYTES = 8 * HTB, NXCD = 8, WGM = 8;
__host__ __device__ __forceinline__ int lds_byte(int r, int c) { const int st = (r >> 4) * 2 + (c >> 5), rr = r & 15, cc = c & 31, ob = rr * 64 + cc * 2; return st * 1024 + (ob ^ (((ob >> 9) & 1) << 5)); }
__host__ __device__ __forceinline__ void stage_rc(int b, int& R, int& C) { const int st = b / 1024, sb = b % 1024, swz = sb ^ (((sb >> 9) & 1) << 5); R = (st >> 1) * 16 + swz / 64; C = (st & 1) * 32 + (swz % 64) / 2; }
__host__ __device__ __forceinline__ int perm32(int rho) { const int n = rho >> 4, i = rho & 15; return 8 * (i >> 2) + 4 * n + (i & 3); }
struct Unit { int pm, pn, z; };
struct Gemm { const bf16_t* A; const bf16_t* Bt; int M, N, K, lda, ldb; long zA, zB; int nz; };
struct StaticOrder {
    int nM, nN, nZ, nwg, G, c;
    __device__ void init(int M, int N, int Z, int G_, int c_) { nM = M / BM; nN = N / BM; nZ = Z; nwg = nM * nN * nZ; G = G_; c = c_; }
    __device__ bool next(int i, Unit& u) const {
        const long L = (long)i * G + c; if (L >= nwg) return false;
        int wgid = (int)L; { const int q = nwg / NXCD, r = nwg % NXCD, xcd = wgid % NXCD, off = wgid / NXCD; wgid = (xcd < r ? xcd * (q + 1) : r * (q + 1) + (xcd - r) * q) + off; }
        const int per = nM * nN; u.z = wgid / per; wgid -= u.z * per;
        const int nig = WGM * nN, gid = wgid / nig, fm = gid * WGM, gsz = (nM - fm) < WGM ? (nM - fm) : WGM;
        u.pm = fm + ((wgid % nig) % gsz); u.pn = (wgid % nig) / gsz; return true;
    }
};
__device__ __forceinline__ unsigned cvt_pk_bf16(float lo, float hi) { unsigned r; asm volatile("v_cvt_pk_bf16_f32 %0, %1, %2" : "=v"(r) : "v"(lo), "v"(hi)); return r; }
struct EpiF32 {
    static constexpr bool PERM = false;
    float* C; int ldc; long zC;
    __device__ __forceinline__ void operator()(const f32x4 (&acc)[2][2][4][2], const Unit& u, int wr, int wc, int fr, int fq) const {
        const int row0 = u.pm * BM + wr * 64 + fr, col0 = u.pn * BM + wc * 32 + 4 * fq; float* Cz = C + (size_t)u.z * zC;
#pragma unroll
        for (int ai = 0; ai < 2; ++ai)
#pragma unroll
            for (int m = 0; m < 4; ++m) { float* rowp = Cz + (size_t)(row0 + ai * HALF + m * 16) * ldc + col0;
#pragma unroll
                for (int bj = 0; bj < 2; ++bj)
#pragma unroll
                    for (int n = 0; n < 2; ++n) *(f32x4*)(rowp + bj * HALF + n * 16) = acc[ai][bj][m][n]; }
    }
};
struct EpiResid {
    static constexpr bool PERM = false;
    const float* base; float* out; int ldc;
    __device__ __forceinline__ void operator()(const f32x4 (&acc)[2][2][4][2], const Unit& u, int wr, int wc, int fr, int fq) const {
        const int row0 = u.pm * BM + wr * 64 + fr, col0 = u.pn * BM + wc * 32 + 4 * fq;
#pragma unroll
        for (int ai = 0; ai < 2; ++ai)
#pragma unroll
            for (int m = 0; m < 4; ++m) { const size_t off = (size_t)(row0 + ai * HALF + m * 16) * ldc + col0;
#pragma unroll
                for (int bj = 0; bj < 2; ++bj)
#pragma unroll
                    for (int n = 0; n < 2; ++n) { const f32x4 bs = *(const f32x4*)(base + off + bj * HALF + n * 16); *(f32x4*)(out + off + bj * HALF + n * 16) = bs * ALPHA + acc[ai][bj][m][n]; }
                asm volatile("" ::: "memory"); }
    }
};
struct EpiBf16 {
    static constexpr bool PERM = true;
    bf16_t* O; int ldc; const float* rs;
    __device__ __forceinline__ void operator()(const f32x4 (&acc)[2][2][4][2], const Unit& u, int wr, int wc, int fr, int fq) const {
        const int row0 = u.pm * BM + wr * 64 + fr, col0 = u.pn * BM + wc * 32 + 8 * fq;
#pragma unroll
        for (int ai = 0; ai < 2; ++ai)
#pragma unroll
            for (int m = 0; m < 4; ++m) { const int row = row0 + ai * HALF + m * 16; bf16_t* rowp = O + (size_t)row * ldc + col0; const float sc = rs ? rs[row] : 1.f;
#pragma unroll
                for (int bj = 0; bj < 2; ++bj) { const f32x4 v0 = acc[ai][bj][m][0] * sc, v1 = acc[ai][bj][m][1] * sc;
                    u32x4 wv; wv.x = cvt_pk_bf16(v0[0], v0[1]); wv.y = cvt_pk_bf16(v0[2], v0[3]); wv.z = cvt_pk_bf16(v1[0], v1[1]); wv.w = cvt_pk_bf16(v1[2], v1[3]);
                    *(u32x4*)(rowp + bj * HALF) = wv; } }
    }
};
template <class Epi, class Sched>
__device__ __forceinline__ void gemm_phase(LAS unsigned char* lds, const Gemm g, const Sched& S, const Epi& E) {
    const int tid = threadIdx.x, wid = __builtin_amdgcn_readfirstlane(tid >> 6), lane = tid & 63, wr = wid >> 2, wc = wid & 3, fr = lane & 15, fq = lane >> 4;
    const int K = g.K, nt = K / BK;
    unsigned voffA[2], voffB[2];
#pragma unroll
    for (int i = 0; i < 2; ++i) { int R, C; stage_rc(tid * 16 + i * 8192, R, C); const int Rb = Epi::PERM ? ((R & ~31) + perm32(R & 31)) : R;
        voffA[i] = (unsigned)(R * g.lda + C) * 2u; voffB[i] = (unsigned)(Rb * g.ldb + C) * 2u; }
    const size_t kstep = (size_t)(BK * 2);
    const size_t hA = (size_t)HALF * g.lda * 2, hB = (size_t)HALF * g.ldb * 2;
    const size_t tA = 2 * hA, tB = 2 * hB;
    const unsigned ldsw = (unsigned)wid * 1024u;
    const int aoff = lds_byte(wr * 64 + fr, fq * 8), boff = lds_byte(wc * 32 + fr, fq * 8);
#define PG8_SA(b, h) (((b) * 2 + (h)) * HTB)
#define PG8_SB(b, h) ((4 + (b) * 2 + (h)) * HTB)
#define PG8_STAGE(bufoff, gbase, voff) do { _Pragma("unroll") for (int _i = 0; _i < 2; ++_i) \
        __builtin_amdgcn_global_load_lds((const unsigned*)((const char*)(gbase) + (voff)[_i]), (LAS unsigned*)(lds + (bufoff) + ldsw + _i * 8192), 16, 0, 0); } while (0)
#define PG8_LDA(dst, b, h) do { _Pragma("unroll") for (int m = 0; m < 4; ++m) _Pragma("unroll") for (int k = 0; k < 2; ++k) dst[m][k] = *(const LAS bf16x8*)(lds + PG8_SA(b, h) + aoff + m * 2048 + k * 1024); } while (0)
#define PG8_LDB(dst, b, h) do { _Pragma("unroll") for (int n = 0; n < 2; ++n) _Pragma("unroll") for (int k = 0; k < 2; ++k) dst[n][k] = *(const LAS bf16x8*)(lds + PG8_SB(b, h) + boff + n * 2048 + k * 1024); } while (0)
#define PG8_MMA(ai, bj, At, Bt) do { __builtin_amdgcn_s_setprio(1); _Pragma("unroll") for (int m = 0; m < 4; ++m) _Pragma("unroll") for (int n = 0; n < 2; ++n) _Pragma("unroll") for (int k = 0; k < 2; ++k) \
        acc[ai][bj][m][n] = __builtin_amdgcn_mfma_f32_16x16x32_bf16(Bt[n][k], At[m][k], acc[ai][bj][m][n], 0, 0, 0); __builtin_amdgcn_s_setprio(0); } while (0)
#define PG8_WAIT_V(n) asm volatile("s_waitcnt vmcnt(" #n ")" ::: "memory")
#define PG8_WAIT_L(n) asm volatile("s_waitcnt lgkmcnt(" #n ")" ::: "memory")
#define PG8_BAR __builtin_amdgcn_s_barrier()
#define PG8_SCHED __builtin_amdgcn_sched_barrier(0)
    Unit cur, nxt; int ui = 0;
    if (!S.next(0, cur)) return;
    f32x4 acc[2][2][4][2];
#pragma unroll
    for (int a = 0; a < 2; ++a)
#pragma unroll
        for (int b = 0; b < 2; ++b)
#pragma unroll
            for (int m = 0; m < 4; ++m)
#pragma unroll
                for (int n = 0; n < 2; ++n) acc[a][b][m][n] = (f32x4){0.f, 0.f, 0.f, 0.f};
    bf16x8 At[4][2], B0[2][2], B1[2][2];
    const char* cA = (const char*)g.A + (size_t)cur.pm * tA + (size_t)cur.z * g.zA * 2; const char* cB = (const char*)g.Bt + (size_t)cur.pn * tB + (size_t)cur.z * g.zB * 2;
    PG8_STAGE(PG8_SB(0, 0), cB, voffB); PG8_STAGE(PG8_SA(0, 0), cA, voffA); PG8_STAGE(PG8_SB(0, 1), cB + hB, voffB); PG8_STAGE(PG8_SA(0, 1), cA + hA, voffA);
    if (wr == 1) PG8_BAR;
    PG8_WAIT_V(4); PG8_BAR;
    PG8_STAGE(PG8_SB(1, 0), cB + kstep, voffB); PG8_STAGE(PG8_SA(1, 0), cA + kstep, voffA); PG8_STAGE(PG8_SB(1, 1), cB + hB + kstep, voffB);
    PG8_WAIT_V(6); PG8_BAR;
    for (;;) {
        const bool has_next = S.next(ui + 1, nxt);
        const char* nA = has_next ? (const char*)g.A + (size_t)nxt.pm * tA + (size_t)nxt.z * g.zA * 2 : cA; const char* nB = has_next ? (const char*)g.Bt + (size_t)nxt.pn * tB + (size_t)nxt.z * g.zB * 2 : cB;
        for (int t = 0; t < nt; t += 2) {
            const bool last = (t == nt - 2);
            const char* a1 = cA + (size_t)(t + 1) * kstep;
            const char* a2 = last ? nA : cA + (size_t)(t + 2) * kstep; const char* b2 = last ? nB : cB + (size_t)(t + 2) * kstep;
            const char* a3 = a2 + kstep; const char* b3 = b2 + kstep;
            PG8_LDB(B0, 0, 0); PG8_SCHED; PG8_LDA(At, 0, 0); PG8_STAGE(PG8_SA(1, 1), a1 + hA, voffA);
            PG8_WAIT_L(8); PG8_BAR; PG8_WAIT_L(0); PG8_MMA(0, 0, At, B0); PG8_BAR; PG8_SCHED;
            PG8_LDB(B1, 0, 1); PG8_STAGE(PG8_SB(0, 0), b2, voffB);
            PG8_BAR; PG8_WAIT_L(0); PG8_MMA(0, 1, At, B1); PG8_BAR;
            PG8_LDA(At, 0, 1); PG8_STAGE(PG8_SA(0, 0), a2, voffA);
            PG8_BAR; PG8_WAIT_L(0); PG8_MMA(1, 0, At, B0); PG8_BAR; PG8_SCHED;
            PG8_STAGE(PG8_SB(0, 1), b2 + hB, voffB);
            PG8_WAIT_V(6); PG8_BAR; PG8_MMA(1, 1, At, B1); PG8_BAR;
            PG8_LDB(B0, 1, 0); PG8_SCHED; PG8_LDA(At, 1, 0); PG8_STAGE(PG8_SA(0, 1), a2 + hA, voffA);
            PG8_WAIT_L(8); PG8_BAR; PG8_WAIT_L(0); PG8_MMA(0, 0, At, B0); PG8_BAR; PG8_SCHED;
            PG8_LDB(B1, 1, 1); PG8_STAGE(PG8_SB(1, 0), b3, voffB);
            PG8_BAR; PG8_WAIT_L(0); PG8_MMA(0, 1, At, B1); PG8_BAR;
            PG8_LDA(At, 1, 1); PG8_STAGE(PG8_SA(1, 0), a3, voffA);
            PG8_BAR; PG8_WAIT_L(0); PG8_MMA(1, 0, At, B0); PG8_BAR; PG8_SCHED;
            PG8_STAGE(PG8_SB(1, 1), b3 + hB, voffB);
            PG8_WAIT_V(6); PG8_BAR; PG8_MMA(1, 1, At, B1); PG8_BAR;
        }
        E(acc, cur, wr, wc, fr, fq);
        if (!has_next) break;
#pragma unroll
        for (int a = 0; a < 2; ++a)
#pragma unroll
            for (int b = 0; b < 2; ++b)
#pragma unroll
                for (int m = 0; m < 4; ++m)
#pragma unroll
                    for (int n = 0; n < 2; ++n) acc[a][b][m][n] = (f32x4){0.f, 0.f, 0.f, 0.f};
        cur = nxt; cA = nA; cB = nB; ++ui;
    }
    PG8_WAIT_V(0);
    if (wr == 0) PG8_BAR;
    PG8_BAR;
#undef PG8_SA
#undef PG8_SB
#undef PG8_STAGE
#undef PG8_LDA
#undef PG8_LDB
#undef PG8_MMA
#undef PG8_WAIT_V
#undef PG8_WAIT_L
#undef PG8_BAR
#undef PG8_SCHED
}
}

struct Args { const float* in[21]; float* out; unsigned char* ws; int ph_lo, ph_hi; };
enum { I_X = 0, I_MEM, I_AB_W_IN, I_A_REL_BIAS, I_B_Q_NORM, I_B_W_UQ, I_B_KV_NORM, I_B_W_UKV, I_AB_W_OUT, I_CD_W_IN, I_D_FORGET_BIAS, I_CD_W_OUT,
       I_MEM_W_Q, I_MEM_W_KV, I_MEM_W_O, I_PEER_W_Q, I_PEER_SUB_KEYS, I_PEER_U, I_PEER_V, I_LN_G, I_LN_B };

struct WI { int tid, lane, wave, gw, ngw, bid, nblk; };

__device__ __forceinline__ void tr_item(const float* W, int K, int ld, int c0, int nc, bf16_t* WT, int r0, const float* scale, LAS float* scr, int item, int lane) {
    const int nblk = (nc + 31) >> 5, kb = item / nblk, nb = item - kb * nblk, k0 = 64 * kb, n0 = 32 * nb;
    const int nn = n0 + (lane & 31); const bool ok = nn < nc;
#pragma unroll 8
    for (int i = 0; i < 32; ++i) { const int kk = 2 * i + (lane >> 5); float v = ok ? W[(size_t)(k0 + kk) * ld + c0 + nn] : 0.f; if (scale) v *= scale[k0 + kk]; scr[kk * 33 + (lane & 31)] = v; }
    LDS_WAIT();
    const int c = lane & 7;
#pragma unroll
    for (int j = 0; j < 4; ++j) { const int n = (lane >> 3) + 8 * j; const LAS float* s = scr + (8 * c) * 33 + n;
        u32x4 o; o.x = pk2(s[0 * 33], s[1 * 33]); o.y = pk2(s[2 * 33], s[3 * 33]); o.z = pk2(s[4 * 33], s[5 * 33]); o.w = pk2(s[6 * 33], s[7 * 33]);
        if (n0 + n < nc) *(u32x4*)(WT + (size_t)(r0 + n0 + n) * K + k0 + 8 * c) = o; }
    LDS_WAIT();
}
__device__ __forceinline__ void cvt_rows(const float* src, bf16_t* dst, size_t n, size_t i0, size_t stride) {
    for (size_t i = i0 * 8; i < n; i += stride * 8) {
        const f32x4 a = *(const f32x4*)(src + i), b = *(const f32x4*)(src + i + 4);
        u32x4 o; o.x = pk2(a.x, a.y); o.y = pk2(a.z, a.w); o.z = pk2(b.x, b.y); o.w = pk2(b.z, b.w);
        *(u32x4*)(dst + i) = o;
    }
}
__device__ __forceinline__ void ph_convert(const Args& a, LAS unsigned char* lds, const WI& w) {
    unsigned char* ws = a.ws;
    LAS float* scr = (LAS float*)(lds + w.wave * 16384);
    constexpr int J1 = 64 * 258, J2 = 24 * 96, J3 = 8 * 128, J4 = 64 * 128, J5 = 64 * 160, J6 = 64 * 192, J7 = 64 * 3, J8 = 64 * 1, J9 = 64 * 128,
                  J10 = 64 * 16, J12 = 64 * 32, J14 = 8 * 128;
    constexpr int NJ = J1 + J2 + J3 + J4 + J5 + J6 + J7 + J8 + J9 + 2 * J10 + 2 * J12 + 2 * J14;
    for (int it = w.gw; it < NJ; it += w.ngw) {
        int r = it; const float* src; int K, ld, c0 = 0, nc, r0 = 0; bf16_t* dst; const float* sc = nullptr;
        if (r < J1) { src = a.in[I_AB_W_IN]; K = 4096; ld = AB_COLS; nc = AB_COLS; dst = (bf16_t*)(ws + WS_W_AB_IN); }
        else if ((r -= J1) < J2) { src = a.in[I_B_W_UQ]; K = 1536; ld = 3072; nc = 3072; dst = (bf16_t*)(ws + WS_W_UQ); sc = a.in[I_B_Q_NORM]; }
        else if ((r -= J2) < J3) { src = a.in[I_B_W_UKV]; K = 512; ld = 4096; nc = 4096; dst = (bf16_t*)(ws + WS_W_UKV); sc = a.in[I_B_KV_NORM]; }
        else if ((r -= J3) < J4) { src = a.in[I_AB_W_OUT]; K = 4096; ld = 4096; nc = 4096; dst = (bf16_t*)(ws + WS_W_AB_OUT); }
        else if ((r -= J4) < J5) { src = a.in[I_CD_W_IN]; K = 4096; ld = CD_COLS; c0 = 0; nc = 5120; r0 = 0; dst = (bf16_t*)(ws + WS_W_CD_IN); }
        else if ((r -= J5) < J6) { src = a.in[I_CD_W_IN]; K = 4096; ld = CD_COLS; c0 = 5216; nc = 6144; r0 = 5120; dst = (bf16_t*)(ws + WS_W_CD_IN); }
        else if ((r -= J6) < J7) { src = a.in[I_CD_W_IN]; K = 4096; ld = CD_COLS; c0 = 5120; nc = 96; r0 = 11264; dst = (bf16_t*)(ws + WS_W_CD_IN); }
        else if ((r -= J7) < J8) { src = a.in[I_CD_W_IN]; K = 4096; ld = CD_COLS; c0 = 11360; nc = 16; r0 = 11360; dst = (bf16_t*)(ws + WS_W_CD_IN); }
        else if ((r -= J8) < J9) { src = a.in[I_CD_W_OUT]; K = 4096; ld = 4096; nc = 4096; dst = (bf16_t*)(ws + WS_W_CD_OUT); }
        else if ((r -= J9) < 2 * J10) { const int l = r / J10; r -= l * J10; src = a.in[I_MEM_W_Q] + (size_t)l * 4096 * 512; K = 4096; ld = 512; nc = 512; dst = (bf16_t*)(ws + WS_W_MEM_Q) + (size_t)l * 512 * 4096; }
        else if ((r -= 2 * J10) < 2 * J12) { const int l = r / J12; r -= l * J12; src = a.in[I_MEM_W_KV] + (size_t)l * 4096 * 1024; K = 4096; ld = 1024; nc = 1024; dst = (bf16_t*)(ws + WS_W_MEM_KV) + (size_t)l * 1024 * 4096; }
        else { r -= 2 * J12; const int l = r / J14; r -= l * J14; src = a.in[I_MEM_W_O] + (size_t)l * 512 * 4096; K = 512; ld = 4096; nc = 4096; dst = (bf16_t*)(ws + WS_W_MEM_O) + (size_t)l * 4096 * 512; }
        tr_item(src, K, ld, c0, nc, dst, r0, sc, scr, r, w.lane);
    }
    { const size_t gt = (size_t)w.gw * 64 + w.lane, ng = (size_t)w.ngw * 64;
      bf16_t* p1 = (bf16_t*)(ws + WS_W_AB_IN) + (size_t)AB_COLS * 4096; const size_t n1 = (size_t)(AB_PAD - AB_COLS) * 4096;
      for (size_t i = gt * 8; i < n1; i += ng * 8) *(u32x4*)(p1 + i) = (u32x4){0u, 0u, 0u, 0u};
      bf16_t* p2 = (bf16_t*)(ws + WS_W_CD_IN) + (size_t)CD_COLS * 4096; const size_t n2 = (size_t)(CD_PAD - CD_COLS) * 4096;
      for (size_t i = gt * 8; i < n2; i += ng * 8) *(u32x4*)(p2 + i) = (u32x4){0u, 0u, 0u, 0u};
      cvt_rows(a.in[I_X], (bf16_t*)(ws + WS_XB), (size_t)T * DM, gt, ng);
      cvt_rows(a.in[I_MEM], (bf16_t*)(ws + WS_MEMB), (size_t)512 * DM, gt, ng);
      cvt_rows(a.in[I_PEER_U], (bf16_t*)(ws + WS_U16), (size_t)2 * 16384 * DM, gt, ng);
      cvt_rows(a.in[I_PEER_V], (bf16_t*)(ws + WS_V16), (size_t)2 * 16384 * DM, gt, ng);
      float* r128 = (float*)(ws + WS_ROPE128); float* r64 = (float*)(ws + WS_ROPE64);
      for (size_t i = gt; i < (size_t)SEQ * 96; i += ng) {
          const int s = (int)(i / 96), j = (int)(i % 96); const bool big = j < 64; const int ii = big ? j : j - 64;
          const double rr = big ? 0.8659643233600653 : 0.7498942093324559; double inv = 1.0;
          for (int q = 0; q < ii; ++q) inv *= rr;
          const double rev = (double)s * inv * 0.15915494309189535; const float fr = (float)(rev - rint(rev));
          const float cs = __builtin_amdgcn_cosf(fr), sn = __builtin_amdgcn_sinf(fr);
          float* o = big ? (r128 + ((size_t)s * 64 + ii) * 2) : (r64 + ((size_t)s * 32 + ii) * 2);
          o[0] = cs; o[1] = sn; }
    }
    {
        LAS float* Ks = (LAS float*)lds; LAS float* Ws = Ks + 128 * 129;
        const int tk = w.tid & 31, tn = w.tid >> 5;
        for (int it = w.bid; it < 2 * 16 * 32; it += w.nblk) {
            const int l = it >> 9, hp = (it >> 5) & 15, kb = it & 31;
            __syncthreads();
            const float* keys = a.in[I_PEER_SUB_KEYS] + ((size_t)(l * 16 + hp) * 128) * 128;
            const float* wq = a.in[I_PEER_W_Q] + ((size_t)l * 4096 + (size_t)kb * 128) * 2048 + hp * 128;
            for (int e = w.tid; e < 128 * 128; e += 512) { const int rrow = e >> 7, d = e & 127; Ks[rrow * 129 + d] = keys[(size_t)rrow * 128 + d]; Ws[rrow * 129 + d] = wq[(size_t)rrow * 2048 + d]; }
            __syncthreads();
            float acc[8][4];
#pragma unroll
            for (int x = 0; x < 8; ++x)
#pragma unroll
                for (int y = 0; y < 4; ++y) acc[x][y] = 0.f;
            for (int d = 0; d < 128; ++d) {
                float kv[8], wv[4];
#pragma unroll
                for (int x = 0; x < 8; ++x) kv[x] = Ks[(tn + 16 * x) * 129 + d];
#pragma unroll
                for (int y = 0; y < 4; ++y) wv[y] = Ws[(tk + 32 * y) * 129 + d];
#pragma unroll
                for (int x = 0; x < 8; ++x)
#pragma unroll
                    for (int y = 0; y < 4; ++y) acc[x][y] += kv[x] * wv[y];
            }
            bf16_t* dst = (bf16_t*)(ws + WS_W_PEER) + ((size_t)l * 2048 + hp * 128) * 4096 + kb * 128;
#pragma unroll
            for (int x = 0; x < 8; ++x)
#pragma unroll
                for (int y = 0; y < 4; ++y) dst[(size_t)(tn + 16 * x) * 4096 + tk + 32 * y] = (bf16_t)f2bf(acc[x][y]);
        }
        __syncthreads();
    }
}

__device__ __forceinline__ int crow(int r, int hi) { return (r & 3) + 8 * (r >> 2) + 4 * hi; }
template <class F>
__device__ __forceinline__ void naive_gemm(const bf16_t* A, int lda, const bf16_t* Bt, int ldb, int M, int N, int K, const WI& w, F epi) {
    const int tm = M >> 5, tn = (N + 31) >> 5;
    const int i = w.lane & 31, g = w.lane >> 5;
    for (int tile = w.gw; tile < tm * tn; tile += w.ngw) {
        const int bn = tile / tm, bm = tile - bn * tm;
        const bf16_t* ap = A + (size_t)(bm * 32 + i) * lda + 8 * g;
        const int nrow = bn * 32 + i; const bool nv = nrow < N;
        const bf16_t* bp = Bt + (size_t)(nv ? nrow : 0) * ldb + 8 * g;
        f32x16 acc = {};
#pragma unroll 4
        for (int k = 0; k < K; k += 16) {
            const bf16x8 av = *(const bf16x8*)(ap + k);
            bf16x8 bv = *(const bf16x8*)(bp + k);
            if (!nv) bv = (bf16x8){0, 0, 0, 0, 0, 0, 0, 0};
            acc = __builtin_amdgcn_mfma_f32_32x32x16_bf16(av, bv, acc, 0, 0, 0);
        }
#pragma unroll
        for (int r = 0; r < 16; ++r) { const int row = bm * 32 + crow(r, g), col = bn * 32 + i; if (col < N) epi(row, col, acc[r]); }
    }
}

__device__ __forceinline__ void ln_rows(const float* src, const float* g, const float* b, float* dstf, bf16_t* dstb, const WI& w) {
    for (int m = w.gw; m < T; m += w.ngw) {
        const f32x4* xr = (const f32x4*)(src + (size_t)m * DM) + w.lane;
        f32x4 v[16]; float s = 0.f;
#pragma unroll
        for (int j = 0; j < 16; ++j) { v[j] = xr[64 * j]; s += (v[j].x + v[j].y) + (v[j].z + v[j].w); }
        const float mean = wave_sum(s) * (1.f / DM); float s2 = 0.f;
#pragma unroll
        for (int j = 0; j < 16; ++j) { v[j] = v[j] - mean; s2 += (v[j].x * v[j].x + v[j].y * v[j].y) + (v[j].z * v[j].z + v[j].w * v[j].w); }
        const float rstd = 1.f / sqrtf(wave_sum(s2) * (1.f / DM) + LN_EPS);
#pragma unroll
        for (int j = 0; j < 16; ++j) {
            const int c = 4 * w.lane + 256 * j;
            const f32x4 gg = *(const f32x4*)(g + c), bb = *(const f32x4*)(b + c);
            const f32x4 o = v[j] * rstd * gg + bb;
            *(f32x4*)(dstf + (size_t)m * DM + c) = o;
            if (dstb) { u32x2 p; p.x = pk2(o.x, o.y); p.y = pk2(o.z, o.w); *(u32x2*)(dstb + (size_t)m * DM + c) = p; }
        }
    }
}

template <int MODE>
__device__ __forceinline__ void attn_naive(const Args& a, int layer, LAS float* qs, const WI& w) {
    constexpr int H = (MODE == 4) ? 4 : 16, DK = (MODE == 1) ? 192 : 128;
    const float scale = (MODE == 1) ? 0.07216878364870322f : 0.08838834764831845f;
    unsigned char* ws = a.ws;
    const float NEG = -__builtin_inff();
    for (int it = w.gw; it < T * H; it += w.ngw) {
        const int h = it / T, t = it - h * T, b = t / SEQ, sp = t - b * SEQ, c = sp >> 6;
        const bf16_t* qp; const bf16_t* kbase; const bf16_t* vbase; int ldk, ldv; bf16_t* op;
        int s_lo = 0, s_hi;
        if (MODE == 0) { const bf16_t* P = (const bf16_t*)(ws + WS_PROJ); qp = P + (size_t)t * AB_MAIN + h * 128; kbase = P + (size_t)b * SEQ * AB_MAIN + 2048 + h * 128; vbase = kbase + 2048; ldk = ldv = AB_MAIN;
            op = (bf16_t*)(ws + WS_ATT) + (size_t)t * DM + h * 128; s_lo = (c - 8) * 64; if (s_lo < 0) s_lo = 0; s_hi = (c + 1) * 64; }
        else if (MODE == 1) { qp = (const bf16_t*)(ws + WS_QB) + (size_t)t * 3072 + h * 192; kbase = (const bf16_t*)(ws + WS_KVB) + (size_t)b * SEQ * 4096 + h * 256; vbase = kbase + 128; ldk = ldv = 4096;
            op = (bf16_t*)(ws + WS_ATT) + (size_t)t * DM + 2048 + h * 128; s_hi = (c + 1) * 64; }
        else if (MODE == 2) { const bf16_t* P = (const bf16_t*)(ws + WS_PROJ); qp = P + (size_t)t * CD_MAIN + h * 128; kbase = P + (size_t)b * SEQ * CD_MAIN + 2048 + (h >> 2) * 128; vbase = kbase + 512; ldk = ldv = CD_MAIN;
            op = (bf16_t*)(ws + WS_ATT) + (size_t)t * DM + h * 128; s_hi = (c + 1) * 64; }
        else if (MODE == 3) { const bf16_t* P = (const bf16_t*)(ws + WS_PROJ); qp = P + (size_t)t * CD_MAIN + 5120 + h * 128; kbase = P + (size_t)b * SEQ * CD_MAIN + 7168 + h * 128; vbase = kbase + 2048; ldk = ldv = CD_MAIN;
            op = (bf16_t*)(ws + WS_ATT) + (size_t)t * DM + 2048 + h * 128; s_hi = sp + 1; }
        else { qp = (const bf16_t*)(ws + WS_MEMQ) + (size_t)t * 512 + h * 128; kbase = (const bf16_t*)(ws + WS_KVM) + ((size_t)layer * 512 + b * 256) * 1024 + h * 128; vbase = kbase + 512; ldk = ldv = 1024;
            op = (bf16_t*)(ws + WS_MEMO) + (size_t)t * 512 + h * 128; s_hi = 256; }
        LDS_WAIT();
        if (MODE == 4) { const float* mq = (const float*)(ws + WS_MQP) + (size_t)t * 512 + h * 128;
            for (int d = w.lane; d < DK; d += 64) qs[d] = bf2f((bf16_t)f2bf((mq[d] + mq[d + (size_t)T * 512]) + (mq[d + (size_t)2 * T * 512] + mq[d + (size_t)3 * T * 512]))); }
        else for (int d = w.lane; d < DK; d += 64) qs[d] = bf2f(qp[d]);
        LDS_WAIT();
        const float* cum = (const float*)(ws + WS_CUM) + ((size_t)b * 16 + h) * SEQ;
        const float ct = (MODE == 3) ? cum[sp] : 0.f;
        const float* relb = a.in[I_A_REL_BIAS] + h * 513;
        const unsigned* mrow = (const unsigned*)(ws + WS_MASK) + (size_t)t * 128;
        float m = NEG, l = 0.f, o0 = 0.f, o1 = 0.f;
        for (int s0 = s_lo; s0 < s_hi; s0 += 64) {
            const int s = s0 + w.lane; bool valid = s < s_hi;
            if (MODE == 2) { if (valid) valid = (mrow[s >> 5] >> (s & 31)) & 1u; }
            float x = NEG;
            if (valid) {
                const bf16_t* kp = kbase + (size_t)s * ldk; float acc = 0.f;
#pragma unroll 4
                for (int d0 = 0; d0 < 128; d0 += 8) { const bf16x8 kv = *(const bf16x8*)(kp + d0);
#pragma unroll
                    for (int e = 0; e < 8; ++e) acc += qs[d0 + e] * bf2f((bf16_t)kv[e]); }
                if (MODE == 1) { const bf16_t* kr = (const bf16_t*)(ws + WS_KR) + ((size_t)b * SEQ + s) * 64;
#pragma unroll 4
                    for (int d0 = 0; d0 < 64; d0 += 8) { const bf16x8 kv = *(const bf16x8*)(kr + d0);
#pragma unroll
                        for (int e = 0; e < 8; ++e) acc += qs[128 + d0 + e] * bf2f((bf16_t)kv[e]); } }
                x = acc * scale;
                if (MODE == 0) { int rel = sp - s; rel = rel < -256 ? -256 : (rel > 256 ? 256 : rel); x += relb[rel + 256]; }
                if (MODE == 3) x += ct - cum[s];
            }
            const float mx = wave_max(x);
            if (mx == NEG) continue;
            const float mn = fmaxf(m, mx); const float p = valid ? __expf(x - mn) : 0.f; const float al = __expf(m - mn);
            l = l * al + wave_sum(p); o0 *= al; o1 *= al; m = mn;
            for (int j = 0; j < 64; ++j) { const float pj = __shfl(p, j);
                if (pj != 0.f) { const bf16_t* vp = vbase + (size_t)(s0 + j) * ldv; o0 += pj * bf2f(vp[w.lane]); o1 += pj * bf2f(vp[w.lane + 64]); } }
        }
        const float rl = 1.f / l;
        op[w.lane] = (bf16_t)f2bf(o0 * rl); op[w.lane + 64] = (bf16_t)f2bf(o1 * rl);
    }
}

__device__ __forceinline__ void rope_pair(float& x1, float& x2, float cs, float sn) { const float a = x1 * cs - x2 * sn, b = x2 * cs + x1 * sn; x1 = a; x2 = b; }
__device__ __forceinline__ void ph_l0_stats(const Args& a, const WI& w) {
    unsigned char* ws = a.ws; const bf16_t* P = (const bf16_t*)(ws + WS_PROJ);
    const float* r64 = (const float*)(ws + WS_ROPE64);
    for (int t = w.gw; t < T; t += w.ngw) {
        const bf16_t* row = P + (size_t)t * AB_MAIN;
        float s = 0.f;
        for (int j = 0; j < 3; ++j) { const bf16x8 v = *(const bf16x8*)(row + 6144 + (j * 64 + w.lane) * 8);
#pragma unroll
            for (int e = 0; e < 8; ++e) { const float f = bf2f((bf16_t)v[e]); s += f * f; } }
        s = wave_sum(s);
        float s2 = 0.f; { const bf16x8 v = *(const bf16x8*)(row + 7680 + w.lane * 8);
#pragma unroll
            for (int e = 0; e < 8; ++e) { const float f = bf2f((bf16_t)v[e]); s2 += f * f; } }
        s2 = wave_sum(s2);
        if (w.lane == 0) { ((float*)(ws + WS_RSQ))[t] = 1.f / sqrtf(s * (1.f / 1536.f) + RMS_EPS); ((float*)(ws + WS_RSKV))[t] = 1.f / sqrtf(s2 * (1.f / 512.f) + RMS_EPS); }
        if (w.lane < 32) { const float* sm = (const float*)(ws + WS_SMALL) + (size_t)t * 128; const int sp = t & (SEQ - 1);
            float x1 = sm[w.lane], x2 = sm[w.lane + 32]; const float cs = r64[((size_t)sp * 32 + w.lane) * 2], sn = r64[((size_t)sp * 32 + w.lane) * 2 + 1];
            rope_pair(x1, x2, cs, sn);
            bf16_t* kr = (bf16_t*)(ws + WS_KR) + (size_t)t * 64; kr[w.lane] = (bf16_t)f2bf(x1); kr[w.lane + 32] = (bf16_t)f2bf(x2); }
    }
}
__device__ __forceinline__ void ph_l0_qrope(const Args& a, const WI& w) {
    unsigned char* ws = a.ws; bf16_t* Q = (bf16_t*)(ws + WS_QB); const float* r64 = (const float*)(ws + WS_ROPE64);
    for (int t = w.gw; t < T; t += w.ngw) {
        const int sp = t & (SEQ - 1);
        for (int e = w.lane; e < 16 * 32; e += 64) { const int h = e >> 5, i = e & 31; bf16_t* q = Q + (size_t)t * 3072 + h * 192 + 128;
            float x1 = bf2f(q[i]), x2 = bf2f(q[i + 32]); rope_pair(x1, x2, r64[((size_t)sp * 32 + i) * 2], r64[((size_t)sp * 32 + i) * 2 + 1]);
            q[i] = (bf16_t)f2bf(x1); q[i + 32] = (bf16_t)f2bf(x2); }
    }
}
__device__ __forceinline__ void ph_l1_elem(const Args& a, const WI& w) {
    unsigned char* ws = a.ws; bf16_t* P = (bf16_t*)(ws + WS_PROJ);
    const float* r128 = (const float*)(ws + WS_ROPE128); const float* r64 = (const float*)(ws + WS_ROPE64);
    for (int t = w.gw; t < T; t += w.ngw) {
        const int b = t / SEQ, sp = t - b * SEQ; bf16_t* row = P + (size_t)t * CD_MAIN;
        for (int e = w.lane; e < 20 * 64; e += 64) { const int h = e >> 6, i = e & 63; bf16_t* q = row + h * 128;
            float x1 = bf2f(q[i]), x2 = bf2f(q[i + 64]); rope_pair(x1, x2, r128[((size_t)sp * 64 + i) * 2], r128[((size_t)sp * 64 + i) * 2 + 1]);
            q[i] = (bf16_t)f2bf(x1); q[i + 64] = (bf16_t)f2bf(x2); }
        for (int e = w.lane; e < 32 * 32; e += 64) { const int h = e >> 5, i = e & 31; bf16_t* q = row + 3072 + h * 64;
            float x1 = bf2f(q[i]), x2 = bf2f(q[i + 32]); rope_pair(x1, x2, r64[((size_t)sp * 32 + i) * 2], r64[((size_t)sp * 32 + i) * 2 + 1]);
            q[i] = (bf16_t)f2bf(x1); q[i + 32] = (bf16_t)f2bf(x2); }
        const float* sm = (const float*)(ws + WS_SMALL) + (size_t)t * 128;
        if (w.lane < 32) { float x1 = sm[w.lane], x2 = sm[w.lane + 32]; rope_pair(x1, x2, r64[((size_t)sp * 32 + w.lane) * 2], r64[((size_t)sp * 32 + w.lane) * 2 + 1]);
            bf16_t* ki = (bf16_t*)(ws + WS_KI) + (size_t)t * 64; ki[w.lane] = (bf16_t)f2bf(x1); ki[w.lane + 32] = (bf16_t)f2bf(x2);
            ((float*)(ws + WS_WI))[(size_t)t * 32 + w.lane] = sm[64 + w.lane] * 0.17677669529663687f; }
        if (w.lane < 16) { const float z = sm[96 + w.lane] + a.in[I_D_FORGET_BIAS][w.lane];
            const float lf = fminf(z, 0.f) - log1pf(__expf(-fabsf(z)));
            ((float*)(ws + WS_LOGF))[((size_t)b * 16 + w.lane) * SEQ + sp] = lf; }
    }
}
__device__ __forceinline__ void ph_l1_scan(const Args& a, const WI& w) {
    unsigned char* ws = a.ws;
    for (int it = w.gw; it < NB * 16; it += w.ngw) {
        const float* src = (const float*)(ws + WS_LOGF) + (size_t)it * SEQ + w.lane * 64; float* dst = (float*)(ws + WS_CUM) + (size_t)it * SEQ + w.lane * 64;
        float tot = 0.f; for (int j = 0; j < 64; ++j) tot += src[j];
        float inc = tot;
#pragma unroll
        for (int o = 1; o < 64; o <<= 1) { const float v = __shfl_up(inc, o); if (w.lane >= o) inc += v; }
        float run = inc - tot;
        for (int j = 0; j < 64; ++j) { run += src[j]; dst[j] = run; }
    }
}
__device__ __forceinline__ void ph_l1_index_naive(const Args& a, LAS float* qs  , const WI& w) {
    unsigned char* ws = a.ws; const bf16_t* P = (const bf16_t*)(ws + WS_PROJ); const bf16_t* KI = (const bf16_t*)(ws + WS_KI);
    const float* WIp = (const float*)(ws + WS_WI); float* SC = (float*)(ws + WS_SCORE);
    for (int t = w.gw; t < T; t += w.ngw) {
        const int b = t / SEQ, sp = t - b * SEQ, nadm = ((sp >> 6) + 1) * 64;
        LDS_WAIT();
        for (int e = w.lane; e < 2048; e += 64) qs[e] = bf2f(P[(size_t)t * CD_MAIN + 3072 + e]);
        if (w.lane < 32) qs[2048 + w.lane] = WIp[(size_t)t * 32 + w.lane];
        LDS_WAIT();
        for (int s0 = 0; s0 < nadm; s0 += 64) {
            const int s = s0 + w.lane; const bf16_t* kp = KI + ((size_t)b * SEQ + s) * 64;
            float k[64];
#pragma unroll
            for (int d0 = 0; d0 < 64; d0 += 8) { const bf16x8 kv = *(const bf16x8*)(kp + d0);
#pragma unroll
                for (int e = 0; e < 8; ++e) k[d0 + e] = bf2f((bf16_t)kv[e]); }
            float sc = 0.f;
            for (int h = 0; h < 32; ++h) { float dot = 0.f;
#pragma unroll
                for (int d = 0; d < 64; ++d) dot += qs[h * 64 + d] * k[d];
                sc += qs[2048 + h] * fmaxf(dot * 0.125f, 0.f); }
            SC[((size_t)b * SEQ + sp) * SEQ + s] = sc;
        }
    }
}
__device__ __forceinline__ void ph_l1_select(const Args& a, const WI& w) {
    unsigned char* ws = a.ws; const float* SC = (const float*)(ws + WS_SCORE); unsigned* MK = (unsigned*)(ws + WS_MASK);
    for (int t = w.gw; t < T; t += w.ngw) {
        const int b = t / SEQ, sp = t - b * SEQ, nblk = (sp >> 6) + 1;
        const float* row = SC + ((size_t)b * SEQ + sp) * SEQ;
        unsigned key[64];
#pragma unroll
        for (int j = 0; j < 64; ++j) { unsigned u = 0u; if (j < nblk) { u = __float_as_uint(row[j * 64 + w.lane]); u ^= (u >> 31) ? 0xFFFFFFFFu : 0x80000000u; } key[j] = u; }
        unsigned thr = 0u;
        if (nblk > 4) {
            for (int bit = 31; bit >= 0; --bit) { const unsigned cand = thr | (1u << bit); int cnt = 0;
#pragma unroll
                for (int j = 0; j < 64; ++j) cnt += (key[j] >= cand) ? 1 : 0;
                cnt = wave_sum_i(cnt); if (cnt >= 256) thr = cand; }
        }
        unsigned lo = 0u, hi = 0u;
#pragma unroll
        for (int j = 0; j < 64; ++j) { const bool sel = (j < nblk) && (key[j] >= thr); const unsigned long long bal = __ballot(sel); if (w.lane == j) { lo = (unsigned)bal; hi = (unsigned)(bal >> 32); } }
        *(u32x2*)(MK + (size_t)t * 128 + 2 * w.lane) = (u32x2){lo, hi};
    }
}

__device__ __forceinline__ void ph_peer_topk(const Args& a, const WI& w) {
    unsigned char* ws = a.ws; const float* PS = (const float*)(ws + WS_PSCORE); int* PIDX = (int*)(ws + WS_PIDX); float* PG = (float*)(ws + WS_PGATE);
    const float NEG = -__builtin_inff();
    for (int t = w.gw; t < T; t += w.ngw) {
        for (int h = 0; h < 8; ++h) {
            const float* s = PS + (size_t)t * 2048 + h * 256;
            float ts[2]; int ti[2];
#pragma unroll
            for (int p = 0; p < 2; ++p) {
                float v0 = s[p * 128 + w.lane], v1 = s[p * 128 + 64 + w.lane]; float mys = NEG; int myi = 0;
                for (int k = 0; k < 16; ++k) {
                    const float m = wave_max(fmaxf(v0, v1));
                    const unsigned long long b0 = __ballot(v0 == m); int idx;
                    if (b0) { const int src = __ffsll((long long)b0) - 1; idx = src; if (w.lane == src) v0 = NEG; }
                    else { const unsigned long long b1 = __ballot(v1 == m); const int src = __ffsll((long long)b1) - 1; idx = src + 64; if (w.lane == src) v1 = NEG; }
                    if (w.lane == k) { mys = m; myi = idx; }
                }
                ts[p] = mys; ti[p] = myi;
            }
            float cv[4];
#pragma unroll
            for (int q = 0; q < 4; ++q) { const int c = w.lane + 64 * q; cv[q] = __shfl(ts[0], c >> 4) + __shfl(ts[1], c & 15); }
            float bs = NEG; int bc = 0;
            for (int k = 0; k < 16; ++k) {
                const float m = wave_max(fmaxf(fmaxf(cv[0], cv[1]), fmaxf(cv[2], cv[3])));
                int cidx = -1;
#pragma unroll
                for (int q = 0; q < 4; ++q) { if (cidx < 0) { const unsigned long long bb = __ballot(cv[q] == m); if (bb) { const int src = __ffsll((long long)bb) - 1; cidx = src + 64 * q; if (w.lane == src) cv[q] = NEG; } } }
                if (w.lane == k) { bs = m; bc = cidx; }
            }
            const int e0 = __shfl(ti[0], bc >> 4), e1 = __shfl(ti[1], bc & 15);
            const float top = __shfl(bs, 0);
            const float ex = (w.lane < 16) ? __expf(bs - top) : 0.f;
            const float den = wave_sum(ex);
            if (w.lane < 16) { PIDX[(size_t)t * 128 + h * 16 + w.lane] = e0 * 128 + e1; PG[(size_t)t * 128 + h * 16 + w.lane] = ex / den; }
        }
    }
}
__device__ __forceinline__ void ph_peer_experts(const Args& a, int layer, float* outf, bf16_t* outb, const float* g, const float* bta, LAS float* wsm  , const WI& w) {
    unsigned char* ws = a.ws; const bf16_t* XB = (const bf16_t*)(ws + WS_XB); const float* HF = (const float*)(ws + WS_HF);
    const bf16_t* U = (const bf16_t*)(ws + WS_U16) + (size_t)layer * 16384 * DM; const bf16_t* V = (const bf16_t*)(ws + WS_V16) + (size_t)layer * 16384 * DM;
    const int* PIDX = (const int*)(ws + WS_PIDX); const float* PG = (const float*)(ws + WS_PGATE);
    for (int t = w.gw; t < T; t += w.ngw) {
        u32x4 xr[8];
#pragma unroll
        for (int j = 0; j < 8; ++j) xr[j] = *(const u32x4*)(XB + (size_t)t * DM + 512 * j + 8 * w.lane);
        LDS_WAIT();
        for (int k0 = 0; k0 < 128; k0 += 4) {
            float z[4];
#pragma unroll
            for (int q = 0; q < 4; ++q) {
                const int e = __builtin_amdgcn_readfirstlane(PIDX[(size_t)t * 128 + k0 + q]);
                const bf16_t* ur = U + (size_t)e * DM + 8 * w.lane; float acc = 0.f;
#pragma unroll
                for (int j = 0; j < 8; ++j) { const u32x4 uv = *(const u32x4*)(ur + 512 * j);
                    acc += __uint_as_float(uv.x << 16) * __uint_as_float(xr[j].x << 16) + __uint_as_float(uv.x & 0xffff0000u) * __uint_as_float(xr[j].x & 0xffff0000u);
                    acc += __uint_as_float(uv.y << 16) * __uint_as_float(xr[j].y << 16) + __uint_as_float(uv.y & 0xffff0000u) * __uint_as_float(xr[j].y & 0xffff0000u);
                    acc += __uint_as_float(uv.z << 16) * __uint_as_float(xr[j].z << 16) + __uint_as_float(uv.z & 0xffff0000u) * __uint_as_float(xr[j].z & 0xffff0000u);
                    acc += __uint_as_float(uv.w << 16) * __uint_as_float(xr[j].w << 16) + __uint_as_float(uv.w & 0xffff0000u) * __uint_as_float(xr[j].w & 0xffff0000u); }
                z[q] = acc;
            }
#pragma unroll
            for (int q = 0; q < 4; ++q) z[q] = wave_sum(z[q]);
            if (w.lane < 4) { const float zz = (w.lane == 0) ? z[0] : (w.lane == 1) ? z[1] : (w.lane == 2) ? z[2] : z[3];
                const float act = 0.5f * zz * (1.f + erff(zz * 0.70710678118654752f));
                wsm[k0 + w.lane] = act * PG[(size_t)t * 128 + k0 + w.lane]; }
        }
        LDS_WAIT();
        float y[64];
#pragma unroll
        for (int i = 0; i < 64; ++i) y[i] = 0.f;
        for (int k0 = 0; k0 < 128; k0 += 2) {
#pragma unroll
            for (int q = 0; q < 2; ++q) {
                const int e = __builtin_amdgcn_readfirstlane(PIDX[(size_t)t * 128 + k0 + q]); const float wt = wsm[k0 + q];
                const bf16_t* vr = V + (size_t)e * DM + 8 * w.lane;
#pragma unroll
                for (int j = 0; j < 8; ++j) { const u32x4 vv = *(const u32x4*)(vr + 512 * j);
                    y[8 * j + 0] += wt * __uint_as_float(vv.x << 16); y[8 * j + 1] += wt * __uint_as_float(vv.x & 0xffff0000u);
                    y[8 * j + 2] += wt * __uint_as_float(vv.y << 16); y[8 * j + 3] += wt * __uint_as_float(vv.y & 0xffff0000u);
                    y[8 * j + 4] += wt * __uint_as_float(vv.z << 16); y[8 * j + 5] += wt * __uint_as_float(vv.z & 0xffff0000u);
                    y[8 * j + 6] += wt * __uint_as_float(vv.w << 16); y[8 * j + 7] += wt * __uint_as_float(vv.w & 0xffff0000u); }
            }
        }
        float s = 0.f;
#pragma unroll
        for (int j = 0; j < 8; ++j) { const float* hp = HF + (size_t)t * DM + 512 * j + 8 * w.lane; const f32x4 h0 = *(const f32x4*)hp, h1 = *(const f32x4*)(hp + 4);
            y[8 * j + 0] += ALPHA * h0.x; y[8 * j + 1] += ALPHA * h0.y; y[8 * j + 2] += ALPHA * h0.z; y[8 * j + 3] += ALPHA * h0.w;
            y[8 * j + 4] += ALPHA * h1.x; y[8 * j + 5] += ALPHA * h1.y; y[8 * j + 6] += ALPHA * h1.z; y[8 * j + 7] += ALPHA * h1.w; }
#pragma unroll
        for (int i = 0; i < 64; ++i) s += y[i];
        const float mean = wave_sum(s) * (1.f / DM); float s2 = 0.f;
#pragma unroll
        for (int i = 0; i < 64; ++i) { y[i] -= mean; s2 += y[i] * y[i]; }
        const float rstd = 1.f / sqrtf(wave_sum(s2) * (1.f / DM) + LN_EPS);
#pragma unroll
        for (int j = 0; j < 8; ++j) { const int c = 512 * j + 8 * w.lane;
            const f32x4 g0 = *(const f32x4*)(g + c), g1 = *(const f32x4*)(g + c + 4), b0 = *(const f32x4*)(bta + c), b1 = *(const f32x4*)(bta + c + 4);
            f32x4 o0, o1;
            o0.x = y[8 * j + 0] * rstd * g0.x + b0.x; o0.y = y[8 * j + 1] * rstd * g0.y + b0.y; o0.z = y[8 * j + 2] * rstd * g0.z + b0.z; o0.w = y[8 * j + 3] * rstd * g0.w + b0.w;
            o1.x = y[8 * j + 4] * rstd * g1.x + b1.x; o1.y = y[8 * j + 5] * rstd * g1.y + b1.y; o1.z = y[8 * j + 6] * rstd * g1.z + b1.z; o1.w = y[8 * j + 7] * rstd * g1.w + b1.w;
            *(f32x4*)(outf + (size_t)t * DM + c) = o0; *(f32x4*)(outf + (size_t)t * DM + c + 4) = o1;
            if (outb) { u32x4 p; p.x = pk2(o0.x, o0.y); p.y = pk2(o0.z, o0.w); p.z = pk2(o1.x, o1.y); p.w = pk2(o1.z, o1.w); *(u32x4*)(outb + (size_t)t * DM + c) = p; } }
    }
}

__global__ void __launch_bounds__(512, 2) mega(Args a) {
    extern __shared__ __attribute__((aligned(16))) unsigned char lds_raw[];
    LAS unsigned char* lds = (LAS unsigned char*)lds_raw;
    WI w; w.tid = threadIdx.x; w.lane = w.tid & 63; w.wave = __builtin_amdgcn_readfirstlane(w.tid >> 6);
    w.bid = blockIdx.x; w.nblk = gridDim.x; w.gw = w.bid * 8 + w.wave; w.ngw = w.nblk * 8;
    unsigned char* ws = a.ws;
    volatile LAS unsigned* misc = (volatile LAS unsigned*)(lds + LDS_MISC);
    if (w.tid < 4) misc[w.tid] = 0u;
    __syncthreads();
    XcdBarrier bar; bar.bar = (unsigned*)(ws + WS_CTL) + 4096; bar.x = 0; bar.st = misc;
#if !MK_PER_PHASE
    bar = xcd_barrier_post((unsigned*)(ws + WS_CTL) + 4096, misc);
#endif
    const int lo = a.ph_lo, hi = a.ph_hi;
#define IN(k) (lo <= (k) && (k) < hi)
#if MK_PER_PHASE
#define SEAM(k) do { } while (0)
#else
#define SEAM(k) do { if (IN(k) && IN((k) + 1)) xcd_barrier(bar); } while (0)
#endif
    LAS float* wlds = (LAS float*)(lds + w.wave * 16384);
    bf16_t* XB = (bf16_t*)(ws + WS_XB); float* HF = (float*)(ws + WS_HF); float* RES = (float*)(ws + WS_RES); bf16_t* PROJ = (bf16_t*)(ws + WS_PROJ);
    bf16_t* ATT = (bf16_t*)(ws + WS_ATT); float* SMALL = (float*)(ws + WS_SMALL);

#define FAST_GEMM(EPI_T, Aptr, lda_, Btptr, ldb_, M_, N_, K_, nz_, zA_, zB_, EPI_OBJ) do { \
        pg8::Gemm g_{Aptr, Btptr, M_, N_, K_, lda_, ldb_, zA_, zB_, nz_}; pg8::StaticOrder S_; S_.init(M_, N_, nz_, w.nblk, w.bid); \
        pg8::gemm_phase<EPI_T, pg8::StaticOrder>(lds, g_, S_, EPI_OBJ); } while (0)
    if (IN(0)) ph_convert(a, lds, w);
    SEAM(0);
    if (IN(1)) {
        FAST_GEMM(pg8::EpiBf16, XB, DM, (const bf16_t*)(ws + WS_W_AB_IN), DM, T, AB_MAIN, DM, 1, 0, 0, (pg8::EpiBf16{PROJ, AB_MAIN, nullptr}));
        naive_gemm(XB, DM, (const bf16_t*)(ws + WS_W_AB_IN) + (size_t)AB_MAIN * DM, DM, T, 64, DM, w, [=](int m, int n, float v) { SMALL[(size_t)m * 128 + n] = v; });
        bf16_t* KVM = (bf16_t*)(ws + WS_KVM);
        naive_gemm((const bf16_t*)(ws + WS_MEMB), DM, (const bf16_t*)(ws + WS_W_MEM_KV), DM, 512, 2048, DM, w,
                   [=](int m, int n, float v) { KVM[((size_t)(n >> 10) * 512 + m) * 1024 + (n & 1023)] = (bf16_t)f2bf(v); });
    }
    SEAM(1);
    if (IN(2)) ph_l0_stats(a, w);
    SEAM(2);
    if (IN(3)) {
        const float* rsq = (const float*)(ws + WS_RSQ); const float* rskv = (const float*)(ws + WS_RSKV);
        bf16_t* QB = (bf16_t*)(ws + WS_QB); bf16_t* KVB = (bf16_t*)(ws + WS_KVB);
        FAST_GEMM(pg8::EpiBf16, PROJ + 6144, AB_MAIN, (const bf16_t*)(ws + WS_W_UQ), 1536, T, 3072, 1536, 1, 0, 0, (pg8::EpiBf16{QB, 3072, rsq}));
        FAST_GEMM(pg8::EpiBf16, PROJ + 7680, AB_MAIN, (const bf16_t*)(ws + WS_W_UKV), 512, T, 4096, 512, 1, 0, 0, (pg8::EpiBf16{KVB, 4096, rskv}));
    }
    SEAM(3);
    if (IN(4)) ph_l0_qrope(a, w);
    SEAM(4);
    if (IN(5)) { attn_naive<0>(a, 0, wlds, w); attn_naive<1>(a, 0, wlds, w); }
    SEAM(5);
    if (IN(6)) { const float* X = a.in[I_X];
        FAST_GEMM(pg8::EpiResid, ATT, DM, (const bf16_t*)(ws + WS_W_AB_OUT), DM, T, DM, DM, 1, 0, 0, (pg8::EpiResid{X, RES, DM})); }
    SEAM(6);
    if (IN(7)) ln_rows(RES, a.in[I_LN_G] + 0 * DM, a.in[I_LN_B] + 0 * DM, HF, XB, w);
    SEAM(7);

#define MEM_PEER_PHASES(L, P0_, LAST)                                                                                                                         \
    if (IN(P0_)) { FAST_GEMM(pg8::EpiF32, XB, DM, (const bf16_t*)(ws + WS_W_MEM_Q) + (size_t)(L) * 512 * DM, DM, T, 512, 1024, 4, 1024, 1024,                    \
                             (pg8::EpiF32{(float*)(ws + WS_MQP), 512, (long)T * 512})); }                                                                       \
    SEAM(P0_);                                                                                                                                                  \
    if (IN(P0_ + 1)) attn_naive<4>(a, (L), wlds, w);                                                                                                            \
    SEAM(P0_ + 1);                                                                                                                                              \
    if (IN(P0_ + 2)) { FAST_GEMM(pg8::EpiResid, (const bf16_t*)(ws + WS_MEMO), 512, (const bf16_t*)(ws + WS_W_MEM_O) + (size_t)(L) * DM * 512, 512, T, DM, 512, 1, 0, 0, \
                                 (pg8::EpiResid{HF, RES, DM})); }                                                                                               \
    SEAM(P0_ + 2);                                                                                                                                              \
    if (IN(P0_ + 3)) ln_rows(RES, a.in[I_LN_G] + ((L) * 3 + 1) * DM, a.in[I_LN_B] + ((L) * 3 + 1) * DM, HF, XB, w);                                             \
    SEAM(P0_ + 3);                                                                                                                                              \
    if (IN(P0_ + 4)) { FAST_GEMM(pg8::EpiF32, XB, DM, (const bf16_t*)(ws + WS_W_PEER) + (size_t)(L) * 2048 * DM, DM, T, 2048, DM, 1, 0, 0,                     \
                                 (pg8::EpiF32{(float*)(ws + WS_PSCORE), 2048, 0})); }                                                                           \
    SEAM(P0_ + 4);                                                                                                                                              \
    if (IN(P0_ + 5)) ph_peer_topk(a, w);                                                                                                                        \
    SEAM(P0_ + 5);                                                                                                                                              \
    if (IN(P0_ + 6)) ph_peer_experts(a, (L), (LAST) ? a.out : HF, (LAST) ? (bf16_t*)nullptr : XB, a.in[I_LN_G] + ((L) * 3 + 2) * DM, a.in[I_LN_B] + ((L) * 3 + 2) * DM, wlds, w); \
    if (!(LAST)) SEAM(P0_ + 6);

    MEM_PEER_PHASES(0, 8, false)

    if (IN(15)) {
        FAST_GEMM(pg8::EpiBf16, XB, DM, (const bf16_t*)(ws + WS_W_CD_IN), DM, T, CD_MAIN, DM, 1, 0, 0, (pg8::EpiBf16{PROJ, CD_MAIN, nullptr}));
        naive_gemm(XB, DM, (const bf16_t*)(ws + WS_W_CD_IN) + (size_t)CD_MAIN * DM, DM, T, 112, DM, w, [=](int m, int n, float v) { SMALL[(size_t)m * 128 + n] = v; });
    }
    SEAM(15);
    if (IN(16)) ph_l1_elem(a, w);
    SEAM(16);
    if (IN(17)) { ph_l1_scan(a, w); ph_l1_index_naive(a, wlds, w); }
    SEAM(17);
    if (IN(18)) ph_l1_select(a, w);
    SEAM(18);
    if (IN(19)) { attn_naive<2>(a, 1, wlds, w); attn_naive<3>(a, 1, wlds, w); }
    SEAM(19);
    if (IN(20)) { FAST_GEMM(pg8::EpiResid, ATT, DM, (const bf16_t*)(ws + WS_W_CD_OUT), DM, T, DM, DM, 1, 0, 0, (pg8::EpiResid{HF, RES, DM})); }
    SEAM(20);
    if (IN(21)) ln_rows(RES, a.in[I_LN_G] + 3 * DM, a.in[I_LN_B] + 3 * DM, HF, XB, w);
    SEAM(21);
    MEM_PEER_PHASES(1, 22, true)
#undef IN
#undef SEAM
}

extern "C" void kernel_launch(void* const* d_in, const int* in_sizes, int n_in, void* d_out, int out_size, void* d_ws, size_t ws_size, hipStream_t stream) {
    static int grid = 0;
    if (grid == 0) {
        if (n_in != 21 || out_size != T * DM || ws_size < WS_END) { fprintf(stderr, "kernel_launch: unexpected shapes (n_in %d out %d ws %zu need %zu)\n", n_in, out_size, ws_size, (size_t)WS_END); grid = -1; return; }
        int dev = 0, cus = 0, per_cu = 0;
        if (hipGetDevice(&dev) != hipSuccess || hipDeviceGetAttribute(&cus, hipDeviceAttributeMultiprocessorCount, dev) != hipSuccess) { grid = -1; return; }
        if (hipFuncSetAttribute((const void*)mega, hipFuncAttributeMaxDynamicSharedMemorySize, LDS_BYTES) != hipSuccess) { fprintf(stderr, "kernel_launch: hipFuncSetAttribute failed\n"); grid = -1; return; }
        if (hipOccupancyMaxActiveBlocksPerMultiprocessor(&per_cu, (const void*)mega, 512, LDS_BYTES) != hipSuccess || per_cu < 1) { fprintf(stderr, "kernel_launch: occupancy query says %d\n", per_cu); }
        (void)hipGetLastError();
        grid = cus;
    }
    if (grid < 0) return;
    (void)hipMemsetAsync((char*)d_ws + WS_CTL, 0, CTL_BYTES, stream);
    Args a{};
    for (int i = 0; i < 21; ++i) a.in[i] = (const float*)d_in[i];
    a.out = (float*)d_out; a.ws = (unsigned char*)d_ws;
#if MK_PER_PHASE
    for (int p = 0; p < NPHASE; ++p) { a.ph_lo = p; a.ph_hi = p + 1; hipLaunchKernelGGL(mega, dim3(grid), dim3(512), LDS_BYTES, stream, a); }
#else
    a.ph_lo = 0; a.ph_hi = NPHASE;
    hipLaunchKernelGGL(mega, dim3(grid), dim3(512), LDS_BYTES, stream, a);
#endif
}
```

```cpp
#include <hip/hip_runtime.h>
#include <cstdio>
#include <cstdint>

#define GAS __attribute__((address_space(1)))
#define LAS __attribute__((address_space(3)))
typedef unsigned short bf16_t;
typedef short bf16x8 __attribute__((ext_vector_type(8)));
typedef float f32x4 __attribute__((ext_vector_type(4)));
typedef float f32x16 __attribute__((ext_vector_type(16)));
typedef unsigned u32x4 __attribute__((ext_vector_type(4)));
typedef unsigned u32x2 __attribute__((ext_vector_type(2)));

#ifndef MK_PER_PHASE
#define MK_PER_PHASE 0
#endif

constexpr int NB = 2, SEQ = 4096, T = NB * SEQ, DM = 4096;
constexpr int AB_COLS = 8256, AB_MAIN = 8192, AB_PAD = 8448;
constexpr int CD_COLS = 11376, CD_MAIN = 11264, CD_PAD = 11520;
constexpr float ALPHA = 1.4142135623730951f;
constexpr float LN_EPS = 1e-5f, RMS_EPS = 1e-6f;
constexpr int NPHASE = 29;

constexpr size_t MiB = 1ull << 20;
constexpr size_t WS_CTL = 0, CTL_BYTES = 1 * MiB;
constexpr size_t WS_ROPE128 = 1 * MiB;
constexpr size_t WS_ROPE64 = 3 * MiB;
constexpr size_t WS_RSQ = 4 * MiB;
constexpr size_t WS_RSKV = 4 * MiB + 65536;
constexpr size_t WS_CUM = 5 * MiB;
constexpr size_t WS_LOGF = 5 * MiB + 524288;
constexpr size_t WS_KR = 6 * MiB;
constexpr size_t WS_KI = 7 * MiB;
constexpr size_t WS_WI = 8 * MiB;
constexpr size_t WS_KVM = 9 * MiB;
constexpr size_t WS_MEMB = 11 * MiB;
constexpr size_t WS_MASK = 15 * MiB;
constexpr size_t WS_PIDX = 19 * MiB;
constexpr size_t WS_PGATE = 23 * MiB;
constexpr size_t WS_MEMQ = 27 * MiB;
constexpr size_t WS_MEMO = 35 * MiB;
constexpr size_t WS_SMALL = 43 * MiB;
constexpr size_t WS_W_AB_IN = 64 * MiB;
constexpr size_t WS_W_UQ = 130 * MiB;
constexpr size_t WS_W_UKV = 139 * MiB;
constexpr size_t WS_W_AB_OUT = 143 * MiB;
constexpr size_t WS_W_CD_IN = 175 * MiB;
constexpr size_t WS_W_CD_OUT = 265 * MiB;
constexpr size_t WS_W_MEM_Q = 297 * MiB;
constexpr size_t WS_W_MEM_KV = 305 * MiB;
constexpr size_t WS_W_MEM_O = 321 * MiB;
constexpr size_t WS_W_PEER = 329 * MiB;
constexpr size_t WS_U16 = 361 * MiB;
constexpr size_t WS_V16 = 617 * MiB;
constexpr size_t WS_XB = 873 * MiB;
constexpr size_t WS_HF = 937 * MiB;
constexpr size_t WS_RES = 1065 * MiB;
constexpr size_t WS_PROJ = 1193 * MiB;
constexpr size_t WS_PSCORE = WS_PROJ;
constexpr size_t WS_ATT = 1369 * MiB;
constexpr size_t WS_QB = 1433 * MiB;
constexpr size_t WS_KVB = 1481 * MiB;
constexpr size_t WS_SCORE = 1433 * MiB;
constexpr size_t WS_MQP = 1561 * MiB;
constexpr size_t WS_END = 1625 * MiB;

constexpr int LDS_BYTES = 147456;
constexpr int LDS_MISC = 140 * 1024;

#define LDS_WAIT() asm volatile("s_waitcnt lgkmcnt(0)" ::: "memory")
__device__ __forceinline__ float bf2f(bf16_t b) { return __uint_as_float(((unsigned)b) << 16); }
__device__ __forceinline__ unsigned f2bf(float f) { unsigned u = __float_as_uint(f); return (u + 0x7fffu + ((u >> 16) & 1u)) >> 16; }
__device__ __forceinline__ unsigned pk2(float lo, float hi) { return f2bf(lo) | (f2bf(hi) << 16); }
__device__ __forceinline__ float wave_sum(float v) {
#pragma unroll
    for (int o = 1; o < 64; o <<= 1) v += __shfl_xor(v, o);
    return v;
}
__device__ __forceinline__ float wave_max(float v) {
#pragma unroll
    for (int o = 1; o < 64; o <<= 1) v = fmaxf(v, __shfl_xor(v, o));
    return v;
}
__device__ __forceinline__ int wave_sum_i(int v) {
#pragma unroll
    for (int o = 1; o < 64; o <<= 1) v += __shfl_xor(v, o);
    return v;
}

#define XB_TMO      128
#define XB_XCNT(j)  (256  + 64 * (j))
#define XB_XSUB(j)  (1280 + 64 * (j))
#define XB_XGEN(j)  (2304 + 64 * (j))
#define XB_TOP      3328
#define XB_TOPGEN   3392
#define XCD_BAR_WORDS 3456
#define XB_SPIN_CAP (1u << 22)

__device__ __forceinline__ unsigned xb_ld(unsigned* p)              { return __hip_atomic_load(p, __ATOMIC_RELAXED, __HIP_MEMORY_SCOPE_AGENT); }
__device__ __forceinline__ unsigned xb_add(unsigned* p, unsigned v) { return __hip_atomic_fetch_add(p, v, __ATOMIC_RELAXED, __HIP_MEMORY_SCOPE_AGENT); }
__device__ __forceinline__ unsigned xb_xcc_id() { return (unsigned)__builtin_amdgcn_s_getreg((3 << 11) | 20) & 0xFu; }
#define XB_SPIN(cond, bar) do { unsigned _sp = 0; while (cond) { __builtin_amdgcn_s_sleep(1); \
    if ((++_sp & 255u) == 0u) { if (xb_ld(&(bar)[XB_TMO])) break; if (_sp > XB_SPIN_CAP) { atomicAdd(&(bar)[XB_TMO], 1u); break; } } } } while (0)

struct XcdBarrier { unsigned* bar; unsigned x; volatile LAS unsigned* st; };

__device__ __forceinline__ XcdBarrier xcd_barrier_post(unsigned* bar, volatile LAS unsigned* st) {
    XcdBarrier b; b.bar = bar; b.x = xb_xcc_id(); b.st = st;
    if (threadIdx.x == 0) (void)xb_add(&bar[XB_XCNT(b.x)], 1u);
    return b;
}
__device__ __forceinline__ void xcd_barrier_complete(unsigned* bar, unsigned x, unsigned& nloc, unsigned& nx) {
    const unsigned G = gridDim.x * gridDim.y * gridDim.z;
    unsigned sum, cnt, mine, sp = 0u;
    for (;;) {
        sum = 0u; cnt = 0u; mine = 0u;
#pragma unroll
        for (unsigned j = 0; j < 16; ++j) { const unsigned c = xb_ld(&bar[XB_XCNT(j)]); sum += c; cnt += (c > 0u) ? 1u : 0u; mine = (j == x) ? c : mine; }
        if (sum == G) break;
        __builtin_amdgcn_s_sleep(1);
        if ((++sp & 255u) == 0u) { if (xb_ld(&bar[XB_TMO])) break; if (sp > XB_SPIN_CAP) { atomicAdd(&bar[XB_TMO], 1u); break; } }
    }
    nloc = mine > 0u ? mine : 1u; nx = cnt > 0u ? cnt : 1u;
}
__device__ __forceinline__ void xcd_barrier(const XcdBarrier& b) {
    asm volatile("s_waitcnt vmcnt(0)" ::: "memory");
    __syncthreads();
    if (threadIdx.x == 0) {
        unsigned* bar = b.bar;
        __builtin_amdgcn_s_waitcnt(0);
        unsigned nloc = b.st[0], nx = b.st[1];
        if (nloc == 0u) { xcd_barrier_complete(bar, b.x, nloc, nx); b.st[0] = nloc; b.st[1] = nx; }
        const unsigned old = xb_add(&bar[XB_XSUB(b.x)], 1u);
        const unsigned gen = old / nloc;
        if (old + 1u == (gen + 1u) * nloc) {
            __builtin_amdgcn_fence(__ATOMIC_RELEASE, "agent");
            asm volatile("s_waitcnt vmcnt(0)" ::: "memory");
            const unsigned og = xb_add(&bar[XB_TOP], 1u);
            const unsigned tg = og / nx;
            if (og + 1u == (tg + 1u) * nx) xb_add(&bar[XB_TOPGEN], 1u);
            else XB_SPIN(xb_ld(&bar[XB_TOPGEN]) == tg, bar);
            __builtin_amdgcn_fence(__ATOMIC_ACQUIRE, "agent");
            xb_add(&bar[XB_XGEN(b.x)], 1u);
            asm volatile("s_waitcnt vmcnt(0)" ::: "memory");
        } else {
            XB_SPIN(xb_ld(&bar[XB_XGEN(b.x)]) == gen, bar);
            __builtin_amdgcn_fence(__ATOMIC_ACQUIRE, "agent");
            asm volatile("s_waitcnt vmcnt(0)" ::: "memory");
        }
    }
    __syncthreads();
}

namespace pg8 {
constexpr int BM = 256, BK = 64, HALF = 128, HTB = HALF * BK * 2, STAGE_BYTES = 8 * HTB, NXCD = 8, WGM = 8;
__host__ __device__ __forceinline__ int lds_byte(int r, int c) { const int st = (r >> 4) * 2 + (c >> 5), rr = r & 15, cc = c & 31, ob = rr * 64 + cc * 2; return st * 1024 + (ob ^ (((ob >> 9) & 1) << 5)); }
__host__ __device__ __forceinline__ void stage_rc(int b, int& R, int& C) { const int st = b / 1024, sb = b % 1024, swz = sb ^ (((sb >> 9) & 1) << 5); R = (st >> 1) * 16 + swz / 64; C = (st & 1) * 32 + (swz % 64) / 2; }
__host__ __device__ __forceinline__ int perm32(int rho) { const int n = rho >> 4, i = rho & 15; return 8 * (i >> 2) + 4 * n + (i & 3); }
struct Unit { int pm, pn, z; };
struct Gemm { const bf16_t* A; const bf16_t* Bt; int M, N, K, lda, ldb; long zA, zB; int nz; };
struct StaticOrder {
    int nM, nN, nZ, nwg, G, c;
    __device__ void init(int M, int N, int Z, int G_, int c_) { nM = M / BM; nN = N / BM; nZ = Z; nwg = nM * nN * nZ; G = G_; c = c_; }
    __device__ bool next(int i, Unit& u) const {
        const long L = (long)i * G + c; if (L >= nwg) return false;
        int wgid = (int)L; { const int q = nwg / NXCD, r = nwg % NXCD, xcd = wgid % NXCD, off = wgid / NXCD; wgid = (xcd < r ? xcd * (q + 1) : r * (q + 1) + (xcd - r) * q) + off; }
        const int per = nM * nN; u.z = wgid / per; wgid -= u.z * per;
        const int nig = WGM * nN, gid = wgid / nig, fm = gid * WGM, gsz = (nM - fm) < WGM ? (nM - fm) : WGM;
        u.pm = fm + ((wgid % nig) % gsz); u.pn = (wgid % nig) / gsz; return true;
    }
};
__device__ __forceinline__ unsigned cvt_pk_bf16(float lo, float hi) { unsigned r; asm volatile("v_cvt_pk_bf16_f32 %0, %1, %2" : "=v"(r) : "v"(lo), "v"(hi)); return r; }
struct EpiF32 {
    static constexpr bool PERM = false;
    float* C; int ldc; long zC;
    __device__ __forceinline__ void operator()(const f32x4 (&acc)[2][2][4][2], const Unit& u, int wr, int wc, int fr, int fq) const {
        const int row0 = u.pm * BM + wr * 64 + fr, col0 = u.pn * BM + wc * 32 + 4 * fq; float* Cz = C + (size_t)u.z * zC;
#pragma unroll
        for (int ai = 0; ai < 2; ++ai)
#pragma unroll
            for (int m = 0; m < 4; ++m) { float* rowp = Cz + (size_t)(row0 + ai * HALF + m * 16) * ldc + col0;
#pragma unroll
                for (int bj = 0; bj < 2; ++bj)
#pragma unroll
                    for (int n = 0; n < 2; ++n) *(f32x4*)(rowp + bj * HALF + n * 16) = acc[ai][bj][m][n]; }
    }
};
struct EpiResid {
    static constexpr bool PERM = false;
    const float* base; float* out; int ldc;
    __device__ __forceinline__ void operator()(const f32x4 (&acc)[2][2][4][2], const Unit& u, int wr, int wc, int fr, int fq) const {
        const int row0 = u.pm * BM + wr * 64 + fr, col0 = u.pn * BM + wc * 32 + 4 * fq;
#pragma unroll
        for (int ai = 0; ai < 2; ++ai)
#pragma unroll
            for (int m = 0; m < 4; ++m) { const size_t off = (size_t)(row0 + ai * HALF + m * 16) * ldc + col0;
#pragma unroll
                for (int bj = 0; bj < 2; ++bj)
#pragma unroll
                    for (int n = 0; n < 2; ++n) { const f32x4 bs = *(const f32x4*)(base + off + bj * HALF + n * 16); *(f32x4*)(out + off + bj * HALF + n * 16) = bs * ALPHA + acc[ai][bj][m][n]; }
                asm volatile("" ::: "memory"); }
    }
};
struct EpiBf16 {
    static constexpr bool PERM = true;
    bf16_t* O; int ldc; const float* rs;
    __device__ __forceinline__ void operator()(const f32x4 (&acc)[2][2][4][2], const Unit& u, int wr, int wc, int fr, int fq) const {
        const int row0 = u.pm * BM + wr * 64 + fr, col0 = u.pn * BM + wc * 32 + 8 * fq;
#pragma unroll
        for (int ai = 0; ai < 2; ++ai)
#pragma unroll
            for (int m = 0; m < 4; ++m) { const int row = row0 + ai * HALF + m * 16; bf16_t* rowp = O + (size_t)row * ldc + col0; const float sc = rs ? rs[row] : 1.f;
#pragma unroll
                for (int bj = 0; bj < 2; ++bj) { const f32x4 v0 = acc[ai][bj][m][0] * sc, v1 = acc[ai][bj][m][1] * sc;
                    u32x4 wv; wv.x = cvt_pk_bf16(v0[0], v0[1]); wv.y = cvt_pk_bf16(v0[2], v0[3]); wv.z = cvt_pk_bf16(v1[0], v1[1]); wv.w = cvt_pk_bf16(v1[2], v1[3]);
                    *(u32x4*)(rowp + bj * HALF) = wv; } }
    }
};
template <class Epi, class Sched>
__device__ __forceinline__ void gemm_phase(LAS unsigned char* lds, const Gemm g, const Sched& S, const Epi& E) {
    const int tid = threadIdx.x, wid = __builtin_amdgcn_readfirstlane(tid >> 6), lane = tid & 63, wr = wid >> 2, wc = wid & 3, fr = lane & 15, fq = lane >> 4;
    const int K = g.K, nt = K / BK;
    unsigned voffA[2], voffB[2];
#pragma unroll
    for (int i = 0; i < 2; ++i) { int R, C; stage_rc(tid * 16 + i * 8192, R, C); const int Rb = Epi::PERM ? ((R & ~31) + perm32(R & 31)) : R;
        voffA[i] = (unsigned)(R * g.lda + C) * 2u; voffB[i] = (unsigned)(Rb * g.ldb + C) * 2u; }
    const size_t kstep = (size_t)(BK * 2);
    const size_t hA = (size_t)HALF * g.lda * 2, hB = (size_t)HALF * g.ldb * 2;
    const size_t tA = 2 * hA, tB = 2 * hB;
    const unsigned ldsw = (unsigned)wid * 1024u;
    const int aoff = lds_byte(wr * 64 + fr, fq * 8), boff = lds_byte(wc * 32 + fr, fq * 8);
#define PG8_SA(b, h) (((b) * 2 + (h)) * HTB)
#define PG8_SB(b, h) ((4 + (b) * 2 + (h)) * HTB)
#define PG8_STAGE(bufoff, gbase, voff) do { _Pragma("unroll") for (int _i = 0; _i < 2; ++_i) \
        __builtin_amdgcn_global_load_lds((const unsigned*)((const char*)(gbase) + (voff)[_i]), (LAS unsigned*)(lds + (bufoff) + ldsw + _i * 8192), 16, 0, 0); } while (0)
#define PG8_LDA(dst, b, h) do { _Pragma("unroll") for (int m = 0; m < 4; ++m) _Pragma("unroll") for (int k = 0; k < 2; ++k) dst[m][k] = *(const LAS bf16x8*)(lds + PG8_SA(b, h) + aoff + m * 2048 + k * 1024); } while (0)
#define PG8_LDB(dst, b, h) do { _Pragma("unroll") for (int n = 0; n < 2; ++n) _Pragma("unroll") for (int k = 0; k < 2; ++k) dst[n][k] = *(const LAS bf16x8*)(lds + PG8_SB(b, h) + boff + n * 2048 + k * 1024); } while (0)
#define PG8_MMA(ai, bj, At, Bt) do { __builtin_amdgcn_s_setprio(1); _Pragma("unroll") for (int m = 0; m < 4; ++m) _Pragma("unroll") for (int n = 0; n < 2; ++n) _Pragma("unroll") for (int k = 0; k < 2; ++k) \
        acc[ai][bj][m][n] = __builtin_amdgcn_mfma_f32_16x16x32_bf16(Bt[n][k], At[m][k], acc[ai][bj][m][n], 0, 0, 0); __builtin_amdgcn_s_setprio(0); } while (0)
#define PG8_WAIT_V(n) asm volatile("s_waitcnt vmcnt(" #n ")" ::: "memory")
#define PG8_WAIT_L(n) asm volatile("s_waitcnt lgkmcnt(" #n ")" ::: "memory")
#define PG8_BAR __builtin_amdgcn_s_barrier()
#define PG8_SCHED __builtin_amdgcn_sched_barrier(0)
    Unit cur, nxt; int ui = 0;
    if (!S.next(0, cur)) return;
    f32x4 acc[2][2][4][2];
#pragma unroll
    for (int a = 0; a < 2; ++a)
#pragma unroll
        for (int b = 0; b < 2; ++b)
#pragma unroll
            for (int m = 0; m < 4; ++m)
#pragma unroll
                for (int n = 0; n < 2; ++n) acc[a][b][m][n] = (f32x4){0.f, 0.f, 0.f, 0.f};
    bf16x8 At[4][2], B0[2][2], B1[2][2];
    const char* cA = (const char*)g.A + (size_t)cur.pm * tA + (size_t)cur.z * g.zA * 2; const char* cB = (const char*)g.Bt + (size_t)cur.pn * tB + (size_t)cur.z * g.zB * 2;
    PG8_STAGE(PG8_SB(0, 0), cB, voffB); PG8_STAGE(PG8_SA(0, 0), cA, voffA); PG8_STAGE(PG8_SB(0, 1), cB + hB, voffB); PG8_STAGE(PG8_SA(0, 1), cA + hA, voffA);
    if (wr == 1) PG8_BAR;
    PG8_WAIT_V(4); PG8_BAR;
    PG8_STAGE(PG8_SB(1, 0), cB + kstep, voffB); PG8_STAGE(PG8_SA(1, 0), cA + kstep, voffA); PG8_STAGE(PG8_SB(1, 1), cB + hB + kstep, voffB);
    PG8_WAIT_V(6); PG8_BAR;
    for (;;) {
        const bool has_next = S.next(ui + 1, nxt);
        const char* nA = has_next ? (const char*)g.A + (size_t)nxt.pm * tA + (size_t)nxt.z * g.zA * 2 : cA; const char* nB = has_next ? (const char*)g.Bt + (size_t)nxt.pn * tB + (size_t)nxt.z * g.zB * 2 : cB;
        for (int t = 0; t < nt; t += 2) {
            const bool last = (t == nt - 2);
            const char* a1 = cA + (size_t)(t + 1) * kstep;
            const char* a2 = last ? nA : cA + (size_t)(t + 2) * kstep; const char* b2 = last ? nB : cB + (size_t)(t + 2) * kstep;
            const char* a3 = a2 + kstep; const char* b3 = b2 + kstep;
            PG8_LDB(B0, 0, 0); PG8_SCHED; PG8_LDA(At, 0, 0); PG8_STAGE(PG8_SA(1, 1), a1 + hA, voffA);
            PG8_WAIT_L(8); PG8_BAR; PG8_WAIT_L(0); PG8_MMA(0, 0, At, B0); PG8_BAR; PG8_SCHED;
            PG8_LDB(B1, 0, 1); PG8_STAGE(PG8_SB(0, 0), b2, voffB);
            PG8_BAR; PG8_WAIT_L(0); PG8_MMA(0, 1, At, B1); PG8_BAR;
            PG8_LDA(At, 0, 1); PG8_STAGE(PG8_SA(0, 0), a2, voffA);
            PG8_BAR; PG8_WAIT_L(0); PG8_MMA(1, 0, At, B0); PG8_BAR; PG8_SCHED;
            PG8_STAGE(PG8_SB(0, 1), b2 + hB, voffB);
            PG8_WAIT_V(6); PG8_BAR; PG8_MMA(1, 1, At, B1); PG8_BAR;
            PG8_LDB(B0, 1, 0); PG8_SCHED; PG8_LDA(At, 1, 0); PG8_STAGE(PG8_SA(0, 1), a2 + hA, voffA);
            PG8_WAIT_L(8); PG8_BAR; PG8_WAIT_L(0); PG8_MMA(0, 0, At, B0); PG8_BAR; PG8_SCHED;
            PG8_LDB(B1, 1, 1); PG8_STAGE(PG8_SB(1, 0), b3, voffB);
            PG8_BAR; PG8_WAIT_L(0); PG8_MMA(0, 1, At, B1); PG8_BAR;
            PG8_LDA(At, 1, 1); PG8_STAGE(PG8_SA(1, 0), a3, voffA);
            PG8_BAR; PG8_WAIT_L(0); PG8_MMA(1, 0, At, B0); PG8_BAR; PG8_SCHED;
            PG8_STAGE(PG8_SB(1, 1), b3 + hB, voffB);
            PG8_WAIT_V(6); PG8_BAR; PG8_MMA(1, 1, At, B1); PG8_BAR;
        }
        E(acc, cur, wr, wc, fr, fq);
        if (!has_next) break;
#pragma unroll
        for (int a = 0; a < 2; ++a)
#pragma unroll
            for (int b = 0; b < 2; ++b)
#pragma unroll
                for (int m = 0; m < 4; ++m)
#pragma unroll
                    for (int n = 0; n < 2; ++n) acc[a][b][m][n] = (f32x4){0.f, 0.f, 0.f, 0.f};
        cur = nxt; cA = nA; cB = nB; ++ui;
    }
    PG8_WAIT_V(0);
    if (wr == 0) PG8_BAR;
    PG8_BAR;
#undef PG8_SA
#undef PG8_SB
#undef PG8_STAGE
#undef PG8_LDA
#undef PG8_LDB
#undef PG8_MMA
#undef PG8_WAIT_V
#undef PG8_WAIT_L
#undef PG8_BAR
#undef PG8_SCHED
}
}

struct Args { const float* in[21]; float* out; unsigned char* ws; int ph_lo, ph_hi; };
enum { I_X = 0, I_MEM, I_AB_W_IN, I_A_REL_BIAS, I_B_Q_NORM, I_B_W_UQ, I_B_KV_NORM, I_B_W_UKV, I_AB_W_OUT, I_CD_W_IN, I_D_FORGET_BIAS, I_CD_W_OUT,
       I_MEM_W_Q, I_MEM_W_KV, I_MEM_W_O, I_PEER_W_Q, I_PEER_SUB_KEYS, I_PEER_U, I_PEER_V, I_LN_G, I_LN_B };

struct WI { int tid, lane, wave, gw, ngw, bid, nblk; };

__device__ __forceinline__ void tr_item(const float* W, int K, int ld, int c0, int nc, bf16_t* WT, int r0, const float* scale, LAS float* scr, int item, int lane) {
    const int nblk = (nc + 31) >> 5, kb = item / nblk, nb = item - kb * nblk, k0 = 64 * kb, n0 = 32 * nb;
    const int nn = n0 + (lane & 31); const bool ok = nn < nc;
#pragma unroll 8
    for (int i = 0; i < 32; ++i) { const int kk = 2 * i + (lane >> 5); float v = ok ? W[(size_t)(k0 + kk) * ld + c0 + nn] : 0.f; if (scale) v *= scale[k0 + kk]; scr[kk * 33 + (lane & 31)] = v; }
    LDS_WAIT();
    const int c = lane & 7;
#pragma unroll
    for (int j = 0; j < 4; ++j) { const int n = (lane >> 3) + 8 * j; const LAS float* s = scr + (8 * c) * 33 + n;
        u32x4 o; o.x = pk2(s[0 * 33], s[1 * 33]); o.y = pk2(s[2 * 33], s[3 * 33]); o.z = pk2(s[4 * 33], s[5 * 33]); o.w = pk2(s[6 * 33], s[7 * 33]);
        if (n0 + n < nc) *(u32x4*)(WT + (size_t)(r0 + n0 + n) * K + k0 + 8 * c) = o; }
    LDS_WAIT();
}
__device__ __forceinline__ void cvt_rows(const float* src, bf16_t* dst, size_t n, size_t i0, size_t stride) {
    for (size_t i = i0 * 8; i < n; i += stride * 8) {
        const f32x4 a = *(const f32x4*)(src + i), b = *(const f32x4*)(src + i + 4);
        u32x4 o; o.x = pk2(a.x, a.y); o.y = pk2(a.z, a.w); o.z = pk2(b.x, b.y); o.w = pk2(b.z, b.w);
        *(u32x4*)(dst + i) = o;
    }
}
__device__ __forceinline__ void ph_convert(const Args& a, LAS unsigned char* lds, const WI& w) {
    unsigned char* ws = a.ws;
    LAS float* scr = (LAS float*)(lds + w.wave * 16384);
    constexpr int J1 = 64 * 258, J2 = 24 * 96, J3 = 8 * 128, J4 = 64 * 128, J5 = 64 * 160, J6 = 64 * 192, J7 = 64 * 3, J8 = 64 * 1, J9 = 64 * 128,
                  J10 = 64 * 16, J12 = 64 * 32, J14 = 8 * 128;
    constexpr int NJ = J1 + J2 + J3 + J4 + J5 + J6 + J7 + J8 + J9 + 2 * J10 + 2 * J12 + 2 * J14;
    for (int it = w.gw; it < NJ; it += w.ngw) {
        int r = it; const float* src; int K, ld, c0 = 0, nc, r0 = 0; bf16_t* dst; const float* sc = nullptr;
        if (r < J1) { src = a.in[I_AB_W_IN]; K = 4096; ld = AB_COLS; nc = AB_COLS; dst = (bf16_t*)(ws + WS_W_AB_IN); }
        else if ((r -= J1) < J2) { src = a.in[I_B_W_UQ]; K = 1536; ld = 3072; nc = 3072; dst = (bf16_t*)(ws + WS_W_UQ); sc = a.in[I_B_Q_NORM]; }
        else if ((r -= J2) < J3) { src = a.in[I_B_W_UKV]; K = 512; ld = 4096; nc = 4096; dst = (bf16_t*)(ws + WS_W_UKV); sc = a.in[I_B_KV_NORM]; }
        else if ((r -= J3) < J4) { src = a.in[I_AB_W_OUT]; K = 4096; ld = 4096; nc = 4096; dst = (bf16_t*)(ws + WS_W_AB_OUT); }
        else if ((r -= J4) < J5) { src = a.in[I_CD_W_IN]; K = 4096; ld = CD_COLS; c0 = 0; nc = 5120; r0 = 0; dst = (bf16_t*)(ws + WS_W_CD_IN); }
        else if ((r -= J5) < J6) { src = a.in[I_CD_W_IN]; K = 4096; ld = CD_COLS; c0 = 5216; nc = 6144; r0 = 5120; dst = (bf16_t*)(ws + WS_W_CD_IN); }
        else if ((r -= J6) < J7) { src = a.in[I_CD_W_IN]; K = 4096; ld = CD_COLS; c0 = 5120; nc = 96; r0 = 11264; dst = (bf16_t*)(ws + WS_W_CD_IN); }
        else if ((r -= J7) < J8) { src = a.in[I_CD_W_IN]; K = 4096; ld = CD_COLS; c0 = 11360; nc = 16; r0 = 11360; dst = (bf16_t*)(ws + WS_W_CD_IN); }
        else if ((r -= J8) < J9) { src = a.in[I_CD_W_OUT]; K = 4096; ld = 4096; nc = 4096; dst = (bf16_t*)(ws + WS_W_CD_OUT); }
        else if ((r -= J9) < 2 * J10) { const int l = r / J10; r -= l * J10; src = a.in[I_MEM_W_Q] + (size_t)l * 4096 * 512; K = 4096; ld = 512; nc = 512; dst = (bf16_t*)(ws + WS_W_MEM_Q) + (size_t)l * 512 * 4096; }
        else if ((r -= 2 * J10) < 2 * J12) { const int l = r / J12; r -= l * J12; src = a.in[I_MEM_W_KV] + (size_t)l * 4096 * 1024; K = 4096; ld = 1024; nc = 1024; dst = (bf16_t*)(ws + WS_W_MEM_KV) + (size_t)l * 1024 * 4096; }
        else { r -= 2 * J12; const int l = r / J14; r -= l * J14; src = a.in[I_MEM_W_O] + (size_t)l * 512 * 4096; K = 512; ld = 4096; nc = 4096; dst = (bf16_t*)(ws + WS_W_MEM_O) + (size_t)l * 4096 * 512; }
        tr_item(src, K, ld, c0, nc, dst, r0, sc, scr, r, w.lane);
    }
    { const size_t gt = (size_t)w.gw * 64 + w.lane, ng = (size_t)w.ngw * 64;
      bf16_t* p1 = (bf16_t*)(ws + WS_W_AB_IN) + (size_t)AB_COLS * 4096; const size_t n1 = (size_t)(AB_PAD - AB_COLS) * 4096;
      for (size_t i = gt * 8; i < n1; i += ng * 8) *(u32x4*)(p1 + i) = (u32x4){0u, 0u, 0u, 0u};
      bf16_t* p2 = (bf16_t*)(ws + WS_W_CD_IN) + (size_t)CD_COLS * 4096; const size_t n2 = (size_t)(CD_PAD - CD_COLS) * 4096;
      for (size_t i = gt * 8; i < n2; i += ng * 8) *(u32x4*)(p2 + i) = (u32x4){0u, 0u, 0u, 0u};
      cvt_rows(a.in[I_X], (bf16_t*)(ws + WS_XB), (size_t)T * DM, gt, ng);
      cvt_rows(a.in[I_MEM], (bf16_t*)(ws + WS_MEMB), (size_t)512 * DM, gt, ng);
      cvt_rows(a.in[I_PEER_U], (bf16_t*)(ws + WS_U16), (size_t)2 * 16384 * DM, gt, ng);
      cvt_rows(a.in[I_PEER_V], (bf16_t*)(ws + WS_V16), (size_t)2 * 16384 * DM, gt, ng);
      float* r128 = (float*)(ws + WS_ROPE128); float* r64 = (float*)(ws + WS_ROPE64);
      for (size_t i = gt; i < (size_t)SEQ * 96; i += ng) {
          const int s = (int)(i / 96), j = (int)(i % 96); const bool big = j < 64; const int ii = big ? j : j - 64;
          const double rr = big ? 0.8659643233600653 : 0.7498942093324559; double inv = 1.0;
          for (int q = 0; q < ii; ++q) inv *= rr;
          const double rev = (double)s * inv * 0.15915494309189535; const float fr = (float)(rev - rint(rev));
          const float cs = __builtin_amdgcn_cosf(fr), sn = __builtin_amdgcn_sinf(fr);
          float* o = big ? (r128 + ((size_t)s * 64 + ii) * 2) : (r64 + ((size_t)s * 32 + ii) * 2);
          o[0] = cs; o[1] = sn; }
    }
    {
        LAS float* Ks = (LAS float*)lds; LAS float* Ws = Ks + 128 * 129;
        const int tk = w.tid & 31, tn = w.tid >> 5;
        for (int it = w.bid; it < 2 * 16 * 32; it += w.nblk) {
            const int l = it >> 9, hp = (it >> 5) & 15, kb = it & 31;
            __syncthreads();
            const float* keys = a.in[I_PEER_SUB_KEYS] + ((size_t)(l * 16 + hp) * 128) * 128;
            const float* wq = a.in[I_PEER_W_Q] + ((size_t)l * 4096 + (size_t)kb * 128) * 2048 + hp * 128;
            for (int e = w.tid; e < 128 * 128; e += 512) { const int rrow = e >> 7, d = e & 127; Ks[rrow * 129 + d] = keys[(size_t)rrow * 128 + d]; Ws[rrow * 129 + d] = wq[(size_t)rrow * 2048 + d]; }
            __syncthreads();
            float acc[8][4];
#pragma unroll
            for (int x = 0; x < 8; ++x)
#pragma unroll
                for (int y = 0; y < 4; ++y) acc[x][y] = 0.f;
            for (int d = 0; d < 128; ++d) {
                float kv[8], wv[4];
#pragma unroll
                for (int x = 0; x < 8; ++x) kv[x] = Ks[(tn + 16 * x) * 129 + d];
#pragma unroll
                for (int y = 0; y < 4; ++y) wv[y] = Ws[(tk + 32 * y) * 129 + d];
#pragma unroll
                for (int x = 0; x < 8; ++x)
#pragma unroll
                    for (int y = 0; y < 4; ++y) acc[x][y] += kv[x] * wv[y];
            }
            bf16_t* dst = (bf16_t*)(ws + WS_W_PEER) + ((size_t)l * 2048 + hp * 128) * 4096 + kb * 128;
#pragma unroll
            for (int x = 0; x < 8; ++x)
#pragma unroll
                for (int y = 0; y < 4; ++y) dst[(size_t)(tn + 16 * x) * 4096 + tk + 32 * y] = (bf16_t)f2bf(acc[x][y]);
        }
        __syncthreads();
    }
}

__device__ __forceinline__ int crow(int r, int hi) { return (r & 3) + 8 * (r >> 2) + 4 * hi; }
template <class F>
__device__ __forceinline__ void naive_gemm(const bf16_t* A, int lda, const bf16_t* Bt, int ldb, int M, int N, int K, const WI& w, F epi) {
    const int tm = M >> 5, tn = (N + 31) >> 5;
    const int i = w.lane & 31, g = w.lane >> 5;
    for (int tile = w.gw; tile < tm * tn; tile += w.ngw) {
        const int bn = tile / tm, bm = tile - bn * tm;
        const bf16_t* ap = A + (size_t)(bm * 32 + i) * lda + 8 * g;
        const int nrow = bn * 32 + i; const bool nv = nrow < N;
        const bf16_t* bp = Bt + (size_t)(nv ? nrow : 0) * ldb + 8 * g;
        f32x16 acc = {};
#pragma unroll 4
        for (int k = 0; k < K; k += 16) {
            const bf16x8 av = *(const bf16x8*)(ap + k);
            bf16x8 bv = *(const bf16x8*)(bp + k);
            if (!nv) bv = (bf16x8){0, 0, 0, 0, 0, 0, 0, 0};
            acc = __builtin_amdgcn_mfma_f32_32x32x16_bf16(av, bv, acc, 0, 0, 0);
        }
#pragma unroll
        for (int r = 0; r < 16; ++r) { const int row = bm * 32 + crow(r, g), col = bn * 32 + i; if (col < N) epi(row, col, acc[r]); }
    }
}

__device__ __forceinline__ void ln_rows(const float* src, const float* g, const float* b, float* dstf, bf16_t* dstb, const WI& w) {
    for (int m = w.gw; m < T; m += w.ngw) {
        const f32x4* xr = (const f32x4*)(src + (size_t)m * DM) + w.lane;
        f32x4 v[16]; float s = 0.f;
#pragma unroll
        for (int j = 0; j < 16; ++j) { v[j] = xr[64 * j]; s += (v[j].x + v[j].y) + (v[j].z + v[j].w); }
        const float mean = wave_sum(s) * (1.f / DM); float s2 = 0.f;
#pragma unroll
        for (int j = 0; j < 16; ++j) { v[j] = v[j] - mean; s2 += (v[j].x * v[j].x + v[j].y * v[j].y) + (v[j].z * v[j].z + v[j].w * v[j].w); }
        const float rstd = 1.f / sqrtf(wave_sum(s2) * (1.f / DM) + LN_EPS);
#pragma unroll
        for (int j = 0; j < 16; ++j) {
            const int c = 4 * w.lane + 256 * j;
            const f32x4 gg = *(const f32x4*)(g + c), bb = *(const f32x4*)(b + c);
            const f32x4 o = v[j] * rstd * gg + bb;
            *(f32x4*)(dstf + (size_t)m * DM + c) = o;
            if (dstb) { u32x2 p; p.x = pk2(o.x, o.y); p.y = pk2(o.z, o.w); *(u32x2*)(dstb + (size_t)m * DM + c) = p; }
        }
    }
}

template <int MODE>
__device__ __forceinline__ void attn_naive(const Args& a, int layer, LAS float* qs, const WI& w) {
    constexpr int H = (MODE == 4) ? 4 : 16, DK = (MODE == 1) ? 192 : 128;
    const float scale = (MODE == 1) ? 0.07216878364870322f : 0.08838834764831845f;
    unsigned char* ws = a.ws;
    const float NEG = -__builtin_inff();
    for (int it = w.gw; it < T * H; it += w.ngw) {
        const int h = it / T, t = it - h * T, b = t / SEQ, sp = t - b * SEQ, c = sp >> 6;
        const bf16_t* qp; const bf16_t* kbase; const bf16_t* vbase; int ldk, ldv; bf16_t* op;
        int s_lo = 0, s_hi;
        if (MODE == 0) { const bf16_t* P = (const bf16_t*)(ws + WS_PROJ); qp = P + (size_t)t * AB_MAIN + h * 128; kbase = P + (size_t)b * SEQ * AB_MAIN + 2048 + h * 128; vbase = kbase + 2048; ldk = ldv = AB_MAIN;
            op = (bf16_t*)(ws + WS_ATT) + (size_t)t * DM + h * 128; s_lo = (c - 8) * 64; if (s_lo < 0) s_lo = 0; s_hi = (c + 1) * 64; }
        else if (MODE == 1) { qp = (const bf16_t*)(ws + WS_QB) + (size_t)t * 3072 + h * 192; kbase = (const bf16_t*)(ws + WS_KVB) + (size_t)b * SEQ * 4096 + h * 256; vbase = kbase + 128; ldk = ldv = 4096;
            op = (bf16_t*)(ws + WS_ATT) + (size_t)t * DM + 2048 + h * 128; s_hi = (c + 1) * 64; }
        else if (MODE == 2) { const bf16_t* P = (const bf16_t*)(ws + WS_PROJ); qp = P + (size_t)t * CD_MAIN + h * 128; kbase = P + (size_t)b * SEQ * CD_MAIN + 2048 + (h >> 2) * 128; vbase = kbase + 512; ldk = ldv = CD_MAIN;
            op = (bf16_t*)(ws + WS_ATT) + (size_t)t * DM + h * 128; s_hi = (c + 1) * 64; }
        else if (MODE == 3) { const bf16_t* P = (const bf16_t*)(ws + WS_PROJ); qp = P + (size_t)t * CD_MAIN + 5120 + h * 128; kbase = P + (size_t)b * SEQ * CD_MAIN + 7168 + h * 128; vbase = kbase + 2048; ldk = ldv = CD_MAIN;
            op = (bf16_t*)(ws + WS_ATT) + (size_t)t * DM + 2048 + h * 128; s_hi = sp + 1; }
        else { qp = (const bf16_t*)(ws + WS_MEMQ) + (size_t)t * 512 + h * 128; kbase = (const bf16_t*)(ws + WS_KVM) + ((size_t)layer * 512 + b * 256) * 1024 + h * 128; vbase = kbase + 512; ldk = ldv = 1024;
            op = (bf16_t*)(ws + WS_MEMO) + (size_t)t * 512 + h * 128; s_hi = 256; }
        LDS_WAIT();
        if (MODE == 4) { const float* mq = (const float*)(ws + WS_MQP) + (size_t)t * 512 + h * 128;
            for (int d = w.lane; d < DK; d += 64) qs[d] = bf2f((bf16_t)f2bf((mq[d] + mq[d + (size_t)T * 512]) + (mq[d + (size_t)2 * T * 512] + mq[d + (size_t)3 * T * 512]))); }
        else for (int d = w.lane; d < DK; d += 64) qs[d] = bf2f(qp[d]);
        LDS_WAIT();
        const float* cum = (const float*)(ws + WS_CUM) + ((size_t)b * 16 + h) * SEQ;
        const float ct = (MODE == 3) ? cum[sp] : 0.f;
        const float* relb = a.in[I_A_REL_BIAS] + h * 513;
        const unsigned* mrow = (const unsigned*)(ws + WS_MASK) + (size_t)t * 128;
        float m = NEG, l = 0.f, o0 = 0.f, o1 = 0.f;
        for (int s0 = s_lo; s0 < s_hi; s0 += 64) {
            const int s = s0 + w.lane; bool valid = s < s_hi;
            if (MODE == 2) { if (valid) valid = (mrow[s >> 5] >> (s & 31)) & 1u; }
            float x = NEG;
            if (valid) {
                const bf16_t* kp = kbase + (size_t)s * ldk; float acc = 0.f;
#pragma unroll 4
                for (int d0 = 0; d0 < 128; d0 += 8) { const bf16x8 kv = *(const bf16x8*)(kp + d0);
#pragma unroll
                    for (int e = 0; e < 8; ++e) acc += qs[d0 + e] * bf2f((bf16_t)kv[e]); }
                if (MODE == 1) { const bf16_t* kr = (const bf16_t*)(ws + WS_KR) + ((size_t)b * SEQ + s) * 64;
#pragma unroll 4
                    for (int d0 = 0; d0 < 64; d0 += 8) { const bf16x8 kv = *(const bf16x8*)(kr + d0);
#pragma unroll
                        for (int e = 0; e < 8; ++e) acc += qs[128 + d0 + e] * bf2f((bf16_t)kv[e]); } }
                x = acc * scale;
                if (MODE == 0) { int rel = sp - s; rel = rel < -256 ? -256 : (rel > 256 ? 256 : rel); x += relb[rel + 256]; }
                if (MODE == 3) x += ct - cum[s];
            }
            const float mx = wave_max(x);
            if (mx == NEG) continue;
            const float mn = fmaxf(m, mx); const float p = valid ? __expf(x - mn) : 0.f; const float al = __expf(m - mn);
            l = l * al + wave_sum(p); o0 *= al; o1 *= al; m = mn;
            for (int j = 0; j < 64; ++j) { const float pj = __shfl(p, j);
                if (pj != 0.f) { const bf16_t* vp = vbase + (size_t)(s0 + j) * ldv; o0 += pj * bf2f(vp[w.lane]); o1 += pj * bf2f(vp[w.lane + 64]); } }
        }
        const float rl = 1.f / l;
        op[w.lane] = (bf16_t)f2bf(o0 * rl); op[w.lane + 64] = (bf16_t)f2bf(o1 * rl);
    }
}

namespace fa {
constexpr int SHM_V = 64 * 128 * 2;
constexpr int LDS_V = 0, LDS_K = 2 * SHM_V, LDS_WS = LDS_K + 2 * 64 * 384, LDS_RELB = LDS_WS + 8 * 64 * 4, LDS_CS = LDS_RELB + 2304, LDS_END = LDS_CS + 512;
#define FA_KSWZ(row, colB, RS) ((row) * (RS) + ((colB) ^ (((row) & 7) << 4)))
__device__ __forceinline__ int v_st(int k, int c) { const int kk = (k & ~0xC) | ((k & 4) << 1) | ((k & 8) >> 1); return ((kk >> 3) * 4 + (c >> 5)) * 512 + ((kk & 7) * 32 + (c & 31)) * 2; }
__device__ __forceinline__ int v_rd_base(int lane) { return ((lane & 3) << 3) | (((lane >> 2) & 3) << 6) | (((lane >> 4) & 1) << 5) | (((lane >> 5) & 1) << 8); }
__device__ __forceinline__ unsigned cvtpk(float lo, float hi) { unsigned r; asm volatile("v_cvt_pk_bf16_f32 %0, %1, %2" : "=v"(r) : "v"(lo), "v"(hi)); return r; }
typedef short s16x4 __attribute__((ext_vector_type(4)));

template <int DK>
__device__ __forceinline__ void qkt(f32x16& p0, f32x16& p1, LAS const char* Kb, int r32, int hi, const bf16x8* qr) {
    constexpr int RS = DK * 2;
    p0 = f32x16{}; p1 = f32x16{};
    LAS const char* kb[4];
#pragma unroll
    for (int dd = 0; dd < 4; ++dd) kb[dd] = Kb + FA_KSWZ(r32, (dd * 16 + hi * 8) * 2, RS);
#pragma unroll
    for (int d0 = 0; d0 < DK / 16; ++d0) { LAS const char* ap = kb[d0 & 3] + (d0 >> 2) * 128;
        const bf16x8 b0 = *(LAS const bf16x8*)ap;
        const bf16x8 b1 = *(LAS const bf16x8*)(ap + 32 * RS);
        p0 = __builtin_amdgcn_mfma_f32_32x32x16_bf16(b0, qr[d0], p0, 0, 0, 0);
        p1 = __builtin_amdgcn_mfma_f32_32x32x16_bf16(b1, qr[d0], p1, 0, 0, 0); }
}
__device__ __forceinline__ void pv_tile(f32x16* o, int vb0, bf16x8 pa0, bf16x8 pa1, bf16x8 pa2, bf16x8 pa3) {
#define FA_TRRD(dst, off) asm volatile("ds_read_b64_tr_b16 %0, %1 offset:%2" : "=&v"(dst) : "v"(vb0), "i"(off) : "memory")
#define FA_PV_D0(d0) do { s16x4 l0, l1, l2, l3, h0, h1, h2, h3; constexpr int b_ = (d0) * 512; \
        FA_TRRD(l0, b_); FA_TRRD(h0, b_ + 2048); FA_TRRD(l1, b_ + 4096); FA_TRRD(h1, b_ + 6144); FA_TRRD(l2, b_ + 8192); FA_TRRD(h2, b_ + 10240); FA_TRRD(l3, b_ + 12288); FA_TRRD(h3, b_ + 14336); \
        asm volatile("s_waitcnt lgkmcnt(0)" ::: "memory"); __builtin_amdgcn_sched_barrier(0); \
        o[d0] = __builtin_amdgcn_mfma_f32_32x32x16_bf16(pa0, (bf16x8){l0[0], l0[1], l0[2], l0[3], h0[0], h0[1], h0[2], h0[3]}, o[d0], 0, 0, 0); \
        o[d0] = __builtin_amdgcn_mfma_f32_32x32x16_bf16(pa1, (bf16x8){l1[0], l1[1], l1[2], l1[3], h1[0], h1[1], h1[2], h1[3]}, o[d0], 0, 0, 0); \
        o[d0] = __builtin_amdgcn_mfma_f32_32x32x16_bf16(pa2, (bf16x8){l2[0], l2[1], l2[2], l2[3], h2[0], h2[1], h2[2], h2[3]}, o[d0], 0, 0, 0); \
        o[d0] = __builtin_amdgcn_mfma_f32_32x32x16_bf16(pa3, (bf16x8){l3[0], l3[1], l3[2], l3[3], h3[0], h3[1], h3[2], h3[3]}, o[d0], 0, 0, 0); } while (0)
    FA_PV_D0(0); FA_PV_D0(1); FA_PV_D0(2); FA_PV_D0(3);
#undef FA_PV_D0
#undef FA_TRRD
}
__device__ __forceinline__ void softmax_tile(f32x16& p0, f32x16& p1, float& m_reg, float& l_reg, float& alpha, bf16x8& pa0, bf16x8& pa1, bf16x8& pa2, bf16x8& pa3) {
    float pmax = p0[0];
#pragma unroll
    for (int r = 1; r < 16; ++r) pmax = fmaxf(pmax, p0[r]);
#pragma unroll
    for (int r = 0; r < 16; ++r) pmax = fmaxf(pmax, p1[r]);
    { auto rr = __builtin_amdgcn_permlane32_swap(__float_as_uint(pmax), __float_as_uint(pmax), false, false);
      pmax = fmaxf(__uint_as_float(rr[0]), __uint_as_float(rr[1])); }
    const float mn = fmaxf(m_reg, pmax); alpha = __builtin_amdgcn_exp2f(m_reg - mn); m_reg = mn;
#pragma unroll
    for (int r = 0; r < 16; ++r) { p0[r] = __builtin_amdgcn_exp2f(p0[r] - mn); p1[r] = __builtin_amdgcn_exp2f(p1[r] - mn); }
    float ps = 0.f;
#pragma unroll
    for (int r = 0; r < 16; ++r) ps += p0[r];
#pragma unroll
    for (int r = 0; r < 16; ++r) ps += p1[r];
    { auto rr = __builtin_amdgcn_permlane32_swap(__float_as_uint(ps), __float_as_uint(ps), false, false);
      ps = __uint_as_float(rr[0]) + __uint_as_float(rr[1]); }
    l_reg = l_reg * alpha + ps;
#define FA_PK4(P, B_, OUT) do { unsigned a0 = cvtpk(P[B_+0], P[B_+1]), a1 = cvtpk(P[B_+2], P[B_+3]); \
        unsigned b0 = cvtpk(P[B_+4], P[B_+5]), b1 = cvtpk(P[B_+6], P[B_+7]); \
        auto r0 = __builtin_amdgcn_permlane32_swap(a0, b0, false, false); auto r1 = __builtin_amdgcn_permlane32_swap(a1, b1, false, false); \
        u32x4 wv = {r0[0], r1[0], r0[1], r1[1]}; OUT = *reinterpret_cast<bf16x8*>(&wv); } while (0)
    FA_PK4(p0, 0, pa0); FA_PK4(p0, 8, pa1); FA_PK4(p1, 0, pa2); FA_PK4(p1, 8, pa3);
#undef FA_PK4
}

template <int MODE>
__device__ __forceinline__ void attn_unit(const Args& a, int layer, LAS unsigned char* lds, int b, int h, int qb) {
    constexpr int DK = (MODE == 1) ? 192 : 128, RS = DK * 2, SHM_K = 64 * RS, NQ = DK / 16;
    constexpr float C2 = (MODE == 1) ? 1.4426950408889634f * 0.07216878364870322f : 1.4426950408889634f * 0.08838834764831845f;
    constexpr float L2E = 1.4426950408889634f;
    unsigned char* ws = a.ws;
    const int tid = threadIdx.x, wid = __builtin_amdgcn_readfirstlane(tid >> 6), lane = tid & 63, r32 = lane & 31, hi = lane >> 5;
    const int P0 = qb * 256, qlo = P0 + wid * 32, row = qlo + r32, cw = qlo >> 6;
    const size_t tb = (size_t)b * SEQ;
    const float NEG = -__builtin_inff();
    const bf16_t* Kg; const bf16_t* Vg; int ldk, ldv; bf16_t* Og; int ldo; int j_lo = 0, j_hi;
    if (MODE == 0) { const bf16_t* P = (const bf16_t*)(ws + WS_PROJ); Kg = P + tb * AB_MAIN + 2048 + h * 128; Vg = Kg + 2048; ldk = ldv = AB_MAIN; Og = (bf16_t*)(ws + WS_ATT) + (tb + qlo) * DM + h * 128; ldo = DM;
        j_lo = (P0 >> 6) - 8; if (j_lo < 0) j_lo = 0; j_hi = (P0 >> 6) + 4; }
    else if (MODE == 1) { Kg = (const bf16_t*)(ws + WS_KVB) + tb * 4096 + h * 256; Vg = Kg + 128; ldk = ldv = 4096; Og = (bf16_t*)(ws + WS_ATT) + (tb + qlo) * DM + 2048 + h * 128; ldo = DM; j_hi = (P0 >> 6) + 4; }
    else if (MODE == 2) { const bf16_t* P = (const bf16_t*)(ws + WS_PROJ); Kg = P + tb * CD_MAIN + 2048 + (h >> 2) * 128; Vg = Kg + 512; ldk = ldv = CD_MAIN; Og = (bf16_t*)(ws + WS_ATT) + (tb + qlo) * DM + h * 128; ldo = DM; j_hi = (P0 >> 6) + 4; }
    else if (MODE == 3) { const bf16_t* P = (const bf16_t*)(ws + WS_PROJ); Kg = P + tb * CD_MAIN + 7168 + h * 128; Vg = Kg + 2048; ldk = ldv = CD_MAIN; Og = (bf16_t*)(ws + WS_ATT) + (tb + qlo) * DM + 2048 + h * 128; ldo = DM; j_hi = (P0 >> 6) + 4; }
    else { Kg = (const bf16_t*)(ws + WS_KVM) + ((size_t)layer * 512 + b * 256) * 1024 + h * 128; Vg = Kg + 512; ldk = ldv = 1024; Og = (bf16_t*)(ws + WS_MEMO) + (tb + qlo) * 512 + h * 128; ldo = 512; j_hi = 4; }
    const int NT = j_hi - j_lo;
    bf16x8 qr[NQ];
    if (MODE == 4) { const float* mq = (const float*)(ws + WS_MQP) + (tb + row) * 512 + h * 128;
#pragma unroll
        for (int d0 = 0; d0 < NQ; ++d0) { const float* p = mq + d0 * 16 + hi * 8; f32x4 s0 = {0.f, 0.f, 0.f, 0.f}, s1 = s0;
#pragma unroll
            for (int z = 0; z < 4; ++z) { s0 += *(const f32x4*)(p + (size_t)z * T * 512); s1 += *(const f32x4*)(p + (size_t)z * T * 512 + 4); }
            u32x4 wv = {cvtpk(s0[0], s0[1]), cvtpk(s0[2], s0[3]), cvtpk(s1[0], s1[1]), cvtpk(s1[2], s1[3])}; qr[d0] = *reinterpret_cast<bf16x8*>(&wv); } }
    else { const bf16_t* Qg;
        if (MODE == 0) Qg = (const bf16_t*)(ws + WS_PROJ) + (tb + row) * AB_MAIN + h * 128;
        else if (MODE == 1) Qg = (const bf16_t*)(ws + WS_QB) + (tb + row) * 3072 + h * 192;
        else if (MODE == 2) Qg = (const bf16_t*)(ws + WS_PROJ) + (tb + row) * CD_MAIN + h * 128;
        else Qg = (const bf16_t*)(ws + WS_PROJ) + (tb + row) * CD_MAIN + 5120 + h * 128;
#pragma unroll
        for (int d0 = 0; d0 < NQ; ++d0) qr[d0] = *(const bf16x8*)(Qg + d0 * 16 + hi * 8); }
    LAS char* V_lds = (LAS char*)lds + LDS_V; LAS char* K_lds = (LAS char*)lds + LDS_K;
    LAS float* wsc = (LAS float*)(lds + LDS_WS) + wid * 64; LAS float* relb = (LAS float*)(lds + LDS_RELB); LAS float* csl = (LAS float*)(lds + LDS_CS);
    const int vbase = (int)(unsigned)(uintptr_t)V_lds + v_rd_base(lane);
    const bf16_t* KRg = (const bf16_t*)(ws + WS_KR) + tb * 64;
    const float* cum = (const float*)(ws + WS_CUM) + ((size_t)b * 16 + h) * SEQ;
    const unsigned* mrow = (const unsigned*)(ws + WS_MASK) + (tb + row) * 128;
    float ctl = 0.f; if (MODE == 3) ctl = cum[row] * L2E;
    if (MODE == 0) { const float* rb = a.in[I_A_REL_BIAS] + h * 513; for (int i = tid; i < 513; i += 512) relb[i] = rb[i] * L2E; }
    float m_reg = -1e30f, l_reg = 0.f; f32x16 o[4] = {};
    unsigned mk0 = 0u, mk1 = 0u; float st_cs = 0.f;
    constexpr int NKI = (DK == 192) ? 3 : 2;
    int koff[NKI]; bool krope[NKI]; int voff[2];
#pragma unroll
    for (int i = 0; i < NKI; ++i) { const int off = (wid * NKI + i) * 1024 + lane * 16; const int rw = off / RS, sw = off - rw * RS, cb = sw ^ ((rw & 7) << 4);
        krope[i] = (DK == 192) && (cb >= 256); koff[i] = krope[i] ? rw * 64 + ((cb - 256) >> 1) : rw * ldk + (cb >> 1); }
#pragma unroll
    for (int i = 0; i < 2; ++i) { const int off = (wid * 2 + i) * 1024 + lane * 16; const int sub = off >> 9, within = off & 511, kk = ((sub >> 2) << 3) | (within >> 6);
        const int k = (kk & ~0xC) | ((kk & 4) << 1) | ((kk & 8) >> 1), c = (sub & 3) * 32 + ((within & 63) >> 1); voff[i] = k * ldv + c; }
#define FA_DMA(j, bf) do { const int k0_ = (j) * 64; \
        _Pragma("unroll") for (int i_ = 0; i_ < NKI; ++i_) { const bf16_t* s_ = (DK == 192 && krope[i_]) ? (KRg + (size_t)k0_ * 64 + koff[i_]) : (Kg + (size_t)k0_ * ldk + koff[i_]); \
            __builtin_amdgcn_global_load_lds((const unsigned*)s_, (LAS unsigned*)(K_lds + (bf) * SHM_K + (wid * NKI + i_) * 1024), 16, 0, 0); } \
        _Pragma("unroll") for (int i_ = 0; i_ < 2; ++i_) \
            __builtin_amdgcn_global_load_lds((const unsigned*)(Vg + (size_t)k0_ * ldv + voff[i_]), (LAS unsigned*)(V_lds + (bf) * SHM_V + (wid * 2 + i_) * 1024), 16, 0, 0); \
        if (MODE == 3) { if (tid < 64) st_cs = cum[k0_ + tid] * L2E; } } while (0)
#define FA_CSW(bf) do { if (MODE == 3) { if (tid < 64) csl[(bf) * 64 + tid] = st_cs; } } while (0)
    __syncthreads();
    FA_DMA(j_lo, 0); asm volatile("s_waitcnt vmcnt(0)" ::: "memory"); FA_CSW(0);
    __syncthreads();
#pragma unroll 1
    for (int t = 0; t < NT; ++t) {
        const int buf = t & 1, j = j_lo + t, kbp = j * 64;
        if (t + 1 < NT) FA_DMA(j + 1, buf ^ 1);
        bool act;
        if (MODE == 0) act = (j >= cw - 8) && (j <= cw);
        else if (MODE == 1 || MODE == 2) act = (j <= cw);
        else if (MODE == 3) act = (kbp <= qlo + 31);
        else act = true;
        if (MODE == 2) { if (act) { const u32x2 mm = *(const u32x2*)(mrow + 2 * j); mk0 = mm.x; mk1 = mm.y; } }
        if (act) {
            f32x16 p0, p1;
            qkt<DK>(p0, p1, K_lds + buf * SHM_K, r32, hi, qr);
            if (MODE == 0) {
                if (qlo - (kbp + 63) >= 256) { const float bf_ = relb[512];
#pragma unroll
                    for (int r = 0; r < 16; ++r) { p0[r] = fmaf(p0[r], C2, bf_); p1[r] = fmaf(p1[r], C2, bf_); } }
                else { const int dq = row - kbp - 4 * hi;
#pragma unroll
                    for (int r = 0; r < 16; ++r) { const int c = (r & 3) + 8 * (r >> 2);
                        int i0 = dq - c; i0 = i0 < -256 ? -256 : (i0 > 256 ? 256 : i0); int i1 = dq - c - 32; i1 = i1 < -256 ? -256 : (i1 > 256 ? 256 : i1);
                        p0[r] = fmaf(p0[r], C2, relb[i0 + 256]); p1[r] = fmaf(p1[r], C2, relb[i1 + 256]); } }
            } else if (MODE == 3) {
                LAS const float* cs = csl + buf * 64 + 4 * hi;
#pragma unroll
                for (int q4 = 0; q4 < 4; ++q4) { const f32x4 c0 = *(LAS const f32x4*)(cs + 8 * q4), c1 = *(LAS const f32x4*)(cs + 32 + 8 * q4);
#pragma unroll
                    for (int e = 0; e < 4; ++e) { p0[4 * q4 + e] = fmaf(p0[4 * q4 + e], C2, ctl - c0[e]); p1[4 * q4 + e] = fmaf(p1[4 * q4 + e], C2, ctl - c1[e]); } }
                if (kbp + 63 > qlo) { const int dq = row - kbp - 4 * hi;
#pragma unroll
                    for (int r = 0; r < 16; ++r) { const int c = (r & 3) + 8 * (r >> 2); if (dq - c < 0) p0[r] = NEG; if (dq - c - 32 < 0) p1[r] = NEG; } }
            } else {
#pragma unroll
                for (int r = 0; r < 16; ++r) { p0[r] *= C2; p1[r] *= C2; }
                if (MODE == 2) {
#pragma unroll
                    for (int r = 0; r < 16; ++r) { const int c = (r & 3) + 8 * (r >> 2) + 4 * hi; if (!((mk0 >> c) & 1u)) p0[r] = NEG; if (!((mk1 >> c) & 1u)) p1[r] = NEG; } }
            }
            float alpha; bf16x8 pa0, pa1, pa2, pa3;
            softmax_tile(p0, p1, m_reg, l_reg, alpha, pa0, pa1, pa2, pa3);
            if (__any(alpha < 1.f)) { if (hi == 0) wsc[r32] = alpha; LDS_WAIT();
#pragma unroll
                for (int r = 0; r < 16; ++r) { const float al = wsc[crow(r, hi)];
#pragma unroll
                    for (int d_ = 0; d_ < 4; ++d_) o[d_][r] *= al; }
                LDS_WAIT(); }
            pv_tile(o, vbase + buf * SHM_V, pa0, pa1, pa2, pa3);
        }
        asm volatile("s_waitcnt vmcnt(0)" ::: "memory");
        if (t + 1 < NT) FA_CSW(buf ^ 1);
        __syncthreads();
    }
#undef FA_DMA
#undef FA_CSW
    if (hi == 0) wsc[32 + r32] = l_reg; LDS_WAIT();
#pragma unroll
    for (int r = 0; r < 16; ++r) { const int orow = crow(r, hi); const float rl = __builtin_amdgcn_rcpf(wsc[32 + orow]);
#pragma unroll
        for (int d0 = 0; d0 < 4; ++d0) { const float v = o[d0][r] * rl; const float vn = __shfl_xor(v, 1);
            if ((r32 & 1) == 0) *(unsigned*)(Og + (size_t)orow * ldo + d0 * 32 + r32) = cvtpk(v, vn); } }
    LDS_WAIT();
}
}

__device__ __forceinline__ void rope_pair(float& x1, float& x2, float cs, float sn) { const float a = x1 * cs - x2 * sn, b = x2 * cs + x1 * sn; x1 = a; x2 = b; }
__device__ __forceinline__ void ph_l0_stats(const Args& a, const WI& w) {
    unsigned char* ws = a.ws; const bf16_t* P = (const bf16_t*)(ws + WS_PROJ);
    const float* r64 = (const float*)(ws + WS_ROPE64);
    for (int t = w.gw; t < T; t += w.ngw) {
        const bf16_t* row = P + (size_t)t * AB_MAIN;
        float s = 0.f;
        for (int j = 0; j < 3; ++j) { const bf16x8 v = *(const bf16x8*)(row + 6144 + (j * 64 + w.lane) * 8);
#pragma unroll
            for (int e = 0; e < 8; ++e) { const float f = bf2f((bf16_t)v[e]); s += f * f; } }
        s = wave_sum(s);
        float s2 = 0.f; { const bf16x8 v = *(const bf16x8*)(row + 7680 + w.lane * 8);
#pragma unroll
            for (int e = 0; e < 8; ++e) { const float f = bf2f((bf16_t)v[e]); s2 += f * f; } }
        s2 = wave_sum(s2);
        if (w.lane == 0) { ((float*)(ws + WS_RSQ))[t] = 1.f / sqrtf(s * (1.f / 1536.f) + RMS_EPS); ((float*)(ws + WS_RSKV))[t] = 1.f / sqrtf(s2 * (1.f / 512.f) + RMS_EPS); }
        if (w.lane < 32) { const float* sm = (const float*)(ws + WS_SMALL) + (size_t)t * 128; const int sp = t & (SEQ - 1);
            float x1 = sm[w.lane], x2 = sm[w.lane + 32]; const float cs = r64[((size_t)sp * 32 + w.lane) * 2], sn = r64[((size_t)sp * 32 + w.lane) * 2 + 1];
            rope_pair(x1, x2, cs, sn);
            bf16_t* kr = (bf16_t*)(ws + WS_KR) + (size_t)t * 64; kr[w.lane] = (bf16_t)f2bf(x1); kr[w.lane + 32] = (bf16_t)f2bf(x2); }
    }
}
__device__ __forceinline__ void ph_l0_qrope(const Args& a, const WI& w) {
    unsigned char* ws = a.ws; bf16_t* Q = (bf16_t*)(ws + WS_QB); const float* r64 = (const float*)(ws + WS_ROPE64);
    for (int t = w.gw; t < T; t += w.ngw) {
        const int sp = t & (SEQ - 1);
        for (int e = w.lane; e < 16 * 32; e += 64) { const int h = e >> 5, i = e & 31; bf16_t* q = Q + (size_t)t * 3072 + h * 192 + 128;
            float x1 = bf2f(q[i]), x2 = bf2f(q[i + 32]); rope_pair(x1, x2, r64[((size_t)sp * 32 + i) * 2], r64[((size_t)sp * 32 + i) * 2 + 1]);
            q[i] = (bf16_t)f2bf(x1); q[i + 32] = (bf16_t)f2bf(x2); }
    }
}
__device__ __forceinline__ void ph_l1_elem(const Args& a, const WI& w) {
    unsigned char* ws = a.ws; bf16_t* P = (bf16_t*)(ws + WS_PROJ);
    const float* r128 = (const float*)(ws + WS_ROPE128); const float* r64 = (const float*)(ws + WS_ROPE64);
    for (int t = w.gw; t < T; t += w.ngw) {
        const int b = t / SEQ, sp = t - b * SEQ; bf16_t* row = P + (size_t)t * CD_MAIN;
        for (int e = w.lane; e < 20 * 64; e += 64) { const int h = e >> 6, i = e & 63; bf16_t* q = row + h * 128;
            float x1 = bf2f(q[i]), x2 = bf2f(q[i + 64]); rope_pair(x1, x2, r128[((size_t)sp * 64 + i) * 2], r128[((size_t)sp * 64 + i) * 2 + 1]);
            q[i] = (bf16_t)f2bf(x1); q[i + 64] = (bf16_t)f2bf(x2); }
        for (int e = w.lane; e < 32 * 32; e += 64) { const int h = e >> 5, i = e & 31; bf16_t* q = row + 3072 + h * 64;
            float x1 = bf2f(q[i]), x2 = bf2f(q[i + 32]); rope_pair(x1, x2, r64[((size_t)sp * 32 + i) * 2], r64[((size_t)sp * 32 + i) * 2 + 1]);
            q[i] = (bf16_t)f2bf(x1); q[i + 32] = (bf16_t)f2bf(x2); }
        const float* sm = (const float*)(ws + WS_SMALL) + (size_t)t * 128;
        if (w.lane < 32) { float x1 = sm[w.lane], x2 = sm[w.lane + 32]; rope_pair(x1, x2, r64[((size_t)sp * 32 + w.lane) * 2], r64[((size_t)sp * 32 + w.lane) * 2 + 1]);
            bf16_t* ki = (bf16_t*)(ws + WS_KI) + (size_t)t * 64; ki[w.lane] = (bf16_t)f2bf(x1); ki[w.lane + 32] = (bf16_t)f2bf(x2);
            ((float*)(ws + WS_WI))[(size_t)t * 32 + w.lane] = sm[64 + w.lane] * 0.17677669529663687f; }
        if (w.lane < 16) { const float z = sm[96 + w.lane] + a.in[I_D_FORGET_BIAS][w.lane];
            const float lf = fminf(z, 0.f) - log1pf(__expf(-fabsf(z)));
            ((float*)(ws + WS_LOGF))[((size_t)b * 16 + w.lane) * SEQ + sp] = lf; }
    }
}
__device__ __forceinline__ void ph_l1_scan(const Args& a, const WI& w) {
    unsigned char* ws = a.ws;
    for (int it = w.gw; it < NB * 16; it += w.ngw) {
        const float* src = (const float*)(ws + WS_LOGF) + (size_t)it * SEQ + w.lane * 64; float* dst = (float*)(ws + WS_CUM) + (size_t)it * SEQ + w.lane * 64;
        float tot = 0.f; for (int j = 0; j < 64; ++j) tot += src[j];
        float inc = tot;
#pragma unroll
        for (int o = 1; o < 64; o <<= 1) { const float v = __shfl_up(inc, o); if (w.lane >= o) inc += v; }
        float run = inc - tot;
        for (int j = 0; j < 64; ++j) { run += src[j]; dst[j] = run; }
    }
}
__device__ __forceinline__ void ph_l1_index_naive(const Args& a, LAS float* qs  , const WI& w) {
    unsigned char* ws = a.ws; const bf16_t* P = (const bf16_t*)(ws + WS_PROJ); const bf16_t* KI = (const bf16_t*)(ws + WS_KI);
    const float* WIp = (const float*)(ws + WS_WI); float* SC = (float*)(ws + WS_SCORE);
    for (int t = w.gw; t < T; t += w.ngw) {
        const int b = t / SEQ, sp = t - b * SEQ, nadm = ((sp >> 6) + 1) * 64;
        LDS_WAIT();
        for (int e = w.lane; e < 2048; e += 64) qs[e] = bf2f(P[(size_t)t * CD_MAIN + 3072 + e]);
        if (w.lane < 32) qs[2048 + w.lane] = WIp[(size_t)t * 32 + w.lane];
        LDS_WAIT();
        for (int s0 = 0; s0 < nadm; s0 += 64) {
            const int s = s0 + w.lane; const bf16_t* kp = KI + ((size_t)b * SEQ + s) * 64;
            float k[64];
#pragma unroll
            for (int d0 = 0; d0 < 64; d0 += 8) { const bf16x8 kv = *(const bf16x8*)(kp + d0);
#pragma unroll
                for (int e = 0; e < 8; ++e) k[d0 + e] = bf2f((bf16_t)kv[e]); }
            float sc = 0.f;
            for (int h = 0; h < 32; ++h) { float dot = 0.f;
#pragma unroll
                for (int d = 0; d < 64; ++d) dot += qs[h * 64 + d] * k[d];
                sc += qs[2048 + h] * fmaxf(dot * 0.125f, 0.f); }
            SC[((size_t)b * SEQ + sp) * SEQ + s] = sc;
        }
    }
}
__device__ __forceinline__ void ph_l1_select(const Args& a, const WI& w) {
    unsigned char* ws = a.ws; const float* SC = (const float*)(ws + WS_SCORE); unsigned* MK = (unsigned*)(ws + WS_MASK);
    for (int t = w.gw; t < T; t += w.ngw) {
        const int b = t / SEQ, sp = t - b * SEQ, nblk = (sp >> 6) + 1;
        const float* row = SC + ((size_t)b * SEQ + sp) * SEQ;
        unsigned key[64];
#pragma unroll
        for (int j = 0; j < 64; ++j) { unsigned u = 0u; if (j < nblk) { u = __float_as_uint(row[j * 64 + w.lane]); u ^= (u >> 31) ? 0xFFFFFFFFu : 0x80000000u; } key[j] = u; }
        unsigned thr = 0u;
        if (nblk > 4) {
            for (int bit = 31; bit >= 0; --bit) { const unsigned cand = thr | (1u << bit); int cnt = 0;
#pragma unroll
                for (int j = 0; j < 64; ++j) cnt += (key[j] >= cand) ? 1 : 0;
                cnt = wave_sum_i(cnt); if (cnt >= 256) thr = cand; }
        }
        unsigned lo = 0u, hi = 0u;
#pragma unroll
        for (int j = 0; j < 64; ++j) { const bool sel = (j < nblk) && (key[j] >= thr); const unsigned long long bal = __ballot(sel); if (w.lane == j) { lo = (unsigned)bal; hi = (unsigned)(bal >> 32); } }
        *(u32x2*)(MK + (size_t)t * 128 + 2 * w.lane) = (u32x2){lo, hi};
    }
}

__device__ __forceinline__ void ph_peer_topk(const Args& a, const WI& w) {
    unsigned char* ws = a.ws; const float* PS = (const float*)(ws + WS_PSCORE); int* PIDX = (int*)(ws + WS_PIDX); float* PG = (float*)(ws + WS_PGATE);
    const float NEG = -__builtin_inff();
    for (int t = w.gw; t < T; t += w.ngw) {
        for (int h = 0; h < 8; ++h) {
            const float* s = PS + (size_t)t * 2048 + h * 256;
            float ts[2]; int ti[2];
#pragma unroll
            for (int p = 0; p < 2; ++p) {
                float v0 = s[p * 128 + w.lane], v1 = s[p * 128 + 64 + w.lane]; float mys = NEG; int myi = 0;
                for (int k = 0; k < 16; ++k) {
                    const float m = wave_max(fmaxf(v0, v1));
                    const unsigned long long b0 = __ballot(v0 == m); int idx;
                    if (b0) { const int src = __ffsll((long long)b0) - 1; idx = src; if (w.lane == src) v0 = NEG; }
                    else { const unsigned long long b1 = __ballot(v1 == m); const int src = __ffsll((long long)b1) - 1; idx = src + 64; if (w.lane == src) v1 = NEG; }
                    if (w.lane == k) { mys = m; myi = idx; }
                }
                ts[p] = mys; ti[p] = myi;
            }
            float cv[4];
#pragma unroll
            for (int q = 0; q < 4; ++q) { const int c = w.lane + 64 * q; cv[q] = __shfl(ts[0], c >> 4) + __shfl(ts[1], c & 15); }
            float bs = NEG; int bc = 0;
            for (int k = 0; k < 16; ++k) {
                const float m = wave_max(fmaxf(fmaxf(cv[0], cv[1]), fmaxf(cv[2], cv[3])));
                int cidx = -1;
#pragma unroll
                for (int q = 0; q < 4; ++q) { if (cidx < 0) { const unsigned long long bb = __ballot(cv[q] == m); if (bb) { const int src = __ffsll((long long)bb) - 1; cidx = src + 64 * q; if (w.lane == src) cv[q] = NEG; } } }
                if (w.lane == k) { bs = m; bc = cidx; }
            }
            const int e0 = __shfl(ti[0], bc >> 4), e1 = __shfl(ti[1], bc & 15);
            const float top = __shfl(bs, 0);
            const float ex = (w.lane < 16) ? __expf(bs - top) : 0.f;
            const float den = wave_sum(ex);
            if (w.lane < 16) { PIDX[(size_t)t * 128 + h * 16 + w.lane] = e0 * 128 + e1; PG[(size_t)t * 128 + h * 16 + w.lane] = ex / den; }
        }
    }
}
__device__ __forceinline__ void ph_peer_experts(const Args& a, int layer, float* outf, bf16_t* outb, const float* g, const float* bta, LAS float* wsm  , const WI& w) {
    unsigned char* ws = a.ws; const bf16_t* XB = (const bf16_t*)(ws + WS_XB); const float* HF = (const float*)(ws + WS_HF);
    const bf16_t* U = (const bf16_t*)(ws + WS_U16) + (size_t)layer * 16384 * DM; const bf16_t* V = (const bf16_t*)(ws + WS_V16) + (size_t)layer * 16384 * DM;
    const int* PIDX = (const int*)(ws + WS_PIDX); const float* PG = (const float*)(ws + WS_PGATE);
    for (int t = w.gw; t < T; t += w.ngw) {
        u32x4 xr[8];
#pragma unroll
        for (int j = 0; j < 8; ++j) xr[j] = *(const u32x4*)(XB + (size_t)t * DM + 512 * j + 8 * w.lane);
        LDS_WAIT();
        for (int k0 = 0; k0 < 128; k0 += 4) {
            float z[4];
#pragma unroll
            for (int q = 0; q < 4; ++q) {
                const int e = __builtin_amdgcn_readfirstlane(PIDX[(size_t)t * 128 + k0 + q]);
                const bf16_t* ur = U + (size_t)e * DM + 8 * w.lane; float acc = 0.f;
#pragma unroll
                for (int j = 0; j < 8; ++j) { const u32x4 uv = *(const u32x4*)(ur + 512 * j);
                    acc += __uint_as_float(uv.x << 16) * __uint_as_float(xr[j].x << 16) + __uint_as_float(uv.x & 0xffff0000u) * __uint_as_float(xr[j].x & 0xffff0000u);
                    acc += __uint_as_float(uv.y << 16) * __uint_as_float(xr[j].y << 16) + __uint_as_float(uv.y & 0xffff0000u) * __uint_as_float(xr[j].y & 0xffff0000u);
                    acc += __uint_as_float(uv.z << 16) * __uint_as_float(xr[j].z << 16) + __uint_as_float(uv.z & 0xffff0000u) * __uint_as_float(xr[j].z & 0xffff0000u);
                    acc += __uint_as_float(uv.w << 16) * __uint_as_float(xr[j].w << 16) + __uint_as_float(uv.w & 0xffff0000u) * __uint_as_float(xr[j].w & 0xffff0000u); }
                z[q] = acc;
            }
#pragma unroll
            for (int q = 0; q < 4; ++q) z[q] = wave_sum(z[q]);
            if (w.lane < 4) { const float zz = (w.lane == 0) ? z[0] : (w.lane == 1) ? z[1] : (w.lane == 2) ? z[2] : z[3];
                const float act = 0.5f * zz * (1.f + erff(zz * 0.70710678118654752f));
                wsm[k0 + w.lane] = act * PG[(size_t)t * 128 + k0 + w.lane]; }
        }
        LDS_WAIT();
        float y[64];
#pragma unroll
        for (int i = 0; i < 64; ++i) y[i] = 0.f;
        for (int k0 = 0; k0 < 128; k0 += 2) {
#pragma unroll
            for (int q = 0; q < 2; ++q) {
                const int e = __builtin_amdgcn_readfirstlane(PIDX[(size_t)t * 128 + k0 + q]); const float wt = wsm[k0 + q];
                const bf16_t* vr = V + (size_t)e * DM + 8 * w.lane;
#pragma unroll
                for (int j = 0; j < 8; ++j) { const u32x4 vv = *(const u32x4*)(vr + 512 * j);
                    y[8 * j + 0] += wt * __uint_as_float(vv.x << 16); y[8 * j + 1] += wt * __uint_as_float(vv.x & 0xffff0000u);
                    y[8 * j + 2] += wt * __uint_as_float(vv.y << 16); y[8 * j + 3] += wt * __uint_as_float(vv.y & 0xffff0000u);
                    y[8 * j + 4] += wt * __uint_as_float(vv.z << 16); y[8 * j + 5] += wt * __uint_as_float(vv.z & 0xffff0000u);
                    y[8 * j + 6] += wt * __uint_as_float(vv.w << 16); y[8 * j + 7] += wt * __uint_as_float(vv.w & 0xffff0000u); }
            }
        }
        float s = 0.f;
#pragma unroll
        for (int j = 0; j < 8; ++j) { const float* hp = HF + (size_t)t * DM + 512 * j + 8 * w.lane; const f32x4 h0 = *(const f32x4*)hp, h1 = *(const f32x4*)(hp + 4);
            y[8 * j + 0] += ALPHA * h0.x; y[8 * j + 1] += ALPHA * h0.y; y[8 * j + 2] += ALPHA * h0.z; y[8 * j + 3] += ALPHA * h0.w;
            y[8 * j + 4] += ALPHA * h1.x; y[8 * j + 5] += ALPHA * h1.y; y[8 * j + 6] += ALPHA * h1.z; y[8 * j + 7] += ALPHA * h1.w; }
#pragma unroll
        for (int i = 0; i < 64; ++i) s += y[i];
        const float mean = wave_sum(s) * (1.f / DM); float s2 = 0.f;
#pragma unroll
        for (int i = 0; i < 64; ++i) { y[i] -= mean; s2 += y[i] * y[i]; }
        const float rstd = 1.f / sqrtf(wave_sum(s2) * (1.f / DM) + LN_EPS);
#pragma unroll
        for (int j = 0; j < 8; ++j) { const int c = 512 * j + 8 * w.lane;
            const f32x4 g0 = *(const f32x4*)(g + c), g1 = *(const f32x4*)(g + c + 4), b0 = *(const f32x4*)(bta + c), b1 = *(const f32x4*)(bta + c + 4);
            f32x4 o0, o1;
            o0.x = y[8 * j + 0] * rstd * g0.x + b0.x; o0.y = y[8 * j + 1] * rstd * g0.y + b0.y; o0.z = y[8 * j + 2] * rstd * g0.z + b0.z; o0.w = y[8 * j + 3] * rstd * g0.w + b0.w;
            o1.x = y[8 * j + 4] * rstd * g1.x + b1.x; o1.y = y[8 * j + 5] * rstd * g1.y + b1.y; o1.z = y[8 * j + 6] * rstd * g1.z + b1.z; o1.w = y[8 * j + 7] * rstd * g1.w + b1.w;
            *(f32x4*)(outf + (size_t)t * DM + c) = o0; *(f32x4*)(outf + (size_t)t * DM + c + 4) = o1;
            if (outb) { u32x4 p; p.x = pk2(o0.x, o0.y); p.y = pk2(o0.z, o0.w); p.z = pk2(o1.x, o1.y); p.w = pk2(o1.z, o1.w); *(u32x4*)(outb + (size_t)t * DM + c) = p; } }
    }
}

__device__ __forceinline__ void ph_attn_l0(const Args& a, LAS unsigned char* lds, const WI& w) {
    for (int pr = w.bid; pr < 256; pr += w.nblk) { const int bh = pr >> 3, x = pr & 7;
        for (int pass = 0; pass < 2; ++pass) fa::attn_unit<1>(a, 0, lds, bh >> 4, bh & 15, pass ? 15 - x : x); }
    for (int u = w.bid; u < 512; u += w.nblk) { const int bh = u >> 4; fa::attn_unit<0>(a, 0, lds, bh >> 4, bh & 15, u & 15); }
}
__device__ __forceinline__ void ph_attn_l1(const Args& a, LAS unsigned char* lds, const WI& w) {
    for (int pr = w.bid; pr < 256; pr += w.nblk) { const int bh = pr >> 3, x = pr & 7;
        for (int pass = 0; pass < 2; ++pass) fa::attn_unit<2>(a, 1, lds, bh >> 4, bh & 15, pass ? 15 - x : x); }
    for (int pr = w.bid; pr < 256; pr += w.nblk) { const int bh = pr >> 3, x = pr & 7;
        for (int pass = 0; pass < 2; ++pass) fa::attn_unit<3>(a, 1, lds, bh >> 4, bh & 15, pass ? 15 - x : x); }
}
__device__ __forceinline__ void ph_attn_mem(const Args& a, int layer, LAS unsigned char* lds, const WI& w) {
    for (int u = w.bid; u < 128; u += w.nblk) { const int bh = u >> 4; fa::attn_unit<4>(a, layer, lds, bh >> 2, bh & 3, u & 15); }
}

__global__ void __launch_bounds__(512, 2) mega(Args a) {
    extern __shared__ __attribute__((aligned(16))) unsigned char lds_raw[];
    LAS unsigned char* lds = (LAS unsigned char*)lds_raw;
    WI w; w.tid = threadIdx.x; w.lane = w.tid & 63; w.wave = __builtin_amdgcn_readfirstlane(w.tid >> 6);
    w.bid = blockIdx.x; w.nblk = gridDim.x; w.gw = w.bid * 8 + w.wave; w.ngw = w.nblk * 8;
    unsigned char* ws = a.ws;
    volatile LAS unsigned* misc = (volatile LAS unsigned*)(lds + LDS_MISC);
    if (w.tid < 4) misc[w.tid] = 0u;
    __syncthreads();
    XcdBarrier bar; bar.bar = (unsigned*)(ws + WS_CTL) + 4096; bar.x = 0; bar.st = misc;
#if !MK_PER_PHASE
    bar = xcd_barrier_post((unsigned*)(ws + WS_CTL) + 4096, misc);
#endif
    const int lo = a.ph_lo, hi = a.ph_hi;
#define IN(k) (lo <= (k) && (k) < hi)
#if MK_PER_PHASE
#define SEAM(k) do { } while (0)
#else
#define SEAM(k) do { if (IN(k) && IN((k) + 1)) xcd_barrier(bar); } while (0)
#endif
    LAS float* wlds = (LAS float*)(lds + w.wave * 16384);
    bf16_t* XB = (bf16_t*)(ws + WS_XB); float* HF = (float*)(ws + WS_HF); float* RES = (float*)(ws + WS_RES); bf16_t* PROJ = (bf16_t*)(ws + WS_PROJ);
    bf16_t* ATT = (bf16_t*)(ws + WS_ATT); float* SMALL = (float*)(ws + WS_SMALL);

#define FAST_GEMM(EPI_T, Aptr, lda_, Btptr, ldb_, M_, N_, K_, nz_, zA_, zB_, EPI_OBJ) do { \
        pg8::Gemm g_{Aptr, Btptr, M_, N_, K_, lda_, ldb_, zA_, zB_, nz_}; pg8::StaticOrder S_; S_.init(M_, N_, nz_, w.nblk, w.bid); \
        pg8::gemm_phase<EPI_T, pg8::StaticOrder>(lds, g_, S_, EPI_OBJ); } while (0)
    if (IN(0)) ph_convert(a, lds, w);
    SEAM(0);
    if (IN(1)) {
        FAST_GEMM(pg8::EpiBf16, XB, DM, (const bf16_t*)(ws + WS_W_AB_IN), DM, T, AB_MAIN, DM, 1, 0, 0, (pg8::EpiBf16{PROJ, AB_MAIN, nullptr}));
        naive_gemm(XB, DM, (const bf16_t*)(ws + WS_W_AB_IN) + (size_t)AB_MAIN * DM, DM, T, 64, DM, w, [=](int m, int n, float v) { SMALL[(size_t)m * 128 + n] = v; });
        bf16_t* KVM = (bf16_t*)(ws + WS_KVM);
        naive_gemm((const bf16_t*)(ws + WS_MEMB), DM, (const bf16_t*)(ws + WS_W_MEM_KV), DM, 512, 2048, DM, w,
                   [=](int m, int n, float v) { KVM[((size_t)(n >> 10) * 512 + m) * 1024 + (n & 1023)] = (bf16_t)f2bf(v); });
    }
    SEAM(1);
    if (IN(2)) ph_l0_stats(a, w);
    SEAM(2);
    if (IN(3)) {
        const float* rsq = (const float*)(ws + WS_RSQ); const float* rskv = (const float*)(ws + WS_RSKV);
        bf16_t* QB = (bf16_t*)(ws + WS_QB); bf16_t* KVB = (bf16_t*)(ws + WS_KVB);
        FAST_GEMM(pg8::EpiBf16, PROJ + 6144, AB_MAIN, (const bf16_t*)(ws + WS_W_UQ), 1536, T, 3072, 1536, 1, 0, 0, (pg8::EpiBf16{QB, 3072, rsq}));
        FAST_GEMM(pg8::EpiBf16, PROJ + 7680, AB_MAIN, (const bf16_t*)(ws + WS_W_UKV), 512, T, 4096, 512, 1, 0, 0, (pg8::EpiBf16{KVB, 4096, rskv}));
    }
    SEAM(3);
    if (IN(4)) ph_l0_qrope(a, w);
    SEAM(4);
    if (IN(5)) ph_attn_l0(a, lds, w);
    SEAM(5);
    if (IN(6)) { const float* X = a.in[I_X];
        FAST_GEMM(pg8::EpiResid, ATT, DM, (const bf16_t*)(ws + WS_W_AB_OUT), DM, T, DM, DM, 1, 0, 0, (pg8::EpiResid{X, RES, DM})); }
    SEAM(6);
    if (IN(7)) ln_rows(RES, a.in[I_LN_G] + 0 * DM, a.in[I_LN_B] + 0 * DM, HF, XB, w);
    SEAM(7);

#define MEM_PEER_PHASES(L, P0_, LAST)                                                                                                                         \
    if (IN(P0_)) { FAST_GEMM(pg8::EpiF32, XB, DM, (const bf16_t*)(ws + WS_W_MEM_Q) + (size_t)(L) * 512 * DM, DM, T, 512, 1024, 4, 1024, 1024,                    \
                             (pg8::EpiF32{(float*)(ws + WS_MQP), 512, (long)T * 512})); }                                                                       \
    SEAM(P0_);                                                                                                                                                  \
    if (IN(P0_ + 1)) ph_attn_mem(a, (L), lds, w);                                                                                                               \
    SEAM(P0_ + 1);                                                                                                                                              \
    if (IN(P0_ + 2)) { FAST_GEMM(pg8::EpiResid, (const bf16_t*)(ws + WS_MEMO), 512, (const bf16_t*)(ws + WS_W_MEM_O) + (size_t)(L) * DM * 512, 512, T, DM, 512, 1, 0, 0, \
                                 (pg8::EpiResid{HF, RES, DM})); }                                                                                               \
    SEAM(P0_ + 2);                                                                                                                                              \
    if (IN(P0_ + 3)) ln_rows(RES, a.in[I_LN_G] + ((L) * 3 + 1) * DM, a.in[I_LN_B] + ((L) * 3 + 1) * DM, HF, XB, w);                                             \
    SEAM(P0_ + 3);                                                                                                                                              \
    if (IN(P0_ + 4)) { FAST_GEMM(pg8::EpiF32, XB, DM, (const bf16_t*)(ws + WS_W_PEER) + (size_t)(L) * 2048 * DM, DM, T, 2048, DM, 1, 0, 0,                     \
                                 (pg8::EpiF32{(float*)(ws + WS_PSCORE), 2048, 0})); }                                                                           \
    SEAM(P0_ + 4);                                                                                                                                              \
    if (IN(P0_ + 5)) ph_peer_topk(a, w);                                                                                                                        \
    SEAM(P0_ + 5);                                                                                                                                              \
    if (IN(P0_ + 6)) ph_peer_experts(a, (L), (LAST) ? a.out : HF, (LAST) ? (bf16_t*)nullptr : XB, a.in[I_LN_G] + ((L) * 3 + 2) * DM, a.in[I_LN_B] + ((L) * 3 + 2) * DM, wlds, w); \
    if (!(LAST)) SEAM(P0_ + 6);

    MEM_PEER_PHASES(0, 8, false)

    if (IN(15)) {
        FAST_GEMM(pg8::EpiBf16, XB, DM, (const bf16_t*)(ws + WS_W_CD_IN), DM, T, CD_MAIN, DM, 1, 0, 0, (pg8::EpiBf16{PROJ, CD_MAIN, nullptr}));
        naive_gemm(XB, DM, (const bf16_t*)(ws + WS_W_CD_IN) + (size_t)CD_MAIN * DM, DM, T, 112, DM, w, [=](int m, int n, float v) { SMALL[(size_t)m * 128 + n] = v; });
    }
    SEAM(15);
    if (IN(16)) ph_l1_elem(a, w);
    SEAM(16);
    if (IN(17)) { ph_l1_scan(a, w); ph_l1_index_naive(a, wlds, w); }
    SEAM(17);
    if (IN(18)) ph_l1_select(a, w);
    SEAM(18);
    if (IN(19)) ph_attn_l1(a, lds, w);
    SEAM(19);
    if (IN(20)) { FAST_GEMM(pg8::EpiResid, ATT, DM, (const bf16_t*)(ws + WS_W_CD_OUT), DM, T, DM, DM, 1, 0, 0, (pg8::EpiResid{HF, RES, DM})); }
    SEAM(20);
    if (IN(21)) ln_rows(RES, a.in[I_LN_G] + 3 * DM, a.in[I_LN_B] + 3 * DM, HF, XB, w);
    SEAM(21);
    MEM_PEER_PHASES(1, 22, true)
#undef IN
#undef SEAM
}

extern "C" void kernel_launch(void* const* d_in, const int* in_sizes, int n_in, void* d_out, int out_size, void* d_ws, size_t ws_size, hipStream_t stream) {
    static int grid = 0;
    if (grid == 0) {
        if (n_in != 21 || out_size != T * DM || ws_size < WS_END) { fprintf(stderr, "kernel_launch: unexpected shapes (n_in %d out %d ws %zu need %zu)\n", n_in, out_size, ws_size, (size_t)WS_END); grid = -1; return; }
        int dev = 0, cus = 0, per_cu = 0;
        if (hipGetDevice(&dev) != hipSuccess || hipDeviceGetAttribute(&cus, hipDeviceAttributeMultiprocessorCount, dev) != hipSuccess) { grid = -1; return; }
        if (hipFuncSetAttribute((const void*)mega, hipFuncAttributeMaxDynamicSharedMemorySize, LDS_BYTES) != hipSuccess) { fprintf(stderr, "kernel_launch: hipFuncSetAttribute failed\n"); grid = -1; return; }
        if (hipOccupancyMaxActiveBlocksPerMultiprocessor(&per_cu, (const void*)mega, 512, LDS_BYTES) != hipSuccess || per_cu < 1) { fprintf(stderr, "kernel_launch: occupancy query says %d\n", per_cu); }
        (void)hipGetLastError();
        grid = cus;
    }
    if (grid < 0) return;
    (void)hipMemsetAsync((char*)d_ws + WS_CTL, 0, CTL_BYTES, stream);
    Args a{};
    for (int i = 0; i < 21; ++i) a.in[i] = (const float*)d_in[i];
    a.out = (float*)d_out; a.ws = (unsigned char*)d_ws;
#if MK_PER_PHASE
    for (int p = 0; p < NPHASE; ++p) { a.ph_lo = p; a.ph_hi = p + 1; hipLaunchKernelGGL(mega, dim3(grid), dim3(512), LDS_BYTES, stream, a); }
#else
    a.ph_lo = 0; a.ph_hi = NPHASE;
    hipLaunchKernelGGL(mega, dim3(grid), dim3(512), LDS_BYTES, stream, a);
#endif
}
```

```cpp
#include <hip/hip_runtime.h>
#include <cstdio>
#include <cstdint>

#define GAS __attribute__((address_space(1)))
#define LAS __attribute__((address_space(3)))
typedef unsigned short bf16_t;
typedef short bf16x8 __attribute__((ext_vector_type(8)));
typedef float f32x4 __attribute__((ext_vector_type(4)));
typedef float f32x16 __attribute__((ext_vector_type(16)));
typedef unsigned u32x4 __attribute__((ext_vector_type(4)));
typedef unsigned u32x2 __attribute__((ext_vector_type(2)));
typedef float f32x2 __attribute__((ext_vector_type(2)));

#ifndef PROBE_DUP
#define PROBE_DUP -1
#endif
#ifndef MK_PER_PHASE
#define MK_PER_PHASE 0
#endif

constexpr int NB = 2, SEQ = 4096, T = NB * SEQ, DM = 4096;
constexpr int AB_COLS = 8256, AB_MAIN = 8192, AB_PAD = 8448;
constexpr int CD_COLS = 11376, CD_MAIN = 11264, CD_PAD = 11520;
constexpr float ALPHA = 1.4142135623730951f;
constexpr float LN_EPS = 1e-5f, RMS_EPS = 1e-6f;
constexpr int NPHASE = 29;

constexpr size_t MiB = 1ull << 20;
constexpr size_t WS_CTL = 0, CTL_BYTES = 1 * MiB;
constexpr size_t WS_ROPE128 = 1 * MiB;
constexpr size_t WS_ROPE64 = 3 * MiB;
constexpr size_t WS_RSQ = 4 * MiB;
constexpr size_t WS_RSKV = 4 * MiB + 65536;
constexpr size_t WS_CUM = 5 * MiB;
constexpr size_t WS_LOGF = 5 * MiB + 524288;
constexpr size_t WS_KR = 6 * MiB;
constexpr size_t WS_KI = 7 * MiB;
constexpr size_t WS_WI = 8 * MiB;
constexpr size_t WS_KVM = 9 * MiB;
constexpr size_t WS_MEMB = 11 * MiB;
constexpr size_t WS_MASK = 15 * MiB;
constexpr size_t WS_PIDX = 19 * MiB;
constexpr size_t WS_PGATE = 23 * MiB;
constexpr size_t WS_MEMQ = 27 * MiB;
constexpr size_t WS_MEMO = 35 * MiB;
constexpr size_t WS_SMALL = 43 * MiB;
constexpr size_t WS_W_AB_IN = 64 * MiB;
constexpr size_t WS_W_UQ = 130 * MiB;
constexpr size_t WS_W_UKV = 139 * MiB;
constexpr size_t WS_W_AB_OUT = 143 * MiB;
constexpr size_t WS_W_CD_IN = 175 * MiB;
constexpr size_t WS_W_CD_OUT = 265 * MiB;
constexpr size_t WS_W_MEM_Q = 297 * MiB;
constexpr size_t WS_W_MEM_KV = 305 * MiB;
constexpr size_t WS_W_MEM_O = 321 * MiB;
constexpr size_t WS_W_PEER = 329 * MiB;
constexpr size_t WS_U8 = 361 * MiB;
constexpr size_t WS_V8 = 489 * MiB;
constexpr size_t WS_USC = 48 * MiB;
constexpr size_t WS_VSC = 48 * MiB + 262144;
constexpr size_t WS_XB = 873 * MiB;
constexpr size_t WS_HF = 937 * MiB;
constexpr size_t WS_RES = 1065 * MiB;
constexpr size_t WS_PROJ = 1193 * MiB;
constexpr size_t WS_PSCORE = WS_PROJ;
constexpr size_t WS_ATT = 1369 * MiB;
constexpr size_t WS_QB = 1433 * MiB;
constexpr size_t WS_KVB = 1481 * MiB;
constexpr size_t WS_SCORE = 1433 * MiB;
constexpr size_t WS_MQP = 1561 * MiB;
constexpr size_t WS_END = 1625 * MiB;

constexpr int LDS_BYTES = 147456;
constexpr int LDS_MISC = 140 * 1024;

#define LDS_WAIT() asm volatile("s_waitcnt lgkmcnt(0)" ::: "memory")
__device__ __forceinline__ float bf2f(bf16_t b) { return __uint_as_float(((unsigned)b) << 16); }
__device__ __forceinline__ unsigned f2bf(float f) { unsigned u = __float_as_uint(f); return (u + 0x7fffu + ((u >> 16) & 1u)) >> 16; }
__device__ __forceinline__ unsigned pk2(float lo, float hi) { return f2bf(lo) | (f2bf(hi) << 16); }
__device__ __forceinline__ float wave_sum(float v) {
#pragma unroll
    for (int o = 1; o < 64; o <<= 1) v += __shfl_xor(v, o);
    return v;
}
__device__ __forceinline__ float wave_max(float v) {
#pragma unroll
    for (int o = 1; o < 64; o <<= 1) v = fmaxf(v, __shfl_xor(v, o));
    return v;
}
__device__ __forceinline__ int wave_sum_i(int v) {
#pragma unroll
    for (int o = 1; o < 64; o <<= 1) v += __shfl_xor(v, o);
    return v;
}

#define XB_TMO      128
#define XB_XCNT(j)  (256  + 64 * (j))
#define XB_XSUB(j)  (1280 + 64 * (j))
#define XB_XGEN(j)  (2304 + 64 * (j))
#define XB_TOP      3328
#define XB_TOPGEN   3392
#define XCD_BAR_WORDS 3456
#define XB_SPIN_CAP (1u << 22)

__device__ __forceinline__ unsigned xb_ld(unsigned* p)              { return __hip_atomic_load(p, __ATOMIC_RELAXED, __HIP_MEMORY_SCOPE_AGENT); }
__device__ __forceinline__ unsigned xb_add(unsigned* p, unsigned v) { return __hip_atomic_fetch_add(p, v, __ATOMIC_RELAXED, __HIP_MEMORY_SCOPE_AGENT); }
__device__ __forceinline__ unsigned xb_xcc_id() { return (unsigned)__builtin_amdgcn_s_getreg((3 << 11) | 20) & 0xFu; }
#define XB_SPIN(cond, bar) do { unsigned _sp = 0; while (cond) { __builtin_amdgcn_s_sleep(1); \
    if ((++_sp & 255u) == 0u) { if (xb_ld(&(bar)[XB_TMO])) break; if (_sp > XB_SPIN_CAP) { atomicAdd(&(bar)[XB_TMO], 1u); break; } } } } while (0)

struct XcdBarrier { unsigned* bar; unsigned x; volatile LAS unsigned* st; };

__device__ __forceinline__ XcdBarrier xcd_barrier_post(unsigned* bar, volatile LAS unsigned* st) {
    XcdBarrier b; b.bar = bar; b.x = xb_xcc_id(); b.st = st;
    if (threadIdx.x == 0) (void)xb_add(&bar[XB_XCNT(b.x)], 1u);
    return b;
}
__device__ __forceinline__ void xcd_barrier_complete(unsigned* bar, unsigned x, unsigned& nloc, unsigned& nx) {
    const unsigned G = gridDim.x * gridDim.y * gridDim.z;
    unsigned sum, cnt, mine, sp = 0u;
    for (;;) {
        sum = 0u; cnt = 0u; mine = 0u;
#pragma unroll
        for (unsigned j = 0; j < 16; ++j) { const unsigned c = xb_ld(&bar[XB_XCNT(j)]); sum += c; cnt += (c > 0u) ? 1u : 0u; mine = (j == x) ? c : mine; }
        if (sum == G) break;
        __builtin_amdgcn_s_sleep(1);
        if ((++sp & 255u) == 0u) { if (xb_ld(&bar[XB_TMO])) break; if (sp > XB_SPIN_CAP) { atomicAdd(&bar[XB_TMO], 1u); break; } }
    }
    nloc = mine > 0u ? mine : 1u; nx = cnt > 0u ? cnt : 1u;
}
__device__ __forceinline__ void xcd_barrier(const XcdBarrier& b) {
    asm volatile("s_waitcnt vmcnt(0)" ::: "memory");
    __syncthreads();
    if (threadIdx.x == 0) {
        unsigned* bar = b.bar;
        __builtin_amdgcn_s_waitcnt(0);
        unsigned nloc = b.st[0], nx = b.st[1];
        if (nloc == 0u) { xcd_barrier_complete(bar, b.x, nloc, nx); b.st[0] = nloc; b.st[1] = nx; }
        const unsigned old = xb_add(&bar[XB_XSUB(b.x)], 1u);
        const unsigned gen = old / nloc;
        if (old + 1u == (gen + 1u) * nloc) {
            __builtin_amdgcn_fence(__ATOMIC_RELEASE, "agent");
            asm volatile("s_waitcnt vmcnt(0)" ::: "memory");
            const unsigned og = xb_add(&bar[XB_TOP], 1u);
            const unsigned tg = og / nx;
            if (og + 1u == (tg + 1u) * nx) xb_add(&bar[XB_TOPGEN], 1u);
            else XB_SPIN(xb_ld(&bar[XB_TOPGEN]) == tg, bar);
            __builtin_amdgcn_fence(__ATOMIC_ACQUIRE, "agent");
            xb_add(&bar[XB_XGEN(b.x)], 1u);
            asm volatile("s_waitcnt vmcnt(0)" ::: "memory");
        } else {
            XB_SPIN(xb_ld(&bar[XB_XGEN(b.x)]) == gen, bar);
            __builtin_amdgcn_fence(__ATOMIC_ACQUIRE, "agent");
            asm volatile("s_waitcnt vmcnt(0)" ::: "memory");
        }
    }
    __syncthreads();
}

namespace pg8 {
constexpr int BM = 256, BK = 64, HALF = 128, HTB = HALF * BK * 2, STAGE_BYTES = 8 * HTB, NXCD = 8, WGM = 8;
__host__ __device__ __forceinline__ int lds_byte(int r, int c) { const int st = (r >> 4) * 2 + (c >> 5), rr = r & 15, cc = c & 31, ob = rr * 64 + cc * 2; return st * 1024 + (ob ^ (((ob >> 9) & 1) << 5)); }
__host__ __device__ __forceinline__ void stage_rc(int b, int& R, int& C) { const int st = b / 1024, sb = b % 1024, swz = sb ^ (((sb >> 9) & 1) << 5); R = (st >> 1) * 16 + swz / 64; C = (st & 1) * 32 + (swz % 64) / 2; }
__host__ __device__ __forceinline__ int perm32(int rho) { const int n = rho >> 4, i = rho & 15; return 8 * (i >> 2) + 4 * n + (i & 3); }
struct Unit { int pm, pn, z; };
struct Gemm { const bf16_t* A; const bf16_t* Bt; int M, N, K, lda, ldb; long zA, zB; int nz; };
struct StaticOrder {
    int nM, nN, nZ, nwg, G, c;
    __device__ void init(int M, int N, int Z, int G_, int c_) { nM = M / BM; nN = N / BM; nZ = Z; nwg = nM * nN * nZ; G = G_; c = c_; }
    __device__ bool next(int i, Unit& u) const {
        const long L = (long)i * G + c; if (L >= nwg) return false;
        int wgid = (int)L; { const int q = nwg / NXCD, r = nwg % NXCD, xcd = wgid % NXCD, off = wgid / NXCD; wgid = (xcd < r ? xcd * (q + 1) : r * (q + 1) + (xcd - r) * q) + off; }
        const int per = nM * nN; u.z = wgid / per; wgid -= u.z * per;
        const int nig = WGM * nN, gid = wgid / nig, fm = gid * WGM, gsz = (nM - fm) < WGM ? (nM - fm) : WGM;
        u.pm = fm + ((wgid % nig) % gsz); u.pn = (wgid % nig) / gsz; return true;
    }
};
__device__ __forceinline__ unsigned cvt_pk_bf16(float lo, float hi) { unsigned r; asm volatile("v_cvt_pk_bf16_f32 %0, %1, %2" : "=v"(r) : "v"(lo), "v"(hi)); return r; }
struct EpiF32 {
    static constexpr bool PERM = false;
    float* C; int ldc; long zC;
    __device__ __forceinline__ void operator()(const f32x4 (&acc)[2][2][4][2], const Unit& u, int wr, int wc, int fr, int fq) const {
        const int row0 = u.pm * BM + wr * 64 + fr, col0 = u.pn * BM + wc * 32 + 4 * fq; float* Cz = C + (size_t)u.z * zC;
#pragma unroll
        for (int ai = 0; ai < 2; ++ai)
#pragma unroll
            for (int m = 0; m < 4; ++m) { float* rowp = Cz + (size_t)(row0 + ai * HALF + m * 16) * ldc + col0;
#pragma unroll
                for (int bj = 0; bj < 2; ++bj)
#pragma unroll
                    for (int n = 0; n < 2; ++n) *(f32x4*)(rowp + bj * HALF + n * 16) = acc[ai][bj][m][n]; }
    }
};
struct EpiResid {
    static constexpr bool PERM = false;
    const float* base; float* out; int ldc;
    __device__ __forceinline__ void operator()(const f32x4 (&acc)[2][2][4][2], const Unit& u, int wr, int wc, int fr, int fq) const {
        const int row0 = u.pm * BM + wr * 64 + fr, col0 = u.pn * BM + wc * 32 + 4 * fq;
#pragma unroll
        for (int ai = 0; ai < 2; ++ai)
#pragma unroll
            for (int m = 0; m < 4; ++m) { const size_t off = (size_t)(row0 + ai * HALF + m * 16) * ldc + col0;
#pragma unroll
                for (int bj = 0; bj < 2; ++bj)
#pragma unroll
                    for (int n = 0; n < 2; ++n) { const f32x4 bs = *(const f32x4*)(base + off + bj * HALF + n * 16); *(f32x4*)(out + off + bj * HALF + n * 16) = bs * ALPHA + acc[ai][bj][m][n]; }
                asm volatile("" ::: "memory"); }
    }
};
struct EpiBf16 {
    static constexpr bool PERM = true;
    bf16_t* O; int ldc; const float* rs;
    __device__ __forceinline__ void operator()(const f32x4 (&acc)[2][2][4][2], const Unit& u, int wr, int wc, int fr, int fq) const {
        const int row0 = u.pm * BM + wr * 64 + fr, col0 = u.pn * BM + wc * 32 + 8 * fq;
#pragma unroll
        for (int ai = 0; ai < 2; ++ai)
#pragma unroll
            for (int m = 0; m < 4; ++m) { const int row = row0 + ai * HALF + m * 16; bf16_t* rowp = O + (size_t)row * ldc + col0; const float sc = rs ? rs[row] : 1.f;
#pragma unroll
                for (int bj = 0; bj < 2; ++bj) { const f32x4 v0 = acc[ai][bj][m][0] * sc, v1 = acc[ai][bj][m][1] * sc;
                    u32x4 wv; wv.x = cvt_pk_bf16(v0[0], v0[1]); wv.y = cvt_pk_bf16(v0[2], v0[3]); wv.z = cvt_pk_bf16(v1[0], v1[1]); wv.w = cvt_pk_bf16(v1[2], v1[3]);
                    *(u32x4*)(rowp + bj * HALF) = wv; } }
    }
};
template <class Epi, class Sched>
__device__ __forceinline__ void gemm_phase(LAS unsigned char* lds, const Gemm g, const Sched& S, const Epi& E) {
    const int tid = threadIdx.x, wid = __builtin_amdgcn_readfirstlane(tid >> 6), lane = tid & 63, wr = wid >> 2, wc = wid & 3, fr = lane & 15, fq = lane >> 4;
    const int K = g.K, nt = K / BK;
    unsigned voffA[2], voffB[2];
#pragma unroll
    for (int i = 0; i < 2; ++i) { int R, C; stage_rc(tid * 16 + i * 8192, R, C); const int Rb = Epi::PERM ? ((R & ~31) + perm32(R & 31)) : R;
        voffA[i] = (unsigned)(R * g.lda + C) * 2u; voffB[i] = (unsigned)(Rb * g.ldb + C) * 2u; }
    const size_t kstep = (size_t)(BK * 2);
    const size_t hA = (size_t)HALF * g.lda * 2, hB = (size_t)HALF * g.ldb * 2;
    const size_t tA = 2 * hA, tB = 2 * hB;
    const unsigned ldsw = (unsigned)wid * 1024u;
    const int aoff = lds_byte(wr * 64 + fr, fq * 8), boff = lds_byte(wc * 32 + fr, fq * 8);
#define PG8_SA(b, h) (((b) * 2 + (h)) * HTB)
#define PG8_SB(b, h) ((4 + (b) * 2 + (h)) * HTB)
#define PG8_STAGE(bufoff, gbase, voff) do { _Pragma("unroll") for (int _i = 0; _i < 2; ++_i) \
        __builtin_amdgcn_global_load_lds((const unsigned*)((const char*)(gbase) + (voff)[_i]), (LAS unsigned*)(lds + (bufoff) + ldsw + _i * 8192), 16, 0, 0); } while (0)
#define PG8_LDA(dst, b, h) do { _Pragma("unroll") for (int m = 0; m < 4; ++m) _Pragma("unroll") for (int k = 0; k < 2; ++k) dst[m][k] = *(const LAS bf16x8*)(lds + PG8_SA(b, h) + aoff + m * 2048 + k * 1024); } while (0)
#define PG8_LDB(dst, b, h) do { _Pragma("unroll") for (int n = 0; n < 2; ++n) _Pragma("unroll") for (int k = 0; k < 2; ++k) dst[n][k] = *(const LAS bf16x8*)(lds + PG8_SB(b, h) + boff + n * 2048 + k * 1024); } while (0)
#define PG8_MMA(ai, bj, At, Bt) do { __builtin_amdgcn_s_setprio(1); _Pragma("unroll") for (int m = 0; m < 4; ++m) _Pragma("unroll") for (int n = 0; n < 2; ++n) _Pragma("unroll") for (int k = 0; k < 2; ++k) \
        acc[ai][bj][m][n] = __builtin_amdgcn_mfma_f32_16x16x32_bf16(Bt[n][k], At[m][k], acc[ai][bj][m][n], 0, 0, 0); __builtin_amdgcn_s_setprio(0); } while (0)
#define PG8_WAIT_V(n) asm volatile("s_waitcnt vmcnt(" #n ")" ::: "memory")
#define PG8_WAIT_L(n) asm volatile("s_waitcnt lgkmcnt(" #n ")" ::: "memory")
#define PG8_BAR __builtin_amdgcn_s_barrier()
#define PG8_SCHED __builtin_amdgcn_sched_barrier(0)
    Unit cur, nxt; int ui = 0;
    if (!S.next(0, cur)) return;
    f32x4 acc[2][2][4][2];
#pragma unroll
    for (int a = 0; a < 2; ++a)
#pragma unroll
        for (int b = 0; b < 2; ++b)
#pragma unroll
            for (int m = 0; m < 4; ++m)
#pragma unroll
                for (int n = 0; n < 2; ++n) acc[a][b][m][n] = (f32x4){0.f, 0.f, 0.f, 0.f};
    bf16x8 At[4][2], B0[2][2], B1[2][2];
    const char* cA = (const char*)g.A + (size_t)cur.pm * tA + (size_t)cur.z * g.zA * 2; const char* cB = (const char*)g.Bt + (size_t)cur.pn * tB + (size_t)cur.z * g.zB * 2;
    PG8_STAGE(PG8_SB(0, 0), cB, voffB); PG8_STAGE(PG8_SA(0, 0), cA, voffA); PG8_STAGE(PG8_SB(0, 1), cB + hB, voffB); PG8_STAGE(PG8_SA(0, 1), cA + hA, voffA);
    if (wr == 1) PG8_BAR;
    PG8_WAIT_V(4); PG8_BAR;
    PG8_STAGE(PG8_SB(1, 0), cB + kstep, voffB); PG8_STAGE(PG8_SA(1, 0), cA + kstep, voffA); PG8_STAGE(PG8_SB(1, 1), cB + hB + kstep, voffB);
    PG8_WAIT_V(6); PG8_BAR;
    for (;;) {
        const bool has_next = S.next(ui + 1, nxt);
        const char* nA = has_next ? (const char*)g.A + (size_t)nxt.pm * tA + (size_t)nxt.z * g.zA * 2 : cA; const char* nB = has_next ? (const char*)g.Bt + (size_t)nxt.pn * tB + (size_t)nxt.z * g.zB * 2 : cB;
        for (int t = 0; t < nt; t += 2) {
            const bool last = (t == nt - 2);
            const char* a1 = cA + (size_t)(t + 1) * kstep;
            const char* a2 = last ? nA : cA + (size_t)(t + 2) * kstep; const char* b2 = last ? nB : cB + (size_t)(t + 2) * kstep;
            const char* a3 = a2 + kstep; const char* b3 = b2 + kstep;
            PG8_LDB(B0, 0, 0); PG8_SCHED; PG8_LDA(At, 0, 0); PG8_STAGE(PG8_SA(1, 1), a1 + hA, voffA);
            PG8_WAIT_L(8); PG8_BAR; PG8_WAIT_L(0); PG8_MMA(0, 0, At, B0); PG8_BAR; PG8_SCHED;
            PG8_LDB(B1, 0, 1); PG8_STAGE(PG8_SB(0, 0), b2, voffB);
            PG8_BAR; PG8_WAIT_L(0); PG8_MMA(0, 1, At, B1); PG8_BAR;
            PG8_LDA(At, 0, 1); PG8_STAGE(PG8_SA(0, 0), a2, voffA);
            PG8_BAR; PG8_WAIT_L(0); PG8_MMA(1, 0, At, B0); PG8_BAR; PG8_SCHED;
            PG8_STAGE(PG8_SB(0, 1), b2 + hB, voffB);
            PG8_WAIT_V(6); PG8_BAR; PG8_MMA(1, 1, At, B1); PG8_BAR;
            PG8_LDB(B0, 1, 0); PG8_SCHED; PG8_LDA(At, 1, 0); PG8_STAGE(PG8_SA(0, 1), a2 + hA, voffA);
            PG8_WAIT_L(8); PG8_BAR; PG8_WAIT_L(0); PG8_MMA(0, 0, At, B0); PG8_BAR; PG8_SCHED;
            PG8_LDB(B1, 1, 1); PG8_STAGE(PG8_SB(1, 0), b3, voffB);
            PG8_BAR; PG8_WAIT_L(0); PG8_MMA(0, 1, At, B1); PG8_BAR;
            PG8_LDA(At, 1, 1); PG8_STAGE(PG8_SA(1, 0), a3, voffA);
            PG8_BAR; PG8_WAIT_L(0); PG8_MMA(1, 0, At, B0); PG8_BAR; PG8_SCHED;
            PG8_STAGE(PG8_SB(1, 1), b3 + hB, voffB);
            PG8_WAIT_V(6); PG8_BAR; PG8_MMA(1, 1, At, B1); PG8_BAR;
        }
        E(acc, cur, wr, wc, fr, fq);
        if (!has_next) break;
#pragma unroll
        for (int a = 0; a < 2; ++a)
#pragma unroll
            for (int b = 0; b < 2; ++b)
#pragma unroll
                for (int m = 0; m < 4; ++m)
#pragma unroll
                    for (int n = 0; n < 2; ++n) acc[a][b][m][n] = (f32x4){0.f, 0.f, 0.f, 0.f};
        cur = nxt; cA = nA; cB = nB; ++ui;
    }
    PG8_WAIT_V(0);
    if (wr == 0) PG8_BAR;
    PG8_BAR;
#undef PG8_SA
#undef PG8_SB
#undef PG8_STAGE
#undef PG8_LDA
#undef PG8_LDB
#undef PG8_MMA
#undef PG8_WAIT_V
#undef PG8_WAIT_L
#undef PG8_BAR
#undef PG8_SCHED
}
}

struct Args { const float* in[21]; float* out; unsigned char* ws; int ph_lo, ph_hi; };
enum { I_X = 0, I_MEM, I_AB_W_IN, I_A_REL_BIAS, I_B_Q_NORM, I_B_W_UQ, I_B_KV_NORM, I_B_W_UKV, I_AB_W_OUT, I_CD_W_IN, I_D_FORGET_BIAS, I_CD_W_OUT,
       I_MEM_W_Q, I_MEM_W_KV, I_MEM_W_O, I_PEER_W_Q, I_PEER_SUB_KEYS, I_PEER_U, I_PEER_V, I_LN_G, I_LN_B };

struct WI { int tid, lane, wave, gw, ngw, bid, nblk; };

__device__ __forceinline__ void tr_item(const float* W, int K, int ld, int c0, int nc, bf16_t* WT, int r0, const float* scale, LAS float* scr, int item, int lane) {
    const int nblk = (nc + 31) >> 5, kb = item / nblk, nb = item - kb * nblk, k0 = 64 * kb, n0 = 32 * nb;
    const int nn = n0 + (lane & 31); const bool ok = nn < nc;
#pragma unroll 8
    for (int i = 0; i < 32; ++i) { const int kk = 2 * i + (lane >> 5); float v = ok ? W[(size_t)(k0 + kk) * ld + c0 + nn] : 0.f; if (scale) v *= scale[k0 + kk]; scr[kk * 33 + (lane & 31)] = v; }
    LDS_WAIT();
    const int c = lane & 7;
#pragma unroll
    for (int j = 0; j < 4; ++j) { const int n = (lane >> 3) + 8 * j; const LAS float* s = scr + (8 * c) * 33 + n;
        u32x4 o; o.x = pk2(s[0 * 33], s[1 * 33]); o.y = pk2(s[2 * 33], s[3 * 33]); o.z = pk2(s[4 * 33], s[5 * 33]); o.w = pk2(s[6 * 33], s[7 * 33]);
        if (n0 + n < nc) *(u32x4*)(WT + (size_t)(r0 + n0 + n) * K + k0 + 8 * c) = o; }
    LDS_WAIT();
}
__device__ __forceinline__ void cvt_rows(const float* src, bf16_t* dst, size_t n, size_t i0, size_t stride) {
    for (size_t i = i0 * 8; i < n; i += stride * 8) {
        const f32x4 a = *(const f32x4*)(src + i), b = *(const f32x4*)(src + i + 4);
        u32x4 o; o.x = pk2(a.x, a.y); o.y = pk2(a.z, a.w); o.z = pk2(b.x, b.y); o.w = pk2(b.z, b.w);
        *(u32x4*)(dst + i) = o;
    }
}
__device__ __forceinline__ void ph_convert(const Args& a, LAS unsigned char* lds, const WI& w) {
    unsigned char* ws = a.ws;
    LAS float* scr = (LAS float*)(lds + w.wave * 16384);
    constexpr int J1 = 64 * 258, J2 = 24 * 96, J3 = 8 * 128, J4 = 64 * 128, J5 = 64 * 160, J6 = 64 * 192, J7 = 64 * 3, J8 = 64 * 1, J9 = 64 * 128,
                  J10 = 64 * 16, J12 = 64 * 32, J14 = 8 * 128;
    constexpr int NJ = J1 + J2 + J3 + J4 + J5 + J6 + J7 + J8 + J9 + 2 * J10 + 2 * J12 + 2 * J14;
    for (int it = w.gw; it < NJ; it += w.ngw) {
        int r = it; const float* src; int K, ld, c0 = 0, nc, r0 = 0; bf16_t* dst; const float* sc = nullptr;
        if (r < J1) { src = a.in[I_AB_W_IN]; K = 4096; ld = AB_COLS; nc = AB_COLS; dst = (bf16_t*)(ws + WS_W_AB_IN); }
        else if ((r -= J1) < J2) { src = a.in[I_B_W_UQ]; K = 1536; ld = 3072; nc = 3072; dst = (bf16_t*)(ws + WS_W_UQ); sc = a.in[I_B_Q_NORM]; }
        else if ((r -= J2) < J3) { src = a.in[I_B_W_UKV]; K = 512; ld = 4096; nc = 4096; dst = (bf16_t*)(ws + WS_W_UKV); sc = a.in[I_B_KV_NORM]; }
        else if ((r -= J3) < J4) { src = a.in[I_AB_W_OUT]; K = 4096; ld = 4096; nc = 4096; dst = (bf16_t*)(ws + WS_W_AB_OUT); }
        else if ((r -= J4) < J5) { src = a.in[I_CD_W_IN]; K = 4096; ld = CD_COLS; c0 = 0; nc = 5120; r0 = 0; dst = (bf16_t*)(ws + WS_W_CD_IN); }
        else if ((r -= J5) < J6) { src = a.in[I_CD_W_IN]; K = 4096; ld = CD_COLS; c0 = 5216; nc = 6144; r0 = 5120; dst = (bf16_t*)(ws + WS_W_CD_IN); }
        else if ((r -= J6) < J7) { src = a.in[I_CD_W_IN]; K = 4096; ld = CD_COLS; c0 = 5120; nc = 96; r0 = 11264; dst = (bf16_t*)(ws + WS_W_CD_IN); }
        else if ((r -= J7) < J8) { src = a.in[I_CD_W_IN]; K = 4096; ld = CD_COLS; c0 = 11360; nc = 16; r0 = 11360; dst = (bf16_t*)(ws + WS_W_CD_IN); }
        else if ((r -= J8) < J9) { src = a.in[I_CD_W_OUT]; K = 4096; ld = 4096; nc = 4096; dst = (bf16_t*)(ws + WS_W_CD_OUT); }
        else if ((r -= J9) < 2 * J10) { const int l = r / J10; r -= l * J10; src = a.in[I_MEM_W_Q] + (size_t)l * 4096 * 512; K = 4096; ld = 512; nc = 512; dst = (bf16_t*)(ws + WS_W_MEM_Q) + (size_t)l * 512 * 4096; }
        else if ((r -= 2 * J10) < 2 * J12) { const int l = r / J12; r -= l * J12; src = a.in[I_MEM_W_KV] + (size_t)l * 4096 * 1024; K = 4096; ld = 1024; nc = 1024; dst = (bf16_t*)(ws + WS_W_MEM_KV) + (size_t)l * 1024 * 4096; }
        else { r -= 2 * J12; const int l = r / J14; r -= l * J14; src = a.in[I_MEM_W_O] + (size_t)l * 512 * 4096; K = 512; ld = 4096; nc = 4096; dst = (bf16_t*)(ws + WS_W_MEM_O) + (size_t)l * 4096 * 512; }
        tr_item(src, K, ld, c0, nc, dst, r0, sc, scr, r, w.lane);
    }
    { const size_t gt = (size_t)w.gw * 64 + w.lane, ng = (size_t)w.ngw * 64;
      bf16_t* p1 = (bf16_t*)(ws + WS_W_AB_IN) + (size_t)AB_COLS * 4096; const size_t n1 = (size_t)(AB_PAD - AB_COLS) * 4096;
      for (size_t i = gt * 8; i < n1; i += ng * 8) *(u32x4*)(p1 + i) = (u32x4){0u, 0u, 0u, 0u};
      bf16_t* p2 = (bf16_t*)(ws + WS_W_CD_IN) + (size_t)CD_COLS * 4096; const size_t n2 = (size_t)(CD_PAD - CD_COLS) * 4096;
      for (size_t i = gt * 8; i < n2; i += ng * 8) *(u32x4*)(p2 + i) = (u32x4){0u, 0u, 0u, 0u};
      cvt_rows(a.in[I_X], (bf16_t*)(ws + WS_XB), (size_t)T * DM, gt, ng);
      cvt_rows(a.in[I_MEM], (bf16_t*)(ws + WS_MEMB), (size_t)512 * DM, gt, ng);
      for (int r = w.gw; r < 65536; r += w.ngw) { const int tbl = r >> 15, rr = r & 32767;
          const float* srow = (tbl ? a.in[I_PEER_V] : a.in[I_PEER_U]) + (size_t)rr * DM;
          f32x4 v[16]; float amax = 0.f;
#pragma unroll
          for (int j = 0; j < 16; ++j) { v[j] = *(const f32x4*)(srow + 4 * w.lane + 256 * j); amax = fmaxf(amax, fmaxf(fmaxf(fabsf(v[j].x), fabsf(v[j].y)), fmaxf(fabsf(v[j].z), fabsf(v[j].w)))); }
          amax = wave_max(amax); const float s = amax > 0.f ? 256.f / amax : 1.f;
          unsigned* drow = (unsigned*)(ws + (tbl ? WS_V8 : WS_U8) + (size_t)rr * DM);
#pragma unroll
          for (int j = 0; j < 16; ++j) { int wv = 0; wv = __builtin_amdgcn_cvt_pk_fp8_f32(v[j].x * s, v[j].y * s, wv, false); wv = __builtin_amdgcn_cvt_pk_fp8_f32(v[j].z * s, v[j].w * s, wv, true); drow[64 * j + w.lane] = (unsigned)wv; }
          if (w.lane == 0) ((float*)(ws + (tbl ? WS_VSC : WS_USC)))[rr] = amax > 0.f ? amax * (1.f / 256.f) : 1.f; }
      float* r128 = (float*)(ws + WS_ROPE128); float* r64 = (float*)(ws + WS_ROPE64);
      for (size_t i = gt; i < (size_t)SEQ * 96; i += ng) {
          const int s = (int)(i / 96), j = (int)(i % 96); const bool big = j < 64; const int ii = big ? j : j - 64;
          const double rr = big ? 0.8659643233600653 : 0.7498942093324559; double inv = 1.0;
          for (int q = 0; q < ii; ++q) inv *= rr;
          const double rev = (double)s * inv * 0.15915494309189535; const float fr = (float)(rev - rint(rev));
          const float cs = __builtin_amdgcn_cosf(fr), sn = __builtin_amdgcn_sinf(fr);
          float* o = big ? (r128 + ((size_t)s * 64 + ii) * 2) : (r64 + ((size_t)s * 32 + ii) * 2);
          o[0] = cs; o[1] = sn; }
    }
    {
        LAS float* Ks = (LAS float*)lds; LAS float* Ws = Ks + 128 * 129;
        const int tk = w.tid & 31, tn = w.tid >> 5;
        for (int it = w.bid; it < 2 * 16 * 32; it += w.nblk) {
            const int l = it >> 9, hp = (it >> 5) & 15, kb = it & 31;
            __syncthreads();
            const float* keys = a.in[I_PEER_SUB_KEYS] + ((size_t)(l * 16 + hp) * 128) * 128;
            const float* wq = a.in[I_PEER_W_Q] + ((size_t)l * 4096 + (size_t)kb * 128) * 2048 + hp * 128;
            for (int e = w.tid; e < 128 * 128; e += 512) { const int rrow = e >> 7, d = e & 127; Ks[rrow * 129 + d] = keys[(size_t)rrow * 128 + d]; Ws[rrow * 129 + d] = wq[(size_t)rrow * 2048 + d]; }
            __syncthreads();
            float acc[8][4];
#pragma unroll
            for (int x = 0; x < 8; ++x)
#pragma unroll
                for (int y = 0; y < 4; ++y) acc[x][y] = 0.f;
            for (int d = 0; d < 128; ++d) {
                float kv[8], wv[4];
#pragma unroll
                for (int x = 0; x < 8; ++x) kv[x] = Ks[(tn + 16 * x) * 129 + d];
#pragma unroll
                for (int y = 0; y < 4; ++y) wv[y] = Ws[(tk + 32 * y) * 129 + d];
#pragma unroll
                for (int x = 0; x < 8; ++x)
#pragma unroll
                    for (int y = 0; y < 4; ++y) acc[x][y] += kv[x] * wv[y];
            }
            bf16_t* dst = (bf16_t*)(ws + WS_W_PEER) + ((size_t)l * 2048 + hp * 128) * 4096 + kb * 128;
#pragma unroll
            for (int x = 0; x < 8; ++x)
#pragma unroll
                for (int y = 0; y < 4; ++y) dst[(size_t)(tn + 16 * x) * 4096 + tk + 32 * y] = (bf16_t)f2bf(acc[x][y]);
        }
        __syncthreads();
    }
}

__device__ __forceinline__ int crow(int r, int hi) { return (r & 3) + 8 * (r >> 2) + 4 * hi; }
template <class F>
__device__ __forceinline__ void naive_gemm(const bf16_t* A, int lda, const bf16_t* Bt, int ldb, int M, int N, int K, const WI& w, F epi) {
    const int tm = M >> 5, tn = (N + 31) >> 5;
    const int i = w.lane & 31, g = w.lane >> 5;
    for (int tile = w.gw; tile < tm * tn; tile += w.ngw) {
        const int bn = tile / tm, bm = tile - bn * tm;
        const bf16_t* ap = A + (size_t)(bm * 32 + i) * lda + 8 * g;
        const int nrow = bn * 32 + i; const bool nv = nrow < N;
        const bf16_t* bp = Bt + (size_t)(nv ? nrow : 0) * ldb + 8 * g;
        f32x16 acc = {};
#pragma unroll 4
        for (int k = 0; k < K; k += 16) {
            const bf16x8 av = *(const bf16x8*)(ap + k);
            bf16x8 bv = *(const bf16x8*)(bp + k);
            if (!nv) bv = (bf16x8){0, 0, 0, 0, 0, 0, 0, 0};
            acc = __builtin_amdgcn_mfma_f32_32x32x16_bf16(av, bv, acc, 0, 0, 0);
        }
#pragma unroll
        for (int r = 0; r < 16; ++r) { const int row = bm * 32 + crow(r, g), col = bn * 32 + i; if (col < N) epi(row, col, acc[r]); }
    }
}

__device__ __forceinline__ void ln_rows(const float* src, const float* g, const float* b, float* dstf, bf16_t* dstb, const WI& w) {
    for (int m = w.gw; m < T; m += w.ngw) {
        const f32x4* xr = (const f32x4*)(src + (size_t)m * DM) + w.lane;
        f32x4 v[16]; float s = 0.f;
#pragma unroll
        for (int j = 0; j < 16; ++j) { v[j] = xr[64 * j]; s += (v[j].x + v[j].y) + (v[j].z + v[j].w); }
        const float mean = wave_sum(s) * (1.f / DM); float s2 = 0.f;
#pragma unroll
        for (int j = 0; j < 16; ++j) { v[j] = v[j] - mean; s2 += (v[j].x * v[j].x + v[j].y * v[j].y) + (v[j].z * v[j].z + v[j].w * v[j].w); }
        const float rstd = 1.f / sqrtf(wave_sum(s2) * (1.f / DM) + LN_EPS);
#pragma unroll
        for (int j = 0; j < 16; ++j) {
            const int c = 4 * w.lane + 256 * j;
            const f32x4 gg = *(const f32x4*)(g + c), bb = *(const f32x4*)(b + c);
            const f32x4 o = v[j] * rstd * gg + bb;
            *(f32x4*)(dstf + (size_t)m * DM + c) = o;
            if (dstb) { u32x2 p; p.x = pk2(o.x, o.y); p.y = pk2(o.z, o.w); *(u32x2*)(dstb + (size_t)m * DM + c) = p; }
        }
    }
}

template <int MODE>
__device__ __forceinline__ void attn_naive(const Args& a, int layer, LAS float* qs, const WI& w) {
    constexpr int H = (MODE == 4) ? 4 : 16, DK = (MODE == 1) ? 192 : 128;
    const float scale = (MODE == 1) ? 0.07216878364870322f : 0.08838834764831845f;
    unsigned char* ws = a.ws;
    const float NEG = -__builtin_inff();
    for (int it = w.gw; it < T * H; it += w.ngw) {
        const int h = it / T, t = it - h * T, b = t / SEQ, sp = t - b * SEQ, c = sp >> 6;
        const bf16_t* qp; const bf16_t* kbase; const bf16_t* vbase; int ldk, ldv; bf16_t* op;
        int s_lo = 0, s_hi;
        if (MODE == 0) { const bf16_t* P = (const bf16_t*)(ws + WS_PROJ); qp = P + (size_t)t * AB_MAIN + h * 128; kbase = P + (size_t)b * SEQ * AB_MAIN + 2048 + h * 128; vbase = kbase + 2048; ldk = ldv = AB_MAIN;
            op = (bf16_t*)(ws + WS_ATT) + (size_t)t * DM + h * 128; s_lo = (c - 8) * 64; if (s_lo < 0) s_lo = 0; s_hi = (c + 1) * 64; }
        else if (MODE == 1) { qp = (const bf16_t*)(ws + WS_QB) + (size_t)t * 3072 + h * 192; kbase = (const bf16_t*)(ws + WS_KVB) + (size_t)b * SEQ * 4096 + h * 256; vbase = kbase + 128; ldk = ldv = 4096;
            op = (bf16_t*)(ws + WS_ATT) + (size_t)t * DM + 2048 + h * 128; s_hi = (c + 1) * 64; }
        else if (MODE == 2) { const bf16_t* P = (const bf16_t*)(ws + WS_PROJ); qp = P + (size_t)t * CD_MAIN + h * 128; kbase = P + (size_t)b * SEQ * CD_MAIN + 2048 + (h >> 2) * 128; vbase = kbase + 512; ldk = ldv = CD_MAIN;
            op = (bf16_t*)(ws + WS_ATT) + (size_t)t * DM + h * 128; s_hi = (c + 1) * 64; }
        else if (MODE == 3) { const bf16_t* P = (const bf16_t*)(ws + WS_PROJ); qp = P + (size_t)t * CD_MAIN + 5120 + h * 128; kbase = P + (size_t)b * SEQ * CD_MAIN + 7168 + h * 128; vbase = kbase + 2048; ldk = ldv = CD_MAIN;
            op = (bf16_t*)(ws + WS_ATT) + (size_t)t * DM + 2048 + h * 128; s_hi = sp + 1; }
        else { qp = (const bf16_t*)(ws + WS_MEMQ) + (size_t)t * 512 + h * 128; kbase = (const bf16_t*)(ws + WS_KVM) + ((size_t)layer * 512 + b * 256) * 1024 + h * 128; vbase = kbase + 512; ldk = ldv = 1024;
            op = (bf16_t*)(ws + WS_MEMO) + (size_t)t * 512 + h * 128; s_hi = 256; }
        LDS_WAIT();
        if (MODE == 4) { const float* mq = (const float*)(ws + WS_MQP) + (size_t)t * 512 + h * 128;
            for (int d = w.lane; d < DK; d += 64) qs[d] = bf2f((bf16_t)f2bf((mq[d] + mq[d + (size_t)T * 512]) + (mq[d + (size_t)2 * T * 512] + mq[d + (size_t)3 * T * 512]))); }
        else for (int d = w.lane; d < DK; d += 64) qs[d] = bf2f(qp[d]);
        LDS_WAIT();
        const float* cum = (const float*)(ws + WS_CUM) + ((size_t)b * 16 + h) * SEQ;
        const float ct = (MODE == 3) ? cum[sp] : 0.f;
        const float* relb = a.in[I_A_REL_BIAS] + h * 513;
        const unsigned* mrow = (const unsigned*)(ws + WS_MASK) + (size_t)t * 128;
        float m = NEG, l = 0.f, o0 = 0.f, o1 = 0.f;
        for (int s0 = s_lo; s0 < s_hi; s0 += 64) {
            const int s = s0 + w.lane; bool valid = s < s_hi;
            if (MODE == 2) { if (valid) valid = (mrow[s >> 5] >> (s & 31)) & 1u; }
            float x = NEG;
            if (valid) {
                const bf16_t* kp = kbase + (size_t)s * ldk; float acc = 0.f;
#pragma unroll 4
                for (int d0 = 0; d0 < 128; d0 += 8) { const bf16x8 kv = *(const bf16x8*)(kp + d0);
#pragma unroll
                    for (int e = 0; e < 8; ++e) acc += qs[d0 + e] * bf2f((bf16_t)kv[e]); }
                if (MODE == 1) { const bf16_t* kr = (const bf16_t*)(ws + WS_KR) + ((size_t)b * SEQ + s) * 64;
#pragma unroll 4
                    for (int d0 = 0; d0 < 64; d0 += 8) { const bf16x8 kv = *(const bf16x8*)(kr + d0);
#pragma unroll
                        for (int e = 0; e < 8; ++e) acc += qs[128 + d0 + e] * bf2f((bf16_t)kv[e]); } }
                x = acc * scale;
                if (MODE == 0) { int rel = sp - s; rel = rel < -256 ? -256 : (rel > 256 ? 256 : rel); x += relb[rel + 256]; }
                if (MODE == 3) x += ct - cum[s];
            }
            const float mx = wave_max(x);
            if (mx == NEG) continue;
            const float mn = fmaxf(m, mx); const float p = valid ? __expf(x - mn) : 0.f; const float al = __expf(m - mn);
            l = l * al + wave_sum(p); o0 *= al; o1 *= al; m = mn;
            for (int j = 0; j < 64; ++j) { const float pj = __shfl(p, j);
                if (pj != 0.f) { const bf16_t* vp = vbase + (size_t)(s0 + j) * ldv; o0 += pj * bf2f(vp[w.lane]); o1 += pj * bf2f(vp[w.lane + 64]); } }
        }
        const float rl = 1.f / l;
        op[w.lane] = (bf16_t)f2bf(o0 * rl); op[w.lane + 64] = (bf16_t)f2bf(o1 * rl);
    }
}

namespace fa {
constexpr int SHM_V = 64 * 128 * 2;
constexpr int LDS_V = 0, LDS_K = 2 * SHM_V, LDS_WS = LDS_K + 2 * 64 * 384, LDS_RELB = LDS_WS + 8 * 64 * 4, LDS_CS = LDS_RELB + 2304, LDS_END = LDS_CS + 512;
#define FA_KSWZ(row, colB, RS) ((row) * (RS) + ((colB) ^ (((row) & 7) << 4)))
__device__ __forceinline__ int v_st(int k, int c) { const int kk = (k & ~0xC) | ((k & 4) << 1) | ((k & 8) >> 1); return ((kk >> 3) * 4 + (c >> 5)) * 512 + ((kk & 7) * 32 + (c & 31)) * 2; }
__device__ __forceinline__ int v_rd_base(int lane) { return ((lane & 3) << 3) | (((lane >> 2) & 3) << 6) | (((lane >> 4) & 1) << 5) | (((lane >> 5) & 1) << 8); }
__device__ __forceinline__ unsigned cvtpk(float lo, float hi) { unsigned r; asm volatile("v_cvt_pk_bf16_f32 %0, %1, %2" : "=v"(r) : "v"(lo), "v"(hi)); return r; }
typedef short s16x4 __attribute__((ext_vector_type(4)));

template <int DK>
__device__ __forceinline__ void qkt(f32x16& p0, f32x16& p1, LAS const char* Kb, int r32, int hi, const bf16x8* qr) {
    constexpr int RS = DK * 2;
    p0 = f32x16{}; p1 = f32x16{};
    LAS const char* kb[4];
#pragma unroll
    for (int dd = 0; dd < 4; ++dd) kb[dd] = Kb + FA_KSWZ(r32, (dd * 16 + hi * 8) * 2, RS);
#pragma unroll
    for (int d0 = 0; d0 < DK / 16; ++d0) { LAS const char* ap = kb[d0 & 3] + (d0 >> 2) * 128;
        const bf16x8 b0 = *(LAS const bf16x8*)ap;
        const bf16x8 b1 = *(LAS const bf16x8*)(ap + 32 * RS);
        p0 = __builtin_amdgcn_mfma_f32_32x32x16_bf16(b0, qr[d0], p0, 0, 0, 0);
        p1 = __builtin_amdgcn_mfma_f32_32x32x16_bf16(b1, qr[d0], p1, 0, 0, 0); }
}
__device__ __forceinline__ void pv_tile(f32x16* o, int vb0, bf16x8 pa0, bf16x8 pa1, bf16x8 pa2, bf16x8 pa3) {
#define FA_TRRD(dst, off) asm volatile("ds_read_b64_tr_b16 %0, %1 offset:%2" : "=&v"(dst) : "v"(vb0), "i"(off) : "memory")
#define FA_PV_D0(d0) do { s16x4 l0, l1, l2, l3, h0, h1, h2, h3; constexpr int b_ = (d0) * 512; \
        FA_TRRD(l0, b_); FA_TRRD(h0, b_ + 2048); FA_TRRD(l1, b_ + 4096); FA_TRRD(h1, b_ + 6144); FA_TRRD(l2, b_ + 8192); FA_TRRD(h2, b_ + 10240); FA_TRRD(l3, b_ + 12288); FA_TRRD(h3, b_ + 14336); \
        asm volatile("s_waitcnt lgkmcnt(0)" ::: "memory"); __builtin_amdgcn_sched_barrier(0); \
        o[d0] = __builtin_amdgcn_mfma_f32_32x32x16_bf16(pa0, (bf16x8){l0[0], l0[1], l0[2], l0[3], h0[0], h0[1], h0[2], h0[3]}, o[d0], 0, 0, 0); \
        o[d0] = __builtin_amdgcn_mfma_f32_32x32x16_bf16(pa1, (bf16x8){l1[0], l1[1], l1[2], l1[3], h1[0], h1[1], h1[2], h1[3]}, o[d0], 0, 0, 0); \
        o[d0] = __builtin_amdgcn_mfma_f32_32x32x16_bf16(pa2, (bf16x8){l2[0], l2[1], l2[2], l2[3], h2[0], h2[1], h2[2], h2[3]}, o[d0], 0, 0, 0); \
        o[d0] = __builtin_amdgcn_mfma_f32_32x32x16_bf16(pa3, (bf16x8){l3[0], l3[1], l3[2], l3[3], h3[0], h3[1], h3[2], h3[3]}, o[d0], 0, 0, 0); } while (0)
    FA_PV_D0(0); FA_PV_D0(1); FA_PV_D0(2); FA_PV_D0(3);
#undef FA_PV_D0
#undef FA_TRRD
}
__device__ __forceinline__ void softmax_tile(f32x16& p0, f32x16& p1, float& m_reg, float& l_reg, float& alpha, bf16x8& pa0, bf16x8& pa1, bf16x8& pa2, bf16x8& pa3) {
    float pmax = p0[0];
#pragma unroll
    for (int r = 1; r < 16; ++r) pmax = fmaxf(pmax, p0[r]);
#pragma unroll
    for (int r = 0; r < 16; ++r) pmax = fmaxf(pmax, p1[r]);
    { auto rr = __builtin_amdgcn_permlane32_swap(__float_as_uint(pmax), __float_as_uint(pmax), false, false);
      pmax = fmaxf(__uint_as_float(rr[0]), __uint_as_float(rr[1])); }
    const float mn = fmaxf(m_reg, pmax); alpha = __builtin_amdgcn_exp2f(m_reg - mn); m_reg = mn;
#pragma unroll
    for (int r = 0; r < 16; ++r) { p0[r] = __builtin_amdgcn_exp2f(p0[r] - mn); p1[r] = __builtin_amdgcn_exp2f(p1[r] - mn); }
    float ps = 0.f;
#pragma unroll
    for (int r = 0; r < 16; ++r) ps += p0[r];
#pragma unroll
    for (int r = 0; r < 16; ++r) ps += p1[r];
    { auto rr = __builtin_amdgcn_permlane32_swap(__float_as_uint(ps), __float_as_uint(ps), false, false);
      ps = __uint_as_float(rr[0]) + __uint_as_float(rr[1]); }
    l_reg = l_reg * alpha + ps;
#define FA_PK4(P, B_, OUT) do { unsigned a0 = cvtpk(P[B_+0], P[B_+1]), a1 = cvtpk(P[B_+2], P[B_+3]); \
        unsigned b0 = cvtpk(P[B_+4], P[B_+5]), b1 = cvtpk(P[B_+6], P[B_+7]); \
        auto r0 = __builtin_amdgcn_permlane32_swap(a0, b0, false, false); auto r1 = __builtin_amdgcn_permlane32_swap(a1, b1, false, false); \
        u32x4 wv = {r0[0], r1[0], r0[1], r1[1]}; OUT = *reinterpret_cast<bf16x8*>(&wv); } while (0)
    FA_PK4(p0, 0, pa0); FA_PK4(p0, 8, pa1); FA_PK4(p1, 0, pa2); FA_PK4(p1, 8, pa3);
#undef FA_PK4
}

template <int MODE>
__device__ __forceinline__ void attn_unit(const Args& a, int layer, LAS unsigned char* lds, int b, int h, int qb) {
    constexpr int DK = (MODE == 1) ? 192 : 128, RS = DK * 2, SHM_K = 64 * RS, NQ = DK / 16;
    constexpr float C2 = (MODE == 1) ? 1.4426950408889634f * 0.07216878364870322f : 1.4426950408889634f * 0.08838834764831845f;
    constexpr float L2E = 1.4426950408889634f;
    unsigned char* ws = a.ws;
    const int tid = threadIdx.x, wid = __builtin_amdgcn_readfirstlane(tid >> 6), lane = tid & 63, r32 = lane & 31, hi = lane >> 5;
    const int P0 = qb * 256, qlo = P0 + wid * 32, row = qlo + r32, cw = qlo >> 6;
    const size_t tb = (size_t)b * SEQ;
    const float NEG = -__builtin_inff();
    const bf16_t* Kg; const bf16_t* Vg; int ldk, ldv; bf16_t* Og; int ldo; int j_lo = 0, j_hi;
    if (MODE == 0) { const bf16_t* P = (const bf16_t*)(ws + WS_PROJ); Kg = P + tb * AB_MAIN + 2048 + h * 128; Vg = Kg + 2048; ldk = ldv = AB_MAIN; Og = (bf16_t*)(ws + WS_ATT) + (tb + qlo) * DM + h * 128; ldo = DM;
        j_lo = (P0 >> 6) - 8; if (j_lo < 0) j_lo = 0; j_hi = (P0 >> 6) + 4; }
    else if (MODE == 1) { Kg = (const bf16_t*)(ws + WS_KVB) + tb * 4096 + h * 256; Vg = Kg + 128; ldk = ldv = 4096; Og = (bf16_t*)(ws + WS_ATT) + (tb + qlo) * DM + 2048 + h * 128; ldo = DM; j_hi = (P0 >> 6) + 4; }
    else if (MODE == 2) { const bf16_t* P = (const bf16_t*)(ws + WS_PROJ); Kg = P + tb * CD_MAIN + 2048 + (h >> 2) * 128; Vg = Kg + 512; ldk = ldv = CD_MAIN; Og = (bf16_t*)(ws + WS_ATT) + (tb + qlo) * DM + h * 128; ldo = DM; j_hi = (P0 >> 6) + 4; }
    else if (MODE == 3) { const bf16_t* P = (const bf16_t*)(ws + WS_PROJ); Kg = P + tb * CD_MAIN + 7168 + h * 128; Vg = Kg + 2048; ldk = ldv = CD_MAIN; Og = (bf16_t*)(ws + WS_ATT) + (tb + qlo) * DM + 2048 + h * 128; ldo = DM; j_hi = (P0 >> 6) + 4; }
    else { Kg = (const bf16_t*)(ws + WS_KVM) + ((size_t)layer * 512 + b * 256) * 1024 + h * 128; Vg = Kg + 512; ldk = ldv = 1024; Og = (bf16_t*)(ws + WS_MEMO) + (tb + qlo) * 512 + h * 128; ldo = 512; j_hi = 4; }
    const int NT = j_hi - j_lo;
    bf16x8 qr[NQ];
    if (MODE == 4) { const float* mq = (const float*)(ws + WS_MQP) + (tb + row) * 512 + h * 128;
#pragma unroll
        for (int d0 = 0; d0 < NQ; ++d0) { const float* p = mq + d0 * 16 + hi * 8; f32x4 s0 = {0.f, 0.f, 0.f, 0.f}, s1 = s0;
#pragma unroll
            for (int z = 0; z < 4; ++z) { s0 += *(const f32x4*)(p + (size_t)z * T * 512); s1 += *(const f32x4*)(p + (size_t)z * T * 512 + 4); }
            u32x4 wv = {cvtpk(s0[0], s0[1]), cvtpk(s0[2], s0[3]), cvtpk(s1[0], s1[1]), cvtpk(s1[2], s1[3])}; qr[d0] = *reinterpret_cast<bf16x8*>(&wv); } }
    else { const bf16_t* Qg;
        if (MODE == 0) Qg = (const bf16_t*)(ws + WS_PROJ) + (tb + row) * AB_MAIN + h * 128;
        else if (MODE == 1) Qg = (const bf16_t*)(ws + WS_QB) + (tb + row) * 3072 + h * 192;
        else if (MODE == 2) Qg = (const bf16_t*)(ws + WS_PROJ) + (tb + row) * CD_MAIN + h * 128;
        else Qg = (const bf16_t*)(ws + WS_PROJ) + (tb + row) * CD_MAIN + 5120 + h * 128;
#pragma unroll
        for (int d0 = 0; d0 < NQ; ++d0) qr[d0] = *(const bf16x8*)(Qg + d0 * 16 + hi * 8); }
    LAS char* V_lds = (LAS char*)lds + LDS_V; LAS char* K_lds = (LAS char*)lds + LDS_K;
    LAS float* wsc = (LAS float*)(lds + LDS_WS) + wid * 64; LAS float* relb = (LAS float*)(lds + LDS_RELB); LAS float* csl = (LAS float*)(lds + LDS_CS);
    const int vbase = (int)(unsigned)(uintptr_t)V_lds + v_rd_base(lane);
    const bf16_t* KRg = (const bf16_t*)(ws + WS_KR) + tb * 64;
    const float* cum = (const float*)(ws + WS_CUM) + ((size_t)b * 16 + h) * SEQ;
    const unsigned* mrow = (const unsigned*)(ws + WS_MASK) + (tb + row) * 128;
    float ctl = 0.f; if (MODE == 3) ctl = cum[row] * L2E;
    if (MODE == 0) { const float* rb = a.in[I_A_REL_BIAS] + h * 513; for (int i = tid; i < 513; i += 512) relb[i] = rb[i] * L2E; }
    float m_reg = -1e30f, l_reg = 0.f; f32x16 o[4] = {};
    unsigned mk0 = 0u, mk1 = 0u; float st_cs = 0.f;
    constexpr int NKI = (DK == 192) ? 3 : 2;
    int koff[NKI]; bool krope[NKI]; int voff[2];
#pragma unroll
    for (int i = 0; i < NKI; ++i) { const int off = (wid * NKI + i) * 1024 + lane * 16; const int rw = off / RS, sw = off - rw * RS, cb = sw ^ ((rw & 7) << 4);
        krope[i] = (DK == 192) && (cb >= 256); koff[i] = krope[i] ? rw * 64 + ((cb - 256) >> 1) : rw * ldk + (cb >> 1); }
#pragma unroll
    for (int i = 0; i < 2; ++i) { const int off = (wid * 2 + i) * 1024 + lane * 16; const int sub = off >> 9, within = off & 511, kk = ((sub >> 2) << 3) | (within >> 6);
        const int k = (kk & ~0xC) | ((kk & 4) << 1) | ((kk & 8) >> 1), c = (sub & 3) * 32 + ((within & 63) >> 1); voff[i] = k * ldv + c; }
#define FA_DMA(j, bf) do { const int k0_ = (j) * 64; \
        _Pragma("unroll") for (int i_ = 0; i_ < NKI; ++i_) { const bf16_t* s_ = (DK == 192 && krope[i_]) ? (KRg + (size_t)k0_ * 64 + koff[i_]) : (Kg + (size_t)k0_ * ldk + koff[i_]); \
            __builtin_amdgcn_global_load_lds((const unsigned*)s_, (LAS unsigned*)(K_lds + (bf) * SHM_K + (wid * NKI + i_) * 1024), 16, 0, 0); } \
        _Pragma("unroll") for (int i_ = 0; i_ < 2; ++i_) \
            __builtin_amdgcn_global_load_lds((const unsigned*)(Vg + (size_t)k0_ * ldv + voff[i_]), (LAS unsigned*)(V_lds + (bf) * SHM_V + (wid * 2 + i_) * 1024), 16, 0, 0); \
        if (MODE == 3) { if (tid < 64) st_cs = cum[k0_ + tid] * L2E; } } while (0)
#define FA_CSW(bf) do { if (MODE == 3) { if (tid < 64) csl[(bf) * 64 + tid] = st_cs; } } while (0)
    __syncthreads();
    FA_DMA(j_lo, 0); asm volatile("s_waitcnt vmcnt(0)" ::: "memory"); FA_CSW(0);
    __syncthreads();
#pragma unroll 1
    for (int t = 0; t < NT; ++t) {
        const int buf = t & 1, j = j_lo + t, kbp = j * 64;
        if (t + 1 < NT) FA_DMA(j + 1, buf ^ 1);
        bool act;
        if (MODE == 0) act = (j >= cw - 8) && (j <= cw);
        else if (MODE == 1 || MODE == 2) act = (j <= cw);
        else if (MODE == 3) act = (kbp <= qlo + 31);
        else act = true;
        if (MODE == 2) { if (act) { const u32x2 mm = *(const u32x2*)(mrow + 2 * j); mk0 = mm.x; mk1 = mm.y; } }
        if (act) {
            f32x16 p0, p1;
            qkt<DK>(p0, p1, K_lds + buf * SHM_K, r32, hi, qr);
            if (MODE == 0) {
                if (qlo - (kbp + 63) >= 256) { const float bf_ = relb[512];
#pragma unroll
                    for (int r = 0; r < 16; ++r) { p0[r] = fmaf(p0[r], C2, bf_); p1[r] = fmaf(p1[r], C2, bf_); } }
                else { const int dq = row - kbp - 4 * hi;
#pragma unroll
                    for (int r = 0; r < 16; ++r) { const int c = (r & 3) + 8 * (r >> 2);
                        int i0 = dq - c; i0 = i0 < -256 ? -256 : (i0 > 256 ? 256 : i0); int i1 = dq - c - 32; i1 = i1 < -256 ? -256 : (i1 > 256 ? 256 : i1);
                        p0[r] = fmaf(p0[r], C2, relb[i0 + 256]); p1[r] = fmaf(p1[r], C2, relb[i1 + 256]); } }
            } else if (MODE == 3) {
                LAS const float* cs = csl + buf * 64 + 4 * hi;
#pragma unroll
                for (int q4 = 0; q4 < 4; ++q4) { const f32x4 c0 = *(LAS const f32x4*)(cs + 8 * q4), c1 = *(LAS const f32x4*)(cs + 32 + 8 * q4);
#pragma unroll
                    for (int e = 0; e < 4; ++e) { p0[4 * q4 + e] = fmaf(p0[4 * q4 + e], C2, ctl - c0[e]); p1[4 * q4 + e] = fmaf(p1[4 * q4 + e], C2, ctl - c1[e]); } }
                if (kbp + 63 > qlo) { const int dq = row - kbp - 4 * hi;
#pragma unroll
                    for (int r = 0; r < 16; ++r) { const int c = (r & 3) + 8 * (r >> 2); if (dq - c < 0) p0[r] = NEG; if (dq - c - 32 < 0) p1[r] = NEG; } }
            } else {
#pragma unroll
                for (int r = 0; r < 16; ++r) { p0[r] *= C2; p1[r] *= C2; }
                if (MODE == 2) {
#pragma unroll
                    for (int r = 0; r < 16; ++r) { const int c = (r & 3) + 8 * (r >> 2) + 4 * hi; if (!((mk0 >> c) & 1u)) p0[r] = NEG; if (!((mk1 >> c) & 1u)) p1[r] = NEG; } }
            }
            float alpha; bf16x8 pa0, pa1, pa2, pa3;
            softmax_tile(p0, p1, m_reg, l_reg, alpha, pa0, pa1, pa2, pa3);
            if (__any(alpha < 1.f)) { if (hi == 0) wsc[r32] = alpha; LDS_WAIT();
#pragma unroll
                for (int r = 0; r < 16; ++r) { const float al = wsc[crow(r, hi)];
#pragma unroll
                    for (int d_ = 0; d_ < 4; ++d_) o[d_][r] *= al; }
                LDS_WAIT(); }
            pv_tile(o, vbase + buf * SHM_V, pa0, pa1, pa2, pa3);
        }
        asm volatile("s_waitcnt vmcnt(0)" ::: "memory");
        if (t + 1 < NT) FA_CSW(buf ^ 1);
        __syncthreads();
    }
#undef FA_DMA
#undef FA_CSW
    if (hi == 0) wsc[32 + r32] = l_reg; LDS_WAIT();
#pragma unroll
    for (int r = 0; r < 16; ++r) { const int orow = crow(r, hi); const float rl = __builtin_amdgcn_rcpf(wsc[32 + orow]);
#pragma unroll
        for (int d0 = 0; d0 < 4; ++d0) { const float v = o[d0][r] * rl; const float vn = __shfl_xor(v, 1);
            if ((r32 & 1) == 0) *(unsigned*)(Og + (size_t)orow * ldo + d0 * 32 + r32) = cvtpk(v, vn); } }
    LDS_WAIT();
}
}

__device__ __forceinline__ void rope_pair(float& x1, float& x2, float cs, float sn) { const float a = x1 * cs - x2 * sn, b = x2 * cs + x1 * sn; x1 = a; x2 = b; }
__device__ __forceinline__ void ph_l0_stats(const Args& a, const WI& w) {
    unsigned char* ws = a.ws; const bf16_t* P = (const bf16_t*)(ws + WS_PROJ);
    const float* r64 = (const float*)(ws + WS_ROPE64);
    for (int t = w.gw; t < T; t += w.ngw) {
        const bf16_t* row = P + (size_t)t * AB_MAIN;
        float s = 0.f;
        for (int j = 0; j < 3; ++j) { const bf16x8 v = *(const bf16x8*)(row + 6144 + (j * 64 + w.lane) * 8);
#pragma unroll
            for (int e = 0; e < 8; ++e) { const float f = bf2f((bf16_t)v[e]); s += f * f; } }
        s = wave_sum(s);
        float s2 = 0.f; { const bf16x8 v = *(const bf16x8*)(row + 7680 + w.lane * 8);
#pragma unroll
            for (int e = 0; e < 8; ++e) { const float f = bf2f((bf16_t)v[e]); s2 += f * f; } }
        s2 = wave_sum(s2);
        if (w.lane == 0) { ((float*)(ws + WS_RSQ))[t] = 1.f / sqrtf(s * (1.f / 1536.f) + RMS_EPS); ((float*)(ws + WS_RSKV))[t] = 1.f / sqrtf(s2 * (1.f / 512.f) + RMS_EPS); }
        if (w.lane < 32) { const float* sm = (const float*)(ws + WS_SMALL) + (size_t)t * 128; const int sp = t & (SEQ - 1);
            float x1 = sm[w.lane], x2 = sm[w.lane + 32]; const float cs = r64[((size_t)sp * 32 + w.lane) * 2], sn = r64[((size_t)sp * 32 + w.lane) * 2 + 1];
            rope_pair(x1, x2, cs, sn);
            bf16_t* kr = (bf16_t*)(ws + WS_KR) + (size_t)t * 64; kr[w.lane] = (bf16_t)f2bf(x1); kr[w.lane + 32] = (bf16_t)f2bf(x2); }
    }
}
__device__ __forceinline__ void ph_l0_qrope(const Args& a, const WI& w) {
    unsigned char* ws = a.ws; bf16_t* Q = (bf16_t*)(ws + WS_QB); const float* r64 = (const float*)(ws + WS_ROPE64);
    for (int t = w.gw; t < T; t += w.ngw) {
        const int sp = t & (SEQ - 1);
        for (int e = w.lane; e < 16 * 32; e += 64) { const int h = e >> 5, i = e & 31; bf16_t* q = Q + (size_t)t * 3072 + h * 192 + 128;
            float x1 = bf2f(q[i]), x2 = bf2f(q[i + 32]); rope_pair(x1, x2, r64[((size_t)sp * 32 + i) * 2], r64[((size_t)sp * 32 + i) * 2 + 1]);
            q[i] = (bf16_t)f2bf(x1); q[i + 32] = (bf16_t)f2bf(x2); }
    }
}
__device__ __forceinline__ void ph_l1_elem(const Args& a, const WI& w) {
    unsigned char* ws = a.ws; bf16_t* P = (bf16_t*)(ws + WS_PROJ);
    const float* r128 = (const float*)(ws + WS_ROPE128); const float* r64 = (const float*)(ws + WS_ROPE64);
    for (int t = w.gw; t < T; t += w.ngw) {
        const int b = t / SEQ, sp = t - b * SEQ; bf16_t* row = P + (size_t)t * CD_MAIN;
        for (int e = w.lane; e < 20 * 64; e += 64) { const int h = e >> 6, i = e & 63; bf16_t* q = row + h * 128;
            float x1 = bf2f(q[i]), x2 = bf2f(q[i + 64]); rope_pair(x1, x2, r128[((size_t)sp * 64 + i) * 2], r128[((size_t)sp * 64 + i) * 2 + 1]);
            q[i] = (bf16_t)f2bf(x1); q[i + 64] = (bf16_t)f2bf(x2); }
        for (int e = w.lane; e < 32 * 32; e += 64) { const int h = e >> 5, i = e & 31; bf16_t* q = row + 3072 + h * 64;
            float x1 = bf2f(q[i]), x2 = bf2f(q[i + 32]); rope_pair(x1, x2, r64[((size_t)sp * 32 + i) * 2], r64[((size_t)sp * 32 + i) * 2 + 1]);
            q[i] = (bf16_t)f2bf(x1); q[i + 32] = (bf16_t)f2bf(x2); }
        const float* sm = (const float*)(ws + WS_SMALL) + (size_t)t * 128;
        if (w.lane < 32) { float x1 = sm[w.lane], x2 = sm[w.lane + 32]; rope_pair(x1, x2, r64[((size_t)sp * 32 + w.lane) * 2], r64[((size_t)sp * 32 + w.lane) * 2 + 1]);
            bf16_t* ki = (bf16_t*)(ws + WS_KI) + (size_t)t * 64; ki[w.lane] = (bf16_t)f2bf(x1); ki[w.lane + 32] = (bf16_t)f2bf(x2);
            ((float*)(ws + WS_WI))[(size_t)t * 32 + w.lane] = sm[64 + w.lane] * 0.17677669529663687f; }
        if (w.lane < 16) { const float z = sm[96 + w.lane] + a.in[I_D_FORGET_BIAS][w.lane];
            const float lf = fminf(z, 0.f) - log1pf(__expf(-fabsf(z)));
            ((float*)(ws + WS_LOGF))[((size_t)b * 16 + w.lane) * SEQ + sp] = lf; }
    }
}
__device__ __forceinline__ void ph_l1_scan(const Args& a, const WI& w) {
    unsigned char* ws = a.ws;
    for (int it = w.gw; it < NB * 16; it += w.ngw) {
        const float* src = (const float*)(ws + WS_LOGF) + (size_t)it * SEQ + w.lane * 64; float* dst = (float*)(ws + WS_CUM) + (size_t)it * SEQ + w.lane * 64;
        float tot = 0.f; for (int j = 0; j < 64; ++j) tot += src[j];
        float inc = tot;
#pragma unroll
        for (int o = 1; o < 64; o <<= 1) { const float v = __shfl_up(inc, o); if (w.lane >= o) inc += v; }
        float run = inc - tot;
        for (int j = 0; j < 64; ++j) { run += src[j]; dst[j] = run; }
    }
}
__device__ __forceinline__ void ph_l1_index_naive(const Args& a, LAS float* qs  , const WI& w) {
    unsigned char* ws = a.ws; const bf16_t* P = (const bf16_t*)(ws + WS_PROJ); const bf16_t* KI = (const bf16_t*)(ws + WS_KI);
    const float* WIp = (const float*)(ws + WS_WI); float* SC = (float*)(ws + WS_SCORE);
    for (int t = w.gw; t < T; t += w.ngw) {
        const int b = t / SEQ, sp = t - b * SEQ, nadm = ((sp >> 6) + 1) * 64;
        LDS_WAIT();
        for (int e = w.lane; e < 2048; e += 64) qs[e] = bf2f(P[(size_t)t * CD_MAIN + 3072 + e]);
        if (w.lane < 32) qs[2048 + w.lane] = WIp[(size_t)t * 32 + w.lane];
        LDS_WAIT();
        for (int s0 = 0; s0 < nadm; s0 += 64) {
            const int s = s0 + w.lane; const bf16_t* kp = KI + ((size_t)b * SEQ + s) * 64;
            float k[64];
#pragma unroll
            for (int d0 = 0; d0 < 64; d0 += 8) { const bf16x8 kv = *(const bf16x8*)(kp + d0);
#pragma unroll
                for (int e = 0; e < 8; ++e) k[d0 + e] = bf2f((bf16_t)kv[e]); }
            float sc = 0.f;
            for (int h = 0; h < 32; ++h) { float dot = 0.f;
#pragma unroll
                for (int d = 0; d < 64; ++d) dot += qs[h * 64 + d] * k[d];
                sc += qs[2048 + h] * fmaxf(dot * 0.125f, 0.f); }
            SC[((size_t)b * SEQ + sp) * SEQ + s] = sc;
        }
    }
}
__device__ __forceinline__ void ph_l1_index(const Args& a, LAS unsigned char* lds, const WI& w) {
    unsigned char* ws = a.ws; const bf16_t* P = (const bf16_t*)(ws + WS_PROJ); const bf16_t* KI = (const bf16_t*)(ws + WS_KI);
    const float* WIp = (const float*)(ws + WS_WI); float* SC = (float*)(ws + WS_SCORE);
    LAS char* Qs = (LAS char*)lds; LAS float* Wt = (LAS float*)(lds + 131072);
    const int tid = w.tid, r32 = w.lane & 31, hi = w.lane >> 5;
    for (int u = w.bid; u < 256; u += w.nblk) {
        const int b = u >> 7, x = (u >> 1) & 63, half = u & 1;
        for (int pass = 0; pass < 2; ++pass) {
            const int qt = pass ? 127 - x : x; const int t0 = b * SEQ + qt * 32; const int nadm = ((qt * 32) >> 6) * 64 + 64, ngrp = (nadm + 127) >> 7;
            __syncthreads();
            for (int e = tid; e < 32 * 256; e += 512) { const int t = e >> 8, c = e & 255; const u32x4 v = *(const u32x4*)(P + (size_t)(t0 + t) * CD_MAIN + 3072 + c * 8);
                const int cs = (c & ~15) | ((c & 15) ^ (t & 15)); *(LAS u32x4*)(Qs + t * 4096 + cs * 16) = v; }
            for (int e = tid; e < 1024; e += 512) { const int t = e >> 5, h = e & 31; Wt[h * 32 + t] = WIp[(size_t)(t0 + t) * 32 + h] * 0.125f; }
            __syncthreads();
            for (int g = half + 2 * w.wave; g < ngrp; g += 16) {
                const int s0 = g * 128;
                bf16x8 kf[4][4];
#pragma unroll
                for (int j = 0; j < 4; ++j)
#pragma unroll
                    for (int dk = 0; dk < 4; ++dk) kf[j][dk] = *(const bf16x8*)(KI + ((size_t)b * SEQ + s0 + 32 * j + r32) * 64 + dk * 16 + hi * 8);
                f32x16 acc[4] = {};
#pragma unroll 2
                for (int h = 0; h < 32; ++h) {
                    bf16x8 qf[4];
#pragma unroll
                    for (int dk = 0; dk < 4; ++dk) qf[dk] = *(LAS const bf16x8*)(Qs + r32 * 4096 + ((((h >> 1) << 4) | ((((h & 1) << 3) | (dk << 1) | hi) ^ (r32 & 15))) << 4));
                    f32x4 wv[4];
#pragma unroll
                    for (int q4 = 0; q4 < 4; ++q4) wv[q4] = *(LAS const f32x4*)(Wt + h * 32 + 8 * q4 + 4 * hi);
#pragma unroll
                    for (int j = 0; j < 4; ++j) { f32x16 tmp = {};
#pragma unroll
                        for (int dk = 0; dk < 4; ++dk) tmp = __builtin_amdgcn_mfma_f32_32x32x16_bf16(qf[dk], kf[j][dk], tmp, 0, 0, 0);
#pragma unroll
                        for (int r = 0; r < 16; ++r) acc[j][r] = fmaf(wv[r >> 2][r & 3], fmaxf(tmp[r], 0.f), acc[j][r]); }
                }
#pragma unroll
                for (int j = 0; j < 4; ++j)
#pragma unroll
                    for (int r = 0; r < 16; ++r) SC[(size_t)(t0 + crow(r, hi)) * SEQ + s0 + 32 * j + r32] = acc[j][r];
            }
        }
    }
    __syncthreads();
}
__device__ __forceinline__ void ph_l1_select(const Args& a, const WI& w) {
    unsigned char* ws = a.ws; const float* SC = (const float*)(ws + WS_SCORE); unsigned* MK = (unsigned*)(ws + WS_MASK);
    for (int t = w.gw; t < T; t += w.ngw) {
        const int b = t / SEQ, sp = t - b * SEQ, nblk = (sp >> 6) + 1;
        const float* row = SC + ((size_t)b * SEQ + sp) * SEQ;
        unsigned key[64];
#pragma unroll
        for (int j = 0; j < 64; ++j) { unsigned u = 0u; if (j < nblk) { u = __float_as_uint(row[j * 64 + w.lane]); u ^= (u >> 31) ? 0xFFFFFFFFu : 0x80000000u; } key[j] = u; }
        unsigned thr = 0u;
        if (nblk > 4) {
            for (int bit = 31; bit >= 0; --bit) { const unsigned cand = thr | (1u << bit); int cnt = 0;
#pragma unroll
                for (int j = 0; j < 64; ++j) cnt += (key[j] >= cand) ? 1 : 0;
                cnt = wave_sum_i(cnt); if (cnt >= 256) thr = cand; }
        }
        unsigned lo = 0u, hi = 0u;
#pragma unroll
        for (int j = 0; j < 64; ++j) { const bool sel = (j < nblk) && (key[j] >= thr); const unsigned long long bal = __ballot(sel); if (w.lane == j) { lo = (unsigned)bal; hi = (unsigned)(bal >> 32); } }
        *(u32x2*)(MK + (size_t)t * 128 + 2 * w.lane) = (u32x2){lo, hi};
    }
}

__device__ __forceinline__ void ph_peer_topk(const Args& a, const WI& w) {
    unsigned char* ws = a.ws; const float* PS = (const float*)(ws + WS_PSCORE); int* PIDX = (int*)(ws + WS_PIDX); float* PG = (float*)(ws + WS_PGATE);
    const float NEG = -__builtin_inff();
    for (int t = w.gw; t < T; t += w.ngw) {
        for (int h = 0; h < 8; ++h) {
            const float* s = PS + (size_t)t * 2048 + h * 256;
            float ts[2]; int ti[2];
#pragma unroll
            for (int p = 0; p < 2; ++p) {
                float v0 = s[p * 128 + w.lane], v1 = s[p * 128 + 64 + w.lane]; float mys = NEG; int myi = 0;
                for (int k = 0; k < 16; ++k) {
                    const float m = wave_max(fmaxf(v0, v1));
                    const unsigned long long b0 = __ballot(v0 == m); int idx;
                    if (b0) { const int src = __ffsll((long long)b0) - 1; idx = src; if (w.lane == src) v0 = NEG; }
                    else { const unsigned long long b1 = __ballot(v1 == m); const int src = __ffsll((long long)b1) - 1; idx = src + 64; if (w.lane == src) v1 = NEG; }
                    if (w.lane == k) { mys = m; myi = idx; }
                }
                ts[p] = mys; ti[p] = myi;
            }
            float cv[4];
#pragma unroll
            for (int q = 0; q < 4; ++q) { const int c = w.lane + 64 * q; cv[q] = __shfl(ts[0], c >> 4) + __shfl(ts[1], c & 15); }
            float bs = NEG; int bc = 0;
            for (int k = 0; k < 16; ++k) {
                const float m = wave_max(fmaxf(fmaxf(cv[0], cv[1]), fmaxf(cv[2], cv[3])));
                int cidx = -1;
#pragma unroll
                for (int q = 0; q < 4; ++q) { if (cidx < 0) { const unsigned long long bb = __ballot(cv[q] == m); if (bb) { const int src = __ffsll((long long)bb) - 1; cidx = src + 64 * q; if (w.lane == src) cv[q] = NEG; } } }
                if (w.lane == k) { bs = m; bc = cidx; }
            }
            const int e0 = __shfl(ti[0], bc >> 4), e1 = __shfl(ti[1], bc & 15);
            const float top = __shfl(bs, 0);
            const float ex = (w.lane < 16) ? __expf(bs - top) : 0.f;
            const float den = wave_sum(ex);
            if (w.lane < 16) { PIDX[(size_t)t * 128 + h * 16 + w.lane] = e0 * 128 + e1; PG[(size_t)t * 128 + h * 16 + w.lane] = ex / den; }
        }
    }
}
__device__ __forceinline__ void ph_peer_experts(const Args& a, int layer, float* outf, bf16_t* outb, const float* g, const float* bta, LAS float* wsm  , const WI& w) {
    unsigned char* ws = a.ws; const float* HF = (const float*)(ws + WS_HF);
    const unsigned char* U8 = ws + WS_U8 + (size_t)layer * 16384 * DM; const unsigned char* V8 = ws + WS_V8 + (size_t)layer * 16384 * DM;
    const float* USC = (const float*)(ws + WS_USC) + layer * 16384; const float* VSC = (const float*)(ws + WS_VSC) + layer * 16384;
    const int* PIDX = (const int*)(ws + WS_PIDX); const float* PG = (const float*)(ws + WS_PGATE);
    const int lane = w.lane;
    for (int t = w.gw; t < T; t += w.ngw) {
        const float* hrow = HF + (size_t)t * DM + 16 * lane;
        const int idx0 = PIDX[(size_t)t * 128 + lane], idx1 = PIDX[(size_t)t * 128 + 64 + lane];
        const float g0 = PG[(size_t)t * 128 + lane], g1 = PG[(size_t)t * 128 + 64 + lane];
        LDS_WAIT();
        {
            f32x2 x[32];
#pragma unroll
            for (int i = 0; i < 4; ++i)
#pragma unroll
                for (int q4 = 0; q4 < 4; ++q4) { const f32x4 v = *(const f32x4*)(hrow + 1024 * i + 4 * q4); x[8 * i + 2 * q4] = (f32x2){v.x, v.y}; x[8 * i + 2 * q4 + 1] = (f32x2){v.z, v.w}; }
#pragma unroll 1
            for (int k0 = 0; k0 < 128; k0 += 8) {
                const int iv = (k0 & 64) ? idx1 : idx0; const float gv = (k0 & 64) ? g1 : g0;
                float z[8];
#pragma unroll
                for (int q = 0; q < 8; ++q) {
                    const int e = __builtin_amdgcn_readlane(iv, (k0 + q) & 63);
                    const u32x4* ur = (const u32x4*)(U8 + (size_t)e * DM + 16 * lane); f32x2 acc = {0.f, 0.f};
#pragma unroll
                    for (int i = 0; i < 4; ++i) { const u32x4 uv = ur[64 * i];
#pragma unroll
                        for (int c = 0; c < 4; ++c) { const f32x2 lo = __builtin_amdgcn_cvt_pk_f32_fp8((int)uv[c], false), hi2 = __builtin_amdgcn_cvt_pk_f32_fp8((int)uv[c], true);
                            acc = __builtin_elementwise_fma(lo, x[8 * i + 2 * c], acc); acc = __builtin_elementwise_fma(hi2, x[8 * i + 2 * c + 1], acc); } }
                    z[q] = acc.x + acc.y;
                }
                float r4[4], r2[2], r1;
#pragma unroll
                for (int i = 0; i < 4; ++i) { const float keep = (lane & 32) ? z[i + 4] : z[i], send = (lane & 32) ? z[i] : z[i + 4]; r4[i] = keep + __shfl_xor(send, 32); }
#pragma unroll
                for (int i = 0; i < 2; ++i) { const float keep = (lane & 16) ? r4[i + 2] : r4[i], send = (lane & 16) ? r4[i] : r4[i + 2]; r2[i] = keep + __shfl_xor(send, 16); }
                { const float keep = (lane & 8) ? r2[1] : r2[0], send = (lane & 8) ? r2[0] : r2[1]; r1 = keep + __shfl_xor(send, 8); }
                r1 += __shfl_xor(r1, 4); r1 += __shfl_xor(r1, 2); r1 += __shfl_xor(r1, 1);
                const int q = lane >> 3; const int e = __shfl(iv, (k0 + q) & 63); const float gt_ = __shfl(gv, (k0 + q) & 63);
                if ((lane & 7) == 0) { const float zz = r1 * USC[e]; const float act = 0.5f * zz * (1.f + erff(zz * 0.70710678118654752f)); wsm[k0 + q] = act * gt_ * VSC[e]; }
            }
        }
        LDS_WAIT();
        f32x2 y[32];
#pragma unroll
        for (int i = 0; i < 32; ++i) y[i] = (f32x2){0.f, 0.f};
#pragma unroll 1
        for (int k0 = 0; k0 < 128; k0 += 8) {
            const int iv = (k0 & 64) ? idx1 : idx0;
#pragma unroll
            for (int q = 0; q < 8; ++q) {
                const int e = __builtin_amdgcn_readlane(iv, (k0 + q) & 63); const float wt = wsm[k0 + q]; const f32x2 wt2 = {wt, wt};
                const u32x4* vr = (const u32x4*)(V8 + (size_t)e * DM + 16 * lane);
#pragma unroll
                for (int i = 0; i < 4; ++i) { const u32x4 vv = vr[64 * i];
#pragma unroll
                    for (int c = 0; c < 4; ++c) { const f32x2 lo = __builtin_amdgcn_cvt_pk_f32_fp8((int)vv[c], false), hi2 = __builtin_amdgcn_cvt_pk_f32_fp8((int)vv[c], true);
                        y[8 * i + 2 * c] = __builtin_elementwise_fma(lo, wt2, y[8 * i + 2 * c]); y[8 * i + 2 * c + 1] = __builtin_elementwise_fma(hi2, wt2, y[8 * i + 2 * c + 1]); } }
            }
        }
        float s = 0.f;
#pragma unroll
        for (int i = 0; i < 4; ++i)
#pragma unroll
            for (int q4 = 0; q4 < 4; ++q4) { const f32x4 v = *(const f32x4*)(hrow + 1024 * i + 4 * q4);
                y[8 * i + 2 * q4].x += ALPHA * v.x; y[8 * i + 2 * q4].y += ALPHA * v.y; y[8 * i + 2 * q4 + 1].x += ALPHA * v.z; y[8 * i + 2 * q4 + 1].y += ALPHA * v.w; }
#pragma unroll
        for (int i = 0; i < 32; ++i) s += y[i].x + y[i].y;
        const float mean = wave_sum(s) * (1.f / DM); float s2 = 0.f;
#pragma unroll
        for (int i = 0; i < 32; ++i) { y[i].x -= mean; y[i].y -= mean; s2 += y[i].x * y[i].x + y[i].y * y[i].y; }
        const float rstd = 1.f / sqrtf(wave_sum(s2) * (1.f / DM) + LN_EPS);
#pragma unroll
        for (int i = 0; i < 4; ++i)
#pragma unroll
            for (int q4 = 0; q4 < 4; ++q4) { const int c = 1024 * i + 16 * lane + 4 * q4;
                const f32x4 gg = *(const f32x4*)(g + c), bb = *(const f32x4*)(bta + c); f32x4 o;
                o.x = y[8 * i + 2 * q4].x * rstd * gg.x + bb.x; o.y = y[8 * i + 2 * q4].y * rstd * gg.y + bb.y; o.z = y[8 * i + 2 * q4 + 1].x * rstd * gg.z + bb.z; o.w = y[8 * i + 2 * q4 + 1].y * rstd * gg.w + bb.w;
                *(f32x4*)(outf + (size_t)t * DM + c) = o;
                if (outb) { u32x2 p; p.x = pk2(o.x, o.y); p.y = pk2(o.z, o.w); *(u32x2*)(outb + (size_t)t * DM + c) = p; } }
    }
}

__device__ __forceinline__ void ph_attn_l0(const Args& a, LAS unsigned char* lds, const WI& w) {
    for (int pr = w.bid; pr < 256; pr += w.nblk) { const int bh = pr >> 3, x = pr & 7;
        for (int pass = 0; pass < 2; ++pass) fa::attn_unit<1>(a, 0, lds, bh >> 4, bh & 15, pass ? 15 - x : x); }
    for (int u = w.bid; u < 512; u += w.nblk) { const int bh = u >> 4; fa::attn_unit<0>(a, 0, lds, bh >> 4, bh & 15, u & 15); }
}
__device__ __forceinline__ void ph_attn_l1(const Args& a, LAS unsigned char* lds, const WI& w) {
    for (int pr = w.bid; pr < 256; pr += w.nblk) { const int bh = pr >> 3, x = pr & 7;
        for (int pass = 0; pass < 2; ++pass) fa::attn_unit<2>(a, 1, lds, bh >> 4, bh & 15, pass ? 15 - x : x); }
    for (int pr = w.bid; pr < 256; pr += w.nblk) { const int bh = pr >> 3, x = pr & 7;
        for (int pass = 0; pass < 2; ++pass) fa::attn_unit<3>(a, 1, lds, bh >> 4, bh & 15, pass ? 15 - x : x); }
}
__device__ __forceinline__ void ph_attn_mem(const Args& a, int layer, LAS unsigned char* lds, const WI& w) {
    for (int u = w.bid; u < 128; u += w.nblk) { const int bh = u >> 4; fa::attn_unit<4>(a, layer, lds, bh >> 2, bh & 3, u & 15); }
}

__global__ void __launch_bounds__(512, 2) mega(Args a) {
    extern __shared__ __attribute__((aligned(16))) unsigned char lds_raw[];
    LAS unsigned char* lds = (LAS unsigned char*)lds_raw;
    WI w; w.tid = threadIdx.x; w.lane = w.tid & 63; w.wave = __builtin_amdgcn_readfirstlane(w.tid >> 6);
    w.bid = blockIdx.x; w.nblk = gridDim.x; w.gw = w.bid * 8 + w.wave; w.ngw = w.nblk * 8;
    unsigned char* ws = a.ws;
    volatile LAS unsigned* misc = (volatile LAS unsigned*)(lds + LDS_MISC);
    if (w.tid < 4) misc[w.tid] = 0u;
    __syncthreads();
    XcdBarrier bar; bar.bar = (unsigned*)(ws + WS_CTL) + 4096; bar.x = 0; bar.st = misc;
#if !MK_PER_PHASE
    bar = xcd_barrier_post((unsigned*)(ws + WS_CTL) + 4096, misc);
#endif
    const int lo = a.ph_lo, hi = a.ph_hi;
#define IN(k) (lo <= (k) && (k) < hi)
#if MK_PER_PHASE
#define SEAM(k) do { } while (0)
#else
#define SEAM(k) do { if (IN(k) && IN((k) + 1)) xcd_barrier(bar); } while (0)
#endif
    LAS float* wlds = (LAS float*)(lds + w.wave * 16384);
    bf16_t* XB = (bf16_t*)(ws + WS_XB); float* HF = (float*)(ws + WS_HF); float* RES = (float*)(ws + WS_RES); bf16_t* PROJ = (bf16_t*)(ws + WS_PROJ);
    bf16_t* ATT = (bf16_t*)(ws + WS_ATT); float* SMALL = (float*)(ws + WS_SMALL);

#define FAST_GEMM(EPI_T, Aptr, lda_, Btptr, ldb_, M_, N_, K_, nz_, zA_, zB_, EPI_OBJ) do { \
        pg8::Gemm g_{Aptr, Btptr, M_, N_, K_, lda_, ldb_, zA_, zB_, nz_}; pg8::StaticOrder S_; S_.init(M_, N_, nz_, w.nblk, w.bid); \
        pg8::gemm_phase<EPI_T, pg8::StaticOrder>(lds, g_, S_, EPI_OBJ); } while (0)
    if (IN(0)) { ph_convert(a, lds, w); if (PROBE_DUP == 0) ph_convert(a, lds, w); }
    SEAM(0);
    if (IN(1)) {
        FAST_GEMM(pg8::EpiBf16, XB, DM, (const bf16_t*)(ws + WS_W_AB_IN), DM, T, AB_MAIN, DM, 1, 0, 0, (pg8::EpiBf16{PROJ, AB_MAIN, nullptr}));
        naive_gemm(XB, DM, (const bf16_t*)(ws + WS_W_AB_IN) + (size_t)AB_MAIN * DM, DM, T, 64, DM, w, [=](int m, int n, float v) { SMALL[(size_t)m * 128 + n] = v; });
        bf16_t* KVM = (bf16_t*)(ws + WS_KVM);
        naive_gemm((const bf16_t*)(ws + WS_MEMB), DM, (const bf16_t*)(ws + WS_W_MEM_KV), DM, 512, 2048, DM, w,
                   [=](int m, int n, float v) { KVM[((size_t)(n >> 10) * 512 + m) * 1024 + (n & 1023)] = (bf16_t)f2bf(v); });
    }
    SEAM(1);
    if (IN(2)) ph_l0_stats(a, w);
    SEAM(2);
    if (IN(3)) {
        const float* rsq = (const float*)(ws + WS_RSQ); const float* rskv = (const float*)(ws + WS_RSKV);
        bf16_t* QB = (bf16_t*)(ws + WS_QB); bf16_t* KVB = (bf16_t*)(ws + WS_KVB);
        FAST_GEMM(pg8::EpiBf16, PROJ + 6144, AB_MAIN, (const bf16_t*)(ws + WS_W_UQ), 1536, T, 3072, 1536, 1, 0, 0, (pg8::EpiBf16{QB, 3072, rsq}));
        FAST_GEMM(pg8::EpiBf16, PROJ + 7680, AB_MAIN, (const bf16_t*)(ws + WS_W_UKV), 512, T, 4096, 512, 1, 0, 0, (pg8::EpiBf16{KVB, 4096, rskv}));
    }
    SEAM(3);
    if (IN(4)) ph_l0_qrope(a, w);
    SEAM(4);
    if (IN(5)) { ph_attn_l0(a, lds, w); if (PROBE_DUP == 5) ph_attn_l0(a, lds, w); }
    SEAM(5);
    if (IN(6)) { const float* X = a.in[I_X];
        FAST_GEMM(pg8::EpiResid, ATT, DM, (const bf16_t*)(ws + WS_W_AB_OUT), DM, T, DM, DM, 1, 0, 0, (pg8::EpiResid{X, RES, DM})); }
    SEAM(6);
    if (IN(7)) ln_rows(RES, a.in[I_LN_G] + 0 * DM, a.in[I_LN_B] + 0 * DM, HF, XB, w);
    SEAM(7);

#define MEM_PEER_PHASES(L, P0_, LAST)                                                                                                                         \
    if (IN(P0_)) { FAST_GEMM(pg8::EpiF32, XB, DM, (const bf16_t*)(ws + WS_W_MEM_Q) + (size_t)(L) * 512 * DM, DM, T, 512, 1024, 4, 1024, 1024,                    \
                             (pg8::EpiF32{(float*)(ws + WS_MQP), 512, (long)T * 512})); }                                                                       \
    SEAM(P0_);                                                                                                                                                  \
    if (IN(P0_ + 1)) ph_attn_mem(a, (L), lds, w);                                                                                                               \
    SEAM(P0_ + 1);                                                                                                                                              \
    if (IN(P0_ + 2)) { FAST_GEMM(pg8::EpiResid, (const bf16_t*)(ws + WS_MEMO), 512, (const bf16_t*)(ws + WS_W_MEM_O) + (size_t)(L) * DM * 512, 512, T, DM, 512, 1, 0, 0, \
                                 (pg8::EpiResid{HF, RES, DM})); }                                                                                               \
    SEAM(P0_ + 2);                                                                                                                                              \
    if (IN(P0_ + 3)) ln_rows(RES, a.in[I_LN_G] + ((L) * 3 + 1) * DM, a.in[I_LN_B] + ((L) * 3 + 1) * DM, HF, XB, w);                                             \
    SEAM(P0_ + 3);                                                                                                                                              \
    if (IN(P0_ + 4)) { FAST_GEMM(pg8::EpiF32, XB, DM, (const bf16_t*)(ws + WS_W_PEER) + (size_t)(L) * 2048 * DM, DM, T, 2048, DM, 1, 0, 0,                     \
                                 (pg8::EpiF32{(float*)(ws + WS_PSCORE), 2048, 0})); }                                                                           \
    SEAM(P0_ + 4);                                                                                                                                              \
    if (IN(P0_ + 5)) { ph_peer_topk(a, w); if (PROBE_DUP == 27 && (LAST)) ph_peer_topk(a, w); }                                                                 \
    SEAM(P0_ + 5);                                                                                                                                              \
    if (IN(P0_ + 6)) { ph_peer_experts(a, (L), (LAST) ? a.out : HF, (LAST) ? (bf16_t*)nullptr : XB, a.in[I_LN_G] + ((L) * 3 + 2) * DM, a.in[I_LN_B] + ((L) * 3 + 2) * DM, wlds, w); \
        if (PROBE_DUP == 28 && (LAST)) ph_peer_experts(a, (L), a.out, (bf16_t*)nullptr, a.in[I_LN_G] + ((L) * 3 + 2) * DM, a.in[I_LN_B] + ((L) * 3 + 2) * DM, wlds, w); } \
    if (!(LAST)) SEAM(P0_ + 6);

    MEM_PEER_PHASES(0, 8, false)

    if (IN(15)) {
        FAST_GEMM(pg8::EpiBf16, XB, DM, (const bf16_t*)(ws + WS_W_CD_IN), DM, T, CD_MAIN, DM, 1, 0, 0, (pg8::EpiBf16{PROJ, CD_MAIN, nullptr}));
        naive_gemm(XB, DM, (const bf16_t*)(ws + WS_W_CD_IN) + (size_t)CD_MAIN * DM, DM, T, 112, DM, w, [=](int m, int n, float v) { SMALL[(size_t)m * 128 + n] = v; });
    }
    SEAM(15);
    if (IN(16)) ph_l1_elem(a, w);
    SEAM(16);
    if (IN(17)) { ph_l1_scan(a, w); ph_l1_index(a, lds, w); if (PROBE_DUP == 17) ph_l1_index(a, lds, w); }
    SEAM(17);
    if (IN(18)) { ph_l1_select(a, w); if (PROBE_DUP == 18) ph_l1_select(a, w); }
    SEAM(18);
    if (IN(19)) { ph_attn_l1(a, lds, w); if (PROBE_DUP == 19) ph_attn_l1(a, lds, w); }
    SEAM(19);
    if (IN(20)) { FAST_GEMM(pg8::EpiResid, ATT, DM, (const bf16_t*)(ws + WS_W_CD_OUT), DM, T, DM, DM, 1, 0, 0, (pg8::EpiResid{HF, RES, DM})); }
    SEAM(20);
    if (IN(21)) ln_rows(RES, a.in[I_LN_G] + 3 * DM, a.in[I_LN_B] + 3 * DM, HF, XB, w);
    SEAM(21);
    MEM_PEER_PHASES(1, 22, true)
#undef IN
#undef SEAM
}

extern "C" void kernel_launch(void* const* d_in, const int* in_sizes, int n_in, void* d_out, int out_size, void* d_ws, size_t ws_size, hipStream_t stream) {
    static int grid = 0;
    if (grid == 0) {
        if (n_in != 21 || out_size != T * DM || ws_size < WS_END) { fprintf(stderr, "kernel_launch: unexpected shapes (n_in %d out %d ws %zu need %zu)\n", n_in, out_size, ws_size, (size_t)WS_END); grid = -1; return; }
        int dev = 0, cus = 0, per_cu = 0;
        if (hipGetDevice(&dev) != hipSuccess || hipDeviceGetAttribute(&cus, hipDeviceAttributeMultiprocessorCount, dev) != hipSuccess) { grid = -1; return; }
        if (hipFuncSetAttribute((const void*)mega, hipFuncAttributeMaxDynamicSharedMemorySize, LDS_BYTES) != hipSuccess) { fprintf(stderr, "kernel_launch: hipFuncSetAttribute failed\n"); grid = -1; return; }
        if (hipOccupancyMaxActiveBlocksPerMultiprocessor(&per_cu, (const void*)mega, 512, LDS_BYTES) != hipSuccess || per_cu < 1) { fprintf(stderr, "kernel_launch: occupancy query says %d\n", per_cu); }
        (void)hipGetLastError();
        grid = cus;
    }
    if (grid < 0) return;
    (void)hipMemsetAsync((char*)d_ws + WS_CTL, 0, CTL_BYTES, stream);
    Args a{};
    for (int i = 0; i < 21; ++i) a.in[i] = (const float*)d_in[i];
    a.out = (float*)d_out; a.ws = (unsigned char*)d_ws;
#if MK_PER_PHASE
    for (int p = 0; p < NPHASE; ++p) { a.ph_lo = p; a.ph_hi = p + 1; hipLaunchKernelGGL(mega, dim3(grid), dim3(512), LDS_BYTES, stream, a); }
#else
    a.ph_lo = 0; a.ph_hi = NPHASE;
    hipLaunchKernelGGL(mega, dim3(grid), dim3(512), LDS_BYTES, stream, a);
#endif
}
```

```cpp
#include <hip/hip_runtime.h>
#include <cstdio>
#include <cstdint>

#define GAS __attribute__((address_space(1)))
#define LAS __attribute__((address_space(3)))
typedef unsigned short bf16_t;
typedef short bf16x8 __attribute__((ext_vector_type(8)));
typedef float f32x4 __attribute__((ext_vector_type(4)));
typedef float f32x16 __attribute__((ext_vector_type(16)));
typedef unsigned u32x4 __attribute__((ext_vector_type(4)));
typedef unsigned u32x2 __attribute__((ext_vector_type(2)));
typedef float f32x2 __attribute__((ext_vector_type(2)));

#ifndef PROBE_DUP
#define PROBE_DUP -1
#endif
#ifndef MK_PER_PHASE
#define MK_PER_PHASE 0
#endif

constexpr int NB = 2, SEQ = 4096, T = NB * SEQ, DM = 4096;
constexpr int AB_COLS = 8256, AB_MAIN = 8192, AB_PAD = 8448;
constexpr int CD_COLS = 11376, CD_MAIN = 11264, CD_PAD = 11520;
constexpr float ALPHA = 1.4142135623730951f;
constexpr float LN_EPS = 1e-5f, RMS_EPS = 1e-6f;
constexpr int NPHASE = 29;

constexpr size_t MiB = 1ull << 20;
constexpr size_t WS_CTL = 0, CTL_BYTES = 1 * MiB;
constexpr size_t WS_ROPE128 = 1 * MiB;
constexpr size_t WS_ROPE64 = 3 * MiB;
constexpr size_t WS_RSQ = 4 * MiB;
constexpr size_t WS_RSKV = 4 * MiB + 65536;
constexpr size_t WS_CUM = 5 * MiB;
constexpr size_t WS_LOGF = 5 * MiB + 524288;
constexpr size_t WS_KR = 6 * MiB;
constexpr size_t WS_KI = 7 * MiB;
constexpr size_t WS_WI = 8 * MiB;
constexpr size_t WS_KVM = 9 * MiB;
constexpr size_t WS_MEMB = 11 * MiB;
constexpr size_t WS_MASK = 15 * MiB;
constexpr size_t WS_PIDX = 19 * MiB;
constexpr size_t WS_PGATE = 23 * MiB;
constexpr size_t WS_MEMQ = 27 * MiB;
constexpr size_t WS_MEMO = 35 * MiB;
constexpr size_t WS_SMALL = 43 * MiB;
constexpr size_t WS_W_AB_IN = 64 * MiB;
constexpr size_t WS_W_UQ = 130 * MiB;
constexpr size_t WS_W_UKV = 139 * MiB;
constexpr size_t WS_W_AB_OUT = 143 * MiB;
constexpr size_t WS_W_CD_IN = 175 * MiB;
constexpr size_t WS_W_CD_OUT = 265 * MiB;
constexpr size_t WS_W_MEM_Q = 297 * MiB;
constexpr size_t WS_W_MEM_KV = 305 * MiB;
constexpr size_t WS_W_MEM_O = 321 * MiB;
constexpr size_t WS_W_PEER = 329 * MiB;
constexpr size_t WS_U8 = 361 * MiB;
constexpr size_t WS_V8 = 489 * MiB;
constexpr size_t WS_USC = 48 * MiB;
constexpr size_t WS_VSC = 48 * MiB + 262144;
constexpr size_t WS_XB = 873 * MiB;
constexpr size_t WS_HF = 937 * MiB;
constexpr size_t WS_RES = 1065 * MiB;
constexpr size_t WS_PROJ = 1193 * MiB;
constexpr size_t WS_PSCORE = WS_PROJ;
constexpr size_t WS_ATT = 1369 * MiB;
constexpr size_t WS_QB = 1433 * MiB;
constexpr size_t WS_KVB = 1481 * MiB;
constexpr size_t WS_SCORE = 1433 * MiB;
constexpr size_t WS_MQP = 1561 * MiB;
constexpr size_t WS_END = 1625 * MiB;

constexpr int LDS_BYTES = 147456;
constexpr int LDS_MISC = 140 * 1024;

#define LDS_WAIT() asm volatile("s_waitcnt lgkmcnt(0)" ::: "memory")
__device__ __forceinline__ float bf2f(bf16_t b) { return __uint_as_float(((unsigned)b) << 16); }
__device__ __forceinline__ unsigned f2bf(float f) { unsigned u = __float_as_uint(f); return (u + 0x7fffu + ((u >> 16) & 1u)) >> 16; }
__device__ __forceinline__ unsigned pk2(float lo, float hi) { return f2bf(lo) | (f2bf(hi) << 16); }
__device__ __forceinline__ float wave_sum(float v) {
#pragma unroll
    for (int o = 1; o < 64; o <<= 1) v += __shfl_xor(v, o);
    return v;
}
__device__ __forceinline__ float wave_max(float v) {
#pragma unroll
    for (int o = 1; o < 64; o <<= 1) v = fmaxf(v, __shfl_xor(v, o));
    return v;
}
__device__ __forceinline__ int wave_sum_i(int v) {
#pragma unroll
    for (int o = 1; o < 64; o <<= 1) v += __shfl_xor(v, o);
    return v;
}

#define XB_TMO      128
#define XB_XCNT(j)  (256  + 64 * (j))
#define XB_XSUB(j)  (1280 + 64 * (j))
#define XB_XGEN(j)  (2304 + 64 * (j))
#define XB_TOP      3328
#define XB_TOPGEN   3392
#define XCD_BAR_WORDS 3456
#define XB_SPIN_CAP (1u << 22)

__device__ __forceinline__ unsigned xb_ld(unsigned* p)              { return __hip_atomic_load(p, __ATOMIC_RELAXED, __HIP_MEMORY_SCOPE_AGENT); }
__device__ __forceinline__ unsigned xb_add(unsigned* p, unsigned v) { return __hip_atomic_fetch_add(p, v, __ATOMIC_RELAXED, __HIP_MEMORY_SCOPE_AGENT); }
__device__ __forceinline__ unsigned xb_xcc_id() { return (unsigned)__builtin_amdgcn_s_getreg((3 << 11) | 20) & 0xFu; }
#define XB_SPIN(cond, bar) do { unsigned _sp = 0; while (cond) { __builtin_amdgcn_s_sleep(1); \
    if ((++_sp & 255u) == 0u) { if (xb_ld(&(bar)[XB_TMO])) break; if (_sp > XB_SPIN_CAP) { atomicAdd(&(bar)[XB_TMO], 1u); break; } } } } while (0)

struct XcdBarrier { unsigned* bar; unsigned x; volatile LAS unsigned* st; };

__device__ __forceinline__ XcdBarrier xcd_barrier_post(unsigned* bar, volatile LAS unsigned* st) {
    XcdBarrier b; b.bar = bar; b.x = xb_xcc_id(); b.st = st;
    if (threadIdx.x == 0) (void)xb_add(&bar[XB_XCNT(b.x)], 1u);
    return b;
}
__device__ __forceinline__ void xcd_barrier_complete(unsigned* bar, unsigned x, unsigned& nloc, unsigned& nx) {
    const unsigned G = gridDim.x * gridDim.y * gridDim.z;
    unsigned sum, cnt, mine, sp = 0u;
    for (;;) {
        sum = 0u; cnt = 0u; mine = 0u;
#pragma unroll
        for (unsigned j = 0; j < 16; ++j) { const unsigned c = xb_ld(&bar[XB_XCNT(j)]); sum += c; cnt += (c > 0u) ? 1u : 0u; mine = (j == x) ? c : mine; }
        if (sum == G) break;
        __builtin_amdgcn_s_sleep(1);
        if ((++sp & 255u) == 0u) { if (xb_ld(&bar[XB_TMO])) break; if (sp > XB_SPIN_CAP) { atomicAdd(&bar[XB_TMO], 1u); break; } }
    }
    nloc = mine > 0u ? mine : 1u; nx = cnt > 0u ? cnt : 1u;
}
__device__ __forceinline__ void xcd_barrier(const XcdBarrier& b) {
    asm volatile("s_waitcnt vmcnt(0)" ::: "memory");
    __syncthreads();
    if (threadIdx.x == 0) {
        unsigned* bar = b.bar;
        __builtin_amdgcn_s_waitcnt(0);
        unsigned nloc = b.st[0], nx = b.st[1];
        if (nloc == 0u) { xcd_barrier_complete(bar, b.x, nloc, nx); b.st[0] = nloc; b.st[1] = nx; }
        const unsigned old = xb_add(&bar[XB_XSUB(b.x)], 1u);
        const unsigned gen = old / nloc;
        if (old + 1u == (gen + 1u) * nloc) {
            __builtin_amdgcn_fence(__ATOMIC_RELEASE, "agent");
            asm volatile("s_waitcnt vmcnt(0)" ::: "memory");
            const unsigned og = xb_add(&bar[XB_TOP], 1u);
            const unsigned tg = og / nx;
            if (og + 1u == (tg + 1u) * nx) xb_add(&bar[XB_TOPGEN], 1u);
            else XB_SPIN(xb_ld(&bar[XB_TOPGEN]) == tg, bar);
            __builtin_amdgcn_fence(__ATOMIC_ACQUIRE, "agent");
            xb_add(&bar[XB_XGEN(b.x)], 1u);
            asm volatile("s_waitcnt vmcnt(0)" ::: "memory");
        } else {
            XB_SPIN(xb_ld(&bar[XB_XGEN(b.x)]) == gen, bar);
            __builtin_amdgcn_fence(__ATOMIC_ACQUIRE, "agent");
            asm volatile("s_waitcnt vmcnt(0)" ::: "memory");
        }
    }
    __syncthreads();
}

namespace pg8 {
constexpr int BM = 256, BK = 64, HALF = 128, HTB = HALF * BK * 2, STAGE_BYTES = 8 * HTB, NXCD = 8, WGM = 8;
__host__ __device__ __forceinline__ int lds_byte(int r, int c) { const int st = (r >> 4) * 2 + (c >> 5), rr = r & 15, cc = c & 31, ob = rr * 64 + cc * 2; return st * 1024 + (ob ^ (((ob >> 9) & 1) << 5)); }
__host__ __device__ __forceinline__ void stage_rc(int b, int& R, int& C) { const int st = b / 1024, sb = b % 1024, swz = sb ^ (((sb >> 9) & 1) << 5); R = (st >> 1) * 16 + swz / 64; C = (st & 1) * 32 + (swz % 64) / 2; }
__host__ __device__ __forceinline__ int perm32(int rho) { const int n = rho >> 4, i = rho & 15; return 8 * (i >> 2) + 4 * n + (i & 3); }
struct Unit { int pm, pn, z; };
struct Gemm { const bf16_t* A; const bf16_t* Bt; int M, N, K, lda, ldb; long zA, zB; int nz; };
struct StaticOrder {
    int nM, nN, nZ, nwg, G, c;
    __device__ void init(int M, int N, int Z, int G_, int c_) { nM = M / BM; nN = N / BM; nZ = Z; nwg = nM * nN * nZ; G = G_; c = c_; }
    __device__ bool next(int i, Unit& u) const {
        const long L = (long)i * G + c; if (L >= nwg) return false;
        int wgid = (int)L; { const int q = nwg / NXCD, r = nwg % NXCD, xcd = wgid % NXCD, off = wgid / NXCD; wgid = (xcd < r ? xcd * (q + 1) : r * (q + 1) + (xcd - r) * q) + off; }
        const int per = nM * nN; u.z = wgid / per; wgid -= u.z * per;
        const int nig = WGM * nN, gid = wgid / nig, fm = gid * WGM, gsz = (nM - fm) < WGM ? (nM - fm) : WGM;
        u.pm = fm + ((wgid % nig) % gsz); u.pn = (wgid % nig) / gsz; return true;
    }
};
__device__ __forceinline__ unsigned cvt_pk_bf16(float lo, float hi) { unsigned r; asm volatile("v_cvt_pk_bf16_f32 %0, %1, %2" : "=v"(r) : "v"(lo), "v"(hi)); return r; }
struct EpiF32 {
    static constexpr bool PERM = false;
    float* C; int ldc; long zC;
    __device__ __forceinline__ void operator()(const f32x4 (&acc)[2][2][4][2], const Unit& u, int wr, int wc, int fr, int fq) const {
        const int row0 = u.pm * BM + wr * 64 + fr, col0 = u.pn * BM + wc * 32 + 4 * fq; float* Cz = C + (size_t)u.z * zC;
#pragma unroll
        for (int ai = 0; ai < 2; ++ai)
#pragma unroll
            for (int m = 0; m < 4; ++m) { float* rowp = Cz + (size_t)(row0 + ai * HALF + m * 16) * ldc + col0;
#pragma unroll
                for (int bj = 0; bj < 2; ++bj)
#pragma unroll
                    for (int n = 0; n < 2; ++n) *(f32x4*)(rowp + bj * HALF + n * 16) = acc[ai][bj][m][n]; }
    }
};
struct EpiResid {
    static constexpr bool PERM = false;
    const float* base; float* out; int ldc;
    __device__ __forceinline__ void operator()(const f32x4 (&acc)[2][2][4][2], const Unit& u, int wr, int wc, int fr, int fq) const {
        const int row0 = u.pm * BM + wr * 64 + fr, col0 = u.pn * BM + wc * 32 + 4 * fq;
#pragma unroll
        for (int ai = 0; ai < 2; ++ai)
#pragma unroll
            for (int m = 0; m < 4; ++m) { const size_t off = (size_t)(row0 + ai * HALF + m * 16) * ldc + col0;
#pragma unroll
                for (int bj = 0; bj < 2; ++bj)
#pragma unroll
                    for (int n = 0; n < 2; ++n) { const f32x4 bs = *(const f32x4*)(base + off + bj * HALF + n * 16); *(f32x4*)(out + off + bj * HALF + n * 16) = bs * ALPHA + acc[ai][bj][m][n]; }
                asm volatile("" ::: "memory"); }
    }
};
struct EpiBf16 {
    static constexpr bool PERM = true;
    bf16_t* O; int ldc; const float* rs;
    __device__ __forceinline__ void operator()(const f32x4 (&acc)[2][2][4][2], const Unit& u, int wr, int wc, int fr, int fq) const {
        const int row0 = u.pm * BM + wr * 64 + fr, col0 = u.pn * BM + wc * 32 + 8 * fq;
#pragma unroll
        for (int ai = 0; ai < 2; ++ai)
#pragma unroll
            for (int m = 0; m < 4; ++m) { const int row = row0 + ai * HALF + m * 16; bf16_t* rowp = O + (size_t)row * ldc + col0; const float sc = rs ? rs[row] : 1.f;
#pragma unroll
                for (int bj = 0; bj < 2; ++bj) { const f32x4 v0 = acc[ai][bj][m][0] * sc, v1 = acc[ai][bj][m][1] * sc;
                    u32x4 wv; wv.x = cvt_pk_bf16(v0[0], v0[1]); wv.y = cvt_pk_bf16(v0[2], v0[3]); wv.z = cvt_pk_bf16(v1[0], v1[1]); wv.w = cvt_pk_bf16(v1[2], v1[3]);
                    *(u32x4*)(rowp + bj * HALF) = wv; } }
    }
};
template <class Epi, class Sched>
__device__ __forceinline__ void gemm_phase(LAS unsigned char* lds, const Gemm g, const Sched& S, const Epi& E) {
    const int tid = threadIdx.x, wid = __builtin_amdgcn_readfirstlane(tid >> 6), lane = tid & 63, wr = wid >> 2, wc = wid & 3, fr = lane & 15, fq = lane >> 4;
    const int K = g.K, nt = K / BK;
    unsigned voffA[2], voffB[2];
#pragma unroll
    for (int i = 0; i < 2; ++i) { int R, C; stage_rc(tid * 16 + i * 8192, R, C); const int Rb = Epi::PERM ? ((R & ~31) + perm32(R & 31)) : R;
        voffA[i] = (unsigned)(R * g.lda + C) * 2u; voffB[i] = (unsigned)(Rb * g.ldb + C) * 2u; }
    const size_t kstep = (size_t)(BK * 2);
    const size_t hA = (size_t)HALF * g.lda * 2, hB = (size_t)HALF * g.ldb * 2;
    const size_t tA = 2 * hA, tB = 2 * hB;
    const unsigned ldsw = (unsigned)wid * 1024u;
    const int aoff = lds_byte(wr * 64 + fr, fq * 8), boff = lds_byte(wc * 32 + fr, fq * 8);
#define PG8_SA(b, h) (((b) * 2 + (h)) * HTB)
#define PG8_SB(b, h) ((4 + (b) * 2 + (h)) * HTB)
#define PG8_STAGE(bufoff, gbase, voff) do { _Pragma("unroll") for (int _i = 0; _i < 2; ++_i) \
        __builtin_amdgcn_global_load_lds((const unsigned*)((const char*)(gbase) + (voff)[_i]), (LAS unsigned*)(lds + (bufoff) + ldsw + _i * 8192), 16, 0, 0); } while (0)
#define PG8_LDA(dst, b, h) do { _Pragma("unroll") for (int m = 0; m < 4; ++m) _Pragma("unroll") for (int k = 0; k < 2; ++k) dst[m][k] = *(const LAS bf16x8*)(lds + PG8_SA(b, h) + aoff + m * 2048 + k * 1024); } while (0)
#define PG8_LDB(dst, b, h) do { _Pragma("unroll") for (int n = 0; n < 2; ++n) _Pragma("unroll") for (int k = 0; k < 2; ++k) dst[n][k] = *(const LAS bf16x8*)(lds + PG8_SB(b, h) + boff + n * 2048 + k * 1024); } while (0)
#define PG8_MMA(ai, bj, At, Bt) do { __builtin_amdgcn_s_setprio(1); _Pragma("unroll") for (int m = 0; m < 4; ++m) _Pragma("unroll") for (int n = 0; n < 2; ++n) _Pragma("unroll") for (int k = 0; k < 2; ++k) \
        acc[ai][bj][m][n] = __builtin_amdgcn_mfma_f32_16x16x32_bf16(Bt[n][k], At[m][k], acc[ai][bj][m][n], 0, 0, 0); __builtin_amdgcn_s_setprio(0); } while (0)
#define PG8_WAIT_V(n) asm volatile("s_waitcnt vmcnt(" #n ")" ::: "memory")
#define PG8_WAIT_L(n) asm volatile("s_waitcnt lgkmcnt(" #n ")" ::: "memory")
#define PG8_BAR __builtin_amdgcn_s_barrier()
#define PG8_SCHED __builtin_amdgcn_sched_barrier(0)
    Unit cur, nxt; int ui = 0;
    if (!S.next(0, cur)) return;
    f32x4 acc[2][2][4][2];
#pragma unroll
    for (int a = 0; a < 2; ++a)
#pragma unroll
        for (int b = 0; b < 2; ++b)
#pragma unroll
            for (int m = 0; m < 4; ++m)
#pragma unroll
                for (int n = 0; n < 2; ++n) acc[a][b][m][n] = (f32x4){0.f, 0.f, 0.f, 0.f};
    bf16x8 At[4][2], B0[2][2], B1[2][2];
    const char* cA = (const char*)g.A + (size_t)cur.pm * tA + (size_t)cur.z * g.zA * 2; const char* cB = (const char*)g.Bt + (size_t)cur.pn * tB + (size_t)cur.z * g.zB * 2;
    PG8_STAGE(PG8_SB(0, 0), cB, voffB); PG8_STAGE(PG8_SA(0, 0), cA, voffA); PG8_STAGE(PG8_SB(0, 1), cB + hB, voffB); PG8_STAGE(PG8_SA(0, 1), cA + hA, voffA);
    if (wr == 1) PG8_BAR;
    PG8_WAIT_V(4); PG8_BAR;
    PG8_STAGE(PG8_SB(1, 0), cB + kstep, voffB); PG8_STAGE(PG8_SA(1, 0), cA + kstep, voffA); PG8_STAGE(PG8_SB(1, 1), cB + hB + kstep, voffB);
    PG8_WAIT_V(6); PG8_BAR;
    for (;;) {
        const bool has_next = S.next(ui + 1, nxt);
        const char* nA = has_next ? (const char*)g.A + (size_t)nxt.pm * tA + (size_t)nxt.z * g.zA * 2 : cA; const char* nB = has_next ? (const char*)g.Bt + (size_t)nxt.pn * tB + (size_t)nxt.z * g.zB * 2 : cB;
        for (int t = 0; t < nt; t += 2) {
            const bool last = (t == nt - 2);
            const char* a1 = cA + (size_t)(t + 1) * kstep;
            const char* a2 = last ? nA : cA + (size_t)(t + 2) * kstep; const char* b2 = last ? nB : cB + (size_t)(t + 2) * kstep;
            const char* a3 = a2 + kstep; const char* b3 = b2 + kstep;
            PG8_LDB(B0, 0, 0); PG8_SCHED; PG8_LDA(At, 0, 0); PG8_STAGE(PG8_SA(1, 1), a1 + hA, voffA);
            PG8_WAIT_L(8); PG8_BAR; PG8_WAIT_L(0); PG8_MMA(0, 0, At, B0); PG8_BAR; PG8_SCHED;
            PG8_LDB(B1, 0, 1); PG8_STAGE(PG8_SB(0, 0), b2, voffB);
            PG8_BAR; PG8_WAIT_L(0); PG8_MMA(0, 1, At, B1); PG8_BAR;
            PG8_LDA(At, 0, 1); PG8_STAGE(PG8_SA(0, 0), a2, voffA);
            PG8_BAR; PG8_WAIT_L(0); PG8_MMA(1, 0, At, B0); PG8_BAR; PG8_SCHED;
            PG8_STAGE(PG8_SB(0, 1), b2 + hB, voffB);
            PG8_WAIT_V(6); PG8_BAR; PG8_MMA(1, 1, At, B1); PG8_BAR;
            PG8_LDB(B0, 1, 0); PG8_SCHED; PG8_LDA(At, 1, 0); PG8_STAGE(PG8_SA(0, 1), a2 + hA, voffA);
            PG8_WAIT_L(8); PG8_BAR; PG8_WAIT_L(0); PG8_MMA(0, 0, At, B0); PG8_BAR; PG8_SCHED;
            PG8_LDB(B1, 1, 1); PG8_STAGE(PG8_SB(1, 0), b3, voffB);
            PG8_BAR; PG8_WAIT_L(0); PG8_MMA(0, 1, At, B1); PG8_BAR;
            PG8_LDA(At, 1, 1); PG8_STAGE(PG8_SA(1, 0), a3, voffA);
            PG8_BAR; PG8_WAIT_L(0); PG8_MMA(1, 0, At, B0); PG8_BAR; PG8_SCHED;
            PG8_STAGE(PG8_SB(1, 1), b3 + hB, voffB);
            PG8_WAIT_V(6); PG8_BAR; PG8_MMA(1, 1, At, B1); PG8_BAR;
        }
        E(acc, cur, wr, wc, fr, fq);
        if (!has_next) break;
#pragma unroll
        for (int a = 0; a < 2; ++a)
#pragma unroll
            for (int b = 0; b < 2; ++b)
#pragma unroll
                for (int m = 0; m < 4; ++m)
#pragma unroll
                    for (int n = 0; n < 2; ++n) acc[a][b][m][n] = (f32x4){0.f, 0.f, 0.f, 0.f};
        cur = nxt; cA = nA; cB = nB; ++ui;
    }
    PG8_WAIT_V(0);
    if (wr == 0) PG8_BAR;
    PG8_BAR;
#undef PG8_SA
#undef PG8_SB
#undef PG8_STAGE
#undef PG8_LDA
#undef PG8_LDB
#undef PG8_MMA
#undef PG8_WAIT_V
#undef PG8_WAIT_L
#undef PG8_BAR
#undef PG8_SCHED
}
}

struct Args { const float* in[21]; float* out; unsigned char* ws; int ph_lo, ph_hi; };
enum { I_X = 0, I_MEM, I_AB_W_IN, I_A_REL_BIAS, I_B_Q_NORM, I_B_W_UQ, I_B_KV_NORM, I_B_W_UKV, I_AB_W_OUT, I_CD_W_IN, I_D_FORGET_BIAS, I_CD_W_OUT,
       I_MEM_W_Q, I_MEM_W_KV, I_MEM_W_O, I_PEER_W_Q, I_PEER_SUB_KEYS, I_PEER_U, I_PEER_V, I_LN_G, I_LN_B };

struct WI { int tid, lane, wave, gw, ngw, bid, nblk; };

__device__ __forceinline__ void tr_item(const float* W, int K, int ld, int c0, int nc, bf16_t* WT, int r0, const float* scale, LAS float* scr, int item, int lane) {
    const int nblk = (nc + 31) >> 5, kb = item / nblk, nb = item - kb * nblk, k0 = 64 * kb, n0 = 32 * nb;
    const int nn = n0 + (lane & 31); const bool ok = nn < nc;
#pragma unroll 8
    for (int i = 0; i < 32; ++i) { const int kk = 2 * i + (lane >> 5); float v = ok ? W[(size_t)(k0 + kk) * ld + c0 + nn] : 0.f; if (scale) v *= scale[k0 + kk]; scr[kk * 33 + (lane & 31)] = v; }
    LDS_WAIT();
    const int c = lane & 7;
#pragma unroll
    for (int j = 0; j < 4; ++j) { const int n = (lane >> 3) + 8 * j; const LAS float* s = scr + (8 * c) * 33 + n;
        u32x4 o; o.x = pk2(s[0 * 33], s[1 * 33]); o.y = pk2(s[2 * 33], s[3 * 33]); o.z = pk2(s[4 * 33], s[5 * 33]); o.w = pk2(s[6 * 33], s[7 * 33]);
        if (n0 + n < nc) *(u32x4*)(WT + (size_t)(r0 + n0 + n) * K + k0 + 8 * c) = o; }
    LDS_WAIT();
}
__device__ __forceinline__ void cvt_rows(const float* src, bf16_t* dst, size_t n, size_t i0, size_t stride) {
    for (size_t i = i0 * 8; i < n; i += stride * 8) {
        const f32x4 a = *(const f32x4*)(src + i), b = *(const f32x4*)(src + i + 4);
        u32x4 o; o.x = pk2(a.x, a.y); o.y = pk2(a.z, a.w); o.z = pk2(b.x, b.y); o.w = pk2(b.z, b.w);
        *(u32x4*)(dst + i) = o;
    }
}
__device__ __forceinline__ void ph_convert(const Args& a, LAS unsigned char* lds, const WI& w) {
    unsigned char* ws = a.ws;
    LAS float* scr = (LAS float*)(lds + w.wave * 16384);
    constexpr int J1 = 64 * 258, J2 = 24 * 96, J3 = 8 * 128, J4 = 64 * 128, J5 = 64 * 160, J6 = 64 * 192, J7 = 64 * 3, J8 = 64 * 1, J9 = 64 * 128,
                  J10 = 64 * 16, J12 = 64 * 32, J14 = 8 * 128;
    constexpr int NJ = J1 + J2 + J3 + J4 + J5 + J6 + J7 + J8 + J9 + 2 * J10 + 2 * J12 + 2 * J14;
    for (int it = w.gw; it < NJ; it += w.ngw) {
        int r = it; const float* src; int K, ld, c0 = 0, nc, r0 = 0; bf16_t* dst; const float* sc = nullptr;
        if (r < J1) { src = a.in[I_AB_W_IN]; K = 4096; ld = AB_COLS; nc = AB_COLS; dst = (bf16_t*)(ws + WS_W_AB_IN); }
        else if ((r -= J1) < J2) { src = a.in[I_B_W_UQ]; K = 1536; ld = 3072; nc = 3072; dst = (bf16_t*)(ws + WS_W_UQ); sc = a.in[I_B_Q_NORM]; }
        else if ((r -= J2) < J3) { src = a.in[I_B_W_UKV]; K = 512; ld = 4096; nc = 4096; dst = (bf16_t*)(ws + WS_W_UKV); sc = a.in[I_B_KV_NORM]; }
        else if ((r -= J3) < J4) { src = a.in[I_AB_W_OUT]; K = 4096; ld = 4096; nc = 4096; dst = (bf16_t*)(ws + WS_W_AB_OUT); }
        else if ((r -= J4) < J5) { src = a.in[I_CD_W_IN]; K = 4096; ld = CD_COLS; c0 = 0; nc = 5120; r0 = 0; dst = (bf16_t*)(ws + WS_W_CD_IN); }
        else if ((r -= J5) < J6) { src = a.in[I_CD_W_IN]; K = 4096; ld = CD_COLS; c0 = 5216; nc = 6144; r0 = 5120; dst = (bf16_t*)(ws + WS_W_CD_IN); }
        else if ((r -= J6) < J7) { src = a.in[I_CD_W_IN]; K = 4096; ld = CD_COLS; c0 = 5120; nc = 96; r0 = 11264; dst = (bf16_t*)(ws + WS_W_CD_IN); }
        else if ((r -= J7) < J8) { src = a.in[I_CD_W_IN]; K = 4096; ld = CD_COLS; c0 = 11360; nc = 16; r0 = 11360; dst = (bf16_t*)(ws + WS_W_CD_IN); }
        else if ((r -= J8) < J9) { src = a.in[I_CD_W_OUT]; K = 4096; ld = 4096; nc = 4096; dst = (bf16_t*)(ws + WS_W_CD_OUT); }
        else if ((r -= J9) < 2 * J10) { const int l = r / J10; r -= l * J10; src = a.in[I_MEM_W_Q] + (size_t)l * 4096 * 512; K = 4096; ld = 512; nc = 512; dst = (bf16_t*)(ws + WS_W_MEM_Q) + (size_t)l * 512 * 4096; }
        else if ((r -= 2 * J10) < 2 * J12) { const int l = r / J12; r -= l * J12; src = a.in[I_MEM_W_KV] + (size_t)l * 4096 * 1024; K = 4096; ld = 1024; nc = 1024; dst = (bf16_t*)(ws + WS_W_MEM_KV) + (size_t)l * 1024 * 4096; }
        else { r -= 2 * J12; const int l = r / J14; r -= l * J14; src = a.in[I_MEM_W_O] + (size_t)l * 512 * 4096; K = 512; ld = 4096; nc = 4096; dst = (bf16_t*)(ws + WS_W_MEM_O) + (size_t)l * 4096 * 512; }
        tr_item(src, K, ld, c0, nc, dst, r0, sc, scr, r, w.lane);
    }
    { const size_t gt = (size_t)w.gw * 64 + w.lane, ng = (size_t)w.ngw * 64;
      bf16_t* p1 = (bf16_t*)(ws + WS_W_AB_IN) + (size_t)AB_COLS * 4096; const size_t n1 = (size_t)(AB_PAD - AB_COLS) * 4096;
      for (size_t i = gt * 8; i < n1; i += ng * 8) *(u32x4*)(p1 + i) = (u32x4){0u, 0u, 0u, 0u};
      bf16_t* p2 = (bf16_t*)(ws + WS_W_CD_IN) + (size_t)CD_COLS * 4096; const size_t n2 = (size_t)(CD_PAD - CD_COLS) * 4096;
      for (size_t i = gt * 8; i < n2; i += ng * 8) *(u32x4*)(p2 + i) = (u32x4){0u, 0u, 0u, 0u};
      cvt_rows(a.in[I_X], (bf16_t*)(ws + WS_XB), (size_t)T * DM, gt, ng);
      cvt_rows(a.in[I_MEM], (bf16_t*)(ws + WS_MEMB), (size_t)512 * DM, gt, ng);
      for (int r = w.gw; r < 65536; r += w.ngw) { const int tbl = r >> 15, rr = r & 32767;
          const float* srow = (tbl ? a.in[I_PEER_V] : a.in[I_PEER_U]) + (size_t)rr * DM;
          f32x4 v[16]; float amax = 0.f;
#pragma unroll
          for (int j = 0; j < 16; ++j) { v[j] = *(const f32x4*)(srow + 4 * w.lane + 256 * j); amax = fmaxf(amax, fmaxf(fmaxf(fabsf(v[j].x), fabsf(v[j].y)), fmaxf(fabsf(v[j].z), fabsf(v[j].w)))); }
          amax = wave_max(amax); const float s = amax > 0.f ? 256.f / amax : 1.f;
          unsigned* drow = (unsigned*)(ws + (tbl ? WS_V8 : WS_U8) + (size_t)rr * DM);
#pragma unroll
          for (int j = 0; j < 16; ++j) { int wv = 0; wv = __builtin_amdgcn_cvt_pk_fp8_f32(v[j].x * s, v[j].y * s, wv, false); wv = __builtin_amdgcn_cvt_pk_fp8_f32(v[j].z * s, v[j].w * s, wv, true); drow[64 * j + w.lane] = (unsigned)wv; }
          if (w.lane == 0) ((float*)(ws + (tbl ? WS_VSC : WS_USC)))[rr] = amax > 0.f ? amax * (1.f / 256.f) : 1.f; }
      float* r128 = (float*)(ws + WS_ROPE128); float* r64 = (float*)(ws + WS_ROPE64);
      for (size_t i = gt; i < (size_t)SEQ * 96; i += ng) {
          const int s = (int)(i / 96), j = (int)(i % 96); const bool big = j < 64; const int ii = big ? j : j - 64;
          const double rr = big ? 0.8659643233600653 : 0.7498942093324559; double inv = 1.0;
          for (int q = 0; q < ii; ++q) inv *= rr;
          const double rev = (double)s * inv * 0.15915494309189535; const float fr = (float)(rev - rint(rev));
          const float cs = __builtin_amdgcn_cosf(fr), sn = __builtin_amdgcn_sinf(fr);
          float* o = big ? (r128 + ((size_t)s * 64 + ii) * 2) : (r64 + ((size_t)s * 32 + ii) * 2);
          o[0] = cs; o[1] = sn; }
    }
    {
        LAS float* Ks = (LAS float*)lds; LAS float* Ws = Ks + 128 * 129;
        const int tk = w.tid & 31, tn = w.tid >> 5;
        for (int it = w.bid; it < 2 * 16 * 32; it += w.nblk) {
            const int l = it >> 9, hp = (it >> 5) & 15, kb = it & 31;
            __syncthreads();
            const float* keys = a.in[I_PEER_SUB_KEYS] + ((size_t)(l * 16 + hp) * 128) * 128;
            const float* wq = a.in[I_PEER_W_Q] + ((size_t)l * 4096 + (size_t)kb * 128) * 2048 + hp * 128;
            for (int e = w.tid; e < 128 * 128; e += 512) { const int rrow = e >> 7, d = e & 127; Ks[rrow * 129 + d] = keys[(size_t)rrow * 128 + d]; Ws[rrow * 129 + d] = wq[(size_t)rrow * 2048 + d]; }
            __syncthreads();
            float acc[8][4];
#pragma unroll
            for (int x = 0; x < 8; ++x)
#pragma unroll
                for (int y = 0; y < 4; ++y) acc[x][y] = 0.f;
            for (int d = 0; d < 128; ++d) {
                float kv[8], wv[4];
#pragma unroll
                for (int x = 0; x < 8; ++x) kv[x] = Ks[(tn + 16 * x) * 129 + d];
#pragma unroll
                for (int y = 0; y < 4; ++y) wv[y] = Ws[(tk + 32 * y) * 129 + d];
#pragma unroll
                for (int x = 0; x < 8; ++x)
#pragma unroll
                    for (int y = 0; y < 4; ++y) acc[x][y] += kv[x] * wv[y];
            }
            bf16_t* dst = (bf16_t*)(ws + WS_W_PEER) + ((size_t)l * 2048 + hp * 128) * 4096 + kb * 128;
#pragma unroll
            for (int x = 0; x < 8; ++x)
#pragma unroll
                for (int y = 0; y < 4; ++y) dst[(size_t)(tn + 16 * x) * 4096 + tk + 32 * y] = (bf16_t)f2bf(acc[x][y]);
        }
        __syncthreads();
    }
}

__device__ __forceinline__ int crow(int r, int hi) { return (r & 3) + 8 * (r >> 2) + 4 * hi; }
template <class F>
__device__ __forceinline__ void naive_gemm(const bf16_t* A, int lda, const bf16_t* Bt, int ldb, int M, int N, int K, const WI& w, F epi) {
    const int tm = M >> 5, tn = (N + 31) >> 5;
    const int i = w.lane & 31, g = w.lane >> 5;
    for (int tile = w.gw; tile < tm * tn; tile += w.ngw) {
        const int bn = tile / tm, bm = tile - bn * tm;
        const bf16_t* ap = A + (size_t)(bm * 32 + i) * lda + 8 * g;
        const int nrow = bn * 32 + i; const bool nv = nrow < N;
        const bf16_t* bp = Bt + (size_t)(nv ? nrow : 0) * ldb + 8 * g;
        f32x16 acc = {};
#pragma unroll 4
        for (int k = 0; k < K; k += 16) {
            const bf16x8 av = *(const bf16x8*)(ap + k);
            bf16x8 bv = *(const bf16x8*)(bp + k);
            if (!nv) bv = (bf16x8){0, 0, 0, 0, 0, 0, 0, 0};
            acc = __builtin_amdgcn_mfma_f32_32x32x16_bf16(av, bv, acc, 0, 0, 0);
        }
#pragma unroll
        for (int r = 0; r < 16; ++r) { const int row = bm * 32 + crow(r, g), col = bn * 32 + i; if (col < N) epi(row, col, acc[r]); }
    }
}

__device__ __forceinline__ void ln_rows(const float* src, const float* g, const float* b, float* dstf, bf16_t* dstb, const WI& w) {
    for (int m = w.gw; m < T; m += w.ngw) {
        const f32x4* xr = (const f32x4*)(src + (size_t)m * DM) + w.lane;
        f32x4 v[16]; float s = 0.f;
#pragma unroll
        for (int j = 0; j < 16; ++j) { v[j] = xr[64 * j]; s += (v[j].x + v[j].y) + (v[j].z + v[j].w); }
        const float mean = wave_sum(s) * (1.f / DM); float s2 = 0.f;
#pragma unroll
        for (int j = 0; j < 16; ++j) { v[j] = v[j] - mean; s2 += (v[j].x * v[j].x + v[j].y * v[j].y) + (v[j].z * v[j].z + v[j].w * v[j].w); }
        const float rstd = 1.f / sqrtf(wave_sum(s2) * (1.f / DM) + LN_EPS);
#pragma unroll
        for (int j = 0; j < 16; ++j) {
            const int c = 4 * w.lane + 256 * j;
            const f32x4 gg = *(const f32x4*)(g + c), bb = *(const f32x4*)(b + c);
            const f32x4 o = v[j] * rstd * gg + bb;
            *(f32x4*)(dstf + (size_t)m * DM + c) = o;
            if (dstb) { u32x2 p; p.x = pk2(o.x, o.y); p.y = pk2(o.z, o.w); *(u32x2*)(dstb + (size_t)m * DM + c) = p; }
        }
    }
}

template <int MODE>
__device__ __forceinline__ void attn_naive(const Args& a, int layer, LAS float* qs, const WI& w) {
    constexpr int H = (MODE == 4) ? 4 : 16, DK = (MODE == 1) ? 192 : 128;
    const float scale = (MODE == 1) ? 0.07216878364870322f : 0.08838834764831845f;
    unsigned char* ws = a.ws;
    const float NEG = -__builtin_inff();
    for (int it = w.gw; it < T * H; it += w.ngw) {
        const int h = it / T, t = it - h * T, b = t / SEQ, sp = t - b * SEQ, c = sp >> 6;
        const bf16_t* qp; const bf16_t* kbase; const bf16_t* vbase; int ldk, ldv; bf16_t* op;
        int s_lo = 0, s_hi;
        if (MODE == 0) { const bf16_t* P = (const bf16_t*)(ws + WS_PROJ); qp = P + (size_t)t * AB_MAIN + h * 128; kbase = P + (size_t)b * SEQ * AB_MAIN + 2048 + h * 128; vbase = kbase + 2048; ldk = ldv = AB_MAIN;
            op = (bf16_t*)(ws + WS_ATT) + (size_t)t * DM + h * 128; s_lo = (c - 8) * 64; if (s_lo < 0) s_lo = 0; s_hi = (c + 1) * 64; }
        else if (MODE == 1) { qp = (const bf16_t*)(ws + WS_QB) + (size_t)t * 3072 + h * 192; kbase = (const bf16_t*)(ws + WS_KVB) + (size_t)b * SEQ * 4096 + h * 256; vbase = kbase + 128; ldk = ldv = 4096;
            op = (bf16_t*)(ws + WS_ATT) + (size_t)t * DM + 2048 + h * 128; s_hi = (c + 1) * 64; }
        else if (MODE == 2) { const bf16_t* P = (const bf16_t*)(ws + WS_PROJ); qp = P + (size_t)t * CD_MAIN + h * 128; kbase = P + (size_t)b * SEQ * CD_MAIN + 2048 + (h >> 2) * 128; vbase = kbase + 512; ldk = ldv = CD_MAIN;
            op = (bf16_t*)(ws + WS_ATT) + (size_t)t * DM + h * 128; s_hi = (c + 1) * 64; }
        else if (MODE == 3) { const bf16_t* P = (const bf16_t*)(ws + WS_PROJ); qp = P + (size_t)t * CD_MAIN + 5120 + h * 128; kbase = P + (size_t)b * SEQ * CD_MAIN + 7168 + h * 128; vbase = kbase + 2048; ldk = ldv = CD_MAIN;
            op = (bf16_t*)(ws + WS_ATT) + (size_t)t * DM + 2048 + h * 128; s_hi = sp + 1; }
        else { qp = (const bf16_t*)(ws + WS_MEMQ) + (size_t)t * 512 + h * 128; kbase = (const bf16_t*)(ws + WS_KVM) + ((size_t)layer * 512 + b * 256) * 1024 + h * 128; vbase = kbase + 512; ldk = ldv = 1024;
            op = (bf16_t*)(ws + WS_MEMO) + (size_t)t * 512 + h * 128; s_hi = 256; }
        LDS_WAIT();
        if (MODE == 4) { const float* mq = (const float*)(ws + WS_MQP) + (size_t)t * 512 + h * 128;
            for (int d = w.lane; d < DK; d += 64) qs[d] = bf2f((bf16_t)f2bf((mq[d] + mq[d + (size_t)T * 512]) + (mq[d + (size_t)2 * T * 512] + mq[d + (size_t)3 * T * 512]))); }
        else for (int d = w.lane; d < DK; d += 64) qs[d] = bf2f(qp[d]);
        LDS_WAIT();
        const float* cum = (const float*)(ws + WS_CUM) + ((size_t)b * 16 + h) * SEQ;
        const float ct = (MODE == 3) ? cum[sp] : 0.f;
        const float* relb = a.in[I_A_REL_BIAS] + h * 513;
        const unsigned* mrow = (const unsigned*)(ws + WS_MASK) + (size_t)t * 128;
        float m = NEG, l = 0.f, o0 = 0.f, o1 = 0.f;
        for (int s0 = s_lo; s0 < s_hi; s0 += 64) {
            const int s = s0 + w.lane; bool valid = s < s_hi;
            if (MODE == 2) { if (valid) valid = (mrow[s >> 5] >> (s & 31)) & 1u; }
            float x = NEG;
            if (valid) {
                const bf16_t* kp = kbase + (size_t)s * ldk; float acc = 0.f;
#pragma unroll 4
                for (int d0 = 0; d0 < 128; d0 += 8) { const bf16x8 kv = *(const bf16x8*)(kp + d0);
#pragma unroll
                    for (int e = 0; e < 8; ++e) acc += qs[d0 + e] * bf2f((bf16_t)kv[e]); }
                if (MODE == 1) { const bf16_t* kr = (const bf16_t*)(ws + WS_KR) + ((size_t)b * SEQ + s) * 64;
#pragma unroll 4
                    for (int d0 = 0; d0 < 64; d0 += 8) { const bf16x8 kv = *(const bf16x8*)(kr + d0);
#pragma unroll
                        for (int e = 0; e < 8; ++e) acc += qs[128 + d0 + e] * bf2f((bf16_t)kv[e]); } }
                x = acc * scale;
                if (MODE == 0) { int rel = sp - s; rel = rel < -256 ? -256 : (rel > 256 ? 256 : rel); x += relb[rel + 256]; }
                if (MODE == 3) x += ct - cum[s];
            }
            const float mx = wave_max(x);
            if (mx == NEG) continue;
            const float mn = fmaxf(m, mx); const float p = valid ? __expf(x - mn) : 0.f; const float al = __expf(m - mn);
            l = l * al + wave_sum(p); o0 *= al; o1 *= al; m = mn;
            for (int j = 0; j < 64; ++j) { const float pj = __shfl(p, j);
                if (pj != 0.f) { const bf16_t* vp = vbase + (size_t)(s0 + j) * ldv; o0 += pj * bf2f(vp[w.lane]); o1 += pj * bf2f(vp[w.lane + 64]); } }
        }
        const float rl = 1.f / l;
        op[w.lane] = (bf16_t)f2bf(o0 * rl); op[w.lane + 64] = (bf16_t)f2bf(o1 * rl);
    }
}

namespace fa {
constexpr int SHM_V = 64 * 128 * 2;
constexpr int LDS_V = 0, LDS_K = 2 * SHM_V, LDS_WS = LDS_K + 2 * 64 * 384, LDS_RELB = LDS_WS + 8 * 64 * 4, LDS_CS = LDS_RELB + 2304, LDS_END = LDS_CS + 512;
#define FA_KSWZ(row, colB, RS) ((row) * (RS) + ((colB) ^ (((row) & 7) << 4)))
__device__ __forceinline__ int v_st(int k, int c) { const int kk = (k & ~0xC) | ((k & 4) << 1) | ((k & 8) >> 1); return ((kk >> 3) * 4 + (c >> 5)) * 512 + ((kk & 7) * 32 + (c & 31)) * 2; }
__device__ __forceinline__ int v_rd_base(int lane) { return ((lane & 3) << 3) | (((lane >> 2) & 3) << 6) | (((lane >> 4) & 1) << 5) | (((lane >> 5) & 1) << 8); }
__device__ __forceinline__ unsigned cvtpk(float lo, float hi) { unsigned r; asm volatile("v_cvt_pk_bf16_f32 %0, %1, %2" : "=v"(r) : "v"(lo), "v"(hi)); return r; }
typedef short s16x4 __attribute__((ext_vector_type(4)));

template <int DK>
__device__ __forceinline__ void qkt(f32x16& p0, f32x16& p1, LAS const char* Kb, int r32, int hi, const bf16x8* qr) {
    constexpr int RS = DK * 2;
    p0 = f32x16{}; p1 = f32x16{};
    LAS const char* kb[4];
#pragma unroll
    for (int dd = 0; dd < 4; ++dd) kb[dd] = Kb + FA_KSWZ(r32, (dd * 16 + hi * 8) * 2, RS);
#pragma unroll
    for (int d0 = 0; d0 < DK / 16; ++d0) { LAS const char* ap = kb[d0 & 3] + (d0 >> 2) * 128;
        const bf16x8 b0 = *(LAS const bf16x8*)ap;
        const bf16x8 b1 = *(LAS const bf16x8*)(ap + 32 * RS);
        p0 = __builtin_amdgcn_mfma_f32_32x32x16_bf16(b0, qr[d0], p0, 0, 0, 0);
        p1 = __builtin_amdgcn_mfma_f32_32x32x16_bf16(b1, qr[d0], p1, 0, 0, 0); }
}
__device__ __forceinline__ void pv_tile(f32x16* o, int vb0, bf16x8 pa0, bf16x8 pa1, bf16x8 pa2, bf16x8 pa3) {
#define FA_TRRD(dst, off) asm volatile("ds_read_b64_tr_b16 %0, %1 offset:%2" : "=&v"(dst) : "v"(vb0), "i"(off) : "memory")
#define FA_PV_D0(d0) do { s16x4 l0, l1, l2, l3, h0, h1, h2, h3; constexpr int b_ = (d0) * 512; \
        FA_TRRD(l0, b_); FA_TRRD(h0, b_ + 2048); FA_TRRD(l1, b_ + 4096); FA_TRRD(h1, b_ + 6144); FA_TRRD(l2, b_ + 8192); FA_TRRD(h2, b_ + 10240); FA_TRRD(l3, b_ + 12288); FA_TRRD(h3, b_ + 14336); \
        asm volatile("s_waitcnt lgkmcnt(0)" ::: "memory"); __builtin_amdgcn_sched_barrier(0); \
        o[d0] = __builtin_amdgcn_mfma_f32_32x32x16_bf16(pa0, (bf16x8){l0[0], l0[1], l0[2], l0[3], h0[0], h0[1], h0[2], h0[3]}, o[d0], 0, 0, 0); \
        o[d0] = __builtin_amdgcn_mfma_f32_32x32x16_bf16(pa1, (bf16x8){l1[0], l1[1], l1[2], l1[3], h1[0], h1[1], h1[2], h1[3]}, o[d0], 0, 0, 0); \
        o[d0] = __builtin_amdgcn_mfma_f32_32x32x16_bf16(pa2, (bf16x8){l2[0], l2[1], l2[2], l2[3], h2[0], h2[1], h2[2], h2[3]}, o[d0], 0, 0, 0); \
        o[d0] = __builtin_amdgcn_mfma_f32_32x32x16_bf16(pa3, (bf16x8){l3[0], l3[1], l3[2], l3[3], h3[0], h3[1], h3[2], h3[3]}, o[d0], 0, 0, 0); } while (0)
    FA_PV_D0(0); FA_PV_D0(1); FA_PV_D0(2); FA_PV_D0(3);
#undef FA_PV_D0
#undef FA_TRRD
}
__device__ __forceinline__ void softmax_tile(f32x16& p0, f32x16& p1, float& m_reg, float& l_reg, float& alpha, bf16x8& pa0, bf16x8& pa1, bf16x8& pa2, bf16x8& pa3) {
    float pmax = p0[0];
#pragma unroll
    for (int r = 1; r < 16; ++r) pmax = fmaxf(pmax, p0[r]);
#pragma unroll
    for (int r = 0; r < 16; ++r) pmax = fmaxf(pmax, p1[r]);
    { auto rr = __builtin_amdgcn_permlane32_swap(__float_as_uint(pmax), __float_as_uint(pmax), false, false);
      pmax = fmaxf(__uint_as_float(rr[0]), __uint_as_float(rr[1])); }
    const float mn = fmaxf(m_reg, pmax); alpha = __builtin_amdgcn_exp2f(m_reg - mn); m_reg = mn;
#pragma unroll
    for (int r = 0; r < 16; ++r) { p0[r] = __builtin_amdgcn_exp2f(p0[r] - mn); p1[r] = __builtin_amdgcn_exp2f(p1[r] - mn); }
    float ps = 0.f;
#pragma unroll
    for (int r = 0; r < 16; ++r) ps += p0[r];
#pragma unroll
    for (int r = 0; r < 16; ++r) ps += p1[r];
    { auto rr = __builtin_amdgcn_permlane32_swap(__float_as_uint(ps), __float_as_uint(ps), false, false);
      ps = __uint_as_float(rr[0]) + __uint_as_float(rr[1]); }
    l_reg = l_reg * alpha + ps;
#define FA_PK4(P, B_, OUT) do { unsigned a0 = cvtpk(P[B_+0], P[B_+1]), a1 = cvtpk(P[B_+2], P[B_+3]); \
        unsigned b0 = cvtpk(P[B_+4], P[B_+5]), b1 = cvtpk(P[B_+6], P[B_+7]); \
        auto r0 = __builtin_amdgcn_permlane32_swap(a0, b0, false, false); auto r1 = __builtin_amdgcn_permlane32_swap(a1, b1, false, false); \
        u32x4 wv = {r0[0], r1[0], r0[1], r1[1]}; OUT = *reinterpret_cast<bf16x8*>(&wv); } while (0)
    FA_PK4(p0, 0, pa0); FA_PK4(p0, 8, pa1); FA_PK4(p1, 0, pa2); FA_PK4(p1, 8, pa3);
#undef FA_PK4
}

template <int MODE>
__device__ __forceinline__ void attn_unit(const Args& a, int layer, LAS unsigned char* lds, int b, int h, int qb) {
    constexpr int DK = (MODE == 1) ? 192 : 128, RS = DK * 2, SHM_K = 64 * RS, NQ = DK / 16;
    constexpr float C2 = (MODE == 1) ? 1.4426950408889634f * 0.07216878364870322f : 1.4426950408889634f * 0.08838834764831845f;
    constexpr float L2E = 1.4426950408889634f;
    unsigned char* ws = a.ws;
    const int tid = threadIdx.x, wid = __builtin_amdgcn_readfirstlane(tid >> 6), lane = tid & 63, r32 = lane & 31, hi = lane >> 5;
    const int P0 = qb * 256, qlo = P0 + wid * 32, row = qlo + r32, cw = qlo >> 6;
    const size_t tb = (size_t)b * SEQ;
    const float NEG = -__builtin_inff();
    const bf16_t* Kg; const bf16_t* Vg; int ldk, ldv; bf16_t* Og; int ldo; int j_lo = 0, j_hi;
    if (MODE == 0) { const bf16_t* P = (const bf16_t*)(ws + WS_PROJ); Kg = P + tb * AB_MAIN + 2048 + h * 128; Vg = Kg + 2048; ldk = ldv = AB_MAIN; Og = (bf16_t*)(ws + WS_ATT) + (tb + qlo) * DM + h * 128; ldo = DM;
        j_lo = (P0 >> 6) - 8; if (j_lo < 0) j_lo = 0; j_hi = (P0 >> 6) + 4; }
    else if (MODE == 1) { Kg = (const bf16_t*)(ws + WS_KVB) + tb * 4096 + h * 256; Vg = Kg + 128; ldk = ldv = 4096; Og = (bf16_t*)(ws + WS_ATT) + (tb + qlo) * DM + 2048 + h * 128; ldo = DM; j_hi = (P0 >> 6) + 4; }
    else if (MODE == 2) { const bf16_t* P = (const bf16_t*)(ws + WS_PROJ); Kg = P + tb * CD_MAIN + 2048 + (h >> 2) * 128; Vg = Kg + 512; ldk = ldv = CD_MAIN; Og = (bf16_t*)(ws + WS_ATT) + (tb + qlo) * DM + h * 128; ldo = DM; j_hi = (P0 >> 6) + 4; }
    else if (MODE == 3) { const bf16_t* P = (const bf16_t*)(ws + WS_PROJ); Kg = P + tb * CD_MAIN + 7168 + h * 128; Vg = Kg + 2048; ldk = ldv = CD_MAIN; Og = (bf16_t*)(ws + WS_ATT) + (tb + qlo) * DM + 2048 + h * 128; ldo = DM; j_hi = (P0 >> 6) + 4; }
    else { Kg = (const bf16_t*)(ws + WS_KVM) + ((size_t)layer * 512 + b * 256) * 1024 + h * 128; Vg = Kg + 512; ldk = ldv = 1024; Og = (bf16_t*)(ws + WS_MEMO) + (tb + qlo) * 512 + h * 128; ldo = 512; j_hi = 4; }
    const int NT = j_hi - j_lo;
    bf16x8 qr[NQ];
    if (MODE == 4) { const float* mq = (const float*)(ws + WS_MQP) + (tb + row) * 512 + h * 128;
#pragma unroll
        for (int d0 = 0; d0 < NQ; ++d0) { const float* p = mq + d0 * 16 + hi * 8; f32x4 s0 = {0.f, 0.f, 0.f, 0.f}, s1 = s0;
#pragma unroll
            for (int z = 0; z < 4; ++z) { s0 += *(const f32x4*)(p + (size_t)z * T * 512); s1 += *(const f32x4*)(p + (size_t)z * T * 512 + 4); }
            u32x4 wv = {cvtpk(s0[0], s0[1]), cvtpk(s0[2], s0[3]), cvtpk(s1[0], s1[1]), cvtpk(s1[2], s1[3])}; qr[d0] = *reinterpret_cast<bf16x8*>(&wv); } }
    else { const bf16_t* Qg;
        if (MODE == 0) Qg = (const bf16_t*)(ws + WS_PROJ) + (tb + row) * AB_MAIN + h * 128;
        else if (MODE == 1) Qg = (const bf16_t*)(ws + WS_QB) + (tb + row) * 3072 + h * 192;
        else if (MODE == 2) Qg = (const bf16_t*)(ws + WS_PROJ) + (tb + row) * CD_MAIN + h * 128;
        else Qg = (const bf16_t*)(ws + WS_PROJ) + (tb + row) * CD_MAIN + 5120 + h * 128;
#pragma unroll
        for (int d0 = 0; d0 < NQ; ++d0) qr[d0] = *(const bf16x8*)(Qg + d0 * 16 + hi * 8); }
    LAS char* V_lds = (LAS char*)lds + LDS_V; LAS char* K_lds = (LAS char*)lds + LDS_K;
    LAS float* wsc = (LAS float*)(lds + LDS_WS) + wid * 64; LAS float* relb = (LAS float*)(lds + LDS_RELB); LAS float* csl = (LAS float*)(lds + LDS_CS);
    const int vbase = (int)(unsigned)(uintptr_t)V_lds + v_rd_base(lane);
    const bf16_t* KRg = (const bf16_t*)(ws + WS_KR) + tb * 64;
    const float* cum = (const float*)(ws + WS_CUM) + ((size_t)b * 16 + h) * SEQ;
    const unsigned* mrow = (const unsigned*)(ws + WS_MASK) + (tb + row) * 128;
    float ctl = 0.f; if (MODE == 3) ctl = cum[row] * L2E;
    if (MODE == 0) { const float* rb = a.in[I_A_REL_BIAS] + h * 513; for (int i = tid; i < 513; i += 512) relb[i] = rb[i] * L2E; }
    float m_reg = -1e30f, l_reg = 0.f; f32x16 o[4] = {};
    unsigned mk0 = 0u, mk1 = 0u; float st_cs = 0.f;
    constexpr int NKI = (DK == 192) ? 3 : 2;
    int koff[NKI]; bool krope[NKI]; int voff[2];
#pragma unroll
    for (int i = 0; i < NKI; ++i) { const int off = (wid * NKI + i) * 1024 + lane * 16; const int rw = off / RS, sw = off - rw * RS, cb = sw ^ ((rw & 7) << 4);
        krope[i] = (DK == 192) && (cb >= 256); koff[i] = krope[i] ? rw * 64 + ((cb - 256) >> 1) : rw * ldk + (cb >> 1); }
#pragma unroll
    for (int i = 0; i < 2; ++i) { const int off = (wid * 2 + i) * 1024 + lane * 16; const int sub = off >> 9, within = off & 511, kk = ((sub >> 2) << 3) | (within >> 6);
        const int k = (kk & ~0xC) | ((kk & 4) << 1) | ((kk & 8) >> 1), c = (sub & 3) * 32 + ((within & 63) >> 1); voff[i] = k * ldv + c; }
#define FA_DMA(j, bf) do { const int k0_ = (j) * 64; \
        _Pragma("unroll") for (int i_ = 0; i_ < NKI; ++i_) { const bf16_t* s_ = (DK == 192 && krope[i_]) ? (KRg + (size_t)k0_ * 64 + koff[i_]) : (Kg + (size_t)k0_ * ldk + koff[i_]); \
            __builtin_amdgcn_global_load_lds((const unsigned*)s_, (LAS unsigned*)(K_lds + (bf) * SHM_K + (wid * NKI + i_) * 1024), 16, 0, 0); } \
        _Pragma("unroll") for (int i_ = 0; i_ < 2; ++i_) \
            __builtin_amdgcn_global_load_lds((const unsigned*)(Vg + (size_t)k0_ * ldv + voff[i_]), (LAS unsigned*)(V_lds + (bf) * SHM_V + (wid * 2 + i_) * 1024), 16, 0, 0); \
        if (MODE == 3) { if (tid < 64) st_cs = cum[k0_ + tid] * L2E; } } while (0)
#define FA_CSW(bf) do { if (MODE == 3) { if (tid < 64) csl[(bf) * 64 + tid] = st_cs; } } while (0)
    __syncthreads();
    FA_DMA(j_lo, 0); asm volatile("s_waitcnt vmcnt(0)" ::: "memory"); FA_CSW(0);
    __syncthreads();
#pragma unroll 1
    for (int t = 0; t < NT; ++t) {
        const int buf = t & 1, j = j_lo + t, kbp = j * 64;
        if (t + 1 < NT) FA_DMA(j + 1, buf ^ 1);
        bool act;
        if (MODE == 0) act = (j >= cw - 8) && (j <= cw);
        else if (MODE == 1 || MODE == 2) act = (j <= cw);
        else if (MODE == 3) act = (kbp <= qlo + 31);
        else act = true;
        if (MODE == 2) { if (act) { const u32x2 mm = *(const u32x2*)(mrow + 2 * j); mk0 = mm.x; mk1 = mm.y; } }
        if (act) {
            f32x16 p0, p1;
            qkt<DK>(p0, p1, K_lds + buf * SHM_K, r32, hi, qr);
            if (MODE == 0) {
                if (qlo - (kbp + 63) >= 256) { const float bf_ = relb[512];
#pragma unroll
                    for (int r = 0; r < 16; ++r) { p0[r] = fmaf(p0[r], C2, bf_); p1[r] = fmaf(p1[r], C2, bf_); } }
                else { const int dq = row - kbp - 4 * hi;
#pragma unroll
                    for (int r = 0; r < 16; ++r) { const int c = (r & 3) + 8 * (r >> 2);
                        int i0 = dq - c; i0 = i0 < -256 ? -256 : (i0 > 256 ? 256 : i0); int i1 = dq - c - 32; i1 = i1 < -256 ? -256 : (i1 > 256 ? 256 : i1);
                        p0[r] = fmaf(p0[r], C2, relb[i0 + 256]); p1[r] = fmaf(p1[r], C2, relb[i1 + 256]); } }
            } else if (MODE == 3) {
                LAS const float* cs = csl + buf * 64 + 4 * hi;
#pragma unroll
                for (int q4 = 0; q4 < 4; ++q4) { const f32x4 c0 = *(LAS const f32x4*)(cs + 8 * q4), c1 = *(LAS const f32x4*)(cs + 32 + 8 * q4);
#pragma unroll
                    for (int e = 0; e < 4; ++e) { p0[4 * q4 + e] = fmaf(p0[4 * q4 + e], C2, ctl - c0[e]); p1[4 * q4 + e] = fmaf(p1[4 * q4 + e], C2, ctl - c1[e]); } }
                if (kbp + 63 > qlo) { const int dq = row - kbp - 4 * hi;
#pragma unroll
                    for (int r = 0; r < 16; ++r) { const int c = (r & 3) + 8 * (r >> 2); if (dq - c < 0) p0[r] = NEG; if (dq - c - 32 < 0) p1[r] = NEG; } }
            } else {
#pragma unroll
                for (int r = 0; r < 16; ++r) { p0[r] *= C2; p1[r] *= C2; }
                if (MODE == 2) {
#pragma unroll
                    for (int r = 0; r < 16; ++r) { const int c = (r & 3) + 8 * (r >> 2) + 4 * hi; if (!((mk0 >> c) & 1u)) p0[r] = NEG; if (!((mk1 >> c) & 1u)) p1[r] = NEG; } }
            }
            float alpha; bf16x8 pa0, pa1, pa2, pa3;
            softmax_tile(p0, p1, m_reg, l_reg, alpha, pa0, pa1, pa2, pa3);
            if (__any(alpha < 1.f)) { if (hi == 0) wsc[r32] = alpha; LDS_WAIT();
#pragma unroll
                for (int r = 0; r < 16; ++r) { const float al = wsc[crow(r, hi)];
#pragma unroll
                    for (int d_ = 0; d_ < 4; ++d_) o[d_][r] *= al; }
                LDS_WAIT(); }
            pv_tile(o, vbase + buf * SHM_V, pa0, pa1, pa2, pa3);
        }
        asm volatile("s_waitcnt vmcnt(0)" ::: "memory");
        if (t + 1 < NT) FA_CSW(buf ^ 1);
        __syncthreads();
    }
#undef FA_DMA
#undef FA_CSW
    if (hi == 0) wsc[32 + r32] = l_reg; LDS_WAIT();
#pragma unroll
    for (int r = 0; r < 16; ++r) { const int orow = crow(r, hi); const float rl = __builtin_amdgcn_rcpf(wsc[32 + orow]);
#pragma unroll
        for (int d0 = 0; d0 < 4; ++d0) { const float v = o[d0][r] * rl; const float vn = __shfl_xor(v, 1);
            if ((r32 & 1) == 0) *(unsigned*)(Og + (size_t)orow * ldo + d0 * 32 + r32) = cvtpk(v, vn); } }
    LDS_WAIT();
}
}

__device__ __forceinline__ void rope_pair(float& x1, float& x2, float cs, float sn) { const float a = x1 * cs - x2 * sn, b = x2 * cs + x1 * sn; x1 = a; x2 = b; }
__device__ __forceinline__ void ph_l0_stats(const Args& a, const WI& w) {
    unsigned char* ws = a.ws; const bf16_t* P = (const bf16_t*)(ws + WS_PROJ);
    const float* r64 = (const float*)(ws + WS_ROPE64);
    for (int t = w.gw; t < T; t += w.ngw) {
        const bf16_t* row = P + (size_t)t * AB_MAIN;
        float s = 0.f;
        for (int j = 0; j < 3; ++j) { const bf16x8 v = *(const bf16x8*)(row + 6144 + (j * 64 + w.lane) * 8);
#pragma unroll
            for (int e = 0; e < 8; ++e) { const float f = bf2f((bf16_t)v[e]); s += f * f; } }
        s = wave_sum(s);
        float s2 = 0.f; { const bf16x8 v = *(const bf16x8*)(row + 7680 + w.lane * 8);
#pragma unroll
            for (int e = 0; e < 8; ++e) { const float f = bf2f((bf16_t)v[e]); s2 += f * f; } }
        s2 = wave_sum(s2);
        if (w.lane == 0) { ((float*)(ws + WS_RSQ))[t] = 1.f / sqrtf(s * (1.f / 1536.f) + RMS_EPS); ((float*)(ws + WS_RSKV))[t] = 1.f / sqrtf(s2 * (1.f / 512.f) + RMS_EPS); }
        if (w.lane < 32) { const float* sm = (const float*)(ws + WS_SMALL) + (size_t)t * 128; const int sp = t & (SEQ - 1);
            float x1 = sm[w.lane], x2 = sm[w.lane + 32]; const float cs = r64[((size_t)sp * 32 + w.lane) * 2], sn = r64[((size_t)sp * 32 + w.lane) * 2 + 1];
            rope_pair(x1, x2, cs, sn);
            bf16_t* kr = (bf16_t*)(ws + WS_KR) + (size_t)t * 64; kr[w.lane] = (bf16_t)f2bf(x1); kr[w.lane + 32] = (bf16_t)f2bf(x2); }
    }
}
__device__ __forceinline__ void ph_l0_qrope(const Args& a, const WI& w) {
    unsigned char* ws = a.ws; bf16_t* Q = (bf16_t*)(ws + WS_QB); const float* r64 = (const float*)(ws + WS_ROPE64);
    for (int t = w.gw; t < T; t += w.ngw) {
        const int sp = t & (SEQ - 1);
        for (int e = w.lane; e < 16 * 32; e += 64) { const int h = e >> 5, i = e & 31; bf16_t* q = Q + (size_t)t * 3072 + h * 192 + 128;
            float x1 = bf2f(q[i]), x2 = bf2f(q[i + 32]); rope_pair(x1, x2, r64[((size_t)sp * 32 + i) * 2], r64[((size_t)sp * 32 + i) * 2 + 1]);
            q[i] = (bf16_t)f2bf(x1); q[i + 32] = (bf16_t)f2bf(x2); }
    }
}
__device__ __forceinline__ void ph_l1_elem(const Args& a, const WI& w) {
    unsigned char* ws = a.ws; bf16_t* P = (bf16_t*)(ws + WS_PROJ);
    const float* r128 = (const float*)(ws + WS_ROPE128); const float* r64 = (const float*)(ws + WS_ROPE64);
    for (int t = w.gw; t < T; t += w.ngw) {
        const int b = t / SEQ, sp = t - b * SEQ; bf16_t* row = P + (size_t)t * CD_MAIN;
        for (int e = w.lane; e < 20 * 64; e += 64) { const int h = e >> 6, i = e & 63; bf16_t* q = row + h * 128;
            float x1 = bf2f(q[i]), x2 = bf2f(q[i + 64]); rope_pair(x1, x2, r128[((size_t)sp * 64 + i) * 2], r128[((size_t)sp * 64 + i) * 2 + 1]);
            q[i] = (bf16_t)f2bf(x1); q[i + 64] = (bf16_t)f2bf(x2); }
        for (int e = w.lane; e < 32 * 32; e += 64) { const int h = e >> 5, i = e & 31; bf16_t* q = row + 3072 + h * 64;
            float x1 = bf2f(q[i]), x2 = bf2f(q[i + 32]); rope_pair(x1, x2, r64[((size_t)sp * 32 + i) * 2], r64[((size_t)sp * 32 + i) * 2 + 1]);
            q[i] = (bf16_t)f2bf(x1); q[i + 32] = (bf16_t)f2bf(x2); }
        const float* sm = (const float*)(ws + WS_SMALL) + (size_t)t * 128;
        if (w.lane < 32) { float x1 = sm[w.lane], x2 = sm[w.lane + 32]; rope_pair(x1, x2, r64[((size_t)sp * 32 + w.lane) * 2], r64[((size_t)sp * 32 + w.lane) * 2 + 1]);
            bf16_t* ki = (bf16_t*)(ws + WS_KI) + (size_t)t * 64; ki[w.lane] = (bf16_t)f2bf(x1); ki[w.lane + 32] = (bf16_t)f2bf(x2);
            ((float*)(ws + WS_WI))[(size_t)t * 32 + w.lane] = sm[64 + w.lane] * 0.17677669529663687f; }
        if (w.lane < 16) { const float z = sm[96 + w.lane] + a.in[I_D_FORGET_BIAS][w.lane];
            const float lf = fminf(z, 0.f) - log1pf(__expf(-fabsf(z)));
            ((float*)(ws + WS_LOGF))[((size_t)b * 16 + w.lane) * SEQ + sp] = lf; }
    }
}
__device__ __forceinline__ void ph_l1_scan(const Args& a, const WI& w) {
    unsigned char* ws = a.ws;
    for (int it = w.gw; it < NB * 16; it += w.ngw) {
        const float* src = (const float*)(ws + WS_LOGF) + (size_t)it * SEQ + w.lane * 64; float* dst = (float*)(ws + WS_CUM) + (size_t)it * SEQ + w.lane * 64;
        float tot = 0.f; for (int j = 0; j < 64; ++j) tot += src[j];
        float inc = tot;
#pragma unroll
        for (int o = 1; o < 64; o <<= 1) { const float v = __shfl_up(inc, o); if (w.lane >= o) inc += v; }
        float run = inc - tot;
        for (int j = 0; j < 64; ++j) { run += src[j]; dst[j] = run; }
    }
}
__device__ __forceinline__ void ph_l1_index_naive(const Args& a, LAS float* qs  , const WI& w) {
    unsigned char* ws = a.ws; const bf16_t* P = (const bf16_t*)(ws + WS_PROJ); const bf16_t* KI = (const bf16_t*)(ws + WS_KI);
    const float* WIp = (const float*)(ws + WS_WI); float* SC = (float*)(ws + WS_SCORE);
    for (int t = w.gw; t < T; t += w.ngw) {
        const int b = t / SEQ, sp = t - b * SEQ, nadm = ((sp >> 6) + 1) * 64;
        LDS_WAIT();
        for (int e = w.lane; e < 2048; e += 64) qs[e] = bf2f(P[(size_t)t * CD_MAIN + 3072 + e]);
        if (w.lane < 32) qs[2048 + w.lane] = WIp[(size_t)t * 32 + w.lane];
        LDS_WAIT();
        for (int s0 = 0; s0 < nadm; s0 += 64) {
            const int s = s0 + w.lane; const bf16_t* kp = KI + ((size_t)b * SEQ + s) * 64;
            float k[64];
#pragma unroll
            for (int d0 = 0; d0 < 64; d0 += 8) { const bf16x8 kv = *(const bf16x8*)(kp + d0);
#pragma unroll
                for (int e = 0; e < 8; ++e) k[d0 + e] = bf2f((bf16_t)kv[e]); }
            float sc = 0.f;
            for (int h = 0; h < 32; ++h) { float dot = 0.f;
#pragma unroll
                for (int d = 0; d < 64; ++d) dot += qs[h * 64 + d] * k[d];
                sc += qs[2048 + h] * fmaxf(dot * 0.125f, 0.f); }
            SC[((size_t)b * SEQ + sp) * SEQ + s] = sc;
        }
    }
}
__device__ __forceinline__ void ph_l1_index(const Args& a, LAS unsigned char* lds, const WI& w) {
    unsigned char* ws = a.ws; const bf16_t* P = (const bf16_t*)(ws + WS_PROJ); const bf16_t* KI = (const bf16_t*)(ws + WS_KI);
    const float* WIp = (const float*)(ws + WS_WI); float* SC = (float*)(ws + WS_SCORE);
    LAS char* Qs = (LAS char*)lds; LAS float* Wt = (LAS float*)(lds + 131072);
    const int tid = w.tid, r32 = w.lane & 31, hi = w.lane >> 5;
    for (int u = w.bid; u < 256; u += w.nblk) {
        const int b = u >> 7, x = (u >> 1) & 63, half = u & 1;
        for (int pass = 0; pass < 2; ++pass) {
            const int qt = pass ? 127 - x : x; const int t0 = b * SEQ + qt * 32; const int nadm = ((qt * 32) >> 6) * 64 + 64, ngrp = (nadm + 127) >> 7;
            __syncthreads();
            for (int e = tid; e < 32 * 256; e += 512) { const int t = e >> 8, c = e & 255; const u32x4 v = *(const u32x4*)(P + (size_t)(t0 + t) * CD_MAIN + 3072 + c * 8);
                const int cs = (c & ~15) | ((c & 15) ^ (t & 15)); *(LAS u32x4*)(Qs + t * 4096 + cs * 16) = v; }
            for (int e = tid; e < 1024; e += 512) { const int t = e >> 5, h = e & 31; Wt[h * 32 + t] = WIp[(size_t)(t0 + t) * 32 + h] * 0.125f; }
            __syncthreads();
            for (int g = half + 2 * w.wave; g < ngrp; g += 16) {
                const int s0 = g * 128;
                bf16x8 kf[4][4];
#pragma unroll
                for (int j = 0; j < 4; ++j)
#pragma unroll
                    for (int dk = 0; dk < 4; ++dk) kf[j][dk] = *(const bf16x8*)(KI + ((size_t)b * SEQ + s0 + 32 * j + r32) * 64 + dk * 16 + hi * 8);
                f32x16 acc[4] = {};
#pragma unroll 2
                for (int h = 0; h < 32; ++h) {
                    bf16x8 qf[4];
#pragma unroll
                    for (int dk = 0; dk < 4; ++dk) qf[dk] = *(LAS const bf16x8*)(Qs + r32 * 4096 + ((((h >> 1) << 4) | ((((h & 1) << 3) | (dk << 1) | hi) ^ (r32 & 15))) << 4));
                    f32x4 wv[4];
#pragma unroll
                    for (int q4 = 0; q4 < 4; ++q4) wv[q4] = *(LAS const f32x4*)(Wt + h * 32 + 8 * q4 + 4 * hi);
#pragma unroll
                    for (int j = 0; j < 4; ++j) { f32x16 tmp = {};
#pragma unroll
                        for (int dk = 0; dk < 4; ++dk) tmp = __builtin_amdgcn_mfma_f32_32x32x16_bf16(qf[dk], kf[j][dk], tmp, 0, 0, 0);
#pragma unroll
                        for (int r = 0; r < 16; ++r) acc[j][r] = fmaf(wv[r >> 2][r & 3], fmaxf(tmp[r], 0.f), acc[j][r]); }
                }
#pragma unroll
                for (int j = 0; j < 4; ++j)
#pragma unroll
                    for (int r = 0; r < 16; ++r) SC[(size_t)(t0 + crow(r, hi)) * SEQ + s0 + 32 * j + r32] = acc[j][r];
            }
        }
    }
    __syncthreads();
}
__device__ __forceinline__ void ph_l1_select(const Args& a, const WI& w) {
    unsigned char* ws = a.ws; const float* SC = (const float*)(ws + WS_SCORE); unsigned* MK = (unsigned*)(ws + WS_MASK);
    for (int t = w.gw; t < T; t += w.ngw) {
        const int b = t / SEQ, sp = t - b * SEQ, nblk = (sp >> 6) + 1;
        const float* row = SC + ((size_t)b * SEQ + sp) * SEQ;
        unsigned key[64];
#pragma unroll
        for (int j = 0; j < 64; ++j) { unsigned u = 0u; if (j < nblk) { u = __float_as_uint(row[j * 64 + w.lane]); u ^= (u >> 31) ? 0xFFFFFFFFu : 0x80000000u; } key[j] = u; }
        unsigned thr = 0u;
        if (nblk > 4) {
            for (int bit = 31; bit >= 0; --bit) { const unsigned cand = thr | (1u << bit); int cnt = 0;
#pragma unroll
                for (int j = 0; j < 64; ++j) cnt += (key[j] >= cand) ? 1 : 0;
                cnt = wave_sum_i(cnt); if (cnt >= 256) thr = cand; }
        }
        unsigned lo = 0u, hi = 0u;
#pragma unroll
        for (int j = 0; j < 64; ++j) { const bool sel = (j < nblk) && (key[j] >= thr); const unsigned long long bal = __ballot(sel); if (w.lane == j) { lo = (unsigned)bal; hi = (unsigned)(bal >> 32); } }
        *(u32x2*)(MK + (size_t)t * 128 + 2 * w.lane) = (u32x2){lo, hi};
    }
}

__device__ __forceinline__ unsigned tk_key(float v, unsigned payload, unsigned pmask) { const unsigned u = __float_as_uint(v); const unsigned m = (unsigned)((int)u >> 31) | 0x80000000u; return ((u ^ m) & ~pmask) | payload; }
__device__ __forceinline__ float tk_val(unsigned key, unsigned pmask) { const unsigned k = key & ~pmask; const unsigned m = ~(unsigned)((int)k >> 31) | 0x80000000u; return __uint_as_float(k ^ m); }
#define TK_INSERT(TOP, key_) do { unsigned k__ = (key_); \
        _Pragma("unroll") for (int q_ = 0; q_ < 16; ++q_) { const unsigned hi__ = TOP[q_] > k__ ? TOP[q_] : k__; k__ = TOP[q_] > k__ ? k__ : TOP[q_]; TOP[q_] = hi__; } } while (0)
__device__ __forceinline__ unsigned tk_sel16(const unsigned (&arr)[16], unsigned i) {
    unsigned x8[8], x4[4], x2[2];
    const unsigned m0 = 0u - (i & 1u), m1 = 0u - ((i >> 1) & 1u), m2 = 0u - ((i >> 2) & 1u), m3 = 0u - ((i >> 3) & 1u);
#pragma unroll
    for (int q = 0; q < 8; ++q) x8[q] = (arr[2 * q + 1] & m0) | (arr[2 * q] & ~m0);
#pragma unroll
    for (int q = 0; q < 4; ++q) x4[q] = (x8[2 * q + 1] & m1) | (x8[2 * q] & ~m1);
#pragma unroll
    for (int q = 0; q < 2; ++q) x2[q] = (x4[2 * q + 1] & m2) | (x4[2 * q] & ~m2);
    return (x2[1] & m3) | (x2[0] & ~m3); }
__device__ __forceinline__ void ph_peer_topk(const Args& a, const WI& w) {
    unsigned char* ws = a.ws; const float* PST = (const float*)(ws + WS_PSCORE); int* PIDX = (int*)(ws + WS_PIDX); float* PG = (float*)(ws + WS_PGATE);
    for (int task = w.gw; task < 128 * 8; task += w.ngw) {
        const int h = task & 7, t = (task >> 3) * 64 + w.lane;
        unsigned t0[16], t1[16];
#pragma unroll
        for (int k = 0; k < 16; ++k) { t0[k] = 0u; t1[k] = 0u; }
        { const float* col = PST + (size_t)(h * 256) * T + t;
#pragma unroll 8
          for (int i = 0; i < 128; ++i) { const float v = col[(size_t)i * T]; TK_INSERT(t0, tk_key(v, 127u - (unsigned)i, 127u)); } }
        { const float* col = PST + (size_t)(h * 256 + 128) * T + t;
#pragma unroll 8
          for (int i = 0; i < 128; ++i) { const float v = col[(size_t)i * T]; TK_INSERT(t1, tk_key(v, 127u - (unsigned)i, 127u)); } }
        float a0[16], a1[16];
#pragma unroll
        for (int k = 0; k < 16; ++k) { a0[k] = tk_val(t0[k], 127u); a1[k] = tk_val(t1[k], 127u); }
        unsigned bk[16];
#pragma unroll
        for (int k = 0; k < 16; ++k) bk[k] = 0u;
#pragma unroll
        for (int i = 0; i < 16; ++i)
#pragma unroll
            for (int j = 0; j < 16; ++j) if ((i + 1) * (j + 1) <= 16) TK_INSERT(bk, tk_key(a0[i] + a1[j], 255u - (unsigned)(i * 16 + j), 255u));
        const float top = tk_val(bk[0], 255u); float den = 0.f; float ex[16];
#pragma unroll
        for (int k = 0; k < 16; ++k) { ex[k] = __expf(tk_val(bk[k], 255u) - top); den += ex[k]; }
        const float rd = 1.f / den;
#pragma unroll
        for (int k = 0; k < 16; ++k) { const unsigned c = 255u - (bk[k] & 255u); const unsigned e0 = 127u - (tk_sel16(t0, c >> 4) & 127u), e1 = 127u - (tk_sel16(t1, c & 15u) & 127u);
            PIDX[(size_t)t * 128 + h * 16 + k] = (int)(e0 * 128u + e1); PG[(size_t)t * 128 + h * 16 + k] = ex[k] * rd; }
    }
}
__device__ __forceinline__ void ph_peer_experts(const Args& a, int layer, float* outf, bf16_t* outb, const float* g, const float* bta, LAS float* wsm  , const WI& w) {
    unsigned char* ws = a.ws; const float* HF = (const float*)(ws + WS_HF);
    const unsigned char* U8 = ws + WS_U8 + (size_t)layer * 16384 * DM; const unsigned char* V8 = ws + WS_V8 + (size_t)layer * 16384 * DM;
    const float* USC = (const float*)(ws + WS_USC) + layer * 16384; const float* VSC = (const float*)(ws + WS_VSC) + layer * 16384;
    const int* PIDX = (const int*)(ws + WS_PIDX); const float* PG = (const float*)(ws + WS_PGATE);
    const int lane = w.lane;
    for (int t = w.gw; t < T; t += w.ngw) {
        const float* hrow = HF + (size_t)t * DM + 16 * lane;
        const int idx0 = PIDX[(size_t)t * 128 + lane], idx1 = PIDX[(size_t)t * 128 + 64 + lane];
        const float g0 = PG[(size_t)t * 128 + lane], g1 = PG[(size_t)t * 128 + 64 + lane];
        LDS_WAIT();
        {
            f32x2 x[32];
#pragma unroll
            for (int i = 0; i < 4; ++i)
#pragma unroll
                for (int q4 = 0; q4 < 4; ++q4) { const f32x4 v = *(const f32x4*)(hrow + 1024 * i + 4 * q4); x[8 * i + 2 * q4] = (f32x2){v.x, v.y}; x[8 * i + 2 * q4 + 1] = (f32x2){v.z, v.w}; }
#pragma unroll 1
            for (int k0 = 0; k0 < 128; k0 += 8) {
                const int iv = (k0 & 64) ? idx1 : idx0; const float gv = (k0 & 64) ? g1 : g0;
                float z[8];
#pragma unroll
                for (int q = 0; q < 8; ++q) {
                    const int e = __builtin_amdgcn_readlane(iv, (k0 + q) & 63);
                    const u32x4* ur = (const u32x4*)(U8 + (size_t)e * DM + 16 * lane); f32x2 acc = {0.f, 0.f};
#pragma unroll
                    for (int i = 0; i < 4; ++i) { const u32x4 uv = ur[64 * i];
#pragma unroll
                        for (int c = 0; c < 4; ++c) { const f32x2 lo = __builtin_amdgcn_cvt_pk_f32_fp8((int)uv[c], false), hi2 = __builtin_amdgcn_cvt_pk_f32_fp8((int)uv[c], true);
                            acc = __builtin_elementwise_fma(lo, x[8 * i + 2 * c], acc); acc = __builtin_elementwise_fma(hi2, x[8 * i + 2 * c + 1], acc); } }
                    z[q] = acc.x + acc.y;
                }
                float r4[4], r2[2], r1;
#pragma unroll
                for (int i = 0; i < 4; ++i) { const float keep = (lane & 32) ? z[i + 4] : z[i], send = (lane & 32) ? z[i] : z[i + 4]; r4[i] = keep + __shfl_xor(send, 32); }
#pragma unroll
                for (int i = 0; i < 2; ++i) { const float keep = (lane & 16) ? r4[i + 2] : r4[i], send = (lane & 16) ? r4[i] : r4[i + 2]; r2[i] = keep + __shfl_xor(send, 16); }
                { const float keep = (lane & 8) ? r2[1] : r2[0], send = (lane & 8) ? r2[0] : r2[1]; r1 = keep + __shfl_xor(send, 8); }
                r1 += __shfl_xor(r1, 4); r1 += __shfl_xor(r1, 2); r1 += __shfl_xor(r1, 1);
                const int q = lane >> 3; const int e = __shfl(iv, (k0 + q) & 63); const float gt_ = __shfl(gv, (k0 + q) & 63);
                if ((lane & 7) == 0) { const float zz = r1 * USC[e]; const float act = 0.5f * zz * (1.f + erff(zz * 0.70710678118654752f)); wsm[k0 + q] = act * gt_ * VSC[e]; }
            }
        }
        LDS_WAIT();
        f32x2 y[32];
#pragma unroll
        for (int i = 0; i < 32; ++i) y[i] = (f32x2){0.f, 0.f};
#pragma unroll 1
        for (int k0 = 0; k0 < 128; k0 += 8) {
            const int iv = (k0 & 64) ? idx1 : idx0;
#pragma unroll
            for (int q = 0; q < 8; ++q) {
                const int e = __builtin_amdgcn_readlane(iv, (k0 + q) & 63); const float wt = wsm[k0 + q]; const f32x2 wt2 = {wt, wt};
                const u32x4* vr = (const u32x4*)(V8 + (size_t)e * DM + 16 * lane);
#pragma unroll
                for (int i = 0; i < 4; ++i) { const u32x4 vv = vr[64 * i];
#pragma unroll
                    for (int c = 0; c < 4; ++c) { const f32x2 lo = __builtin_amdgcn_cvt_pk_f32_fp8((int)vv[c], false), hi2 = __builtin_amdgcn_cvt_pk_f32_fp8((int)vv[c], true);
                        y[8 * i + 2 * c] = __builtin_elementwise_fma(lo, wt2, y[8 * i + 2 * c]); y[8 * i + 2 * c + 1] = __builtin_elementwise_fma(hi2, wt2, y[8 * i + 2 * c + 1]); } }
            }
        }
        float s = 0.f;
#pragma unroll
        for (int i = 0; i < 4; ++i)
#pragma unroll
            for (int q4 = 0; q4 < 4; ++q4) { const f32x4 v = *(const f32x4*)(hrow + 1024 * i + 4 * q4);
                y[8 * i + 2 * q4].x += ALPHA * v.x; y[8 * i + 2 * q4].y += ALPHA * v.y; y[8 * i + 2 * q4 + 1].x += ALPHA * v.z; y[8 * i + 2 * q4 + 1].y += ALPHA * v.w; }
#pragma unroll
        for (int i = 0; i < 32; ++i) s += y[i].x + y[i].y;
        const float mean = wave_sum(s) * (1.f / DM); float s2 = 0.f;
#pragma unroll
        for (int i = 0; i < 32; ++i) { y[i].x -= mean; y[i].y -= mean; s2 += y[i].x * y[i].x + y[i].y * y[i].y; }
        const float rstd = 1.f / sqrtf(wave_sum(s2) * (1.f / DM) + LN_EPS);
#pragma unroll
        for (int i = 0; i < 4; ++i)
#pragma unroll
            for (int q4 = 0; q4 < 4; ++q4) { const int c = 1024 * i + 16 * lane + 4 * q4;
                const f32x4 gg = *(const f32x4*)(g + c), bb = *(const f32x4*)(bta + c); f32x4 o;
                o.x = y[8 * i + 2 * q4].x * rstd * gg.x + bb.x; o.y = y[8 * i + 2 * q4].y * rstd * gg.y + bb.y; o.z = y[8 * i + 2 * q4 + 1].x * rstd * gg.z + bb.z; o.w = y[8 * i + 2 * q4 + 1].y * rstd * gg.w + bb.w;
                *(f32x4*)(outf + (size_t)t * DM + c) = o;
                if (outb) { u32x2 p; p.x = pk2(o.x, o.y); p.y = pk2(o.z, o.w); *(u32x2*)(outb + (size_t)t * DM + c) = p; } }
    }
}

__device__ __forceinline__ void ph_attn_l0(const Args& a, LAS unsigned char* lds, const WI& w) {
    for (int pr = w.bid; pr < 256; pr += w.nblk) { const int bh = pr >> 3, x = pr & 7;
        for (int pass = 0; pass < 2; ++pass) fa::attn_unit<1>(a, 0, lds, bh >> 4, bh & 15, pass ? 15 - x : x); }
    for (int u = w.bid; u < 512; u += w.nblk) { const int bh = u >> 4; fa::attn_unit<0>(a, 0, lds, bh >> 4, bh & 15, u & 15); }
}
__device__ __forceinline__ void ph_attn_l1(const Args& a, LAS unsigned char* lds, const WI& w) {
    for (int pr = w.bid; pr < 256; pr += w.nblk) { const int bh = pr >> 3, x = pr & 7;
        for (int pass = 0; pass < 2; ++pass) fa::attn_unit<2>(a, 1, lds, bh >> 4, bh & 15, pass ? 15 - x : x); }
    for (int pr = w.bid; pr < 256; pr += w.nblk) { const int bh = pr >> 3, x = pr & 7;
        for (int pass = 0; pass < 2; ++pass) fa::attn_unit<3>(a, 1, lds, bh >> 4, bh & 15, pass ? 15 - x : x); }
}
__device__ __forceinline__ void ph_attn_mem(const Args& a, int layer, LAS unsigned char* lds, const WI& w) {
    for (int u = w.bid; u < 128; u += w.nblk) { const int bh = u >> 4; fa::attn_unit<4>(a, layer, lds, bh >> 2, bh & 3, u & 15); }
}

__global__ void __launch_bounds__(512, 2) mega(Args a) {
    extern __shared__ __attribute__((aligned(16))) unsigned char lds_raw[];
    LAS unsigned char* lds = (LAS unsigned char*)lds_raw;
    WI w; w.tid = threadIdx.x; w.lane = w.tid & 63; w.wave = __builtin_amdgcn_readfirstlane(w.tid >> 6);
    w.bid = blockIdx.x; w.nblk = gridDim.x; w.gw = w.bid * 8 + w.wave; w.ngw = w.nblk * 8;
    unsigned char* ws = a.ws;
    volatile LAS unsigned* misc = (volatile LAS unsigned*)(lds + LDS_MISC);
    if (w.tid < 4) misc[w.tid] = 0u;
    __syncthreads();
    XcdBarrier bar; bar.bar = (unsigned*)(ws + WS_CTL) + 4096; bar.x = 0; bar.st = misc;
#if !MK_PER_PHASE
    bar = xcd_barrier_post((unsigned*)(ws + WS_CTL) + 4096, misc);
#endif
    const int lo = a.ph_lo, hi = a.ph_hi;
#define IN(k) (lo <= (k) && (k) < hi)
#if MK_PER_PHASE
#define SEAM(k) do { } while (0)
#else
#define SEAM(k) do { if (IN(k) && IN((k) + 1)) xcd_barrier(bar); } while (0)
#endif
    LAS float* wlds = (LAS float*)(lds + w.wave * 16384);
    bf16_t* XB = (bf16_t*)(ws + WS_XB); float* HF = (float*)(ws + WS_HF); float* RES = (float*)(ws + WS_RES); bf16_t* PROJ = (bf16_t*)(ws + WS_PROJ);
    bf16_t* ATT = (bf16_t*)(ws + WS_ATT); float* SMALL = (float*)(ws + WS_SMALL);

#define FAST_GEMM(EPI_T, Aptr, lda_, Btptr, ldb_, M_, N_, K_, nz_, zA_, zB_, EPI_OBJ) do { \
        pg8::Gemm g_{Aptr, Btptr, M_, N_, K_, lda_, ldb_, zA_, zB_, nz_}; pg8::StaticOrder S_; S_.init(M_, N_, nz_, w.nblk, w.bid); \
        pg8::gemm_phase<EPI_T, pg8::StaticOrder>(lds, g_, S_, EPI_OBJ); } while (0)
    if (IN(0)) { ph_convert(a, lds, w); if (PROBE_DUP == 0) ph_convert(a, lds, w); }
    SEAM(0);
    if (IN(1)) {
        FAST_GEMM(pg8::EpiBf16, XB, DM, (const bf16_t*)(ws + WS_W_AB_IN), DM, T, AB_MAIN, DM, 1, 0, 0, (pg8::EpiBf16{PROJ, AB_MAIN, nullptr}));
        naive_gemm(XB, DM, (const bf16_t*)(ws + WS_W_AB_IN) + (size_t)AB_MAIN * DM, DM, T, 64, DM, w, [=](int m, int n, float v) { SMALL[(size_t)m * 128 + n] = v; });
        bf16_t* KVM = (bf16_t*)(ws + WS_KVM);
        naive_gemm((const bf16_t*)(ws + WS_MEMB), DM, (const bf16_t*)(ws + WS_W_MEM_KV), DM, 512, 2048, DM, w,
                   [=](int m, int n, float v) { KVM[((size_t)(n >> 10) * 512 + m) * 1024 + (n & 1023)] = (bf16_t)f2bf(v); });
    }
    SEAM(1);
    if (IN(2)) ph_l0_stats(a, w);
    SEAM(2);
    if (IN(3)) {
        const float* rsq = (const float*)(ws + WS_RSQ); const float* rskv = (const float*)(ws + WS_RSKV);
        bf16_t* QB = (bf16_t*)(ws + WS_QB); bf16_t* KVB = (bf16_t*)(ws + WS_KVB);
        FAST_GEMM(pg8::EpiBf16, PROJ + 6144, AB_MAIN, (const bf16_t*)(ws + WS_W_UQ), 1536, T, 3072, 1536, 1, 0, 0, (pg8::EpiBf16{QB, 3072, rsq}));
        FAST_GEMM(pg8::EpiBf16, PROJ + 7680, AB_MAIN, (const bf16_t*)(ws + WS_W_UKV), 512, T, 4096, 512, 1, 0, 0, (pg8::EpiBf16{KVB, 4096, rskv}));
    }
    SEAM(3);
    if (IN(4)) ph_l0_qrope(a, w);
    SEAM(4);
    if (IN(5)) { ph_attn_l0(a, lds, w); if (PROBE_DUP == 5) ph_attn_l0(a, lds, w); }
    SEAM(5);
    if (IN(6)) { const float* X = a.in[I_X];
        FAST_GEMM(pg8::EpiResid, ATT, DM, (const bf16_t*)(ws + WS_W_AB_OUT), DM, T, DM, DM, 1, 0, 0, (pg8::EpiResid{X, RES, DM})); }
    SEAM(6);
    if (IN(7)) ln_rows(RES, a.in[I_LN_G] + 0 * DM, a.in[I_LN_B] + 0 * DM, HF, XB, w);
    SEAM(7);

#define MEM_PEER_PHASES(L, P0_, LAST)                                                                                                                         \
    if (IN(P0_)) { FAST_GEMM(pg8::EpiF32, XB, DM, (const bf16_t*)(ws + WS_W_MEM_Q) + (size_t)(L) * 512 * DM, DM, T, 512, 1024, 4, 1024, 1024,                    \
                             (pg8::EpiF32{(float*)(ws + WS_MQP), 512, (long)T * 512})); }                                                                       \
    SEAM(P0_);                                                                                                                                                  \
    if (IN(P0_ + 1)) ph_attn_mem(a, (L), lds, w);                                                                                                               \
    SEAM(P0_ + 1);                                                                                                                                              \
    if (IN(P0_ + 2)) { FAST_GEMM(pg8::EpiResid, (const bf16_t*)(ws + WS_MEMO), 512, (const bf16_t*)(ws + WS_W_MEM_O) + (size_t)(L) * DM * 512, 512, T, DM, 512, 1, 0, 0, \
                                 (pg8::EpiResid{HF, RES, DM})); }                                                                                               \
    SEAM(P0_ + 2);                                                                                                                                              \
    if (IN(P0_ + 3)) ln_rows(RES, a.in[I_LN_G] + ((L) * 3 + 1) * DM, a.in[I_LN_B] + ((L) * 3 + 1) * DM, HF, XB, w);                                             \
    SEAM(P0_ + 3);                                                                                                                                              \
    if (IN(P0_ + 4)) { FAST_GEMM(pg8::EpiF32, (const bf16_t*)(ws + WS_W_PEER) + (size_t)(L) * 2048 * DM, DM, XB, DM, 2048, T, DM, 1, 0, 0,                     \
                                 (pg8::EpiF32{(float*)(ws + WS_PSCORE), T, 0})); }                                                                              \
    SEAM(P0_ + 4);                                                                                                                                              \
    if (IN(P0_ + 5)) { ph_peer_topk(a, w); if (PROBE_DUP == 27 && (LAST)) ph_peer_topk(a, w); }                                                                 \
    SEAM(P0_ + 5);                                                                                                                                              \
    if (IN(P0_ + 6)) { ph_peer_experts(a, (L), (LAST) ? a.out : HF, (LAST) ? (bf16_t*)nullptr : XB, a.in[I_LN_G] + ((L) * 3 + 2) * DM, a.in[I_LN_B] + ((L) * 3 + 2) * DM, wlds, w); \
        if (PROBE_DUP == 28 && (LAST)) ph_peer_experts(a, (L), a.out, (bf16_t*)nullptr, a.in[I_LN_G] + ((L) * 3 + 2) * DM, a.in[I_LN_B] + ((L) * 3 + 2) * DM, wlds, w); } \
    if (!(LAST)) SEAM(P0_ + 6);

    MEM_PEER_PHASES(0, 8, false)

    if (IN(15)) {
        FAST_GEMM(pg8::EpiBf16, XB, DM, (const bf16_t*)(ws + WS_W_CD_IN), DM, T, CD_MAIN, DM, 1, 0, 0, (pg8::EpiBf16{PROJ, CD_MAIN, nullptr}));
        naive_gemm(XB, DM, (const bf16_t*)(ws + WS_W_CD_IN) + (size_t)CD_MAIN * DM, DM, T, 112, DM, w, [=](int m, int n, float v) { SMALL[(size_t)m * 128 + n] = v; });
    }
    SEAM(15);
    if (IN(16)) ph_l1_elem(a, w);
    SEAM(16);
    if (IN(17)) { ph_l1_scan(a, w); ph_l1_index(a, lds, w); if (PROBE_DUP == 17) ph_l1_index(a, lds, w); }
    SEAM(17);
    if (IN(18)) { ph_l1_select(a, w); if (PROBE_DUP == 18) ph_l1_select(a, w); }
    SEAM(18);
    if (IN(19)) { ph_attn_l1(a, lds, w); if (PROBE_DUP == 19) ph_attn_l1(a, lds, w); }
    SEAM(19);
    if (IN(20)) { FAST_GEMM(pg8::EpiResid, ATT, DM, (const bf16_t*)(ws + WS_W_CD_OUT), DM, T, DM, DM, 1, 0, 0, (pg8::EpiResid{HF, RES, DM})); }
    SEAM(20);
    if (IN(21)) ln_rows(RES, a.in[I_LN_G] + 3 * DM, a.in[I_LN_B] + 3 * DM, HF, XB, w);
    SEAM(21);
    MEM_PEER_PHASES(1, 22, true)
#undef IN
#undef SEAM
}

extern "C" void kernel_launch(void* const* d_in, const int* in_sizes, int n_in, void* d_out, int out_size, void* d_ws, size_t ws_size, hipStream_t stream) {
    static int grid = 0;
    if (grid == 0) {
        if (n_in != 21 || out_size != T * DM || ws_size < WS_END) { fprintf(stderr, "kernel_launch: unexpected shapes (n_in %d out %d ws %zu need %zu)\n", n_in, out_size, ws_size, (size_t)WS_END); grid = -1; return; }
        int dev = 0, cus = 0, per_cu = 0;
        if (hipGetDevice(&dev) != hipSuccess || hipDeviceGetAttribute(&cus, hipDeviceAttributeMultiprocessorCount, dev) != hipSuccess) { grid = -1; return; }
        if (hipFuncSetAttribute((const void*)mega, hipFuncAttributeMaxDynamicSharedMemorySize, LDS_BYTES) != hipSuccess) { fprintf(stderr, "kernel_launch: hipFuncSetAttribute failed\n"); grid = -1; return; }
        if (hipOccupancyMaxActiveBlocksPerMultiprocessor(&per_cu, (const void*)mega, 512, LDS_BYTES) != hipSuccess || per_cu < 1) { fprintf(stderr, "kernel_launch: occupancy query says %d\n", per_cu); }
        (void)hipGetLastError();
        grid = cus;
    }
    if (grid < 0) return;
    (void)hipMemsetAsync((char*)d_ws + WS_CTL, 0, CTL_BYTES, stream);
    Args a{};
    for (int i = 0; i < 21; ++i) a.in[i] = (const float*)d_in[i];
    a.out = (float*)d_out; a.ws = (unsigned char*)d_ws;
#if MK_PER_PHASE
    for (int p = 0; p < NPHASE; ++p) { a.ph_lo = p; a.ph_hi = p + 1; hipLaunchKernelGGL(mega, dim3(grid), dim3(512), LDS_BYTES, stream, a); }
#else
    a.ph_lo = 0; a.ph_hi = NPHASE;
    hipLaunchKernelGGL(mega, dim3(grid), dim3(512), LDS_BYTES, stream, a);
#endif
}
```

```cpp
#include <hip/hip_runtime.h>
#include <cstdio>
#include <cstdint>

#define GAS __attribute__((address_space(1)))
#define LAS __attribute__((address_space(3)))
typedef unsigned short bf16_t;
typedef short bf16x8 __attribute__((ext_vector_type(8)));
typedef float f32x4 __attribute__((ext_vector_type(4)));
typedef float f32x16 __attribute__((ext_vector_type(16)));
typedef unsigned u32x4 __attribute__((ext_vector_type(4)));
typedef unsigned u32x2 __attribute__((ext_vector_type(2)));
typedef float f32x2 __attribute__((ext_vector_type(2)));

#ifndef PROBE_DUP
#define PROBE_DUP -1
#endif
#ifndef MK_PER_PHASE
#define MK_PER_PHASE 0
#endif

constexpr int NB = 2, SEQ = 4096, T = NB * SEQ, DM = 4096;
constexpr int AB_COLS = 8256, AB_MAIN = 8192, AB_PAD = 8448;
constexpr int CD_COLS = 11376, CD_MAIN = 11264, CD_PAD = 11520;
constexpr float ALPHA = 1.4142135623730951f;
constexpr float LN_EPS = 1e-5f, RMS_EPS = 1e-6f;
constexpr int NPHASE = 29;

constexpr size_t MiB = 1ull << 20;
constexpr size_t WS_CTL = 0, CTL_BYTES = 1 * MiB;
constexpr size_t WS_ROPE128 = 1 * MiB;
constexpr size_t WS_ROPE64 = 3 * MiB;
constexpr size_t WS_RSQ = 4 * MiB;
constexpr size_t WS_RSKV = 4 * MiB + 65536;
constexpr size_t WS_CUM = 5 * MiB;
constexpr size_t WS_LOGF = 5 * MiB + 524288;
constexpr size_t WS_KR = 6 * MiB;
constexpr size_t WS_KI = 7 * MiB;
constexpr size_t WS_WI = 8 * MiB;
constexpr size_t WS_KVM = 9 * MiB;
constexpr size_t WS_MEMB = 11 * MiB;
constexpr size_t WS_MASK = 15 * MiB;
constexpr size_t WS_PIDX = 19 * MiB;
constexpr size_t WS_PGATE = 23 * MiB;
constexpr size_t WS_MEMQ = 27 * MiB;
constexpr size_t WS_MEMO = 35 * MiB;
constexpr size_t WS_SMALL = 43 * MiB;
constexpr size_t WS_W_AB_IN = 64 * MiB;
constexpr size_t WS_W_UQ = 130 * MiB;
constexpr size_t WS_W_UKV = 139 * MiB;
constexpr size_t WS_W_AB_OUT = 143 * MiB;
constexpr size_t WS_W_CD_IN = 175 * MiB;
constexpr size_t WS_W_CD_OUT = 265 * MiB;
constexpr size_t WS_W_MEM_Q = 297 * MiB;
constexpr size_t WS_W_MEM_KV = 305 * MiB;
constexpr size_t WS_W_MEM_O = 321 * MiB;
constexpr size_t WS_W_PEER = 329 * MiB;
constexpr size_t WS_U8 = 361 * MiB;
constexpr size_t WS_V8 = 489 * MiB;
constexpr size_t WS_USC = 48 * MiB;
constexpr size_t WS_VSC = 48 * MiB + 262144;
constexpr size_t WS_XB = 873 * MiB;
constexpr size_t WS_HF = 937 * MiB;
constexpr size_t WS_RES = 1065 * MiB;
constexpr size_t WS_PROJ = 1193 * MiB;
constexpr size_t WS_PSCORE = WS_PROJ;
constexpr size_t WS_ATT = 1369 * MiB;
constexpr size_t WS_QB = 1433 * MiB;
constexpr size_t WS_KVB = 1481 * MiB;
constexpr size_t WS_SCORE = 1433 * MiB;
constexpr size_t WS_MQP = 1561 * MiB;
constexpr size_t WS_END = 1625 * MiB;

constexpr int LDS_BYTES = 147456;
constexpr int LDS_MISC = 140 * 1024;

#define LDS_WAIT() asm volatile("s_waitcnt lgkmcnt(0)" ::: "memory")
__device__ __forceinline__ float bf2f(bf16_t b) { return __uint_as_float(((unsigned)b) << 16); }
__device__ __forceinline__ unsigned f2bf(float f) { unsigned u = __float_as_uint(f); return (u + 0x7fffu + ((u >> 16) & 1u)) >> 16; }
__device__ __forceinline__ unsigned pk2(float lo, float hi) { return f2bf(lo) | (f2bf(hi) << 16); }
__device__ __forceinline__ float wave_sum(float v) {
#pragma unroll
    for (int o = 1; o < 64; o <<= 1) v += __shfl_xor(v, o);
    return v;
}
__device__ __forceinline__ float wave_max(float v) {
#pragma unroll
    for (int o = 1; o < 64; o <<= 1) v = fmaxf(v, __shfl_xor(v, o));
    return v;
}
__device__ __forceinline__ int wave_sum_i(int v) {
#pragma unroll
    for (int o = 1; o < 64; o <<= 1) v += __shfl_xor(v, o);
    return v;
}

#define XB_TMO      128
#define XB_XCNT(j)  (256  + 64 * (j))
#define XB_XSUB(j)  (1280 + 64 * (j))
#define XB_XGEN(j)  (2304 + 64 * (j))
#define XB_TOP      3328
#define XB_TOPGEN   3392
#define XCD_BAR_WORDS 3456
#define XB_SPIN_CAP (1u << 22)

__device__ __forceinline__ unsigned xb_ld(unsigned* p)              { return __hip_atomic_load(p, __ATOMIC_RELAXED, __HIP_MEMORY_SCOPE_AGENT); }
__device__ __forceinline__ unsigned xb_add(unsigned* p, unsigned v) { return __hip_atomic_fetch_add(p, v, __ATOMIC_RELAXED, __HIP_MEMORY_SCOPE_AGENT); }
__device__ __forceinline__ unsigned xb_xcc_id() { return (unsigned)__builtin_amdgcn_s_getreg((3 << 11) | 20) & 0xFu; }
#define XB_SPIN(cond, bar) do { unsigned _sp = 0; while (cond) { __builtin_amdgcn_s_sleep(1); \
    if ((++_sp & 255u) == 0u) { if (xb_ld(&(bar)[XB_TMO])) break; if (_sp > XB_SPIN_CAP) { atomicAdd(&(bar)[XB_TMO], 1u); break; } } } } while (0)

struct XcdBarrier { unsigned* bar; unsigned x; volatile LAS unsigned* st; };

__device__ __forceinline__ XcdBarrier xcd_barrier_post(unsigned* bar, volatile LAS unsigned* st) {
    XcdBarrier b; b.bar = bar; b.x = xb_xcc_id(); b.st = st;
    if (threadIdx.x == 0) (void)xb_add(&bar[XB_XCNT(b.x)], 1u);
    return b;
}
__device__ __forceinline__ void xcd_barrier_complete(unsigned* bar, unsigned x, unsigned& nloc, unsigned& nx) {
    const unsigned G = gridDim.x * gridDim.y * gridDim.z;
    unsigned sum, cnt, mine, sp = 0u;
    for (;;) {
        sum = 0u; cnt = 0u; mine = 0u;
#pragma unroll
        for (unsigned j = 0; j < 16; ++j) { const unsigned c = xb_ld(&bar[XB_XCNT(j)]); sum += c; cnt += (c > 0u) ? 1u : 0u; mine = (j == x) ? c : mine; }
        if (sum == G) break;
        __builtin_amdgcn_s_sleep(1);
        if ((++sp & 255u) == 0u) { if (xb_ld(&bar[XB_TMO])) break; if (sp > XB_SPIN_CAP) { atomicAdd(&bar[XB_TMO], 1u); break; } }
    }
    nloc = mine > 0u ? mine : 1u; nx = cnt > 0u ? cnt : 1u;
}
__device__ __forceinline__ void xcd_barrier(const XcdBarrier& b) {
    asm volatile("s_waitcnt vmcnt(0)" ::: "memory");
    __syncthreads();
    if (threadIdx.x == 0) {
        unsigned* bar = b.bar;
        __builtin_amdgcn_s_waitcnt(0);
        unsigned nloc = b.st[0], nx = b.st[1];
        if (nloc == 0u) { xcd_barrier_complete(bar, b.x, nloc, nx); b.st[0] = nloc; b.st[1] = nx; }
        const unsigned old = xb_add(&bar[XB_XSUB(b.x)], 1u);
        const unsigned gen = old / nloc;
        if (old + 1u == (gen + 1u) * nloc) {
            __builtin_amdgcn_fence(__ATOMIC_RELEASE, "agent");
            asm volatile("s_waitcnt vmcnt(0)" ::: "memory");
            const unsigned og = xb_add(&bar[XB_TOP], 1u);
            const unsigned tg = og / nx;
            if (og + 1u == (tg + 1u) * nx) xb_add(&bar[XB_TOPGEN], 1u);
            else XB_SPIN(xb_ld(&bar[XB_TOPGEN]) == tg, bar);
            __builtin_amdgcn_fence(__ATOMIC_ACQUIRE, "agent");
            xb_add(&bar[XB_XGEN(b.x)], 1u);
            asm volatile("s_waitcnt vmcnt(0)" ::: "memory");
        } else {
            XB_SPIN(xb_ld(&bar[XB_XGEN(b.x)]) == gen, bar);
            __builtin_amdgcn_fence(__ATOMIC_ACQUIRE, "agent");
            asm volatile("s_waitcnt vmcnt(0)" ::: "memory");
        }
    }
    __syncthreads();
}

namespace pg8 {
constexpr int BM = 256, BK = 64, HALF = 128, HTB = HALF * BK * 2, STAGE_BYTES = 8 * HTB, NXCD = 8, WGM = 8;
__host__ __device__ __forceinline__ int lds_byte(int r, int c) { const int st = (r >> 4) * 2 + (c >> 5), rr = r & 15, cc = c & 31, ob = rr * 64 + cc * 2; return st * 1024 + (ob ^ (((ob >> 9) & 1) << 5)); }
__host__ __device__ __forceinline__ void stage_rc(int b, int& R, int& C) { const int st = b / 1024, sb = b % 1024, swz = sb ^ (((sb >> 9) & 1) << 5); R = (st >> 1) * 16 + swz / 64; C = (st & 1) * 32 + (swz % 64) / 2; }
__host__ __device__ __forceinline__ int perm32(int rho) { const int n = rho >> 4, i = rho & 15; return 8 * (i >> 2) + 4 * n + (i & 3); }
struct Unit { int pm, pn, z; };
struct Gemm { const bf16_t* A; const bf16_t* Bt; int M, N, K, lda, ldb; long zA, zB; int nz; };
struct StaticOrder {
    int nM, nN, nZ, nwg, G, c;
    __device__ void init(int M, int N, int Z, int G_, int c_) { nM = M / BM; nN = N / BM; nZ = Z; nwg = nM * nN * nZ; G = G_; c = c_; }
    __device__ bool next(int i, Unit& u) const {
        const long L = (long)i * G + c; if (L >= nwg) return false;
        int wgid = (int)L; { const int q = nwg / NXCD, r = nwg % NXCD, xcd = wgid % NXCD, off = wgid / NXCD; wgid = (xcd < r ? xcd * (q + 1) : r * (q + 1) + (xcd - r) * q) + off; }
        const int per = nM * nN; u.z = wgid / per; wgid -= u.z * per;
        const int nig = WGM * nN, gid = wgid / nig, fm = gid * WGM, gsz = (nM - fm) < WGM ? (nM - fm) : WGM;
        u.pm = fm + ((wgid % nig) % gsz); u.pn = (wgid % nig) / gsz; return true;
    }
};
__device__ __forceinline__ unsigned cvt_pk_bf16(float lo, float hi) { unsigned r; asm volatile("v_cvt_pk_bf16_f32 %0, %1, %2" : "=v"(r) : "v"(lo), "v"(hi)); return r; }
struct EpiF32 {
    static constexpr bool PERM = false;
    float* C; int ldc; long zC;
    __device__ __forceinline__ void operator()(const f32x4 (&acc)[2][2][4][2], const Unit& u, int wr, int wc, int fr, int fq) const {
        const int row0 = u.pm * BM + wr * 64 + fr, col0 = u.pn * BM + wc * 32 + 4 * fq; float* Cz = C + (size_t)u.z * zC;
#pragma unroll
        for (int ai = 0; ai < 2; ++ai)
#pragma unroll
            for (int m = 0; m < 4; ++m) { float* rowp = Cz + (size_t)(row0 + ai * HALF + m * 16) * ldc + col0;
#pragma unroll
                for (int bj = 0; bj < 2; ++bj)
#pragma unroll
                    for (int n = 0; n < 2; ++n) *(f32x4*)(rowp + bj * HALF + n * 16) = acc[ai][bj][m][n]; }
    }
};
struct EpiResid {
    static constexpr bool PERM = false;
    const float* base; float* out; int ldc;
    __device__ __forceinline__ void operator()(const f32x4 (&acc)[2][2][4][2], const Unit& u, int wr, int wc, int fr, int fq) const {
        const int row0 = u.pm * BM + wr * 64 + fr, col0 = u.pn * BM + wc * 32 + 4 * fq;
#pragma unroll
        for (int ai = 0; ai < 2; ++ai)
#pragma unroll
            for (int m = 0; m < 4; ++m) { const size_t off = (size_t)(row0 + ai * HALF + m * 16) * ldc + col0;
#pragma unroll
                for (int bj = 0; bj < 2; ++bj)
#pragma unroll
                    for (int n = 0; n < 2; ++n) { const f32x4 bs = *(const f32x4*)(base + off + bj * HALF + n * 16); *(f32x4*)(out + off + bj * HALF + n * 16) = bs * ALPHA + acc[ai][bj][m][n]; }
                asm volatile("" ::: "memory"); }
    }
};
struct EpiBf16 {
    static constexpr bool PERM = true;
    bf16_t* O; int ldc; const float* rs;
    __device__ __forceinline__ void operator()(const f32x4 (&acc)[2][2][4][2], const Unit& u, int wr, int wc, int fr, int fq) const {
        const int row0 = u.pm * BM + wr * 64 + fr, col0 = u.pn * BM + wc * 32 + 8 * fq;
#pragma unroll
        for (int ai = 0; ai < 2; ++ai)
#pragma unroll
            for (int m = 0; m < 4; ++m) { const int row = row0 + ai * HALF + m * 16; bf16_t* rowp = O + (size_t)row * ldc + col0; const float sc = rs ? rs[row] : 1.f;
#pragma unroll
                for (int bj = 0; bj < 2; ++bj) { const f32x4 v0 = acc[ai][bj][m][0] * sc, v1 = acc[ai][bj][m][1] * sc;
                    u32x4 wv; wv.x = cvt_pk_bf16(v0[0], v0[1]); wv.y = cvt_pk_bf16(v0[2], v0[3]); wv.z = cvt_pk_bf16(v1[0], v1[1]); wv.w = cvt_pk_bf16(v1[2], v1[3]);
                    *(u32x4*)(rowp + bj * HALF) = wv; } }
    }
};
template <class Epi, class Sched>
__device__ __forceinline__ void gemm_phase(LAS unsigned char* lds, const Gemm g, const Sched& S, const Epi& E) {
    const int tid = threadIdx.x, wid = __builtin_amdgcn_readfirstlane(tid >> 6), lane = tid & 63, wr = wid >> 2, wc = wid & 3, fr = lane & 15, fq = lane >> 4;
    const int K = g.K, nt = K / BK;
    unsigned voffA[2], voffB[2];
#pragma unroll
    for (int i = 0; i < 2; ++i) { int R, C; stage_rc(tid * 16 + i * 8192, R, C); const int Rb = Epi::PERM ? ((R & ~31) + perm32(R & 31)) : R;
        voffA[i] = (unsigned)(R * g.lda + C) * 2u; voffB[i] = (unsigned)(Rb * g.ldb + C) * 2u; }
    const size_t kstep = (size_t)(BK * 2);
    const size_t hA = (size_t)HALF * g.lda * 2, hB = (size_t)HALF * g.ldb * 2;
    const size_t tA = 2 * hA, tB = 2 * hB;
    const unsigned ldsw = (unsigned)wid * 1024u;
    const int aoff = lds_byte(wr * 64 + fr, fq * 8), boff = lds_byte(wc * 32 + fr, fq * 8);
#define PG8_SA(b, h) (((b) * 2 + (h)) * HTB)
#define PG8_SB(b, h) ((4 + (b) * 2 + (h)) * HTB)
#define PG8_STAGE(bufoff, gbase, voff) do { _Pragma("unroll") for (int _i = 0; _i < 2; ++_i) \
        __builtin_amdgcn_global_load_lds((const unsigned*)((const char*)(gbase) + (voff)[_i]), (LAS unsigned*)(lds + (bufoff) + ldsw + _i * 8192), 16, 0, 0); } while (0)
#define PG8_LDA(dst, b, h) do { _Pragma("unroll") for (int m = 0; m < 4; ++m) _Pragma("unroll") for (int k = 0; k < 2; ++k) dst[m][k] = *(const LAS bf16x8*)(lds + PG8_SA(b, h) + aoff + m * 2048 + k * 1024); } while (0)
#define PG8_LDB(dst, b, h) do { _Pragma("unroll") for (int n = 0; n < 2; ++n) _Pragma("unroll") for (int k = 0; k < 2; ++k) dst[n][k] = *(const LAS bf16x8*)(lds + PG8_SB(b, h) + boff + n * 2048 + k * 1024); } while (0)
#define PG8_MMA(ai, bj, At, Bt) do { __builtin_amdgcn_s_setprio(1); _Pragma("unroll") for (int m = 0; m < 4; ++m) _Pragma("unroll") for (int n = 0; n < 2; ++n) _Pragma("unroll") for (int k = 0; k < 2; ++k) \
        acc[ai][bj][m][n] = __builtin_amdgcn_mfma_f32_16x16x32_bf16(Bt[n][k], At[m][k], acc[ai][bj][m][n], 0, 0, 0); __builtin_amdgcn_s_setprio(0); } while (0)
#define PG8_WAIT_V(n) asm volatile("s_waitcnt vmcnt(" #n ")" ::: "memory")
#define PG8_WAIT_L(n) asm volatile("s_waitcnt lgkmcnt(" #n ")" ::: "memory")
#define PG8_BAR __builtin_amdgcn_s_barrier()
#define PG8_SCHED __builtin_amdgcn_sched_barrier(0)
    Unit cur, nxt; int ui = 0;
    if (!S.next(0, cur)) return;
    f32x4 acc[2][2][4][2];
#pragma unroll
    for (int a = 0; a < 2; ++a)
#pragma unroll
        for (int b = 0; b < 2; ++b)
#pragma unroll
            for (int m = 0; m < 4; ++m)
#pragma unroll
                for (int n = 0; n < 2; ++n) acc[a][b][m][n] = (f32x4){0.f, 0.f, 0.f, 0.f};
    bf16x8 At[4][2], B0[2][2], B1[2][2];
    const char* cA = (const char*)g.A + (size_t)cur.pm * tA + (size_t)cur.z * g.zA * 2; const char* cB = (const char*)g.Bt + (size_t)cur.pn * tB + (size_t)cur.z * g.zB * 2;
    PG8_STAGE(PG8_SB(0, 0), cB, voffB); PG8_STAGE(PG8_SA(0, 0), cA, voffA); PG8_STAGE(PG8_SB(0, 1), cB + hB, voffB); PG8_STAGE(PG8_SA(0, 1), cA + hA, voffA);
    if (wr == 1) PG8_BAR;
    PG8_WAIT_V(4); PG8_BAR;
    PG8_STAGE(PG8_SB(1, 0), cB + kstep, voffB); PG8_STAGE(PG8_SA(1, 0), cA + kstep, voffA); PG8_STAGE(PG8_SB(1, 1), cB + hB + kstep, voffB);
    PG8_WAIT_V(6); PG8_BAR;
    for (;;) {
        const bool has_next = S.next(ui + 1, nxt);
        const char* nA = has_next ? (const char*)g.A + (size_t)nxt.pm * tA + (size_t)nxt.z * g.zA * 2 : cA; const char* nB = has_next ? (const char*)g.Bt + (size_t)nxt.pn * tB + (size_t)nxt.z * g.zB * 2 : cB;
        for (int t = 0; t < nt; t += 2) {
            const bool last = (t == nt - 2);
            const char* a1 = cA + (size_t)(t + 1) * kstep;
            const char* a2 = last ? nA : cA + (size_t)(t + 2) * kstep; const char* b2 = last ? nB : cB + (size_t)(t + 2) * kstep;
            const char* a3 = a2 + kstep; const char* b3 = b2 + kstep;
            PG8_LDB(B0, 0, 0); PG8_SCHED; PG8_LDA(At, 0, 0); PG8_STAGE(PG8_SA(1, 1), a1 + hA, voffA);
            PG8_WAIT_L(8); PG8_BAR; PG8_WAIT_L(0); PG8_MMA(0, 0, At, B0); PG8_BAR; PG8_SCHED;
            PG8_LDB(B1, 0, 1); PG8_STAGE(PG8_SB(0, 0), b2, voffB);
            PG8_BAR; PG8_WAIT_L(0); PG8_MMA(0, 1, At, B1); PG8_BAR;
            PG8_LDA(At, 0, 1); PG8_STAGE(PG8_SA(0, 0), a2, voffA);
            PG8_BAR; PG8_WAIT_L(0); PG8_MMA(1, 0, At, B0); PG8_BAR; PG8_SCHED;
            PG8_STAGE(PG8_SB(0, 1), b2 + hB, voffB);
            PG8_WAIT_V(6); PG8_BAR; PG8_MMA(1, 1, At, B1); PG8_BAR;
            PG8_LDB(B0, 1, 0); PG8_SCHED; PG8_LDA(At, 1, 0); PG8_STAGE(PG8_SA(0, 1), a2 + hA, voffA);
            PG8_WAIT_L(8); PG8_BAR; PG8_WAIT_L(0); PG8_MMA(0, 0, At, B0); PG8_BAR; PG8_SCHED;
            PG8_LDB(B1, 1, 1); PG8_STAGE(PG8_SB(1, 0), b3, voffB);
            PG8_BAR; PG8_WAIT_L(0); PG8_MMA(0, 1, At, B1); PG8_BAR;
            PG8_LDA(At, 1, 1); PG8_STAGE(PG8_SA(1, 0), a3, voffA);
            PG8_BAR; PG8_WAIT_L(0); PG8_MMA(1, 0, At, B0); PG8_BAR; PG8_SCHED;
            PG8_STAGE(PG8_SB(1, 1), b3 + hB, voffB);
            PG8_WAIT_V(6); PG8_BAR; PG8_MMA(1, 1, At, B1); PG8_BAR;
        }
        E(acc, cur, wr, wc, fr, fq);
        if (!has_next) break;
#pragma unroll
        for (int a = 0; a < 2; ++a)
#pragma unroll
            for (int b = 0; b < 2; ++b)
#pragma unroll
                for (int m = 0; m < 4; ++m)
#pragma unroll
                    for (int n = 0; n < 2; ++n) acc[a][b][m][n] = (f32x4){0.f, 0.f, 0.f, 0.f};
        cur = nxt; cA = nA; cB = nB; ++ui;
    }
    PG8_WAIT_V(0);
    if (wr == 0) PG8_BAR;
    PG8_BAR;
#undef PG8_SA
#undef PG8_SB
#undef PG8_STAGE
#undef PG8_LDA
#undef PG8_LDB
#undef PG8_MMA
#undef PG8_WAIT_V
#undef PG8_WAIT_L
#undef PG8_BAR
#undef PG8_SCHED
}
}

struct Args { const float* in[21]; float* out; unsigned char* ws; int ph_lo, ph_hi; };
enum { I_X = 0, I_MEM, I_AB_W_IN, I_A_REL_BIAS, I_B_Q_NORM, I_B_W_UQ, I_B_KV_NORM, I_B_W_UKV, I_AB_W_OUT, I_CD_W_IN, I_D_FORGET_BIAS, I_CD_W_OUT,
       I_MEM_W_Q, I_MEM_W_KV, I_MEM_W_O, I_PEER_W_Q, I_PEER_SUB_KEYS, I_PEER_U, I_PEER_V, I_LN_G, I_LN_B };

struct WI { int tid, lane, wave, gw, ngw, bid, nblk; };

__device__ __forceinline__ void tr_item(const float* W, int K, int ld, int c0, int nc, bf16_t* WT, int r0, const float* scale, LAS float* scr, int item, int lane) {
    const int nblk = (nc + 31) >> 5, kb = item / nblk, nb = item - kb * nblk, k0 = 64 * kb, n0 = 32 * nb;
    const int nn = n0 + (lane & 31); const bool ok = nn < nc;
#pragma unroll 8
    for (int i = 0; i < 32; ++i) { const int kk = 2 * i + (lane >> 5); float v = ok ? W[(size_t)(k0 + kk) * ld + c0 + nn] : 0.f; if (scale) v *= scale[k0 + kk]; scr[kk * 33 + (lane & 31)] = v; }
    LDS_WAIT();
    const int c = lane & 7;
#pragma unroll
    for (int j = 0; j < 4; ++j) { const int n = (lane >> 3) + 8 * j; const LAS float* s = scr + (8 * c) * 33 + n;
        u32x4 o; o.x = pk2(s[0 * 33], s[1 * 33]); o.y = pk2(s[2 * 33], s[3 * 33]); o.z = pk2(s[4 * 33], s[5 * 33]); o.w = pk2(s[6 * 33], s[7 * 33]);
        if (n0 + n < nc) *(u32x4*)(WT + (size_t)(r0 + n0 + n) * K + k0 + 8 * c) = o; }
    LDS_WAIT();
}
__device__ __forceinline__ void cvt_rows(const float* src, bf16_t* dst, size_t n, size_t i0, size_t stride) {
    for (size_t i = i0 * 8; i < n; i += stride * 8) {
        const f32x4 a = *(const f32x4*)(src + i), b = *(const f32x4*)(src + i + 4);
        u32x4 o; o.x = pk2(a.x, a.y); o.y = pk2(a.z, a.w); o.z = pk2(b.x, b.y); o.w = pk2(b.z, b.w);
        *(u32x4*)(dst + i) = o;
    }
}
__device__ __forceinline__ void ph_convert(const Args& a, LAS unsigned char* lds, const WI& w) {
    unsigned char* ws = a.ws;
    LAS float* scr = (LAS float*)(lds + w.wave * 16384);
    constexpr int J1 = 64 * 258, J2 = 24 * 96, J3 = 8 * 128, J4 = 64 * 128, J5 = 64 * 160, J6 = 64 * 192, J7 = 64 * 3, J8 = 64 * 1, J9 = 64 * 128,
                  J10 = 64 * 16, J12 = 64 * 32, J14 = 8 * 128;
    constexpr int NJ = J1 + J2 + J3 + J4 + J5 + J6 + J7 + J8 + J9 + 2 * J10 + 2 * J12 + 2 * J14;
    for (int it = w.gw; it < NJ; it += w.ngw) {
        int r = it; const float* src; int K, ld, c0 = 0, nc, r0 = 0; bf16_t* dst; const float* sc = nullptr;
        if (r < J1) { src = a.in[I_AB_W_IN]; K = 4096; ld = AB_COLS; nc = AB_COLS; dst = (bf16_t*)(ws + WS_W_AB_IN); }
        else if ((r -= J1) < J2) { src = a.in[I_B_W_UQ]; K = 1536; ld = 3072; nc = 3072; dst = (bf16_t*)(ws + WS_W_UQ); sc = a.in[I_B_Q_NORM]; }
        else if ((r -= J2) < J3) { src = a.in[I_B_W_UKV]; K = 512; ld = 4096; nc = 4096; dst = (bf16_t*)(ws + WS_W_UKV); sc = a.in[I_B_KV_NORM]; }
        else if ((r -= J3) < J4) { src = a.in[I_AB_W_OUT]; K = 4096; ld = 4096; nc = 4096; dst = (bf16_t*)(ws + WS_W_AB_OUT); }
        else if ((r -= J4) < J5) { src = a.in[I_CD_W_IN]; K = 4096; ld = CD_COLS; c0 = 0; nc = 5120; r0 = 0; dst = (bf16_t*)(ws + WS_W_CD_IN); }
        else if ((r -= J5) < J6) { src = a.in[I_CD_W_IN]; K = 4096; ld = CD_COLS; c0 = 5216; nc = 6144; r0 = 5120; dst = (bf16_t*)(ws + WS_W_CD_IN); }
        else if ((r -= J6) < J7) { src = a.in[I_CD_W_IN]; K = 4096; ld = CD_COLS; c0 = 5120; nc = 96; r0 = 11264; dst = (bf16_t*)(ws + WS_W_CD_IN); }
        else if ((r -= J7) < J8) { src = a.in[I_CD_W_IN]; K = 4096; ld = CD_COLS; c0 = 11360; nc = 16; r0 = 11360; dst = (bf16_t*)(ws + WS_W_CD_IN); }
        else if ((r -= J8) < J9) { src = a.in[I_CD_W_OUT]; K = 4096; ld = 4096; nc = 4096; dst = (bf16_t*)(ws + WS_W_CD_OUT); }
        else if ((r -= J9) < 2 * J10) { const int l = r / J10; r -= l * J10; src = a.in[I_MEM_W_Q] + (size_t)l * 4096 * 512; K = 4096; ld = 512; nc = 512; dst = (bf16_t*)(ws + WS_W_MEM_Q) + (size_t)l * 512 * 4096; }
        else if ((r -= 2 * J10) < 2 * J12) { const int l = r / J12; r -= l * J12; src = a.in[I_MEM_W_KV] + (size_t)l * 4096 * 1024; K = 4096; ld = 1024; nc = 1024; dst = (bf16_t*)(ws + WS_W_MEM_KV) + (size_t)l * 1024 * 4096; }
        else { r -= 2 * J12; const int l = r / J14; r -= l * J14; src = a.in[I_MEM_W_O] + (size_t)l * 512 * 4096; K = 512; ld = 4096; nc = 4096; dst = (bf16_t*)(ws + WS_W_MEM_O) + (size_t)l * 4096 * 512; }
        tr_item(src, K, ld, c0, nc, dst, r0, sc, scr, r, w.lane);
    }
    { const size_t gt = (size_t)w.gw * 64 + w.lane, ng = (size_t)w.ngw * 64;
      bf16_t* p1 = (bf16_t*)(ws + WS_W_AB_IN) + (size_t)AB_COLS * 4096; const size_t n1 = (size_t)(AB_PAD - AB_COLS) * 4096;
      for (size_t i = gt * 8; i < n1; i += ng * 8) *(u32x4*)(p1 + i) = (u32x4){0u, 0u, 0u, 0u};
      bf16_t* p2 = (bf16_t*)(ws + WS_W_CD_IN) + (size_t)CD_COLS * 4096; const size_t n2 = (size_t)(CD_PAD - CD_COLS) * 4096;
      for (size_t i = gt * 8; i < n2; i += ng * 8) *(u32x4*)(p2 + i) = (u32x4){0u, 0u, 0u, 0u};
      cvt_rows(a.in[I_X], (bf16_t*)(ws + WS_XB), (size_t)T * DM, gt, ng);
      cvt_rows(a.in[I_MEM], (bf16_t*)(ws + WS_MEMB), (size_t)512 * DM, gt, ng);
      for (int r = w.gw; r < 65536; r += w.ngw) { const int tbl = r >> 15, rr = r & 32767;
          const float* srow = (tbl ? a.in[I_PEER_V] : a.in[I_PEER_U]) + (size_t)rr * DM;
          f32x4 v[16]; float amax = 0.f;
#pragma unroll
          for (int j = 0; j < 16; ++j) { v[j] = *(const f32x4*)(srow + 4 * w.lane + 256 * j); amax = fmaxf(amax, fmaxf(fmaxf(fabsf(v[j].x), fabsf(v[j].y)), fmaxf(fabsf(v[j].z), fabsf(v[j].w)))); }
          amax = wave_max(amax); const float s = amax > 0.f ? 256.f / amax : 1.f;
          unsigned* drow = (unsigned*)(ws + (tbl ? WS_V8 : WS_U8) + (size_t)rr * DM);
#pragma unroll
          for (int j = 0; j < 16; ++j) { int wv = 0; wv = __builtin_amdgcn_cvt_pk_fp8_f32(v[j].x * s, v[j].y * s, wv, false); wv = __builtin_amdgcn_cvt_pk_fp8_f32(v[j].z * s, v[j].w * s, wv, true); drow[64 * j + w.lane] = (unsigned)wv; }
          if (w.lane == 0) ((float*)(ws + (tbl ? WS_VSC : WS_USC)))[rr] = amax > 0.f ? amax * (1.f / 256.f) : 1.f; }
      float* r128 = (float*)(ws + WS_ROPE128); float* r64 = (float*)(ws + WS_ROPE64);
      for (size_t i = gt; i < (size_t)SEQ * 96; i += ng) {
          const int s = (int)(i / 96), j = (int)(i % 96); const bool big = j < 64; const int ii = big ? j : j - 64;
          const double rr = big ? 0.8659643233600653 : 0.7498942093324559; double inv = 1.0;
          for (int q = 0; q < ii; ++q) inv *= rr;
          const double rev = (double)s * inv * 0.15915494309189535; const float fr = (float)(rev - rint(rev));
          const float cs = __builtin_amdgcn_cosf(fr), sn = __builtin_amdgcn_sinf(fr);
          float* o = big ? (r128 + ((size_t)s * 64 + ii) * 2) : (r64 + ((size_t)s * 32 + ii) * 2);
          o[0] = cs; o[1] = sn; }
    }
    {
        LAS float* Ks = (LAS float*)lds; LAS float* Ws = Ks + 128 * 129;
        const int tk = w.tid & 31, tn = w.tid >> 5;
        for (int it = w.bid; it < 2 * 16 * 32; it += w.nblk) {
            const int l = it >> 9, hp = (it >> 5) & 15, kb = it & 31;
            __syncthreads();
            const float* keys = a.in[I_PEER_SUB_KEYS] + ((size_t)(l * 16 + hp) * 128) * 128;
            const float* wq = a.in[I_PEER_W_Q] + ((size_t)l * 4096 + (size_t)kb * 128) * 2048 + hp * 128;
            for (int e = w.tid; e < 128 * 128; e += 512) { const int rrow = e >> 7, d = e & 127; Ks[rrow * 129 + d] = keys[(size_t)rrow * 128 + d]; Ws[rrow * 129 + d] = wq[(size_t)rrow * 2048 + d]; }
            __syncthreads();
            float acc[8][4];
#pragma unroll
            for (int x = 0; x < 8; ++x)
#pragma unroll
                for (int y = 0; y < 4; ++y) acc[x][y] = 0.f;
            for (int d = 0; d < 128; ++d) {
                float kv[8], wv[4];
#pragma unroll
                for (int x = 0; x < 8; ++x) kv[x] = Ks[(tn + 16 * x) * 129 + d];
#pragma unroll
                for (int y = 0; y < 4; ++y) wv[y] = Ws[(tk + 32 * y) * 129 + d];
#pragma unroll
                for (int x = 0; x < 8; ++x)
#pragma unroll
                    for (int y = 0; y < 4; ++y) acc[x][y] += kv[x] * wv[y];
            }
            bf16_t* dst = (bf16_t*)(ws + WS_W_PEER) + ((size_t)l * 2048 + hp * 128) * 4096 + kb * 128;
#pragma unroll
            for (int x = 0; x < 8; ++x)
#pragma unroll
                for (int y = 0; y < 4; ++y) dst[(size_t)(tn + 16 * x) * 4096 + tk + 32 * y] = (bf16_t)f2bf(acc[x][y]);
        }
        __syncthreads();
    }
}

__device__ __forceinline__ int crow(int r, int hi) { return (r & 3) + 8 * (r >> 2) + 4 * hi; }
template <class F>
__device__ __forceinline__ void naive_gemm(const bf16_t* A, int lda, const bf16_t* Bt, int ldb, int M, int N, int K, const WI& w, F epi) {
    const int tm = M >> 5, tn = (N + 31) >> 5;
    const int i = w.lane & 31, g = w.lane >> 5;
    for (int tile = w.gw; tile < tm * tn; tile += w.ngw) {
        const int bn = tile / tm, bm = tile - bn * tm;
        const bf16_t* ap = A + (size_t)(bm * 32 + i) * lda + 8 * g;
        const int nrow = bn * 32 + i; const bool nv = nrow < N;
        const bf16_t* bp = Bt + (size_t)(nv ? nrow : 0) * ldb + 8 * g;
        f32x16 acc = {};
#pragma unroll 4
        for (int k = 0; k < K; k += 16) {
            const bf16x8 av = *(const bf16x8*)(ap + k);
            bf16x8 bv = *(const bf16x8*)(bp + k);
            if (!nv) bv = (bf16x8){0, 0, 0, 0, 0, 0, 0, 0};
            acc = __builtin_amdgcn_mfma_f32_32x32x16_bf16(av, bv, acc, 0, 0, 0);
        }
#pragma unroll
        for (int r = 0; r < 16; ++r) { const int row = bm * 32 + crow(r, g), col = bn * 32 + i; if (col < N) epi(row, col, acc[r]); }
    }
}

__device__ __forceinline__ void ln_rows(const float* src, const float* g, const float* b, float* dstf, bf16_t* dstb, const WI& w) {
    for (int m = w.gw; m < T; m += w.ngw) {
        const f32x4* xr = (const f32x4*)(src + (size_t)m * DM) + w.lane;
        f32x4 v[16]; float s = 0.f;
#pragma unroll
        for (int j = 0; j < 16; ++j) { v[j] = xr[64 * j]; s += (v[j].x + v[j].y) + (v[j].z + v[j].w); }
        const float mean = wave_sum(s) * (1.f / DM); float s2 = 0.f;
#pragma unroll
        for (int j = 0; j < 16; ++j) { v[j] = v[j] - mean; s2 += (v[j].x * v[j].x + v[j].y * v[j].y) + (v[j].z * v[j].z + v[j].w * v[j].w); }
        const float rstd = 1.f / sqrtf(wave_sum(s2) * (1.f / DM) + LN_EPS);
#pragma unroll
        for (int j = 0; j < 16; ++j) {
            const int c = 4 * w.lane + 256 * j;
            const f32x4 gg = *(const f32x4*)(g + c), bb = *(const f32x4*)(b + c);
            const f32x4 o = v[j] * rstd * gg + bb;
            *(f32x4*)(dstf + (size_t)m * DM + c) = o;
            if (dstb) { u32x2 p; p.x = pk2(o.x, o.y); p.y = pk2(o.z, o.w); *(u32x2*)(dstb + (size_t)m * DM + c) = p; }
        }
    }
}

template <int MODE>
__device__ __forceinline__ void attn_naive(const Args& a, int layer, LAS float* qs, const WI& w) {
    constexpr int H = (MODE == 4) ? 4 : 16, DK = (MODE == 1) ? 192 : 128;
    const float scale = (MODE == 1) ? 0.07216878364870322f : 0.08838834764831845f;
    unsigned char* ws = a.ws;
    const float NEG = -__builtin_inff();
    for (int it = w.gw; it < T * H; it += w.ngw) {
        const int h = it / T, t = it - h * T, b = t / SEQ, sp = t - b * SEQ, c = sp >> 6;
        const bf16_t* qp; const bf16_t* kbase; const bf16_t* vbase; int ldk, ldv; bf16_t* op;
        int s_lo = 0, s_hi;
        if (MODE == 0) { const bf16_t* P = (const bf16_t*)(ws + WS_PROJ); qp = P + (size_t)t * AB_MAIN + h * 128; kbase = P + (size_t)b * SEQ * AB_MAIN + 2048 + h * 128; vbase = kbase + 2048; ldk = ldv = AB_MAIN;
            op = (bf16_t*)(ws + WS_ATT) + (size_t)t * DM + h * 128; s_lo = (c - 8) * 64; if (s_lo < 0) s_lo = 0; s_hi = (c + 1) * 64; }
        else if (MODE == 1) { qp = (const bf16_t*)(ws + WS_QB) + (size_t)t * 3072 + h * 192; kbase = (const bf16_t*)(ws + WS_KVB) + (size_t)b * SEQ * 4096 + h * 256; vbase = kbase + 128; ldk = ldv = 4096;
            op = (bf16_t*)(ws + WS_ATT) + (size_t)t * DM + 2048 + h * 128; s_hi = (c + 1) * 64; }
        else if (MODE == 2) { const bf16_t* P = (const bf16_t*)(ws + WS_PROJ); qp = P + (size_t)t * CD_MAIN + h * 128; kbase = P + (size_t)b * SEQ * CD_MAIN + 2048 + (h >> 2) * 128; vbase = kbase + 512; ldk = ldv = CD_MAIN;
            op = (bf16_t*)(ws + WS_ATT) + (size_t)t * DM + h * 128; s_hi = (c + 1) * 64; }
        else if (MODE == 3) { const bf16_t* P = (const bf16_t*)(ws + WS_PROJ); qp = P + (size_t)t * CD_MAIN + 5120 + h * 128; kbase = P + (size_t)b * SEQ * CD_MAIN + 7168 + h * 128; vbase = kbase + 2048; ldk = ldv = CD_MAIN;
            op = (bf16_t*)(ws + WS_ATT) + (size_t)t * DM + 2048 + h * 128; s_hi = sp + 1; }
        else { qp = (const bf16_t*)(ws + WS_MEMQ) + (size_t)t * 512 + h * 128; kbase = (const bf16_t*)(ws + WS_KVM) + ((size_t)layer * 512 + b * 256) * 1024 + h * 128; vbase = kbase + 512; ldk = ldv = 1024;
            op = (bf16_t*)(ws + WS_MEMO) + (size_t)t * 512 + h * 128; s_hi = 256; }
        LDS_WAIT();
        if (MODE == 4) { const float* mq = (const float*)(ws + WS_MQP) + (size_t)t * 512 + h * 128;
            for (int d = w.lane; d < DK; d += 64) qs[d] = bf2f((bf16_t)f2bf((mq[d] + mq[d + (size_t)T * 512]) + (mq[d + (size_t)2 * T * 512] + mq[d + (size_t)3 * T * 512]))); }
        else for (int d = w.lane; d < DK; d += 64) qs[d] = bf2f(qp[d]);
        LDS_WAIT();
        const float* cum = (const float*)(ws + WS_CUM) + ((size_t)b * 16 + h) * SEQ;
        const float ct = (MODE == 3) ? cum[sp] : 0.f;
        const float* relb = a.in[I_A_REL_BIAS] + h * 513;
        const unsigned* mrow = (const unsigned*)(ws + WS_MASK) + (size_t)t * 128;
        float m = NEG, l = 0.f, o0 = 0.f, o1 = 0.f;
        for (int s0 = s_lo; s0 < s_hi; s0 += 64) {
            const int s = s0 + w.lane; bool valid = s < s_hi;
            if (MODE == 2) { if (valid) valid = (mrow[s >> 5] >> (s & 31)) & 1u; }
            float x = NEG;
            if (valid) {
                const bf16_t* kp = kbase + (size_t)s * ldk; float acc = 0.f;
#pragma unroll 4
                for (int d0 = 0; d0 < 128; d0 += 8) { const bf16x8 kv = *(const bf16x8*)(kp + d0);
#pragma unroll
                    for (int e = 0; e < 8; ++e) acc += qs[d0 + e] * bf2f((bf16_t)kv[e]); }
                if (MODE == 1) { const bf16_t* kr = (const bf16_t*)(ws + WS_KR) + ((size_t)b * SEQ + s) * 64;
#pragma unroll 4
                    for (int d0 = 0; d0 < 64; d0 += 8) { const bf16x8 kv = *(const bf16x8*)(kr + d0);
#pragma unroll
                        for (int e = 0; e < 8; ++e) acc += qs[128 + d0 + e] * bf2f((bf16_t)kv[e]); } }
                x = acc * scale;
                if (MODE == 0) { int rel = sp - s; rel = rel < -256 ? -256 : (rel > 256 ? 256 : rel); x += relb[rel + 256]; }
                if (MODE == 3) x += ct - cum[s];
            }
            const float mx = wave_max(x);
            if (mx == NEG) continue;
            const float mn = fmaxf(m, mx); const float p = valid ? __expf(x - mn) : 0.f; const float al = __expf(m - mn);
            l = l * al + wave_sum(p); o0 *= al; o1 *= al; m = mn;
            for (int j = 0; j < 64; ++j) { const float pj = __shfl(p, j);
                if (pj != 0.f) { const bf16_t* vp = vbase + (size_t)(s0 + j) * ldv; o0 += pj * bf2f(vp[w.lane]); o1 += pj * bf2f(vp[w.lane + 64]); } }
        }
        const float rl = 1.f / l;
        op[w.lane] = (bf16_t)f2bf(o0 * rl); op[w.lane + 64] = (bf16_t)f2bf(o1 * rl);
    }
}

namespace fa {
constexpr int SHM_V = 64 * 128 * 2;
constexpr int LDS_V = 0, LDS_K = 2 * SHM_V, LDS_WS = LDS_K + 2 * 64 * 384, LDS_RELB = LDS_WS + 8 * 64 * 4, LDS_CS = LDS_RELB + 2304, LDS_END = LDS_CS + 512;
#define FA_KSWZ(row, colB, RS) ((row) * (RS) + ((colB) ^ (((row) & 7) << 4)))
__device__ __forceinline__ int v_st(int k, int c) { const int kk = (k & ~0xC) | ((k & 4) << 1) | ((k & 8) >> 1); return ((kk >> 3) * 4 + (c >> 5)) * 512 + ((kk & 7) * 32 + (c & 31)) * 2; }
__device__ __forceinline__ int v_rd_base(int lane) { return ((lane & 3) << 3) | (((lane >> 2) & 3) << 6) | (((lane >> 4) & 1) << 5) | (((lane >> 5) & 1) << 8); }
__device__ __forceinline__ unsigned cvtpk(float lo, float hi) { unsigned r; asm volatile("v_cvt_pk_bf16_f32 %0, %1, %2" : "=v"(r) : "v"(lo), "v"(hi)); return r; }
typedef short s16x4 __attribute__((ext_vector_type(4)));

template <int DK>
__device__ __forceinline__ void qkt(f32x16& p0, f32x16& p1, LAS const char* Kb, int r32, int hi, const bf16x8* qr) {
    constexpr int RS = DK * 2;
    p0 = f32x16{}; p1 = f32x16{};
    LAS const char* kb[4];
#pragma unroll
    for (int dd = 0; dd < 4; ++dd) kb[dd] = Kb + FA_KSWZ(r32, (dd * 16 + hi * 8) * 2, RS);
#pragma unroll
    for (int d0 = 0; d0 < DK / 16; ++d0) { LAS const char* ap = kb[d0 & 3] + (d0 >> 2) * 128;
        const bf16x8 b0 = *(LAS const bf16x8*)ap;
        const bf16x8 b1 = *(LAS const bf16x8*)(ap + 32 * RS);
        p0 = __builtin_amdgcn_mfma_f32_32x32x16_bf16(b0, qr[d0], p0, 0, 0, 0);
        p1 = __builtin_amdgcn_mfma_f32_32x32x16_bf16(b1, qr[d0], p1, 0, 0, 0); }
}
__device__ __forceinline__ void pv_tile(f32x16* o, int vb0, bf16x8 pa0, bf16x8 pa1, bf16x8 pa2, bf16x8 pa3) {
#define FA_TRRD(dst, off) asm volatile("ds_read_b64_tr_b16 %0, %1 offset:%2" : "=&v"(dst) : "v"(vb0), "i"(off) : "memory")
#define FA_PV_D0(d0) do { s16x4 l0, l1, l2, l3, h0, h1, h2, h3; constexpr int b_ = (d0) * 512; \
        FA_TRRD(l0, b_); FA_TRRD(h0, b_ + 2048); FA_TRRD(l1, b_ + 4096); FA_TRRD(h1, b_ + 6144); FA_TRRD(l2, b_ + 8192); FA_TRRD(h2, b_ + 10240); FA_TRRD(l3, b_ + 12288); FA_TRRD(h3, b_ + 14336); \
        asm volatile("s_waitcnt lgkmcnt(0)" ::: "memory"); __builtin_amdgcn_sched_barrier(0); \
        o[d0] = __builtin_amdgcn_mfma_f32_32x32x16_bf16(pa0, (bf16x8){l0[0], l0[1], l0[2], l0[3], h0[0], h0[1], h0[2], h0[3]}, o[d0], 0, 0, 0); \
        o[d0] = __builtin_amdgcn_mfma_f32_32x32x16_bf16(pa1, (bf16x8){l1[0], l1[1], l1[2], l1[3], h1[0], h1[1], h1[2], h1[3]}, o[d0], 0, 0, 0); \
        o[d0] = __builtin_amdgcn_mfma_f32_32x32x16_bf16(pa2, (bf16x8){l2[0], l2[1], l2[2], l2[3], h2[0], h2[1], h2[2], h2[3]}, o[d0], 0, 0, 0); \
        o[d0] = __builtin_amdgcn_mfma_f32_32x32x16_bf16(pa3, (bf16x8){l3[0], l3[1], l3[2], l3[3], h3[0], h3[1], h3[2], h3[3]}, o[d0], 0, 0, 0); } while (0)
    FA_PV_D0(0); FA_PV_D0(1); FA_PV_D0(2); FA_PV_D0(3);
#undef FA_PV_D0
#undef FA_TRRD
}
__device__ __forceinline__ void softmax_tile(f32x16& p0, f32x16& p1, float& m_reg, float& l_reg, float& alpha, bf16x8& pa0, bf16x8& pa1, bf16x8& pa2, bf16x8& pa3) {
    float pmax = p0[0];
#pragma unroll
    for (int r = 1; r < 16; ++r) pmax = fmaxf(pmax, p0[r]);
#pragma unroll
    for (int r = 0; r < 16; ++r) pmax = fmaxf(pmax, p1[r]);
    { auto rr = __builtin_amdgcn_permlane32_swap(__float_as_uint(pmax), __float_as_uint(pmax), false, false);
      pmax = fmaxf(__uint_as_float(rr[0]), __uint_as_float(rr[1])); }
    const float mn = fmaxf(m_reg, pmax); alpha = __builtin_amdgcn_exp2f(m_reg - mn); m_reg = mn;
#pragma unroll
    for (int r = 0; r < 16; ++r) { p0[r] = __builtin_amdgcn_exp2f(p0[r] - mn); p1[r] = __builtin_amdgcn_exp2f(p1[r] - mn); }
    float ps = 0.f;
#pragma unroll
    for (int r = 0; r < 16; ++r) ps += p0[r];
#pragma unroll
    for (int r = 0; r < 16; ++r) ps += p1[r];
    { auto rr = __builtin_amdgcn_permlane32_swap(__float_as_uint(ps), __float_as_uint(ps), false, false);
      ps = __uint_as_float(rr[0]) + __uint_as_float(rr[1]); }
    l_reg = l_reg * alpha + ps;
#define FA_PK4(P, B_, OUT) do { unsigned a0 = cvtpk(P[B_+0], P[B_+1]), a1 = cvtpk(P[B_+2], P[B_+3]); \
        unsigned b0 = cvtpk(P[B_+4], P[B_+5]), b1 = cvtpk(P[B_+6], P[B_+7]); \
        auto r0 = __builtin_amdgcn_permlane32_swap(a0, b0, false, false); auto r1 = __builtin_amdgcn_permlane32_swap(a1, b1, false, false); \
        u32x4 wv = {r0[0], r1[0], r0[1], r1[1]}; OUT = *reinterpret_cast<bf16x8*>(&wv); } while (0)
    FA_PK4(p0, 0, pa0); FA_PK4(p0, 8, pa1); FA_PK4(p1, 0, pa2); FA_PK4(p1, 8, pa3);
#undef FA_PK4
}

template <int MODE>
__device__ __forceinline__ void attn_unit(const Args& a, int layer, LAS unsigned char* lds, int b, int h, int qb) {
    constexpr int DK = (MODE == 1) ? 192 : 128, RS = DK * 2, SHM_K = 64 * RS, NQ = DK / 16;
    constexpr float C2 = (MODE == 1) ? 1.4426950408889634f * 0.07216878364870322f : 1.4426950408889634f * 0.08838834764831845f;
    constexpr float L2E = 1.4426950408889634f;
    unsigned char* ws = a.ws;
    const int tid = threadIdx.x, wid = __builtin_amdgcn_readfirstlane(tid >> 6), lane = tid & 63, r32 = lane & 31, hi = lane >> 5;
    const int P0 = qb * 256, qlo = P0 + wid * 32, row = qlo + r32, cw = qlo >> 6;
    const size_t tb = (size_t)b * SEQ;
    const float NEG = -__builtin_inff();
    const bf16_t* Kg; const bf16_t* Vg; int ldk, ldv; bf16_t* Og; int ldo; int j_lo = 0, j_hi;
    if (MODE == 0) { const bf16_t* P = (const bf16_t*)(ws + WS_PROJ); Kg = P + tb * AB_MAIN + 2048 + h * 128; Vg = Kg + 2048; ldk = ldv = AB_MAIN; Og = (bf16_t*)(ws + WS_ATT) + (tb + qlo) * DM + h * 128; ldo = DM;
        j_lo = (P0 >> 6) - 8; if (j_lo < 0) j_lo = 0; j_hi = (P0 >> 6) + 4; }
    else if (MODE == 1) { Kg = (const bf16_t*)(ws + WS_KVB) + tb * 4096 + h * 256; Vg = Kg + 128; ldk = ldv = 4096; Og = (bf16_t*)(ws + WS_ATT) + (tb + qlo) * DM + 2048 + h * 128; ldo = DM; j_hi = (P0 >> 6) + 4; }
    else if (MODE == 2) { const bf16_t* P = (const bf16_t*)(ws + WS_PROJ); Kg = P + tb * CD_MAIN + 2048 + (h >> 2) * 128; Vg = Kg + 512; ldk = ldv = CD_MAIN; Og = (bf16_t*)(ws + WS_ATT) + (tb + qlo) * DM + h * 128; ldo = DM; j_hi = (P0 >> 6) + 4; }
    else if (MODE == 3) { const bf16_t* P = (const bf16_t*)(ws + WS_PROJ); Kg = P + tb * CD_MAIN + 7168 + h * 128; Vg = Kg + 2048; ldk = ldv = CD_MAIN; Og = (bf16_t*)(ws + WS_ATT) + (tb + qlo) * DM + 2048 + h * 128; ldo = DM; j_hi = (P0 >> 6) + 4; }
    else { Kg = (const bf16_t*)(ws + WS_KVM) + ((size_t)layer * 512 + b * 256) * 1024 + h * 128; Vg = Kg + 512; ldk = ldv = 1024; Og = (bf16_t*)(ws + WS_MEMO) + (tb + qlo) * 512 + h * 128; ldo = 512; j_hi = 4; }
    const int NT = j_hi - j_lo;
    bf16x8 qr[NQ];
    if (MODE == 4) { const float* mq = (const float*)(ws + WS_MQP) + (tb + row) * 512 + h * 128;
#pragma unroll
        for (int d0 = 0; d0 < NQ; ++d0) { const float* p = mq + d0 * 16 + hi * 8; f32x4 s0 = {0.f, 0.f, 0.f, 0.f}, s1 = s0;
#pragma unroll
            for (int z = 0; z < 4; ++z) { s0 += *(const f32x4*)(p + (size_t)z * T * 512); s1 += *(const f32x4*)(p + (size_t)z * T * 512 + 4); }
            u32x4 wv = {cvtpk(s0[0], s0[1]), cvtpk(s0[2], s0[3]), cvtpk(s1[0], s1[1]), cvtpk(s1[2], s1[3])}; qr[d0] = *reinterpret_cast<bf16x8*>(&wv); } }
    else { const bf16_t* Qg;
        if (MODE == 0) Qg = (const bf16_t*)(ws + WS_PROJ) + (tb + row) * AB_MAIN + h * 128;
        else if (MODE == 1) Qg = (const bf16_t*)(ws + WS_QB) + (tb + row) * 3072 + h * 192;
        else if (MODE == 2) Qg = (const bf16_t*)(ws + WS_PROJ) + (tb + row) * CD_MAIN + h * 128;
        else Qg = (const bf16_t*)(ws + WS_PROJ) + (tb + row) * CD_MAIN + 5120 + h * 128;
#pragma unroll
        for (int d0 = 0; d0 < NQ; ++d0) qr[d0] = *(const bf16x8*)(Qg + d0 * 16 + hi * 8); }
    LAS char* V_lds = (LAS char*)lds + LDS_V; LAS char* K_lds = (LAS char*)lds + LDS_K;
    LAS float* wsc = (LAS float*)(lds + LDS_WS) + wid * 64; LAS float* relb = (LAS float*)(lds + LDS_RELB); LAS float* csl = (LAS float*)(lds + LDS_CS);
    const int vbase = (int)(unsigned)(uintptr_t)V_lds + v_rd_base(lane);
    const bf16_t* KRg = (const bf16_t*)(ws + WS_KR) + tb * 64;
    const float* cum = (const float*)(ws + WS_CUM) + ((size_t)b * 16 + h) * SEQ;
    const unsigned* mrow = (const unsigned*)(ws + WS_MASK) + (tb + row) * 128;
    float ctl = 0.f; if (MODE == 3) ctl = cum[row] * L2E;
    if (MODE == 0) { const float* rb = a.in[I_A_REL_BIAS] + h * 513; for (int i = tid; i < 513; i += 512) relb[i] = rb[i] * L2E; }
    float m_reg = -1e30f, l_reg = 0.f; f32x16 o[4] = {};
    unsigned mk0 = 0u, mk1 = 0u; float st_cs = 0.f;
    constexpr int NKI = (DK == 192) ? 3 : 2;
    int koff[NKI]; bool krope[NKI]; int voff[2];
#pragma unroll
    for (int i = 0; i < NKI; ++i) { const int off = (wid * NKI + i) * 1024 + lane * 16; const int rw = off / RS, sw = off - rw * RS, cb = sw ^ ((rw & 7) << 4);
        krope[i] = (DK == 192) && (cb >= 256); koff[i] = krope[i] ? rw * 64 + ((cb - 256) >> 1) : rw * ldk + (cb >> 1); }
#pragma unroll
    for (int i = 0; i < 2; ++i) { const int off = (wid * 2 + i) * 1024 + lane * 16; const int sub = off >> 9, within = off & 511, kk = ((sub >> 2) << 3) | (within >> 6);
        const int k = (kk & ~0xC) | ((kk & 4) << 1) | ((kk & 8) >> 1), c = (sub & 3) * 32 + ((within & 63) >> 1); voff[i] = k * ldv + c; }
#define FA_DMA(j, bf) do { const int k0_ = (j) * 64; \
        _Pragma("unroll") for (int i_ = 0; i_ < NKI; ++i_) { const bf16_t* s_ = (DK == 192 && krope[i_]) ? (KRg + (size_t)k0_ * 64 + koff[i_]) : (Kg + (size_t)k0_ * ldk + koff[i_]); \
            __builtin_amdgcn_global_load_lds((const unsigned*)s_, (LAS unsigned*)(K_lds + (bf) * SHM_K + (wid * NKI + i_) * 1024), 16, 0, 0); } \
        _Pragma("unroll") for (int i_ = 0; i_ < 2; ++i_) \
            __builtin_amdgcn_global_load_lds((const unsigned*)(Vg + (size_t)k0_ * ldv + voff[i_]), (LAS unsigned*)(V_lds + (bf) * SHM_V + (wid * 2 + i_) * 1024), 16, 0, 0); \
        if (MODE == 3) { if (tid < 64) st_cs = cum[k0_ + tid] * L2E; } } while (0)
#define FA_CSW(bf) do { if (MODE == 3) { if (tid < 64) csl[(bf) * 64 + tid] = st_cs; } } while (0)
    __syncthreads();
    FA_DMA(j_lo, 0); asm volatile("s_waitcnt vmcnt(0)" ::: "memory"); FA_CSW(0);
    __syncthreads();
#pragma unroll 1
    for (int t = 0; t < NT; ++t) {
        const int buf = t & 1, j = j_lo + t, kbp = j * 64;
        if (t + 1 < NT) FA_DMA(j + 1, buf ^ 1);
        bool act;
        if (MODE == 0) act = (j >= cw - 8) && (j <= cw);
        else if (MODE == 1 || MODE == 2) act = (j <= cw);
        else if (MODE == 3) act = (kbp <= qlo + 31);
        else act = true;
        if (MODE == 2) { if (act) { const u32x2 mm = *(const u32x2*)(mrow + 2 * j); mk0 = mm.x; mk1 = mm.y; } }
        if (act) {
            f32x16 p0, p1;
            qkt<DK>(p0, p1, K_lds + buf * SHM_K, r32, hi, qr);
            if (MODE == 0) {
                if (qlo - (kbp + 63) >= 256) { const float bf_ = relb[512];
#pragma unroll
                    for (int r = 0; r < 16; ++r) { p0[r] = fmaf(p0[r], C2, bf_); p1[r] = fmaf(p1[r], C2, bf_); } }
                else { const int dq = row - kbp - 4 * hi;
#pragma unroll
                    for (int r = 0; r < 16; ++r) { const int c = (r & 3) + 8 * (r >> 2);
                        int i0 = dq - c; i0 = i0 < -256 ? -256 : (i0 > 256 ? 256 : i0); int i1 = dq - c - 32; i1 = i1 < -256 ? -256 : (i1 > 256 ? 256 : i1);
                        p0[r] = fmaf(p0[r], C2, relb[i0 + 256]); p1[r] = fmaf(p1[r], C2, relb[i1 + 256]); } }
            } else if (MODE == 3) {
                LAS const float* cs = csl + buf * 64 + 4 * hi;
#pragma unroll
                for (int q4 = 0; q4 < 4; ++q4) { const f32x4 c0 = *(LAS const f32x4*)(cs + 8 * q4), c1 = *(LAS const f32x4*)(cs + 32 + 8 * q4);
#pragma unroll
                    for (int e = 0; e < 4; ++e) { p0[4 * q4 + e] = fmaf(p0[4 * q4 + e], C2, ctl - c0[e]); p1[4 * q4 + e] = fmaf(p1[4 * q4 + e], C2, ctl - c1[e]); } }
                if (kbp + 63 > qlo) { const int dq = row - kbp - 4 * hi;
#pragma unroll
                    for (int r = 0; r < 16; ++r) { const int c = (r & 3) + 8 * (r >> 2); if (dq - c < 0) p0[r] = NEG; if (dq - c - 32 < 0) p1[r] = NEG; } }
            } else {
#pragma unroll
                for (int r = 0; r < 16; ++r) { p0[r] *= C2; p1[r] *= C2; }
                if (MODE == 2) {
#pragma unroll
                    for (int r = 0; r < 16; ++r) { const int c = (r & 3) + 8 * (r >> 2) + 4 * hi; if (!((mk0 >> c) & 1u)) p0[r] = NEG; if (!((mk1 >> c) & 1u)) p1[r] = NEG; } }
            }
            float alpha; bf16x8 pa0, pa1, pa2, pa3;
            softmax_tile(p0, p1, m_reg, l_reg, alpha, pa0, pa1, pa2, pa3);
            if (__any(alpha < 1.f)) { if (hi == 0) wsc[r32] = alpha; LDS_WAIT();
#pragma unroll
                for (int r = 0; r < 16; ++r) { const float al = wsc[crow(r, hi)];
#pragma unroll
                    for (int d_ = 0; d_ < 4; ++d_) o[d_][r] *= al; }
                LDS_WAIT(); }
            pv_tile(o, vbase + buf * SHM_V, pa0, pa1, pa2, pa3);
        }
        asm volatile("s_waitcnt vmcnt(0)" ::: "memory");
        if (t + 1 < NT) FA_CSW(buf ^ 1);
        __syncthreads();
    }
#undef FA_DMA
#undef FA_CSW
    if (hi == 0) wsc[32 + r32] = l_reg; LDS_WAIT();
#pragma unroll
    for (int r = 0; r < 16; ++r) { const int orow = crow(r, hi); const float rl = __builtin_amdgcn_rcpf(wsc[32 + orow]);
#pragma unroll
        for (int d0 = 0; d0 < 4; ++d0) { const float v = o[d0][r] * rl; const float vn = __shfl_xor(v, 1);
            if ((r32 & 1) == 0) *(unsigned*)(Og + (size_t)orow * ldo + d0 * 32 + r32) = cvtpk(v, vn); } }
    LDS_WAIT();
}
}

__device__ __forceinline__ void rope_pair(float& x1, float& x2, float cs, float sn) { const float a = x1 * cs - x2 * sn, b = x2 * cs + x1 * sn; x1 = a; x2 = b; }
__device__ __forceinline__ void ph_l0_stats(const Args& a, const WI& w) {
    unsigned char* ws = a.ws; const bf16_t* P = (const bf16_t*)(ws + WS_PROJ);
    const float* r64 = (const float*)(ws + WS_ROPE64);
    for (int t = w.gw; t < T; t += w.ngw) {
        const bf16_t* row = P + (size_t)t * AB_MAIN;
        float s = 0.f;
        for (int j = 0; j < 3; ++j) { const bf16x8 v = *(const bf16x8*)(row + 6144 + (j * 64 + w.lane) * 8);
#pragma unroll
            for (int e = 0; e < 8; ++e) { const float f = bf2f((bf16_t)v[e]); s += f * f; } }
        s = wave_sum(s);
        float s2 = 0.f; { const bf16x8 v = *(const bf16x8*)(row + 7680 + w.lane * 8);
#pragma unroll
            for (int e = 0; e < 8; ++e) { const float f = bf2f((bf16_t)v[e]); s2 += f * f; } }
        s2 = wave_sum(s2);
        if (w.lane == 0) { ((float*)(ws + WS_RSQ))[t] = 1.f / sqrtf(s * (1.f / 1536.f) + RMS_EPS); ((float*)(ws + WS_RSKV))[t] = 1.f / sqrtf(s2 * (1.f / 512.f) + RMS_EPS); }
        if (w.lane < 32) { const float* sm = (const float*)(ws + WS_SMALL) + (size_t)t * 128; const int sp = t & (SEQ - 1);
            float x1 = sm[w.lane], x2 = sm[w.lane + 32]; const float cs = r64[((size_t)sp * 32 + w.lane) * 2], sn = r64[((size_t)sp * 32 + w.lane) * 2 + 1];
            rope_pair(x1, x2, cs, sn);
            bf16_t* kr = (bf16_t*)(ws + WS_KR) + (size_t)t * 64; kr[w.lane] = (bf16_t)f2bf(x1); kr[w.lane + 32] = (bf16_t)f2bf(x2); }
    }
}
__device__ __forceinline__ void ph_l0_qrope(const Args& a, const WI& w) {
    unsigned char* ws = a.ws; bf16_t* Q = (bf16_t*)(ws + WS_QB); const float* r64 = (const float*)(ws + WS_ROPE64);
    for (int t = w.gw; t < T; t += w.ngw) {
        const int sp = t & (SEQ - 1);
        for (int e = w.lane; e < 16 * 32; e += 64) { const int h = e >> 5, i = e & 31; bf16_t* q = Q + (size_t)t * 3072 + h * 192 + 128;
            float x1 = bf2f(q[i]), x2 = bf2f(q[i + 32]); rope_pair(x1, x2, r64[((size_t)sp * 32 + i) * 2], r64[((size_t)sp * 32 + i) * 2 + 1]);
            q[i] = (bf16_t)f2bf(x1); q[i + 32] = (bf16_t)f2bf(x2); }
    }
}
__device__ __forceinline__ void ph_l1_elem(const Args& a, const WI& w) {
    unsigned char* ws = a.ws; bf16_t* P = (bf16_t*)(ws + WS_PROJ);
    const float* r128 = (const float*)(ws + WS_ROPE128); const float* r64 = (const float*)(ws + WS_ROPE64);
    for (int t = w.gw; t < T; t += w.ngw) {
        const int b = t / SEQ, sp = t - b * SEQ; bf16_t* row = P + (size_t)t * CD_MAIN;
        for (int e = w.lane; e < 20 * 64; e += 64) { const int h = e >> 6, i = e & 63; bf16_t* q = row + h * 128;
            float x1 = bf2f(q[i]), x2 = bf2f(q[i + 64]); rope_pair(x1, x2, r128[((size_t)sp * 64 + i) * 2], r128[((size_t)sp * 64 + i) * 2 + 1]);
            q[i] = (bf16_t)f2bf(x1); q[i + 64] = (bf16_t)f2bf(x2); }
        for (int e = w.lane; e < 32 * 32; e += 64) { const int h = e >> 5, i = e & 31; bf16_t* q = row + 3072 + h * 64;
            float x1 = bf2f(q[i]), x2 = bf2f(q[i + 32]); rope_pair(x1, x2, r64[((size_t)sp * 32 + i) * 2], r64[((size_t)sp * 32 + i) * 2 + 1]);
            q[i] = (bf16_t)f2bf(x1); q[i + 32] = (bf16_t)f2bf(x2); }
        const float* sm = (const float*)(ws + WS_SMALL) + (size_t)t * 128;
        if (w.lane < 32) { float x1 = sm[w.lane], x2 = sm[w.lane + 32]; rope_pair(x1, x2, r64[((size_t)sp * 32 + w.lane) * 2], r64[((size_t)sp * 32 + w.lane) * 2 + 1]);
            bf16_t* ki = (bf16_t*)(ws + WS_KI) + (size_t)t * 64; ki[w.lane] = (bf16_t)f2bf(x1); ki[w.lane + 32] = (bf16_t)f2bf(x2);
            ((float*)(ws + WS_WI))[(size_t)t * 32 + w.lane] = sm[64 + w.lane] * 0.17677669529663687f; }
        if (w.lane < 16) { const float z = sm[96 + w.lane] + a.in[I_D_FORGET_BIAS][w.lane];
            const float lf = fminf(z, 0.f) - log1pf(__expf(-fabsf(z)));
            ((float*)(ws + WS_LOGF))[((size_t)b * 16 + w.lane) * SEQ + sp] = lf; }
    }
}
__device__ __forceinline__ void ph_l1_scan(const Args& a, const WI& w) {
    unsigned char* ws = a.ws;
    for (int it = w.gw; it < NB * 16; it += w.ngw) {
        const float* src = (const float*)(ws + WS_LOGF) + (size_t)it * SEQ + w.lane * 64; float* dst = (float*)(ws + WS_CUM) + (size_t)it * SEQ + w.lane * 64;
        float tot = 0.f; for (int j = 0; j < 64; ++j) tot += src[j];
        float inc = tot;
#pragma unroll
        for (int o = 1; o < 64; o <<= 1) { const float v = __shfl_up(inc, o); if (w.lane >= o) inc += v; }
        float run = inc - tot;
        for (int j = 0; j < 64; ++j) { run += src[j]; dst[j] = run; }
    }
}
__device__ __forceinline__ void ph_l1_index_naive(const Args& a, LAS float* qs  , const WI& w) {
    unsigned char* ws = a.ws; const bf16_t* P = (const bf16_t*)(ws + WS_PROJ); const bf16_t* KI = (const bf16_t*)(ws + WS_KI);
    const float* WIp = (const float*)(ws + WS_WI); float* SC = (float*)(ws + WS_SCORE);
    for (int t = w.gw; t < T; t += w.ngw) {
        const int b = t / SEQ, sp = t - b * SEQ, nadm = ((sp >> 6) + 1) * 64;
        LDS_WAIT();
        for (int e = w.lane; e < 2048; e += 64) qs[e] = bf2f(P[(size_t)t * CD_MAIN + 3072 + e]);
        if (w.lane < 32) qs[2048 + w.lane] = WIp[(size_t)t * 32 + w.lane];
        LDS_WAIT();
        for (int s0 = 0; s0 < nadm; s0 += 64) {
            const int s = s0 + w.lane; const bf16_t* kp = KI + ((size_t)b * SEQ + s) * 64;
            float k[64];
#pragma unroll
            for (int d0 = 0; d0 < 64; d0 += 8) { const bf16x8 kv = *(const bf16x8*)(kp + d0);
#pragma unroll
                for (int e = 0; e < 8; ++e) k[d0 + e] = bf2f((bf16_t)kv[e]); }
            float sc = 0.f;
            for (int h = 0; h < 32; ++h) { float dot = 0.f;
#pragma unroll
                for (int d = 0; d < 64; ++d) dot += qs[h * 64 + d] * k[d];
                sc += qs[2048 + h] * fmaxf(dot * 0.125f, 0.f); }
            SC[((size_t)b * SEQ + sp) * SEQ + s] = sc;
        }
    }
}
__device__ __forceinline__ void ph_l1_index(const Args& a, LAS unsigned char* lds, const WI& w) {
    unsigned char* ws = a.ws; const bf16_t* P = (const bf16_t*)(ws + WS_PROJ); const bf16_t* KI = (const bf16_t*)(ws + WS_KI);
    const float* WIp = (const float*)(ws + WS_WI); float* SC = (float*)(ws + WS_SCORE);
    LAS char* Qs = (LAS char*)lds; LAS float* Wt = (LAS float*)(lds + 131072);
    const int tid = w.tid, r32 = w.lane & 31, hi = w.lane >> 5;
    for (int u = w.bid; u < 256; u += w.nblk) {
        const int b = u >> 7, x = (u >> 1) & 63, half = u & 1;
        for (int pass = 0; pass < 2; ++pass) {
            const int qt = pass ? 127 - x : x; const int t0 = b * SEQ + qt * 32; const int nadm = ((qt * 32) >> 6) * 64 + 64, ngrp = (nadm + 127) >> 7;
            __syncthreads();
            for (int e = tid; e < 32 * 256; e += 512) { const int t = e >> 8, c = e & 255; const u32x4 v = *(const u32x4*)(P + (size_t)(t0 + t) * CD_MAIN + 3072 + c * 8);
                const int cs = (c & ~15) | ((c & 15) ^ (t & 15)); *(LAS u32x4*)(Qs + t * 4096 + cs * 16) = v; }
            for (int e = tid; e < 1024; e += 512) { const int t = e >> 5, h = e & 31; Wt[h * 32 + t] = WIp[(size_t)(t0 + t) * 32 + h] * 0.125f; }
            __syncthreads();
            for (int g = half + 2 * w.wave; g < ngrp; g += 16) {
                const int s0 = g * 128;
                bf16x8 kf[4][4];
#pragma unroll
                for (int j = 0; j < 4; ++j)
#pragma unroll
                    for (int dk = 0; dk < 4; ++dk) kf[j][dk] = *(const bf16x8*)(KI + ((size_t)b * SEQ + s0 + 32 * j + r32) * 64 + dk * 16 + hi * 8);
                f32x16 acc[4] = {};
#pragma unroll 2
                for (int h = 0; h < 32; ++h) {
                    bf16x8 qf[4];
#pragma unroll
                    for (int dk = 0; dk < 4; ++dk) qf[dk] = *(LAS const bf16x8*)(Qs + r32 * 4096 + ((((h >> 1) << 4) | ((((h & 1) << 3) | (dk << 1) | hi) ^ (r32 & 15))) << 4));
                    f32x4 wv[4];
#pragma unroll
                    for (int q4 = 0; q4 < 4; ++q4) wv[q4] = *(LAS const f32x4*)(Wt + h * 32 + 8 * q4 + 4 * hi);
#pragma unroll
                    for (int j = 0; j < 4; ++j) { f32x16 tmp = {};
#pragma unroll
                        for (int dk = 0; dk < 4; ++dk) tmp = __builtin_amdgcn_mfma_f32_32x32x16_bf16(qf[dk], kf[j][dk], tmp, 0, 0, 0);
#pragma unroll
                        for (int r = 0; r < 16; ++r) acc[j][r] = fmaf(wv[r >> 2][r & 3], fmaxf(tmp[r], 0.f), acc[j][r]); }
                }
#pragma unroll
                for (int j = 0; j < 4; ++j)
#pragma unroll
                    for (int r = 0; r < 16; ++r) SC[(size_t)(t0 + crow(r, hi)) * SEQ + s0 + 32 * j + r32] = acc[j][r];
            }
        }
    }
    __syncthreads();
}
__device__ __forceinline__ void ph_l1_select(const Args& a, const WI& w) {
    unsigned char* ws = a.ws; const float* SC = (const float*)(ws + WS_SCORE); unsigned* MK = (unsigned*)(ws + WS_MASK);
    for (int t = w.gw; t < T; t += w.ngw) {
        const int b = t / SEQ, sp = t - b * SEQ, nblk = (sp >> 6) + 1;
        const float* row = SC + ((size_t)b * SEQ + sp) * SEQ;
        unsigned key[64];
#pragma unroll
        for (int j = 0; j < 64; ++j) { unsigned u = 0u; if (j < nblk) { u = __float_as_uint(row[j * 64 + w.lane]); u ^= (u >> 31) ? 0xFFFFFFFFu : 0x80000000u; } key[j] = u; }
        unsigned thr = 0u;
        if (nblk > 4) {
            for (int bit = 31; bit >= 0; --bit) { const unsigned cand = thr | (1u << bit); int cnt = 0;
#pragma unroll
                for (int j = 0; j < 64; ++j) cnt += (key[j] >= cand) ? 1 : 0;
                cnt = wave_sum_i(cnt); if (cnt >= 256) thr = cand; }
        }
        unsigned lo = 0u, hi = 0u;
#pragma unroll
        for (int j = 0; j < 64; ++j) { const bool sel = (j < nblk) && (key[j] >= thr); const unsigned long long bal = __ballot(sel); if (w.lane == j) { lo = (unsigned)bal; hi = (unsigned)(bal >> 32); } }
        *(u32x2*)(MK + (size_t)t * 128 + 2 * w.lane) = (u32x2){lo, hi};
    }
}

__device__ __forceinline__ unsigned tk_key(float v, unsigned payload, unsigned pmask) { const unsigned u = __float_as_uint(v); const unsigned m = (unsigned)((int)u >> 31) | 0x80000000u; return ((u ^ m) & ~pmask) | payload; }
__device__ __forceinline__ float tk_val(unsigned key, unsigned pmask) { const unsigned k = key & ~pmask; const unsigned m = ~(unsigned)((int)k >> 31) | 0x80000000u; return __uint_as_float(k ^ m); }
#define TK_INSERT(TOP, key_) do { unsigned k__ = (key_); \
        _Pragma("unroll") for (int q_ = 0; q_ < 16; ++q_) { const unsigned hi__ = TOP[q_] > k__ ? TOP[q_] : k__; k__ = TOP[q_] > k__ ? k__ : TOP[q_]; TOP[q_] = hi__; } } while (0)
__device__ __forceinline__ unsigned tk_sel16(const unsigned (&arr)[16], unsigned i) {
    unsigned x8[8], x4[4], x2[2];
    const unsigned m0 = 0u - (i & 1u), m1 = 0u - ((i >> 1) & 1u), m2 = 0u - ((i >> 2) & 1u), m3 = 0u - ((i >> 3) & 1u);
#pragma unroll
    for (int q = 0; q < 8; ++q) x8[q] = (arr[2 * q + 1] & m0) | (arr[2 * q] & ~m0);
#pragma unroll
    for (int q = 0; q < 4; ++q) x4[q] = (x8[2 * q + 1] & m1) | (x8[2 * q] & ~m1);
#pragma unroll
    for (int q = 0; q < 2; ++q) x2[q] = (x4[2 * q + 1] & m2) | (x4[2 * q] & ~m2);
    return (x2[1] & m3) | (x2[0] & ~m3); }
__device__ __forceinline__ void ph_peer_topk(const Args& a, const WI& w) {
    unsigned char* ws = a.ws; const float* PST = (const float*)(ws + WS_PSCORE); int* PIDX = (int*)(ws + WS_PIDX); float* PG = (float*)(ws + WS_PGATE);
    for (int task = w.gw; task < 128 * 8; task += w.ngw) {
        const int h = task & 7, t = (task >> 3) * 64 + w.lane;
        unsigned t0[16], t1[16];
#pragma unroll
        for (int k = 0; k < 16; ++k) { t0[k] = 0u; t1[k] = 0u; }
        { const float* col = PST + (size_t)(h * 256) * T + t;
#pragma unroll 8
          for (int i = 0; i < 128; ++i) { const float v = col[(size_t)i * T]; TK_INSERT(t0, tk_key(v, 127u - (unsigned)i, 127u)); } }
        { const float* col = PST + (size_t)(h * 256 + 128) * T + t;
#pragma unroll 8
          for (int i = 0; i < 128; ++i) { const float v = col[(size_t)i * T]; TK_INSERT(t1, tk_key(v, 127u - (unsigned)i, 127u)); } }
        float a0[16], a1[16];
#pragma unroll
        for (int k = 0; k < 16; ++k) { a0[k] = tk_val(t0[k], 127u); a1[k] = tk_val(t1[k], 127u); }
        unsigned bk[16];
#pragma unroll
        for (int k = 0; k < 16; ++k) bk[k] = 0u;
#pragma unroll
        for (int i = 0; i < 16; ++i)
#pragma unroll
            for (int j = 0; j < 16; ++j) if ((i + 1) * (j + 1) <= 16) TK_INSERT(bk, tk_key(a0[i] + a1[j], 255u - (unsigned)(i * 16 + j), 255u));
        const float top = tk_val(bk[0], 255u); float den = 0.f; float ex[16];
#pragma unroll
        for (int k = 0; k < 16; ++k) { ex[k] = __expf(tk_val(bk[k], 255u) - top); den += ex[k]; }
        const float rd = 1.f / den;
#pragma unroll
        for (int k = 0; k < 16; ++k) { const unsigned c = 255u - (bk[k] & 255u); const unsigned e0 = 127u - (tk_sel16(t0, c >> 4) & 127u), e1 = 127u - (tk_sel16(t1, c & 15u) & 127u);
            PIDX[(size_t)t * 128 + h * 16 + k] = (int)(e0 * 128u + e1); PG[(size_t)t * 128 + h * 16 + k] = ex[k] * rd; }
    }
}
__device__ __forceinline__ void ph_peer_experts(const Args& a, int layer, float* outf, bf16_t* outb, const float* g, const float* bta, LAS float* wsm  , const WI& w) {
    unsigned char* ws = a.ws; const float* HF = (const float*)(ws + WS_HF);
    const unsigned char* U8 = ws + WS_U8 + (size_t)layer * 16384 * DM; const unsigned char* V8 = ws + WS_V8 + (size_t)layer * 16384 * DM;
    const float* USC = (const float*)(ws + WS_USC) + layer * 16384; const float* VSC = (const float*)(ws + WS_VSC) + layer * 16384;
    const int* PIDX = (const int*)(ws + WS_PIDX); const float* PG = (const float*)(ws + WS_PGATE);
    const int lane = w.lane;
    for (int t = w.gw; t < T; t += w.ngw) {
        const float* hrow = HF + (size_t)t * DM + 16 * lane;
        const int idx0 = PIDX[(size_t)t * 128 + lane], idx1 = PIDX[(size_t)t * 128 + 64 + lane];
        const float g0 = PG[(size_t)t * 128 + lane], g1 = PG[(size_t)t * 128 + 64 + lane];
        LDS_WAIT();
#define PE_LOAD(BUF, TBL, kb_) do { const int iv_ = ((kb_) & 64) ? idx1 : idx0; \
            _Pragma("unroll") for (int q_ = 0; q_ < 2; ++q_) { const int e_ = __builtin_amdgcn_readlane(iv_, ((kb_) + q_) & 63); const u32x4* r_ = (const u32x4*)(TBL + (size_t)e_ * DM + 16 * lane); \
                _Pragma("unroll") for (int i_ = 0; i_ < 4; ++i_) BUF[q_][i_] = r_[64 * i_]; } } while (0)
#define PE_DOT(BUF, Z, zo_) do { _Pragma("unroll") for (int q_ = 0; q_ < 2; ++q_) { f32x2 acc_ = {0.f, 0.f}; \
            _Pragma("unroll") for (int i_ = 0; i_ < 4; ++i_) _Pragma("unroll") for (int c_ = 0; c_ < 4; ++c_) { \
                const f32x2 lo_ = __builtin_amdgcn_cvt_pk_f32_fp8((int)BUF[q_][i_][c_], false), hi_ = __builtin_amdgcn_cvt_pk_f32_fp8((int)BUF[q_][i_][c_], true); \
                acc_ = __builtin_elementwise_fma(lo_, x[8 * i_ + 2 * c_], acc_); acc_ = __builtin_elementwise_fma(hi_, x[8 * i_ + 2 * c_ + 1], acc_); } \
            Z[(zo_) + q_] = acc_.x + acc_.y; } } while (0)
#define PE_AXPY(BUF, kb_) do { _Pragma("unroll") for (int q_ = 0; q_ < 2; ++q_) { const float wt_ = wsm[(kb_) + q_]; const f32x2 wt2_ = {wt_, wt_}; \
            _Pragma("unroll") for (int i_ = 0; i_ < 4; ++i_) _Pragma("unroll") for (int c_ = 0; c_ < 4; ++c_) { \
                const f32x2 lo_ = __builtin_amdgcn_cvt_pk_f32_fp8((int)BUF[q_][i_][c_], false), hi_ = __builtin_amdgcn_cvt_pk_f32_fp8((int)BUF[q_][i_][c_], true); \
                y[8 * i_ + 2 * c_] = __builtin_elementwise_fma(lo_, wt2_, y[8 * i_ + 2 * c_]); y[8 * i_ + 2 * c_ + 1] = __builtin_elementwise_fma(hi_, wt2_, y[8 * i_ + 2 * c_ + 1]); } } } while (0)
#define PE_SB() __builtin_amdgcn_sched_barrier(0)
        u32x4 bA[2][4], bB[2][4];
        {
            f32x2 x[32];
#pragma unroll
            for (int i = 0; i < 4; ++i)
#pragma unroll
                for (int q4 = 0; q4 < 4; ++q4) { const f32x4 v = *(const f32x4*)(hrow + 1024 * i + 4 * q4); x[8 * i + 2 * q4] = (f32x2){v.x, v.y}; x[8 * i + 2 * q4 + 1] = (f32x2){v.z, v.w}; }
            PE_LOAD(bA, U8, 0); PE_SB();
#pragma unroll 1
            for (int k0 = 0; k0 < 128; k0 += 8) {
                const int iv = (k0 & 64) ? idx1 : idx0; const float gv = (k0 & 64) ? g1 : g0;
                float z[8];
                PE_LOAD(bB, U8, k0 + 2); PE_SB(); PE_DOT(bA, z, 0); PE_SB();
                PE_LOAD(bA, U8, k0 + 4); PE_SB(); PE_DOT(bB, z, 2); PE_SB();
                PE_LOAD(bB, U8, k0 + 6); PE_SB(); PE_DOT(bA, z, 4); PE_SB();
                PE_LOAD(bA, U8, (k0 + 8) & 127); PE_SB(); PE_DOT(bB, z, 6); PE_SB();
                float r4[4], r2[2], r1;
#pragma unroll
                for (int i = 0; i < 4; ++i) { const float keep = (lane & 32) ? z[i + 4] : z[i], send = (lane & 32) ? z[i] : z[i + 4]; r4[i] = keep + __shfl_xor(send, 32); }
#pragma unroll
                for (int i = 0; i < 2; ++i) { const float keep = (lane & 16) ? r4[i + 2] : r4[i], send = (lane & 16) ? r4[i] : r4[i + 2]; r2[i] = keep + __shfl_xor(send, 16); }
                { const float keep = (lane & 8) ? r2[1] : r2[0], send = (lane & 8) ? r2[0] : r2[1]; r1 = keep + __shfl_xor(send, 8); }
                r1 += __shfl_xor(r1, 4); r1 += __shfl_xor(r1, 2); r1 += __shfl_xor(r1, 1);
                const int q = lane >> 3; const int e = __shfl(iv, (k0 + q) & 63); const float gt_ = __shfl(gv, (k0 + q) & 63);
                if ((lane & 7) == 0) { const float zz = r1 * USC[e]; const float act = 0.5f * zz * (1.f + erff(zz * 0.70710678118654752f)); wsm[k0 + q] = act * gt_ * VSC[e]; }
            }
        }
        LDS_WAIT();
        f32x2 y[32];
#pragma unroll
        for (int i = 0; i < 32; ++i) y[i] = (f32x2){0.f, 0.f};
        PE_LOAD(bA, V8, 0); PE_SB();
#pragma unroll 1
        for (int k0 = 0; k0 < 128; k0 += 8) {
            PE_LOAD(bB, V8, k0 + 2); PE_SB(); PE_AXPY(bA, k0); PE_SB();
            PE_LOAD(bA, V8, k0 + 4); PE_SB(); PE_AXPY(bB, k0 + 2); PE_SB();
            PE_LOAD(bB, V8, k0 + 6); PE_SB(); PE_AXPY(bA, k0 + 4); PE_SB();
            PE_LOAD(bA, V8, (k0 + 8) & 127); PE_SB(); PE_AXPY(bB, k0 + 6); PE_SB();
        }
#undef PE_LOAD
#undef PE_DOT
#undef PE_AXPY
#undef PE_SB
        float s = 0.f;
#pragma unroll
        for (int i = 0; i < 4; ++i)
#pragma unroll
            for (int q4 = 0; q4 < 4; ++q4) { const f32x4 v = *(const f32x4*)(hrow + 1024 * i + 4 * q4);
                y[8 * i + 2 * q4].x += ALPHA * v.x; y[8 * i + 2 * q4].y += ALPHA * v.y; y[8 * i + 2 * q4 + 1].x += ALPHA * v.z; y[8 * i + 2 * q4 + 1].y += ALPHA * v.w; }
#pragma unroll
        for (int i = 0; i < 32; ++i) s += y[i].x + y[i].y;
        const float mean = wave_sum(s) * (1.f / DM); float s2 = 0.f;
#pragma unroll
        for (int i = 0; i < 32; ++i) { y[i].x -= mean; y[i].y -= mean; s2 += y[i].x * y[i].x + y[i].y * y[i].y; }
        const float rstd = 1.f / sqrtf(wave_sum(s2) * (1.f / DM) + LN_EPS);
#pragma unroll
        for (int i = 0; i < 4; ++i)
#pragma unroll
            for (int q4 = 0; q4 < 4; ++q4) { const int c = 1024 * i + 16 * lane + 4 * q4;
                const f32x4 gg = *(const f32x4*)(g + c), bb = *(const f32x4*)(bta + c); f32x4 o;
                o.x = y[8 * i + 2 * q4].x * rstd * gg.x + bb.x; o.y = y[8 * i + 2 * q4].y * rstd * gg.y + bb.y; o.z = y[8 * i + 2 * q4 + 1].x * rstd * gg.z + bb.z; o.w = y[8 * i + 2 * q4 + 1].y * rstd * gg.w + bb.w;
                *(f32x4*)(outf + (size_t)t * DM + c) = o;
                if (outb) { u32x2 p; p.x = pk2(o.x, o.y); p.y = pk2(o.z, o.w); *(u32x2*)(outb + (size_t)t * DM + c) = p; } }
    }
}

__device__ __forceinline__ void ph_attn_l0(const Args& a, LAS unsigned char* lds, const WI& w) {
    for (int pr = w.bid; pr < 256; pr += w.nblk) { const int bh = pr >> 3, x = pr & 7;
        for (int pass = 0; pass < 2; ++pass) fa::attn_unit<1>(a, 0, lds, bh >> 4, bh & 15, pass ? 15 - x : x); }
    for (int u = w.bid; u < 512; u += w.nblk) { const int bh = u >> 4; fa::attn_unit<0>(a, 0, lds, bh >> 4, bh & 15, u & 15); }
}
__device__ __forceinline__ void ph_attn_l1(const Args& a, LAS unsigned char* lds, const WI& w) {
    for (int pr = w.bid; pr < 256; pr += w.nblk) { const int bh = pr >> 3, x = pr & 7;
        for (int pass = 0; pass < 2; ++pass) fa::attn_unit<2>(a, 1, lds, bh >> 4, bh & 15, pass ? 15 - x : x); }
    for (int pr = w.bid; pr < 256; pr += w.nblk) { const int bh = pr >> 3, x = pr & 7;
        for (int pass = 0; pass < 2; ++pass) fa::attn_unit<3>(a, 1, lds, bh >> 4, bh & 15, pass ? 15 - x : x); }
}
__device__ __forceinline__ void ph_attn_mem(const Args& a, int layer, LAS unsigned char* lds, const WI& w) {
    for (int u = w.bid; u < 128; u += w.nblk) { const int bh = u >> 4; fa::attn_unit<4>(a, layer, lds, bh >> 2, bh & 3, u & 15); }
}

__global__ void __launch_bounds__(512, 2) mega(Args a) {
    extern __shared__ __attribute__((aligned(16))) unsigned char lds_raw[];
    LAS unsigned char* lds = (LAS unsigned char*)lds_raw;
    WI w; w.tid = threadIdx.x; w.lane = w.tid & 63; w.wave = __builtin_amdgcn_readfirstlane(w.tid >> 6);
    w.bid = blockIdx.x; w.nblk = gridDim.x; w.gw = w.bid * 8 + w.wave; w.ngw = w.nblk * 8;
    unsigned char* ws = a.ws;
    volatile LAS unsigned* misc = (volatile LAS unsigned*)(lds + LDS_MISC);
    if (w.tid < 4) misc[w.tid] = 0u;
    __syncthreads();
    XcdBarrier bar; bar.bar = (unsigned*)(ws + WS_CTL) + 4096; bar.x = 0; bar.st = misc;
#if !MK_PER_PHASE
    bar = xcd_barrier_post((unsigned*)(ws + WS_CTL) + 4096, misc);
#endif
    const int lo = a.ph_lo, hi = a.ph_hi;
#define IN(k) (lo <= (k) && (k) < hi)
#if MK_PER_PHASE
#define SEAM(k) do { } while (0)
#else
#define SEAM(k) do { if (IN(k) && IN((k) + 1)) xcd_barrier(bar); } while (0)
#endif
    LAS float* wlds = (LAS float*)(lds + w.wave * 16384);
    bf16_t* XB = (bf16_t*)(ws + WS_XB); float* HF = (float*)(ws + WS_HF); float* RES = (float*)(ws + WS_RES); bf16_t* PROJ = (bf16_t*)(ws + WS_PROJ);
    bf16_t* ATT = (bf16_t*)(ws + WS_ATT); float* SMALL = (float*)(ws + WS_SMALL);

#define FAST_GEMM(EPI_T, Aptr, lda_, Btptr, ldb_, M_, N_, K_, nz_, zA_, zB_, EPI_OBJ) do { \
        pg8::Gemm g_{Aptr, Btptr, M_, N_, K_, lda_, ldb_, zA_, zB_, nz_}; pg8::StaticOrder S_; S_.init(M_, N_, nz_, w.nblk, w.bid); \
        pg8::gemm_phase<EPI_T, pg8::StaticOrder>(lds, g_, S_, EPI_OBJ); } while (0)
    if (IN(0)) { ph_convert(a, lds, w); if (PROBE_DUP == 0) ph_convert(a, lds, w); }
    SEAM(0);
    if (IN(1)) {
        FAST_GEMM(pg8::EpiBf16, XB, DM, (const bf16_t*)(ws + WS_W_AB_IN), DM, T, AB_MAIN, DM, 1, 0, 0, (pg8::EpiBf16{PROJ, AB_MAIN, nullptr}));
        naive_gemm(XB, DM, (const bf16_t*)(ws + WS_W_AB_IN) + (size_t)AB_MAIN * DM, DM, T, 64, DM, w, [=](int m, int n, float v) { SMALL[(size_t)m * 128 + n] = v; });
        bf16_t* KVM = (bf16_t*)(ws + WS_KVM);
        naive_gemm((const bf16_t*)(ws + WS_MEMB), DM, (const bf16_t*)(ws + WS_W_MEM_KV), DM, 512, 2048, DM, w,
                   [=](int m, int n, float v) { KVM[((size_t)(n >> 10) * 512 + m) * 1024 + (n & 1023)] = (bf16_t)f2bf(v); });
    }
    SEAM(1);
    if (IN(2)) ph_l0_stats(a, w);
    SEAM(2);
    if (IN(3)) {
        const float* rsq = (const float*)(ws + WS_RSQ); const float* rskv = (const float*)(ws + WS_RSKV);
        bf16_t* QB = (bf16_t*)(ws + WS_QB); bf16_t* KVB = (bf16_t*)(ws + WS_KVB);
        FAST_GEMM(pg8::EpiBf16, PROJ + 6144, AB_MAIN, (const bf16_t*)(ws + WS_W_UQ), 1536, T, 3072, 1536, 1, 0, 0, (pg8::EpiBf16{QB, 3072, rsq}));
        FAST_GEMM(pg8::EpiBf16, PROJ + 7680, AB_MAIN, (const bf16_t*)(ws + WS_W_UKV), 512, T, 4096, 512, 1, 0, 0, (pg8::EpiBf16{KVB, 4096, rskv}));
    }
    SEAM(3);
    if (IN(4)) ph_l0_qrope(a, w);
    SEAM(4);
    if (IN(5)) { ph_attn_l0(a, lds, w); if (PROBE_DUP == 5) ph_attn_l0(a, lds, w); }
    SEAM(5);
    if (IN(6)) { const float* X = a.in[I_X];
        FAST_GEMM(pg8::EpiResid, ATT, DM, (const bf16_t*)(ws + WS_W_AB_OUT), DM, T, DM, DM, 1, 0, 0, (pg8::EpiResid{X, RES, DM})); }
    SEAM(6);
    if (IN(7)) ln_rows(RES, a.in[I_LN_G] + 0 * DM, a.in[I_LN_B] + 0 * DM, HF, XB, w);
    SEAM(7);

#define MEM_PEER_PHASES(L, P0_, LAST)                                                                                                                         \
    if (IN(P0_)) { FAST_GEMM(pg8::EpiF32, XB, DM, (const bf16_t*)(ws + WS_W_MEM_Q) + (size_t)(L) * 512 * DM, DM, T, 512, 1024, 4, 1024, 1024,                    \
                             (pg8::EpiF32{(float*)(ws + WS_MQP), 512, (long)T * 512})); }                                                                       \
    SEAM(P0_);                                                                                                                                                  \
    if (IN(P0_ + 1)) ph_attn_mem(a, (L), lds, w);                                                                                                               \
    SEAM(P0_ + 1);                                                                                                                                              \
    if (IN(P0_ + 2)) { FAST_GEMM(pg8::EpiResid, (const bf16_t*)(ws + WS_MEMO), 512, (const bf16_t*)(ws + WS_W_MEM_O) + (size_t)(L) * DM * 512, 512, T, DM, 512, 1, 0, 0, \
                                 (pg8::EpiResid{HF, RES, DM})); }                                                                                               \
    SEAM(P0_ + 2);                                                                                                                                              \
    if (IN(P0_ + 3)) ln_rows(RES, a.in[I_LN_G] + ((L) * 3 + 1) * DM, a.in[I_LN_B] + ((L) * 3 + 1) * DM, HF, XB, w);                                             \
    SEAM(P0_ + 3);                                                                                                                                              \
    if (IN(P0_ + 4)) { FAST_GEMM(pg8::EpiF32, (const bf16_t*)(ws + WS_W_PEER) + (size_t)(L) * 2048 * DM, DM, XB, DM, 2048, T, DM, 1, 0, 0,                     \
                                 (pg8::EpiF32{(float*)(ws + WS_PSCORE), T, 0})); }                                                                              \
    SEAM(P0_ + 4);                                                                                                                                              \
    if (IN(P0_ + 5)) { ph_peer_topk(a, w); if (PROBE_DUP == 27 && (LAST)) ph_peer_topk(a, w); }                                                                 \
    SEAM(P0_ + 5);                                                                                                                                              \
    if (IN(P0_ + 6)) { ph_peer_experts(a, (L), (LAST) ? a.out : HF, (LAST) ? (bf16_t*)nullptr : XB, a.in[I_LN_G] + ((L) * 3 + 2) * DM, a.in[I_LN_B] + ((L) * 3 + 2) * DM, wlds, w); \
        if (PROBE_DUP == 28 && (LAST)) ph_peer_experts(a, (L), a.out, (bf16_t*)nullptr, a.in[I_LN_G] + ((L) * 3 + 2) * DM, a.in[I_LN_B] + ((L) * 3 + 2) * DM, wlds, w); } \
    if (!(LAST)) SEAM(P0_ + 6);

    MEM_PEER_PHASES(0, 8, false)

    if (IN(15)) {
        FAST_GEMM(pg8::EpiBf16, XB, DM, (const bf16_t*)(ws + WS_W_CD_IN), DM, T, CD_MAIN, DM, 1, 0, 0, (pg8::EpiBf16{PROJ, CD_MAIN, nullptr}));
        naive_gemm(XB, DM, (const bf16_t*)(ws + WS_W_CD_IN) + (size_t)CD_MAIN * DM, DM, T, 112, DM, w, [=](int m, int n, float v) { SMALL[(size_t)m * 128 + n] = v; });
    }
    SEAM(15);
    if (IN(16)) ph_l1_elem(a, w);
    SEAM(16);
    if (IN(17)) { ph_l1_scan(a, w); ph_l1_index(a, lds, w); if (PROBE_DUP == 17) ph_l1_index(a, lds, w); }
    SEAM(17);
    if (IN(18)) { ph_l1_select(a, w); if (PROBE_DUP == 18) ph_l1_select(a, w); }
    SEAM(18);
    if (IN(19)) { ph_attn_l1(a, lds, w); if (PROBE_DUP == 19) ph_attn_l1(a, lds, w); }
    SEAM(19);
    if (IN(20)) { FAST_GEMM(pg8::EpiResid, ATT, DM, (const bf16_t*)(ws + WS_W_CD_OUT), DM, T, DM, DM, 1, 0, 0, (pg8::EpiResid{HF, RES, DM})); }
    SEAM(20);
    if (IN(21)) ln_rows(RES, a.in[I_LN_G] + 3 * DM, a.in[I_LN_B] + 3 * DM, HF, XB, w);
    SEAM(21);
    MEM_PEER_PHASES(1, 22, true)
#undef IN
#undef SEAM
}

extern "C" void kernel_launch(void* const* d_in, const int* in_sizes, int n_in, void* d_out, int out_size, void* d_ws, size_t ws_size, hipStream_t stream) {
    static int grid = 0;
    if (grid == 0) {
        if (n_in != 21 || out_size != T * DM || ws_size < WS_END) { fprintf(stderr, "kernel_launch: unexpected shapes (n_in %d out %d ws %zu need %zu)\n", n_in, out_size, ws_size, (size_t)WS_END); grid = -1; return; }
        int dev = 0, cus = 0, per_cu = 0;
        if (hipGetDevice(&dev) != hipSuccess || hipDeviceGetAttribute(&cus, hipDeviceAttributeMultiprocessorCount, dev) != hipSuccess) { grid = -1; return; }
        if (hipFuncSetAttribute((const void*)mega, hipFuncAttributeMaxDynamicSharedMemorySize, LDS_BYTES) != hipSuccess) { fprintf(stderr, "kernel_launch: hipFuncSetAttribute failed\n"); grid = -1; return; }
        if (hipOccupancyMaxActiveBlocksPerMultiprocessor(&per_cu, (const void*)mega, 512, LDS_BYTES) != hipSuccess || per_cu < 1) { fprintf(stderr, "kernel_launch: occupancy query says %d\n", per_cu); }
        (void)hipGetLastError();
        grid = cus;
    }
    if (grid < 0) return;
    (void)hipMemsetAsync((char*)d_ws + WS_CTL, 0, CTL_BYTES, stream);
    Args a{};
    for (int i = 0; i < 21; ++i) a.in[i] = (const float*)d_in[i];
    a.out = (float*)d_out; a.ws = (unsigned char*)d_ws;
#if MK_PER_PHASE
    for (int p = 0; p < NPHASE; ++p) { a.ph_lo = p; a.ph_hi = p + 1; hipLaunchKernelGGL(mega, dim3(grid), dim3(512), LDS_BYTES, stream, a); }
#else
    a.ph_lo = 0; a.ph_hi = NPHASE;
    hipLaunchKernelGGL(mega, dim3(grid), dim3(512), LDS_BYTES, stream, a);
#endif
}
```

```cpp
#include <hip/hip_runtime.h>
#include <cstdio>
#include <cstdint>

#define GAS __attribute__((address_space(1)))
#define LAS __attribute__((address_space(3)))
typedef unsigned short bf16_t;
typedef short bf16x8 __attribute__((ext_vector_type(8)));
typedef float f32x4 __attribute__((ext_vector_type(4)));
typedef float f32x16 __attribute__((ext_vector_type(16)));
typedef unsigned u32x4 __attribute__((ext_vector_type(4)));
typedef unsigned u32x2 __attribute__((ext_vector_type(2)));
typedef float f32x2 __attribute__((ext_vector_type(2)));

#ifndef PROBE_DUP
#define PROBE_DUP -1
#endif
#ifndef MK_PER_PHASE
#define MK_PER_PHASE 0
#endif

constexpr int NB = 2, SEQ = 4096, T = NB * SEQ, DM = 4096;
constexpr int AB_COLS = 8256, AB_MAIN = 8192, AB_PAD = 8448;
constexpr int CD_COLS = 11376, CD_MAIN = 11264, CD_PAD = 11520;
constexpr float ALPHA = 1.4142135623730951f;
constexpr float LN_EPS = 1e-5f, RMS_EPS = 1e-6f;
constexpr int NPHASE = 29;

constexpr size_t MiB = 1ull << 20;
constexpr size_t WS_CTL = 0, CTL_BYTES = 1 * MiB;
constexpr size_t WS_ROPE128 = 1 * MiB;
constexpr size_t WS_ROPE64 = 3 * MiB;
constexpr size_t WS_RSQ = 4 * MiB;
constexpr size_t WS_RSKV = 4 * MiB + 65536;
constexpr size_t WS_CUM = 5 * MiB;
constexpr size_t WS_LOGF = 5 * MiB + 524288;
constexpr size_t WS_KR = 6 * MiB;
constexpr size_t WS_KI = 7 * MiB;
constexpr size_t WS_WI = 8 * MiB;
constexpr size_t WS_KVM = 9 * MiB;
constexpr size_t WS_MEMB = 11 * MiB;
constexpr size_t WS_MASK = 15 * MiB;
constexpr size_t WS_PIDX = 19 * MiB;
constexpr size_t WS_PGATE = 23 * MiB;
constexpr size_t WS_MEMQ = 27 * MiB;
constexpr size_t WS_MEMO = 35 * MiB;
constexpr size_t WS_SMALL = 43 * MiB;
constexpr size_t WS_W_AB_IN = 64 * MiB;
constexpr size_t WS_W_UQ = 130 * MiB;
constexpr size_t WS_W_UKV = 139 * MiB;
constexpr size_t WS_W_AB_OUT = 143 * MiB;
constexpr size_t WS_W_CD_IN = 175 * MiB;
constexpr size_t WS_W_CD_OUT = 265 * MiB;
constexpr size_t WS_W_MEM_Q = 297 * MiB;
constexpr size_t WS_W_MEM_KV = 305 * MiB;
constexpr size_t WS_W_MEM_O = 321 * MiB;
constexpr size_t WS_W_PEER = 329 * MiB;
constexpr size_t WS_U8 = 361 * MiB;
constexpr size_t WS_V8 = 489 * MiB;
constexpr size_t WS_USC = 48 * MiB;
constexpr size_t WS_VSC = 48 * MiB + 262144;
constexpr size_t WS_XB = 873 * MiB;
constexpr size_t WS_HF = 937 * MiB;
constexpr size_t WS_RES = 1065 * MiB;
constexpr size_t WS_PROJ = 1193 * MiB;
constexpr size_t WS_PSCORE = WS_PROJ;
constexpr size_t WS_ATT = 1369 * MiB;
constexpr size_t WS_QB = 1433 * MiB;
constexpr size_t WS_KVB = 1481 * MiB;
constexpr size_t WS_SCORE = 1433 * MiB;
constexpr size_t WS_MQP = 1561 * MiB;
constexpr size_t WS_END = 1625 * MiB;

constexpr int LDS_BYTES = 147456;
constexpr int LDS_MISC = 140 * 1024;

#define LDS_WAIT() asm volatile("s_waitcnt lgkmcnt(0)" ::: "memory")
__device__ __forceinline__ float bf2f(bf16_t b) { return __uint_as_float(((unsigned)b) << 16); }
__device__ __forceinline__ unsigned f2bf(float f) { unsigned u = __float_as_uint(f); return (u + 0x7fffu + ((u >> 16) & 1u)) >> 16; }
__device__ __forceinline__ unsigned pk2(float lo, float hi) { return f2bf(lo) | (f2bf(hi) << 16); }
__device__ __forceinline__ float wave_sum(float v) {
#pragma unroll
    for (int o = 1; o < 64; o <<= 1) v += __shfl_xor(v, o);
    return v;
}
__device__ __forceinline__ float wave_max(float v) {
#pragma unroll
    for (int o = 1; o < 64; o <<= 1) v = fmaxf(v, __shfl_xor(v, o));
    return v;
}
__device__ __forceinline__ int wave_sum_i(int v) {
#pragma unroll
    for (int o = 1; o < 64; o <<= 1) v += __shfl_xor(v, o);
    return v;
}

#define XB_TMO      128
#define XB_XCNT(j)  (256  + 64 * (j))
#define XB_XSUB(j)  (1280 + 64 * (j))
#define XB_XGEN(j)  (2304 + 64 * (j))
#define XB_TOP      3328
#define XB_TOPGEN   3392
#define XCD_BAR_WORDS 3456
#define XB_SPIN_CAP (1u << 22)

__device__ __forceinline__ unsigned xb_ld(unsigned* p)              { return __hip_atomic_load(p, __ATOMIC_RELAXED, __HIP_MEMORY_SCOPE_AGENT); }
__device__ __forceinline__ unsigned xb_add(unsigned* p, unsigned v) { return __hip_atomic_fetch_add(p, v, __ATOMIC_RELAXED, __HIP_MEMORY_SCOPE_AGENT); }
__device__ __forceinline__ unsigned xb_xcc_id() { return (unsigned)__builtin_amdgcn_s_getreg((3 << 11) | 20) & 0xFu; }
#define XB_SPIN(cond, bar) do { unsigned _sp = 0; while (cond) { __builtin_amdgcn_s_sleep(1); \
    if ((++_sp & 255u) == 0u) { if (xb_ld(&(bar)[XB_TMO])) break; if (_sp > XB_SPIN_CAP) { atomicAdd(&(bar)[XB_TMO], 1u); break; } } } } while (0)

struct XcdBarrier { unsigned* bar; unsigned x; volatile LAS unsigned* st; };

__device__ __forceinline__ XcdBarrier xcd_barrier_post(unsigned* bar, volatile LAS unsigned* st) {
    XcdBarrier b; b.bar = bar; b.x = xb_xcc_id(); b.st = st;
    if (threadIdx.x == 0) (void)xb_add(&bar[XB_XCNT(b.x)], 1u);
    return b;
}
__device__ __forceinline__ void xcd_barrier_complete(unsigned* bar, unsigned x, unsigned& nloc, unsigned& nx) {
    const unsigned G = gridDim.x * gridDim.y * gridDim.z;
    unsigned sum, cnt, mine, sp = 0u;
    for (;;) {
        sum = 0u; cnt = 0u; mine = 0u;
#pragma unroll
        for (unsigned j = 0; j < 16; ++j) { const unsigned c = xb_ld(&bar[XB_XCNT(j)]); sum += c; cnt += (c > 0u) ? 1u : 0u; mine = (j == x) ? c : mine; }
        if (sum == G) break;
        __builtin_amdgcn_s_sleep(1);
        if ((++sp & 255u) == 0u) { if (xb_ld(&bar[XB_TMO])) break; if (sp > XB_SPIN_CAP) { atomicAdd(&bar[XB_TMO], 1u); break; } }
    }
    nloc = mine > 0u ? mine : 1u; nx = cnt > 0u ? cnt : 1u;
}
__device__ __forceinline__ void xcd_barrier(const XcdBarrier& b) {
    asm volatile("s_waitcnt vmcnt(0)" ::: "memory");
    __syncthreads();
    if (threadIdx.x == 0) {
        unsigned* bar = b.bar;
        __builtin_amdgcn_s_waitcnt(0);
        unsigned nloc = b.st[0], nx = b.st[1];
        if (nloc == 0u) { xcd_barrier_complete(bar, b.x, nloc, nx); b.st[0] = nloc; b.st[1] = nx; }
        const unsigned old = xb_add(&bar[XB_XSUB(b.x)], 1u);
        const unsigned gen = old / nloc;
        if (old + 1u == (gen + 1u) * nloc) {
            __builtin_amdgcn_fence(__ATOMIC_RELEASE, "agent");
            asm volatile("s_waitcnt vmcnt(0)" ::: "memory");
            const unsigned og = xb_add(&bar[XB_TOP], 1u);
            const unsigned tg = og / nx;
            if (og + 1u == (tg + 1u) * nx) xb_add(&bar[XB_TOPGEN], 1u);
            else XB_SPIN(xb_ld(&bar[XB_TOPGEN]) == tg, bar);
            __builtin_amdgcn_fence(__ATOMIC_ACQUIRE, "agent");
            xb_add(&bar[XB_XGEN(b.x)], 1u);
            asm volatile("s_waitcnt vmcnt(0)" ::: "memory");
        } else {
            XB_SPIN(xb_ld(&bar[XB_XGEN(b.x)]) == gen, bar);
            __builtin_amdgcn_fence(__ATOMIC_ACQUIRE, "agent");
            asm volatile("s_waitcnt vmcnt(0)" ::: "memory");
        }
    }
    __syncthreads();
}

namespace pg8 {
constexpr int BM = 256, BK = 64, HALF = 128, HTB = HALF * BK * 2, STAGE_BYTES = 8 * HTB, NXCD = 8, WGM = 8;
__host__ __device__ __forceinline__ int lds_byte(int r, int c) { const int st = (r >> 4) * 2 + (c >> 5), rr = r & 15, cc = c & 31, ob = rr * 64 + cc * 2; return st * 1024 + (ob ^ (((ob >> 9) & 1) << 5)); }
__host__ __device__ __forceinline__ void stage_rc(int b, int& R, int& C) { const int st = b / 1024, sb = b % 1024, swz = sb ^ (((sb >> 9) & 1) << 5); R = (st >> 1) * 16 + swz / 64; C = (st & 1) * 32 + (swz % 64) / 2; }
__host__ __device__ __forceinline__ int perm32(int rho) { const int n = rho >> 4, i = rho & 15; return 8 * (i >> 2) + 4 * n + (i & 3); }
struct Unit { int pm, pn, z; };
struct Gemm { const bf16_t* A; const bf16_t* Bt; int M, N, K, lda, ldb; long zA, zB; int nz; };
struct StaticOrder {
    int nM, nN, nZ, nwg, G, c;
    __device__ void init(int M, int N, int Z, int G_, int c_) { nM = M / BM; nN = N / BM; nZ = Z; nwg = nM * nN * nZ; G = G_; c = c_; }
    __device__ bool next(int i, Unit& u) const {
        const long L = (long)i * G + c; if (L >= nwg) return false;
        int wgid = (int)L; { const int q = nwg / NXCD, r = nwg % NXCD, xcd = wgid % NXCD, off = wgid / NXCD; wgid = (xcd < r ? xcd * (q + 1) : r * (q + 1) + (xcd - r) * q) + off; }
        const int per = nM * nN; u.z = wgid / per; wgid -= u.z * per;
        const int nig = WGM * nN, gid = wgid / nig, fm = gid * WGM, gsz = (nM - fm) < WGM ? (nM - fm) : WGM;
        u.pm = fm + ((wgid % nig) % gsz); u.pn = (wgid % nig) / gsz; return true;
    }
};
__device__ __forceinline__ unsigned cvt_pk_bf16(float lo, float hi) { unsigned r; asm volatile("v_cvt_pk_bf16_f32 %0, %1, %2" : "=v"(r) : "v"(lo), "v"(hi)); return r; }
struct EpiF32 {
    static constexpr bool PERM = false;
    float* C; int ldc; long zC;
    __device__ __forceinline__ void operator()(const f32x4 (&acc)[2][2][4][2], const Unit& u, int wr, int wc, int fr, int fq) const {
        const int row0 = u.pm * BM + wr * 64 + fr, col0 = u.pn * BM + wc * 32 + 4 * fq; float* Cz = C + (size_t)u.z * zC;
#pragma unroll
        for (int ai = 0; ai < 2; ++ai)
#pragma unroll
            for (int m = 0; m < 4; ++m) { float* rowp = Cz + (size_t)(row0 + ai * HALF + m * 16) * ldc + col0;
#pragma unroll
                for (int bj = 0; bj < 2; ++bj)
#pragma unroll
                    for (int n = 0; n < 2; ++n) *(f32x4*)(rowp + bj * HALF + n * 16) = acc[ai][bj][m][n]; }
    }
};
struct EpiResid {
    static constexpr bool PERM = false;
    const float* base; float* out; int ldc;
    __device__ __forceinline__ void operator()(const f32x4 (&acc)[2][2][4][2], const Unit& u, int wr, int wc, int fr, int fq) const {
        const int row0 = u.pm * BM + wr * 64 + fr, col0 = u.pn * BM + wc * 32 + 4 * fq;
#pragma unroll
        for (int ai = 0; ai < 2; ++ai)
#pragma unroll
            for (int m = 0; m < 4; ++m) { const size_t off = (size_t)(row0 + ai * HALF + m * 16) * ldc + col0;
#pragma unroll
                for (int bj = 0; bj < 2; ++bj)
#pragma unroll
                    for (int n = 0; n < 2; ++n) { const f32x4 bs = *(const f32x4*)(base + off + bj * HALF + n * 16); *(f32x4*)(out + off + bj * HALF + n * 16) = bs * ALPHA + acc[ai][bj][m][n]; }
                asm volatile("" ::: "memory"); }
    }
};
struct EpiBf16 {
    static constexpr bool PERM = true;
    bf16_t* O; int ldc; const float* rs;
    __device__ __forceinline__ void operator()(const f32x4 (&acc)[2][2][4][2], const Unit& u, int wr, int wc, int fr, int fq) const {
        const int row0 = u.pm * BM + wr * 64 + fr, col0 = u.pn * BM + wc * 32 + 8 * fq;
#pragma unroll
        for (int ai = 0; ai < 2; ++ai)
#pragma unroll
            for (int m = 0; m < 4; ++m) { const int row = row0 + ai * HALF + m * 16; bf16_t* rowp = O + (size_t)row * ldc + col0; const float sc = rs ? rs[row] : 1.f;
#pragma unroll
                for (int bj = 0; bj < 2; ++bj) { const f32x4 v0 = acc[ai][bj][m][0] * sc, v1 = acc[ai][bj][m][1] * sc;
                    u32x4 wv; wv.x = cvt_pk_bf16(v0[0], v0[1]); wv.y = cvt_pk_bf16(v0[2], v0[3]); wv.z = cvt_pk_bf16(v1[0], v1[1]); wv.w = cvt_pk_bf16(v1[2], v1[3]);
                    *(u32x4*)(rowp + bj * HALF) = wv; } }
    }
};
template <class Epi, class Sched>
__device__ __forceinline__ void gemm_phase(LAS unsigned char* lds, const Gemm g, const Sched& S, const Epi& E) {
    const int tid = threadIdx.x, wid = __builtin_amdgcn_readfirstlane(tid >> 6), lane = tid & 63, wr = wid >> 2, wc = wid & 3, fr = lane & 15, fq = lane >> 4;
    const int K = g.K, nt = K / BK;
    unsigned voffA[2], voffB[2];
#pragma unroll
    for (int i = 0; i < 2; ++i) { int R, C; stage_rc(tid * 16 + i * 8192, R, C); const int Rb = Epi::PERM ? ((R & ~31) + perm32(R & 31)) : R;
        voffA[i] = (unsigned)(R * g.lda + C) * 2u; voffB[i] = (unsigned)(Rb * g.ldb + C) * 2u; }
    const size_t kstep = (size_t)(BK * 2);
    const size_t hA = (size_t)HALF * g.lda * 2, hB = (size_t)HALF * g.ldb * 2;
    const size_t tA = 2 * hA, tB = 2 * hB;
    const unsigned ldsw = (unsigned)wid * 1024u;
    const int aoff = lds_byte(wr * 64 + fr, fq * 8), boff = lds_byte(wc * 32 + fr, fq * 8);
#define PG8_SA(b, h) (((b) * 2 + (h)) * HTB)
#define PG8_SB(b, h) ((4 + (b) * 2 + (h)) * HTB)
#define PG8_STAGE(bufoff, gbase, voff) do { _Pragma("unroll") for (int _i = 0; _i < 2; ++_i) \
        __builtin_amdgcn_global_load_lds((const unsigned*)((const char*)(gbase) + (voff)[_i]), (LAS unsigned*)(lds + (bufoff) + ldsw + _i * 8192), 16, 0, 0); } while (0)
#define PG8_LDA(dst, b, h) do { _Pragma("unroll") for (int m = 0; m < 4; ++m) _Pragma("unroll") for (int k = 0; k < 2; ++k) dst[m][k] = *(const LAS bf16x8*)(lds + PG8_SA(b, h) + aoff + m * 2048 + k * 1024); } while (0)
#define PG8_LDB(dst, b, h) do { _Pragma("unroll") for (int n = 0; n < 2; ++n) _Pragma("unroll") for (int k = 0; k < 2; ++k) dst[n][k] = *(const LAS bf16x8*)(lds + PG8_SB(b, h) + boff + n * 2048 + k * 1024); } while (0)
#define PG8_MMA(ai, bj, At, Bt) do { __builtin_amdgcn_s_setprio(1); _Pragma("unroll") for (int m = 0; m < 4; ++m) _Pragma("unroll") for (int n = 0; n < 2; ++n) _Pragma("unroll") for (int k = 0; k < 2; ++k) \
        acc[ai][bj][m][n] = __builtin_amdgcn_mfma_f32_16x16x32_bf16(Bt[n][k], At[m][k], acc[ai][bj][m][n], 0, 0, 0); __builtin_amdgcn_s_setprio(0); } while (0)
#define PG8_WAIT_V(n) asm volatile("s_waitcnt vmcnt(" #n ")" ::: "memory")
#define PG8_WAIT_L(n) asm volatile("s_waitcnt lgkmcnt(" #n ")" ::: "memory")
#define PG8_BAR __builtin_amdgcn_s_barrier()
#define PG8_SCHED __builtin_amdgcn_sched_barrier(0)
    Unit cur, nxt; int ui = 0;
    if (!S.next(0, cur)) return;
    f32x4 acc[2][2][4][2];
#pragma unroll
    for (int a = 0; a < 2; ++a)
#pragma unroll
        for (int b = 0; b < 2; ++b)
#pragma unroll
            for (int m = 0; m < 4; ++m)
#pragma unroll
                for (int n = 0; n < 2; ++n) acc[a][b][m][n] = (f32x4){0.f, 0.f, 0.f, 0.f};
    bf16x8 At[4][2], B0[2][2], B1[2][2];
    const char* cA = (const char*)g.A + (size_t)cur.pm * tA + (size_t)cur.z * g.zA * 2; const char* cB = (const char*)g.Bt + (size_t)cur.pn * tB + (size_t)cur.z * g.zB * 2;
    PG8_STAGE(PG8_SB(0, 0), cB, voffB); PG8_STAGE(PG8_SA(0, 0), cA, voffA); PG8_STAGE(PG8_SB(0, 1), cB + hB, voffB); PG8_STAGE(PG8_SA(0, 1), cA + hA, voffA);
    if (wr == 1) PG8_BAR;
    PG8_WAIT_V(4); PG8_BAR;
    PG8_STAGE(PG8_SB(1, 0), cB + kstep, voffB); PG8_STAGE(PG8_SA(1, 0), cA + kstep, voffA); PG8_STAGE(PG8_SB(1, 1), cB + hB + kstep, voffB);
    PG8_WAIT_V(6); PG8_BAR;
    for (;;) {
        const bool has_next = S.next(ui + 1, nxt);
        const char* nA = has_next ? (const char*)g.A + (size_t)nxt.pm * tA + (size_t)nxt.z * g.zA * 2 : cA; const char* nB = has_next ? (const char*)g.Bt + (size_t)nxt.pn * tB + (size_t)nxt.z * g.zB * 2 : cB;
        for (int t = 0; t < nt; t += 2) {
            const bool last = (t == nt - 2);
            const char* a1 = cA + (size_t)(t + 1) * kstep;
            const char* a2 = last ? nA : cA + (size_t)(t + 2) * kstep; const char* b2 = last ? nB : cB + (size_t)(t + 2) * kstep;
            const char* a3 = a2 + kstep; const char* b3 = b2 + kstep;
            PG8_LDB(B0, 0, 0); PG8_SCHED; PG8_LDA(At, 0, 0); PG8_STAGE(PG8_SA(1, 1), a1 + hA, voffA);
            PG8_WAIT_L(8); PG8_BAR; PG8_WAIT_L(0); PG8_MMA(0, 0, At, B0); PG8_BAR; PG8_SCHED;
            PG8_LDB(B1, 0, 1); PG8_STAGE(PG8_SB(0, 0), b2, voffB);
            PG8_BAR; PG8_WAIT_L(0); PG8_MMA(0, 1, At, B1); PG8_BAR;
            PG8_LDA(At, 0, 1); PG8_STAGE(PG8_SA(0, 0), a2, voffA);
            PG8_BAR; PG8_WAIT_L(0); PG8_MMA(1, 0, At, B0); PG8_BAR; PG8_SCHED;
            PG8_STAGE(PG8_SB(0, 1), b2 + hB, voffB);
            PG8_WAIT_V(6); PG8_BAR; PG8_MMA(1, 1, At, B1); PG8_BAR;
            PG8_LDB(B0, 1, 0); PG8_SCHED; PG8_LDA(At, 1, 0); PG8_STAGE(PG8_SA(0, 1), a2 + hA, voffA);
            PG8_WAIT_L(8); PG8_BAR; PG8_WAIT_L(0); PG8_MMA(0, 0, At, B0); PG8_BAR; PG8_SCHED;
            PG8_LDB(B1, 1, 1); PG8_STAGE(PG8_SB(1, 0), b3, voffB);
            PG8_BAR; PG8_WAIT_L(0); PG8_MMA(0, 1, At, B1); PG8_BAR;
            PG8_LDA(At, 1, 1); PG8_STAGE(PG8_SA(1, 0), a3, voffA);
            PG8_BAR; PG8_WAIT_L(0); PG8_MMA(1, 0, At, B0); PG8_BAR; PG8_SCHED;
            PG8_STAGE(PG8_SB(1, 1), b3 + hB, voffB);
            PG8_WAIT_V(6); PG8_BAR; PG8_MMA(1, 1, At, B1); PG8_BAR;
        }
        E(acc, cur, wr, wc, fr, fq);
        if (!has_next) break;
#pragma unroll
        for (int a = 0; a < 2; ++a)
#pragma unroll
            for (int b = 0; b < 2; ++b)
#pragma unroll
                for (int m = 0; m < 4; ++m)
#pragma unroll
                    for (int n = 0; n < 2; ++n) acc[a][b][m][n] = (f32x4){0.f, 0.f, 0.f, 0.f};
        cur = nxt; cA = nA; cB = nB; ++ui;
    }
    PG8_WAIT_V(0);
    if (wr == 0) PG8_BAR;
    PG8_BAR;
#undef PG8_SA
#undef PG8_SB
#undef PG8_STAGE
#undef PG8_LDA
#undef PG8_LDB
#undef PG8_MMA
#undef PG8_WAIT_V
#undef PG8_WAIT_L
#undef PG8_BAR
#undef PG8_SCHED
}
}

struct Args { const float* in[21]; float* out; unsigned char* ws; int ph_lo, ph_hi; };
enum { I_X = 0, I_MEM, I_AB_W_IN, I_A_REL_BIAS, I_B_Q_NORM, I_B_W_UQ, I_B_KV_NORM, I_B_W_UKV, I_AB_W_OUT, I_CD_W_IN, I_D_FORGET_BIAS, I_CD_W_OUT,
       I_MEM_W_Q, I_MEM_W_KV, I_MEM_W_O, I_PEER_W_Q, I_PEER_SUB_KEYS, I_PEER_U, I_PEER_V, I_LN_G, I_LN_B };

struct WI { int tid, lane, wave, gw, ngw, bid, nblk; };

__device__ __forceinline__ void tr_item(const float* W, int K, int ld, int c0, int nc, bf16_t* WT, int r0, const float* scale, LAS float* scr, int item, int lane) {
    const int nblk = (nc + 63) >> 6, kb = item / nblk, nb = item - kb * nblk, k0 = 64 * kb, n0 = 64 * nb;
    const int ln = (lane & 15) * 4, lk = lane >> 4; const bool ok = n0 + ln < nc;
    const float* src = W + (size_t)(k0 + lk) * ld + c0 + n0 + ln;
    f32x4 v[16];
#pragma unroll
    for (int i = 0; i < 16; ++i) v[i] = ok ? *(const f32x4*)(src + (size_t)(4 * i) * ld) : (f32x4){0.f, 0.f, 0.f, 0.f};
#pragma unroll
    for (int i = 0; i < 16; ++i) { const int kk = lk + 4 * i; const float s = scale ? scale[k0 + kk] : 1.f; LAS float* d = scr + kk * 65 + ln;
        d[0] = v[i].x * s; d[1] = v[i].y * s; d[2] = v[i].z * s; d[3] = v[i].w * s; }
    LDS_WAIT();
    const int c = lane & 7;
#pragma unroll
    for (int j = 0; j < 8; ++j) { const int n = (lane >> 3) + 8 * j; const LAS float* s = scr + (8 * c) * 65 + n;
        u32x4 o; o.x = pk2(s[0 * 65], s[1 * 65]); o.y = pk2(s[2 * 65], s[3 * 65]); o.z = pk2(s[4 * 65], s[5 * 65]); o.w = pk2(s[6 * 65], s[7 * 65]);
        if (n0 + n < nc) *(u32x4*)(WT + (size_t)(r0 + n0 + n) * K + k0 + 8 * c) = o; }
    LDS_WAIT();
}
__device__ __forceinline__ void cvt_rows(const float* src, bf16_t* dst, size_t n, size_t i0, size_t stride) {
    size_t i = i0 * 8;
    for (; i + 3 * stride * 8 < n; i += 4 * stride * 8) {
        f32x4 a[4], b[4];
#pragma unroll
        for (int q = 0; q < 4; ++q) { a[q] = *(const f32x4*)(src + i + q * stride * 8); b[q] = *(const f32x4*)(src + i + q * stride * 8 + 4); }
#pragma unroll
        for (int q = 0; q < 4; ++q) { u32x4 o; o.x = pk2(a[q].x, a[q].y); o.y = pk2(a[q].z, a[q].w); o.z = pk2(b[q].x, b[q].y); o.w = pk2(b[q].z, b[q].w); *(u32x4*)(dst + i + q * stride * 8) = o; }
    }
    for (; i < n; i += stride * 8) {
        const f32x4 a = *(const f32x4*)(src + i), b = *(const f32x4*)(src + i + 4);
        u32x4 o; o.x = pk2(a.x, a.y); o.y = pk2(a.z, a.w); o.z = pk2(b.x, b.y); o.w = pk2(b.z, b.w);
        *(u32x4*)(dst + i) = o;
    }
}
__device__ __forceinline__ void ph_convert(const Args& a, LAS unsigned char* lds, const WI& w) {
    unsigned char* ws = a.ws;
    LAS float* scr = (LAS float*)(lds + w.wave * 16640);
    constexpr int J1 = 64 * 129, J2 = 24 * 48, J3 = 8 * 64, J4 = 64 * 64, J5 = 64 * 80, J6 = 64 * 96, J7 = 64 * 2, J8 = 64 * 1, J9 = 64 * 64,
                  J10 = 64 * 8, J12 = 64 * 16, J14 = 8 * 64;
    constexpr int NJ = J1 + J2 + J3 + J4 + J5 + J6 + J7 + J8 + J9 + 2 * J10 + 2 * J12 + 2 * J14;
    for (int it = w.gw; it < NJ; it += w.ngw) {
        int r = it; const float* src; int K, ld, c0 = 0, nc, r0 = 0; bf16_t* dst; const float* sc = nullptr;
        if (r < J1) { src = a.in[I_AB_W_IN]; K = 4096; ld = AB_COLS; nc = AB_COLS; dst = (bf16_t*)(ws + WS_W_AB_IN); }
        else if ((r -= J1) < J2) { src = a.in[I_B_W_UQ]; K = 1536; ld = 3072; nc = 3072; dst = (bf16_t*)(ws + WS_W_UQ); sc = a.in[I_B_Q_NORM]; }
        else if ((r -= J2) < J3) { src = a.in[I_B_W_UKV]; K = 512; ld = 4096; nc = 4096; dst = (bf16_t*)(ws + WS_W_UKV); sc = a.in[I_B_KV_NORM]; }
        else if ((r -= J3) < J4) { src = a.in[I_AB_W_OUT]; K = 4096; ld = 4096; nc = 4096; dst = (bf16_t*)(ws + WS_W_AB_OUT); }
        else if ((r -= J4) < J5) { src = a.in[I_CD_W_IN]; K = 4096; ld = CD_COLS; c0 = 0; nc = 5120; r0 = 0; dst = (bf16_t*)(ws + WS_W_CD_IN); }
        else if ((r -= J5) < J6) { src = a.in[I_CD_W_IN]; K = 4096; ld = CD_COLS; c0 = 5216; nc = 6144; r0 = 5120; dst = (bf16_t*)(ws + WS_W_CD_IN); }
        else if ((r -= J6) < J7) { src = a.in[I_CD_W_IN]; K = 4096; ld = CD_COLS; c0 = 5120; nc = 96; r0 = 11264; dst = (bf16_t*)(ws + WS_W_CD_IN); }
        else if ((r -= J7) < J8) { src = a.in[I_CD_W_IN]; K = 4096; ld = CD_COLS; c0 = 11360; nc = 16; r0 = 11360; dst = (bf16_t*)(ws + WS_W_CD_IN); }
        else if ((r -= J8) < J9) { src = a.in[I_CD_W_OUT]; K = 4096; ld = 4096; nc = 4096; dst = (bf16_t*)(ws + WS_W_CD_OUT); }
        else if ((r -= J9) < 2 * J10) { const int l = r / J10; r -= l * J10; src = a.in[I_MEM_W_Q] + (size_t)l * 4096 * 512; K = 4096; ld = 512; nc = 512; dst = (bf16_t*)(ws + WS_W_MEM_Q) + (size_t)l * 512 * 4096; }
        else if ((r -= 2 * J10) < 2 * J12) { const int l = r / J12; r -= l * J12; src = a.in[I_MEM_W_KV] + (size_t)l * 4096 * 1024; K = 4096; ld = 1024; nc = 1024; dst = (bf16_t*)(ws + WS_W_MEM_KV) + (size_t)l * 1024 * 4096; }
        else { r -= 2 * J12; const int l = r / J14; r -= l * J14; src = a.in[I_MEM_W_O] + (size_t)l * 512 * 4096; K = 512; ld = 4096; nc = 4096; dst = (bf16_t*)(ws + WS_W_MEM_O) + (size_t)l * 4096 * 512; }
        tr_item(src, K, ld, c0, nc, dst, r0, sc, scr, r, w.lane);
    }
    { const size_t gt = (size_t)w.gw * 64 + w.lane, ng = (size_t)w.ngw * 64;
      bf16_t* p1 = (bf16_t*)(ws + WS_W_AB_IN) + (size_t)AB_COLS * 4096; const size_t n1 = (size_t)(AB_PAD - AB_COLS) * 4096;
      for (size_t i = gt * 8; i < n1; i += ng * 8) *(u32x4*)(p1 + i) = (u32x4){0u, 0u, 0u, 0u};
      bf16_t* p2 = (bf16_t*)(ws + WS_W_CD_IN) + (size_t)CD_COLS * 4096; const size_t n2 = (size_t)(CD_PAD - CD_COLS) * 4096;
      for (size_t i = gt * 8; i < n2; i += ng * 8) *(u32x4*)(p2 + i) = (u32x4){0u, 0u, 0u, 0u};
      cvt_rows(a.in[I_X], (bf16_t*)(ws + WS_XB), (size_t)T * DM, gt, ng);
      cvt_rows(a.in[I_MEM], (bf16_t*)(ws + WS_MEMB), (size_t)512 * DM, gt, ng);
      for (int r = w.gw; r < 65536; r += w.ngw) { const int tbl = r >> 15, rr = r & 32767;
          const float* srow = (tbl ? a.in[I_PEER_V] : a.in[I_PEER_U]) + (size_t)rr * DM;
          f32x4 v[16]; float amax = 0.f;
#pragma unroll
          for (int j = 0; j < 16; ++j) { v[j] = *(const f32x4*)(srow + 4 * w.lane + 256 * j); amax = fmaxf(amax, fmaxf(fmaxf(fabsf(v[j].x), fabsf(v[j].y)), fmaxf(fabsf(v[j].z), fabsf(v[j].w)))); }
          amax = wave_max(amax); const float s = amax > 0.f ? 256.f / amax : 1.f;
          unsigned* drow = (unsigned*)(ws + (tbl ? WS_V8 : WS_U8) + (size_t)rr * DM);
#pragma unroll
          for (int j = 0; j < 16; ++j) { int wv = 0; wv = __builtin_amdgcn_cvt_pk_fp8_f32(v[j].x * s, v[j].y * s, wv, false); wv = __builtin_amdgcn_cvt_pk_fp8_f32(v[j].z * s, v[j].w * s, wv, true); drow[64 * j + w.lane] = (unsigned)wv; }
          if (w.lane == 0) ((float*)(ws + (tbl ? WS_VSC : WS_USC)))[rr] = amax > 0.f ? amax * (1.f / 256.f) : 1.f; }
      float* r128 = (float*)(ws + WS_ROPE128); float* r64 = (float*)(ws + WS_ROPE64);
      for (size_t i = gt; i < (size_t)SEQ * 96; i += ng) {
          const int s = (int)(i / 96), j = (int)(i % 96); const bool big = j < 64; const int ii = big ? j : j - 64;
          const double rr = big ? 0.8659643233600653 : 0.7498942093324559; double inv = 1.0;
          for (int q = 0; q < ii; ++q) inv *= rr;
          const double rev = (double)s * inv * 0.15915494309189535; const float fr = (float)(rev - rint(rev));
          const float cs = __builtin_amdgcn_cosf(fr), sn = __builtin_amdgcn_sinf(fr);
          float* o = big ? (r128 + ((size_t)s * 64 + ii) * 2) : (r64 + ((size_t)s * 32 + ii) * 2);
          o[0] = cs; o[1] = sn; }
    }
    {
        LAS float* Ks = (LAS float*)lds; LAS float* Ws = Ks + 128 * 129;
        const int tk = w.tid & 31, tn = w.tid >> 5;
        for (int it = w.bid; it < 2 * 16 * 32; it += w.nblk) {
            const int l = it >> 9, hp = (it >> 5) & 15, kb = it & 31;
            __syncthreads();
            const float* keys = a.in[I_PEER_SUB_KEYS] + ((size_t)(l * 16 + hp) * 128) * 128;
            const float* wq = a.in[I_PEER_W_Q] + ((size_t)l * 4096 + (size_t)kb * 128) * 2048 + hp * 128;
            for (int e = w.tid; e < 128 * 128; e += 512) { const int rrow = e >> 7, d = e & 127; Ks[rrow * 129 + d] = keys[(size_t)rrow * 128 + d]; Ws[rrow * 129 + d] = wq[(size_t)rrow * 2048 + d]; }
            __syncthreads();
            float acc[8][4];
#pragma unroll
            for (int x = 0; x < 8; ++x)
#pragma unroll
                for (int y = 0; y < 4; ++y) acc[x][y] = 0.f;
            for (int d = 0; d < 128; ++d) {
                float kv[8], wv[4];
#pragma unroll
                for (int x = 0; x < 8; ++x) kv[x] = Ks[(tn + 16 * x) * 129 + d];
#pragma unroll
                for (int y = 0; y < 4; ++y) wv[y] = Ws[(tk + 32 * y) * 129 + d];
#pragma unroll
                for (int x = 0; x < 8; ++x)
#pragma unroll
                    for (int y = 0; y < 4; ++y) acc[x][y] += kv[x] * wv[y];
            }
            bf16_t* dst = (bf16_t*)(ws + WS_W_PEER) + ((size_t)l * 2048 + hp * 128) * 4096 + kb * 128;
#pragma unroll
            for (int x = 0; x < 8; ++x)
#pragma unroll
                for (int y = 0; y < 4; ++y) dst[(size_t)(tn + 16 * x) * 4096 + tk + 32 * y] = (bf16_t)f2bf(acc[x][y]);
        }
        __syncthreads();
    }
}

__device__ __forceinline__ int crow(int r, int hi) { return (r & 3) + 8 * (r >> 2) + 4 * hi; }
template <class F>
__device__ __forceinline__ void naive_gemm(const bf16_t* A, int lda, const bf16_t* Bt, int ldb, int M, int N, int K, const WI& w, F epi) {
    const int tm = M >> 5, tn = (N + 31) >> 5;
    const int i = w.lane & 31, g = w.lane >> 5;
    for (int tile = w.gw; tile < tm * tn; tile += w.ngw) {
        const int bn = tile / tm, bm = tile - bn * tm;
        const bf16_t* ap = A + (size_t)(bm * 32 + i) * lda + 8 * g;
        const int nrow = bn * 32 + i; const bool nv = nrow < N;
        const bf16_t* bp = Bt + (size_t)(nv ? nrow : 0) * ldb + 8 * g;
        f32x16 acc = {};
#pragma unroll 4
        for (int k = 0; k < K; k += 16) {
            const bf16x8 av = *(const bf16x8*)(ap + k);
            bf16x8 bv = *(const bf16x8*)(bp + k);
            if (!nv) bv = (bf16x8){0, 0, 0, 0, 0, 0, 0, 0};
            acc = __builtin_amdgcn_mfma_f32_32x32x16_bf16(av, bv, acc, 0, 0, 0);
        }
#pragma unroll
        for (int r = 0; r < 16; ++r) { const int row = bm * 32 + crow(r, g), col = bn * 32 + i; if (col < N) epi(row, col, acc[r]); }
    }
}

__device__ __forceinline__ void ln_rows(const float* src, const float* g, const float* b, float* dstf, bf16_t* dstb, const WI& w) {
    for (int m = w.gw; m < T; m += w.ngw) {
        const f32x4* xr = (const f32x4*)(src + (size_t)m * DM) + w.lane;
        f32x4 v[16]; float s = 0.f;
#pragma unroll
        for (int j = 0; j < 16; ++j) { v[j] = xr[64 * j]; s += (v[j].x + v[j].y) + (v[j].z + v[j].w); }
        const float mean = wave_sum(s) * (1.f / DM); float s2 = 0.f;
#pragma unroll
        for (int j = 0; j < 16; ++j) { v[j] = v[j] - mean; s2 += (v[j].x * v[j].x + v[j].y * v[j].y) + (v[j].z * v[j].z + v[j].w * v[j].w); }
        const float rstd = 1.f / sqrtf(wave_sum(s2) * (1.f / DM) + LN_EPS);
#pragma unroll
        for (int j = 0; j < 16; ++j) {
            const int c = 4 * w.lane + 256 * j;
            const f32x4 gg = *(const f32x4*)(g + c), bb = *(const f32x4*)(b + c);
            const f32x4 o = v[j] * rstd * gg + bb;
            *(f32x4*)(dstf + (size_t)m * DM + c) = o;
            if (dstb) { u32x2 p; p.x = pk2(o.x, o.y); p.y = pk2(o.z, o.w); *(u32x2*)(dstb + (size_t)m * DM + c) = p; }
        }
    }
}

template <int MODE>
__device__ __forceinline__ void attn_naive(const Args& a, int layer, LAS float* qs, const WI& w) {
    constexpr int H = (MODE == 4) ? 4 : 16, DK = (MODE == 1) ? 192 : 128;
    const float scale = (MODE == 1) ? 0.07216878364870322f : 0.08838834764831845f;
    unsigned char* ws = a.ws;
    const float NEG = -__builtin_inff();
    for (int it = w.gw; it < T * H; it += w.ngw) {
        const int h = it / T, t = it - h * T, b = t / SEQ, sp = t - b * SEQ, c = sp >> 6;
        const bf16_t* qp; const bf16_t* kbase; const bf16_t* vbase; int ldk, ldv; bf16_t* op;
        int s_lo = 0, s_hi;
        if (MODE == 0) { const bf16_t* P = (const bf16_t*)(ws + WS_PROJ); qp = P + (size_t)t * AB_MAIN + h * 128; kbase = P + (size_t)b * SEQ * AB_MAIN + 2048 + h * 128; vbase = kbase + 2048; ldk = ldv = AB_MAIN;
            op = (bf16_t*)(ws + WS_ATT) + (size_t)t * DM + h * 128; s_lo = (c - 8) * 64; if (s_lo < 0) s_lo = 0; s_hi = (c + 1) * 64; }
        else if (MODE == 1) { qp = (const bf16_t*)(ws + WS_QB) + (size_t)t * 3072 + h * 192; kbase = (const bf16_t*)(ws + WS_KVB) + (size_t)b * SEQ * 4096 + h * 256; vbase = kbase + 128; ldk = ldv = 4096;
            op = (bf16_t*)(ws + WS_ATT) + (size_t)t * DM + 2048 + h * 128; s_hi = (c + 1) * 64; }
        else if (MODE == 2) { const bf16_t* P = (const bf16_t*)(ws + WS_PROJ); qp = P + (size_t)t * CD_MAIN + h * 128; kbase = P + (size_t)b * SEQ * CD_MAIN + 2048 + (h >> 2) * 128; vbase = kbase + 512; ldk = ldv = CD_MAIN;
            op = (bf16_t*)(ws + WS_ATT) + (size_t)t * DM + h * 128; s_hi = (c + 1) * 64; }
        else if (MODE == 3) { const bf16_t* P = (const bf16_t*)(ws + WS_PROJ); qp = P + (size_t)t * CD_MAIN + 5120 + h * 128; kbase = P + (size_t)b * SEQ * CD_MAIN + 7168 + h * 128; vbase = kbase + 2048; ldk = ldv = CD_MAIN;
            op = (bf16_t*)(ws + WS_ATT) + (size_t)t * DM + 2048 + h * 128; s_hi = sp + 1; }
        else { qp = (const bf16_t*)(ws + WS_MEMQ) + (size_t)t * 512 + h * 128; kbase = (const bf16_t*)(ws + WS_KVM) + ((size_t)layer * 512 + b * 256) * 1024 + h * 128; vbase = kbase + 512; ldk = ldv = 1024;
            op = (bf16_t*)(ws + WS_MEMO) + (size_t)t * 512 + h * 128; s_hi = 256; }
        LDS_WAIT();
        if (MODE == 4) { const float* mq = (const float*)(ws + WS_MQP) + (size_t)t * 512 + h * 128;
            for (int d = w.lane; d < DK; d += 64) qs[d] = bf2f((bf16_t)f2bf((mq[d] + mq[d + (size_t)T * 512]) + (mq[d + (size_t)2 * T * 512] + mq[d + (size_t)3 * T * 512]))); }
        else for (int d = w.lane; d < DK; d += 64) qs[d] = bf2f(qp[d]);
        LDS_WAIT();
        const float* cum = (const float*)(ws + WS_CUM) + ((size_t)b * 16 + h) * SEQ;
        const float ct = (MODE == 3) ? cum[sp] : 0.f;
        const float* relb = a.in[I_A_REL_BIAS] + h * 513;
        const unsigned* mrow = (const unsigned*)(ws + WS_MASK) + (size_t)t * 128;
        float m = NEG, l = 0.f, o0 = 0.f, o1 = 0.f;
        for (int s0 = s_lo; s0 < s_hi; s0 += 64) {
            const int s = s0 + w.lane; bool valid = s < s_hi;
            if (MODE == 2) { if (valid) valid = (mrow[s >> 5] >> (s & 31)) & 1u; }
            float x = NEG;
            if (valid) {
                const bf16_t* kp = kbase + (size_t)s * ldk; float acc = 0.f;
#pragma unroll 4
                for (int d0 = 0; d0 < 128; d0 += 8) { const bf16x8 kv = *(const bf16x8*)(kp + d0);
#pragma unroll
                    for (int e = 0; e < 8; ++e) acc += qs[d0 + e] * bf2f((bf16_t)kv[e]); }
                if (MODE == 1) { const bf16_t* kr = (const bf16_t*)(ws + WS_KR) + ((size_t)b * SEQ + s) * 64;
#pragma unroll 4
                    for (int d0 = 0; d0 < 64; d0 += 8) { const bf16x8 kv = *(const bf16x8*)(kr + d0);
#pragma unroll
                        for (int e = 0; e < 8; ++e) acc += qs[128 + d0 + e] * bf2f((bf16_t)kv[e]); } }
                x = acc * scale;
                if (MODE == 0) { int rel = sp - s; rel = rel < -256 ? -256 : (rel > 256 ? 256 : rel); x += relb[rel + 256]; }
                if (MODE == 3) x += ct - cum[s];
            }
            const float mx = wave_max(x);
            if (mx == NEG) continue;
            const float mn = fmaxf(m, mx); const float p = valid ? __expf(x - mn) : 0.f; const float al = __expf(m - mn);
            l = l * al + wave_sum(p); o0 *= al; o1 *= al; m = mn;
            for (int j = 0; j < 64; ++j) { const float pj = __shfl(p, j);
                if (pj != 0.f) { const bf16_t* vp = vbase + (size_t)(s0 + j) * ldv; o0 += pj * bf2f(vp[w.lane]); o1 += pj * bf2f(vp[w.lane + 64]); } }
        }
        const float rl = 1.f / l;
        op[w.lane] = (bf16_t)f2bf(o0 * rl); op[w.lane + 64] = (bf16_t)f2bf(o1 * rl);
    }
}

namespace fa {
constexpr int SHM_V = 64 * 128 * 2;
constexpr int LDS_V = 0, LDS_K = 2 * SHM_V, LDS_WS = LDS_K + 2 * 64 * 384, LDS_RELB = LDS_WS + 8 * 64 * 4, LDS_CS = LDS_RELB + 2304, LDS_END = LDS_CS + 512;
#define FA_KSWZ(row, colB, RS) ((row) * (RS) + ((colB) ^ (((row) & 7) << 4)))
__device__ __forceinline__ int v_st(int k, int c) { const int kk = (k & ~0xC) | ((k & 4) << 1) | ((k & 8) >> 1); return ((kk >> 3) * 4 + (c >> 5)) * 512 + ((kk & 7) * 32 + (c & 31)) * 2; }
__device__ __forceinline__ int v_rd_base(int lane) { return ((lane & 3) << 3) | (((lane >> 2) & 3) << 6) | (((lane >> 4) & 1) << 5) | (((lane >> 5) & 1) << 8); }
__device__ __forceinline__ unsigned cvtpk(float lo, float hi) { unsigned r; asm volatile("v_cvt_pk_bf16_f32 %0, %1, %2" : "=v"(r) : "v"(lo), "v"(hi)); return r; }
typedef short s16x4 __attribute__((ext_vector_type(4)));

template <int DK>
__device__ __forceinline__ void qkt(f32x16& p0, f32x16& p1, LAS const char* Kb, int r32, int hi, const bf16x8* qr) {
    constexpr int RS = DK * 2;
    p0 = f32x16{}; p1 = f32x16{};
    LAS const char* kb[4];
#pragma unroll
    for (int dd = 0; dd < 4; ++dd) kb[dd] = Kb + FA_KSWZ(r32, (dd * 16 + hi * 8) * 2, RS);
#pragma unroll
    for (int d0 = 0; d0 < DK / 16; ++d0) { LAS const char* ap = kb[d0 & 3] + (d0 >> 2) * 128;
        const bf16x8 b0 = *(LAS const bf16x8*)ap;
        const bf16x8 b1 = *(LAS const bf16x8*)(ap + 32 * RS);
        p0 = __builtin_amdgcn_mfma_f32_32x32x16_bf16(b0, qr[d0], p0, 0, 0, 0);
        p1 = __builtin_amdgcn_mfma_f32_32x32x16_bf16(b1, qr[d0], p1, 0, 0, 0); }
}
__device__ __forceinline__ void pv_tile(f32x16* o, int vb0, bf16x8 pa0, bf16x8 pa1, bf16x8 pa2, bf16x8 pa3) {
#define FA_TRRD(dst, off) asm volatile("ds_read_b64_tr_b16 %0, %1 offset:%2" : "=&v"(dst) : "v"(vb0), "i"(off) : "memory")
#define FA_PV_D0(d0) do { s16x4 l0, l1, l2, l3, h0, h1, h2, h3; constexpr int b_ = (d0) * 512; \
        FA_TRRD(l0, b_); FA_TRRD(h0, b_ + 2048); FA_TRRD(l1, b_ + 4096); FA_TRRD(h1, b_ + 6144); FA_TRRD(l2, b_ + 8192); FA_TRRD(h2, b_ + 10240); FA_TRRD(l3, b_ + 12288); FA_TRRD(h3, b_ + 14336); \
        asm volatile("s_waitcnt lgkmcnt(0)" ::: "memory"); __builtin_amdgcn_sched_barrier(0); \
        o[d0] = __builtin_amdgcn_mfma_f32_32x32x16_bf16(pa0, (bf16x8){l0[0], l0[1], l0[2], l0[3], h0[0], h0[1], h0[2], h0[3]}, o[d0], 0, 0, 0); \
        o[d0] = __builtin_amdgcn_mfma_f32_32x32x16_bf16(pa1, (bf16x8){l1[0], l1[1], l1[2], l1[3], h1[0], h1[1], h1[2], h1[3]}, o[d0], 0, 0, 0); \
        o[d0] = __builtin_amdgcn_mfma_f32_32x32x16_bf16(pa2, (bf16x8){l2[0], l2[1], l2[2], l2[3], h2[0], h2[1], h2[2], h2[3]}, o[d0], 0, 0, 0); \
        o[d0] = __builtin_amdgcn_mfma_f32_32x32x16_bf16(pa3, (bf16x8){l3[0], l3[1], l3[2], l3[3], h3[0], h3[1], h3[2], h3[3]}, o[d0], 0, 0, 0); } while (0)
    FA_PV_D0(0); FA_PV_D0(1); FA_PV_D0(2); FA_PV_D0(3);
#undef FA_PV_D0
#undef FA_TRRD
}
__device__ __forceinline__ void softmax_tile(f32x16& p0, f32x16& p1, float& m_reg, float& l_reg, float& alpha, bf16x8& pa0, bf16x8& pa1, bf16x8& pa2, bf16x8& pa3) {
    float pmax = p0[0];
#pragma unroll
    for (int r = 1; r < 16; ++r) pmax = fmaxf(pmax, p0[r]);
#pragma unroll
    for (int r = 0; r < 16; ++r) pmax = fmaxf(pmax, p1[r]);
    { auto rr = __builtin_amdgcn_permlane32_swap(__float_as_uint(pmax), __float_as_uint(pmax), false, false);
      pmax = fmaxf(__uint_as_float(rr[0]), __uint_as_float(rr[1])); }
    const float mn = fmaxf(m_reg, pmax); alpha = __builtin_amdgcn_exp2f(m_reg - mn); m_reg = mn;
#pragma unroll
    for (int r = 0; r < 16; ++r) { p0[r] = __builtin_amdgcn_exp2f(p0[r] - mn); p1[r] = __builtin_amdgcn_exp2f(p1[r] - mn); }
    float ps = 0.f;
#pragma unroll
    for (int r = 0; r < 16; ++r) ps += p0[r];
#pragma unroll
    for (int r = 0; r < 16; ++r) ps += p1[r];
    { auto rr = __builtin_amdgcn_permlane32_swap(__float_as_uint(ps), __float_as_uint(ps), false, false);
      ps = __uint_as_float(rr[0]) + __uint_as_float(rr[1]); }
    l_reg = l_reg * alpha + ps;
#define FA_PK4(P, B_, OUT) do { unsigned a0 = cvtpk(P[B_+0], P[B_+1]), a1 = cvtpk(P[B_+2], P[B_+3]); \
        unsigned b0 = cvtpk(P[B_+4], P[B_+5]), b1 = cvtpk(P[B_+6], P[B_+7]); \
        auto r0 = __builtin_amdgcn_permlane32_swap(a0, b0, false, false); auto r1 = __builtin_amdgcn_permlane32_swap(a1, b1, false, false); \
        u32x4 wv = {r0[0], r1[0], r0[1], r1[1]}; OUT = *reinterpret_cast<bf16x8*>(&wv); } while (0)
    FA_PK4(p0, 0, pa0); FA_PK4(p0, 8, pa1); FA_PK4(p1, 0, pa2); FA_PK4(p1, 8, pa3);
#undef FA_PK4
}

template <int MODE>
__device__ __forceinline__ void attn_unit(const Args& a, int layer, LAS unsigned char* lds, int b, int h, int qb) {
    constexpr int DK = (MODE == 1) ? 192 : 128, RS = DK * 2, SHM_K = 64 * RS, NQ = DK / 16;
    constexpr float C2 = (MODE == 1) ? 1.4426950408889634f * 0.07216878364870322f : 1.4426950408889634f * 0.08838834764831845f;
    constexpr float L2E = 1.4426950408889634f;
    unsigned char* ws = a.ws;
    const int tid = threadIdx.x, wid = __builtin_amdgcn_readfirstlane(tid >> 6), lane = tid & 63, r32 = lane & 31, hi = lane >> 5;
    const int P0 = qb * 256, qlo = P0 + wid * 32, row = qlo + r32, cw = qlo >> 6;
    const size_t tb = (size_t)b * SEQ;
    const float NEG = -__builtin_inff();
    const bf16_t* Kg; const bf16_t* Vg; int ldk, ldv; bf16_t* Og; int ldo; int j_lo = 0, j_hi;
    if (MODE == 0) { const bf16_t* P = (const bf16_t*)(ws + WS_PROJ); Kg = P + tb * AB_MAIN + 2048 + h * 128; Vg = Kg + 2048; ldk = ldv = AB_MAIN; Og = (bf16_t*)(ws + WS_ATT) + (tb + qlo) * DM + h * 128; ldo = DM;
        j_lo = (P0 >> 6) - 8; if (j_lo < 0) j_lo = 0; j_hi = (P0 >> 6) + 4; }
    else if (MODE == 1) { Kg = (const bf16_t*)(ws + WS_KVB) + tb * 4096 + h * 256; Vg = Kg + 128; ldk = ldv = 4096; Og = (bf16_t*)(ws + WS_ATT) + (tb + qlo) * DM + 2048 + h * 128; ldo = DM; j_hi = (P0 >> 6) + 4; }
    else if (MODE == 2) { const bf16_t* P = (const bf16_t*)(ws + WS_PROJ); Kg = P + tb * CD_MAIN + 2048 + (h >> 2) * 128; Vg = Kg + 512; ldk = ldv = CD_MAIN; Og = (bf16_t*)(ws + WS_ATT) + (tb + qlo) * DM + h * 128; ldo = DM; j_hi = (P0 >> 6) + 4; }
    else if (MODE == 3) { const bf16_t* P = (const bf16_t*)(ws + WS_PROJ); Kg = P + tb * CD_MAIN + 7168 + h * 128; Vg = Kg + 2048; ldk = ldv = CD_MAIN; Og = (bf16_t*)(ws + WS_ATT) + (tb + qlo) * DM + 2048 + h * 128; ldo = DM; j_hi = (P0 >> 6) + 4; }
    else { Kg = (const bf16_t*)(ws + WS_KVM) + ((size_t)layer * 512 + b * 256) * 1024 + h * 128; Vg = Kg + 512; ldk = ldv = 1024; Og = (bf16_t*)(ws + WS_MEMO) + (tb + qlo) * 512 + h * 128; ldo = 512; j_hi = 4; }
    const int NT = j_hi - j_lo;
    bf16x8 qr[NQ];
    if (MODE == 4) { const float* mq = (const float*)(ws + WS_MQP) + (tb + row) * 512 + h * 128;
#pragma unroll
        for (int d0 = 0; d0 < NQ; ++d0) { const float* p = mq + d0 * 16 + hi * 8; f32x4 s0 = {0.f, 0.f, 0.f, 0.f}, s1 = s0;
#pragma unroll
            for (int z = 0; z < 4; ++z) { s0 += *(const f32x4*)(p + (size_t)z * T * 512); s1 += *(const f32x4*)(p + (size_t)z * T * 512 + 4); }
            u32x4 wv = {cvtpk(s0[0], s0[1]), cvtpk(s0[2], s0[3]), cvtpk(s1[0], s1[1]), cvtpk(s1[2], s1[3])}; qr[d0] = *reinterpret_cast<bf16x8*>(&wv); } }
    else { const bf16_t* Qg;
        if (MODE == 0) Qg = (const bf16_t*)(ws + WS_PROJ) + (tb + row) * AB_MAIN + h * 128;
        else if (MODE == 1) Qg = (const bf16_t*)(ws + WS_QB) + (tb + row) * 3072 + h * 192;
        else if (MODE == 2) Qg = (const bf16_t*)(ws + WS_PROJ) + (tb + row) * CD_MAIN + h * 128;
        else Qg = (const bf16_t*)(ws + WS_PROJ) + (tb + row) * CD_MAIN + 5120 + h * 128;
#pragma unroll
        for (int d0 = 0; d0 < NQ; ++d0) qr[d0] = *(const bf16x8*)(Qg + d0 * 16 + hi * 8); }
    LAS char* V_lds = (LAS char*)lds + LDS_V; LAS char* K_lds = (LAS char*)lds + LDS_K;
    LAS float* wsc = (LAS float*)(lds + LDS_WS) + wid * 64; LAS float* relb = (LAS float*)(lds + LDS_RELB); LAS float* csl = (LAS float*)(lds + LDS_CS);
    const int vbase = (int)(unsigned)(uintptr_t)V_lds + v_rd_base(lane);
    const bf16_t* KRg = (const bf16_t*)(ws + WS_KR) + tb * 64;
    const float* cum = (const float*)(ws + WS_CUM) + ((size_t)b * 16 + h) * SEQ;
    const unsigned* mrow = (const unsigned*)(ws + WS_MASK) + (tb + row) * 128;
    float ctl = 0.f; if (MODE == 3) ctl = cum[row] * L2E;
    if (MODE == 0) { const float* rb = a.in[I_A_REL_BIAS] + h * 513; for (int i = tid; i < 513; i += 512) relb[i] = rb[i] * L2E; }
    float m_reg = -1e30f, l_reg = 0.f; f32x16 o[4] = {};
    unsigned mk0 = 0u, mk1 = 0u; float st_cs = 0.f;
    constexpr int NKI = (DK == 192) ? 3 : 2;
    int koff[NKI]; bool krope[NKI]; int voff[2];
#pragma unroll
    for (int i = 0; i < NKI; ++i) { const int off = (wid * NKI + i) * 1024 + lane * 16; const int rw = off / RS, sw = off - rw * RS, cb = sw ^ ((rw & 7) << 4);
        krope[i] = (DK == 192) && (cb >= 256); koff[i] = krope[i] ? rw * 64 + ((cb - 256) >> 1) : rw * ldk + (cb >> 1); }
#pragma unroll
    for (int i = 0; i < 2; ++i) { const int off = (wid * 2 + i) * 1024 + lane * 16; const int sub = off >> 9, within = off & 511, kk = ((sub >> 2) << 3) | (within >> 6);
        const int k = (kk & ~0xC) | ((kk & 4) << 1) | ((kk & 8) >> 1), c = (sub & 3) * 32 + ((within & 63) >> 1); voff[i] = k * ldv + c; }
#define FA_DMA(j, bf) do { const int k0_ = (j) * 64; \
        _Pragma("unroll") for (int i_ = 0; i_ < NKI; ++i_) { const bf16_t* s_ = (DK == 192 && krope[i_]) ? (KRg + (size_t)k0_ * 64 + koff[i_]) : (Kg + (size_t)k0_ * ldk + koff[i_]); \
            __builtin_amdgcn_global_load_lds((const unsigned*)s_, (LAS unsigned*)(K_lds + (bf) * SHM_K + (wid * NKI + i_) * 1024), 16, 0, 0); } \
        _Pragma("unroll") for (int i_ = 0; i_ < 2; ++i_) \
            __builtin_amdgcn_global_load_lds((const unsigned*)(Vg + (size_t)k0_ * ldv + voff[i_]), (LAS unsigned*)(V_lds + (bf) * SHM_V + (wid * 2 + i_) * 1024), 16, 0, 0); \
        if (MODE == 3) { if (tid < 64) st_cs = cum[k0_ + tid] * L2E; } } while (0)
#define FA_CSW(bf) do { if (MODE == 3) { if (tid < 64) csl[(bf) * 64 + tid] = st_cs; } } while (0)
    __syncthreads();
    FA_DMA(j_lo, 0); asm volatile("s_waitcnt vmcnt(0)" ::: "memory"); FA_CSW(0);
    __syncthreads();
#pragma unroll 1
    for (int t = 0; t < NT; ++t) {
        const int buf = t & 1, j = j_lo + t, kbp = j * 64;
        if (t + 1 < NT) FA_DMA(j + 1, buf ^ 1);
        bool act;
        if (MODE == 0) act = (j >= cw - 8) && (j <= cw);
        else if (MODE == 1 || MODE == 2) act = (j <= cw);
        else if (MODE == 3) act = (kbp <= qlo + 31);
        else act = true;
        if (MODE == 2) { if (act) { const u32x2 mm = *(const u32x2*)(mrow + 2 * j); mk0 = mm.x; mk1 = mm.y; } }
        if (act) {
            f32x16 p0, p1;
            qkt<DK>(p0, p1, K_lds + buf * SHM_K, r32, hi, qr);
            if (MODE == 0) {
                if (qlo - (kbp + 63) >= 256) { const float bf_ = relb[512];
#pragma unroll
                    for (int r = 0; r < 16; ++r) { p0[r] = fmaf(p0[r], C2, bf_); p1[r] = fmaf(p1[r], C2, bf_); } }
                else { const int dq = row - kbp - 4 * hi;
#pragma unroll
                    for (int r = 0; r < 16; ++r) { const int c = (r & 3) + 8 * (r >> 2);
                        int i0 = dq - c; i0 = i0 < -256 ? -256 : (i0 > 256 ? 256 : i0); int i1 = dq - c - 32; i1 = i1 < -256 ? -256 : (i1 > 256 ? 256 : i1);
                        p0[r] = fmaf(p0[r], C2, relb[i0 + 256]); p1[r] = fmaf(p1[r], C2, relb[i1 + 256]); } }
            } else if (MODE == 3) {
                LAS const float* cs = csl + buf * 64 + 4 * hi;
#pragma unroll
                for (int q4 = 0; q4 < 4; ++q4) { const f32x4 c0 = *(LAS const f32x4*)(cs + 8 * q4), c1 = *(LAS const f32x4*)(cs + 32 + 8 * q4);
#pragma unroll
                    for (int e = 0; e < 4; ++e) { p0[4 * q4 + e] = fmaf(p0[4 * q4 + e], C2, ctl - c0[e]); p1[4 * q4 + e] = fmaf(p1[4 * q4 + e], C2, ctl - c1[e]); } }
                if (kbp + 63 > qlo) { const int dq = row - kbp - 4 * hi;
#pragma unroll
                    for (int r = 0; r < 16; ++r) { const int c = (r & 3) + 8 * (r >> 2); if (dq - c < 0) p0[r] = NEG; if (dq - c - 32 < 0) p1[r] = NEG; } }
            } else {
#pragma unroll
                for (int r = 0; r < 16; ++r) { p0[r] *= C2; p1[r] *= C2; }
                if (MODE == 2) {
#pragma unroll
                    for (int r = 0; r < 16; ++r) { const int c = (r & 3) + 8 * (r >> 2) + 4 * hi; if (!((mk0 >> c) & 1u)) p0[r] = NEG; if (!((mk1 >> c) & 1u)) p1[r] = NEG; } }
            }
            float alpha; bf16x8 pa0, pa1, pa2, pa3;
            softmax_tile(p0, p1, m_reg, l_reg, alpha, pa0, pa1, pa2, pa3);
            if (__any(alpha < 1.f)) { if (hi == 0) wsc[r32] = alpha; LDS_WAIT();
#pragma unroll
                for (int r = 0; r < 16; ++r) { const float al = wsc[crow(r, hi)];
#pragma unroll
                    for (int d_ = 0; d_ < 4; ++d_) o[d_][r] *= al; }
                LDS_WAIT(); }
            pv_tile(o, vbase + buf * SHM_V, pa0, pa1, pa2, pa3);
        }
        asm volatile("s_waitcnt vmcnt(0)" ::: "memory");
        if (t + 1 < NT) FA_CSW(buf ^ 1);
        __syncthreads();
    }
#undef FA_DMA
#undef FA_CSW
    if (hi == 0) wsc[32 + r32] = l_reg; LDS_WAIT();
#pragma unroll
    for (int r = 0; r < 16; ++r) { const int orow = crow(r, hi); const float rl = __builtin_amdgcn_rcpf(wsc[32 + orow]);
#pragma unroll
        for (int d0 = 0; d0 < 4; ++d0) { const float v = o[d0][r] * rl; const float vn = __shfl_xor(v, 1);
            if ((r32 & 1) == 0) *(unsigned*)(Og + (size_t)orow * ldo + d0 * 32 + r32) = cvtpk(v, vn); } }
    LDS_WAIT();
}
}

__device__ __forceinline__ void rope_pair(float& x1, float& x2, float cs, float sn) { const float a = x1 * cs - x2 * sn, b = x2 * cs + x1 * sn; x1 = a; x2 = b; }
__device__ __forceinline__ void ph_l0_stats(const Args& a, const WI& w) {
    unsigned char* ws = a.ws; const bf16_t* P = (const bf16_t*)(ws + WS_PROJ);
    const float* r64 = (const float*)(ws + WS_ROPE64);
    for (int t = w.gw; t < T; t += w.ngw) {
        const bf16_t* row = P + (size_t)t * AB_MAIN;
        float s = 0.f;
        for (int j = 0; j < 3; ++j) { const bf16x8 v = *(const bf16x8*)(row + 6144 + (j * 64 + w.lane) * 8);
#pragma unroll
            for (int e = 0; e < 8; ++e) { const float f = bf2f((bf16_t)v[e]); s += f * f; } }
        s = wave_sum(s);
        float s2 = 0.f; { const bf16x8 v = *(const bf16x8*)(row + 7680 + w.lane * 8);
#pragma unroll
            for (int e = 0; e < 8; ++e) { const float f = bf2f((bf16_t)v[e]); s2 += f * f; } }
        s2 = wave_sum(s2);
        if (w.lane == 0) { ((float*)(ws + WS_RSQ))[t] = 1.f / sqrtf(s * (1.f / 1536.f) + RMS_EPS); ((float*)(ws + WS_RSKV))[t] = 1.f / sqrtf(s2 * (1.f / 512.f) + RMS_EPS); }
        if (w.lane < 32) { const float* sm = (const float*)(ws + WS_MQP) + (size_t)t * 256; const int sp = t & (SEQ - 1);
            float x1 = 0.f, x2 = 0.f;
#pragma unroll
            for (int z = 0; z < 8; ++z) { x1 += sm[(size_t)z * T * 256 + w.lane]; x2 += sm[(size_t)z * T * 256 + w.lane + 32]; } const float cs = r64[((size_t)sp * 32 + w.lane) * 2], sn = r64[((size_t)sp * 32 + w.lane) * 2 + 1];
            rope_pair(x1, x2, cs, sn);
            bf16_t* kr = (bf16_t*)(ws + WS_KR) + (size_t)t * 64; kr[w.lane] = (bf16_t)f2bf(x1); kr[w.lane + 32] = (bf16_t)f2bf(x2); }
    }
}
__device__ __forceinline__ void ph_l0_qrope(const Args& a, const WI& w) {
    unsigned char* ws = a.ws; bf16_t* Q = (bf16_t*)(ws + WS_QB); const float* r64 = (const float*)(ws + WS_ROPE64);
    for (int t = w.gw; t < T; t += w.ngw) {
        const int sp = t & (SEQ - 1);
        for (int e = w.lane; e < 16 * 32; e += 64) { const int h = e >> 5, i = e & 31; bf16_t* q = Q + (size_t)t * 3072 + h * 192 + 128;
            float x1 = bf2f(q[i]), x2 = bf2f(q[i + 32]); rope_pair(x1, x2, r64[((size_t)sp * 32 + i) * 2], r64[((size_t)sp * 32 + i) * 2 + 1]);
            q[i] = (bf16_t)f2bf(x1); q[i + 32] = (bf16_t)f2bf(x2); }
    }
}
__device__ __forceinline__ void ph_l1_elem(const Args& a, LAS float* sml  , const WI& w) {
    unsigned char* ws = a.ws; bf16_t* P = (bf16_t*)(ws + WS_PROJ);
    const float* r128 = (const float*)(ws + WS_ROPE128); const float* r64 = (const float*)(ws + WS_ROPE64);
    for (int t = w.gw; t < T; t += w.ngw) {
        const int b = t / SEQ, sp = t - b * SEQ; bf16_t* row = P + (size_t)t * CD_MAIN;
        for (int e = w.lane; e < 20 * 64; e += 64) { const int h = e >> 6, i = e & 63; bf16_t* q = row + h * 128;
            float x1 = bf2f(q[i]), x2 = bf2f(q[i + 64]); rope_pair(x1, x2, r128[((size_t)sp * 64 + i) * 2], r128[((size_t)sp * 64 + i) * 2 + 1]);
            q[i] = (bf16_t)f2bf(x1); q[i + 64] = (bf16_t)f2bf(x2); }
        for (int e = w.lane; e < 32 * 32; e += 64) { const int h = e >> 5, i = e & 31; bf16_t* q = row + 3072 + h * 64;
            float x1 = bf2f(q[i]), x2 = bf2f(q[i + 32]); rope_pair(x1, x2, r64[((size_t)sp * 32 + i) * 2], r64[((size_t)sp * 32 + i) * 2 + 1]);
            q[i] = (bf16_t)f2bf(x1); q[i + 32] = (bf16_t)f2bf(x2); }
        const float* smp = (const float*)(ws + WS_MQP) + (size_t)t * 256;
        float smv0 = 0.f, smv1 = 0.f;
#pragma unroll
        for (int z = 0; z < 8; ++z) { smv0 += smp[(size_t)z * T * 256 + w.lane]; smv1 += smp[(size_t)z * T * 256 + 64 + w.lane]; }
        LDS_WAIT(); sml[w.lane] = smv0; sml[64 + w.lane] = smv1; LDS_WAIT();
        LAS const float* sm = sml;
        if (w.lane < 32) { float x1 = sm[w.lane], x2 = sm[w.lane + 32]; rope_pair(x1, x2, r64[((size_t)sp * 32 + w.lane) * 2], r64[((size_t)sp * 32 + w.lane) * 2 + 1]);
            bf16_t* ki = (bf16_t*)(ws + WS_KI) + (size_t)t * 64; ki[w.lane] = (bf16_t)f2bf(x1); ki[w.lane + 32] = (bf16_t)f2bf(x2);
            ((float*)(ws + WS_WI))[(size_t)t * 32 + w.lane] = sm[64 + w.lane] * 0.17677669529663687f; }
        if (w.lane < 16) { const float z = sm[96 + w.lane] + a.in[I_D_FORGET_BIAS][w.lane];
            const float lf = fminf(z, 0.f) - log1pf(__expf(-fabsf(z)));
            ((float*)(ws + WS_LOGF))[((size_t)b * 16 + w.lane) * SEQ + sp] = lf; }
    }
}
__device__ __forceinline__ void ph_l1_scan(const Args& a, LAS float* sh  , const WI& w) {
    unsigned char* ws = a.ws;
    for (int it = w.bid; it < NB * 16; it += w.nblk) {
        const float* src = (const float*)(ws + WS_LOGF) + (size_t)it * SEQ + w.tid * 8; float* dst = (float*)(ws + WS_CUM) + (size_t)it * SEQ + w.tid * 8;
        const f32x4 v0 = *(const f32x4*)src, v1 = *(const f32x4*)(src + 4);
        float c[8]; c[0] = v0.x; c[1] = c[0] + v0.y; c[2] = c[1] + v0.z; c[3] = c[2] + v0.w; c[4] = c[3] + v1.x; c[5] = c[4] + v1.y; c[6] = c[5] + v1.z; c[7] = c[6] + v1.w;
        float inc = c[7];
#pragma unroll
        for (int o = 1; o < 64; o <<= 1) { const float v = __shfl_up(inc, o); if (w.lane >= o) inc += v; }
        __syncthreads();
        if (w.lane == 63) sh[w.wave] = inc;
        __syncthreads();
        float base = inc - c[7];
        for (int q = 0; q < w.wave; ++q) base += sh[q];
        *(f32x4*)dst = (f32x4){c[0] + base, c[1] + base, c[2] + base, c[3] + base}; *(f32x4*)(dst + 4) = (f32x4){c[4] + base, c[5] + base, c[6] + base, c[7] + base};
    }
    __syncthreads();
}
__device__ __forceinline__ void ph_l1_index_naive(const Args& a, LAS float* qs  , const WI& w) {
    unsigned char* ws = a.ws; const bf16_t* P = (const bf16_t*)(ws + WS_PROJ); const bf16_t* KI = (const bf16_t*)(ws + WS_KI);
    const float* WIp = (const float*)(ws + WS_WI); float* SC = (float*)(ws + WS_SCORE);
    for (int t = w.gw; t < T; t += w.ngw) {
        const int b = t / SEQ, sp = t - b * SEQ, nadm = ((sp >> 6) + 1) * 64;
        LDS_WAIT();
        for (int e = w.lane; e < 2048; e += 64) qs[e] = bf2f(P[(size_t)t * CD_MAIN + 3072 + e]);
        if (w.lane < 32) qs[2048 + w.lane] = WIp[(size_t)t * 32 + w.lane];
        LDS_WAIT();
        for (int s0 = 0; s0 < nadm; s0 += 64) {
            const int s = s0 + w.lane; const bf16_t* kp = KI + ((size_t)b * SEQ + s) * 64;
            float k[64];
#pragma unroll
            for (int d0 = 0; d0 < 64; d0 += 8) { const bf16x8 kv = *(const bf16x8*)(kp + d0);
#pragma unroll
                for (int e = 0; e < 8; ++e) k[d0 + e] = bf2f((bf16_t)kv[e]); }
            float sc = 0.f;
            for (int h = 0; h < 32; ++h) { float dot = 0.f;
#pragma unroll
                for (int d = 0; d < 64; ++d) dot += qs[h * 64 + d] * k[d];
                sc += qs[2048 + h] * fmaxf(dot * 0.125f, 0.f); }
            SC[((size_t)b * SEQ + sp) * SEQ + s] = sc;
        }
    }
}
__device__ __forceinline__ void ph_l1_index(const Args& a, LAS unsigned char* lds, const WI& w) {
    unsigned char* ws = a.ws; const bf16_t* P = (const bf16_t*)(ws + WS_PROJ); const bf16_t* KI = (const bf16_t*)(ws + WS_KI);
    const float* WIp = (const float*)(ws + WS_WI); float* SC = (float*)(ws + WS_SCORE);
    LAS char* Qs = (LAS char*)lds; LAS float* Wt = (LAS float*)(lds + 131072);
    const int tid = w.tid, r32 = w.lane & 31, hi = w.lane >> 5;
    for (int u = w.bid; u < 256; u += w.nblk) {
        const int b = u >> 7, x = (u >> 1) & 63, half = u & 1;
        for (int pass = 0; pass < 2; ++pass) {
            const int qt = pass ? 127 - x : x; const int t0 = b * SEQ + qt * 32; const int nadm = ((qt * 32) >> 6) * 64 + 64, ngrp = (nadm + 127) >> 7;
            __syncthreads();
            for (int e = tid; e < 32 * 256; e += 512) { const int t = e >> 8, c = e & 255; const u32x4 v = *(const u32x4*)(P + (size_t)(t0 + t) * CD_MAIN + 3072 + c * 8);
                const int cs = (c & ~15) | ((c & 15) ^ (t & 15)); *(LAS u32x4*)(Qs + t * 4096 + cs * 16) = v; }
            for (int e = tid; e < 1024; e += 512) { const int t = e >> 5, h = e & 31; Wt[h * 32 + t] = WIp[(size_t)(t0 + t) * 32 + h] * 0.125f; }
            __syncthreads();
            for (int g = half + 2 * w.wave; g < ngrp; g += 16) {
                const int s0 = g * 128;
                bf16x8 kf[4][4];
#pragma unroll
                for (int j = 0; j < 4; ++j)
#pragma unroll
                    for (int dk = 0; dk < 4; ++dk) kf[j][dk] = *(const bf16x8*)(KI + ((size_t)b * SEQ + s0 + 32 * j + r32) * 64 + dk * 16 + hi * 8);
                f32x16 acc[4] = {};
#pragma unroll 2
                for (int h = 0; h < 32; ++h) {
                    bf16x8 qf[4];
#pragma unroll
                    for (int dk = 0; dk < 4; ++dk) qf[dk] = *(LAS const bf16x8*)(Qs + r32 * 4096 + ((((h >> 1) << 4) | ((((h & 1) << 3) | (dk << 1) | hi) ^ (r32 & 15))) << 4));
                    f32x4 wv[4];
#pragma unroll
                    for (int q4 = 0; q4 < 4; ++q4) wv[q4] = *(LAS const f32x4*)(Wt + h * 32 + 8 * q4 + 4 * hi);
#pragma unroll
                    for (int j = 0; j < 4; ++j) { f32x16 tmp = {};
#pragma unroll
                        for (int dk = 0; dk < 4; ++dk) tmp = __builtin_amdgcn_mfma_f32_32x32x16_bf16(qf[dk], kf[j][dk], tmp, 0, 0, 0);
#pragma unroll
                        for (int r = 0; r < 16; ++r) acc[j][r] = fmaf(wv[r >> 2][r & 3], fmaxf(tmp[r], 0.f), acc[j][r]); }
                }
#pragma unroll
                for (int j = 0; j < 4; ++j)
#pragma unroll
                    for (int r = 0; r < 16; ++r) SC[(size_t)(t0 + crow(r, hi)) * SEQ + s0 + 32 * j + r32] = acc[j][r];
            }
        }
    }
    __syncthreads();
}
__device__ __forceinline__ void ph_l1_select(const Args& a, const WI& w) {
    unsigned char* ws = a.ws; const float* SC = (const float*)(ws + WS_SCORE); unsigned* MK = (unsigned*)(ws + WS_MASK);
    for (int t = w.gw; t < T; t += w.ngw) {
        const int b = t / SEQ, sp = t - b * SEQ, nblk = (sp >> 6) + 1;
        const float* row = SC + ((size_t)b * SEQ + sp) * SEQ;
        unsigned key[64];
#pragma unroll
        for (int j = 0; j < 64; ++j) { unsigned u = 0u; if (j < nblk) { u = __float_as_uint(row[j * 64 + w.lane]); u ^= (u >> 31) ? 0xFFFFFFFFu : 0x80000000u; } key[j] = u; }
        unsigned thr = 0u;
        if (nblk > 4) {
            for (int bit = 31; bit >= 0; --bit) { const unsigned cand = thr | (1u << bit); int cnt = 0;
#pragma unroll
                for (int j = 0; j < 64; ++j) cnt += (key[j] >= cand) ? 1 : 0;
                cnt = wave_sum_i(cnt); if (cnt >= 256) thr = cand; }
        }
        unsigned lo = 0u, hi = 0u;
#pragma unroll
        for (int j = 0; j < 64; ++j) { const bool sel = (j < nblk) && (key[j] >= thr); const unsigned long long bal = __ballot(sel); if (w.lane == j) { lo = (unsigned)bal; hi = (unsigned)(bal >> 32); } }
        *(u32x2*)(MK + (size_t)t * 128 + 2 * w.lane) = (u32x2){lo, hi};
    }
}

__device__ __forceinline__ unsigned tk_key(float v, unsigned payload, unsigned pmask) { const unsigned u = __float_as_uint(v); const unsigned m = (unsigned)((int)u >> 31) | 0x80000000u; return ((u ^ m) & ~pmask) | payload; }
__device__ __forceinline__ float tk_val(unsigned key, unsigned pmask) { const unsigned k = key & ~pmask; const unsigned m = ~(unsigned)((int)k >> 31) | 0x80000000u; return __uint_as_float(k ^ m); }
#define TK_INSERT(TOP, key_) do { unsigned k__ = (key_); \
        _Pragma("unroll") for (int q_ = 0; q_ < 16; ++q_) { const unsigned hi__ = TOP[q_] > k__ ? TOP[q_] : k__; k__ = TOP[q_] > k__ ? k__ : TOP[q_]; TOP[q_] = hi__; } } while (0)
__device__ __forceinline__ unsigned tk_sel16(const unsigned (&arr)[16], unsigned i) {
    unsigned x8[8], x4[4], x2[2];
    const unsigned m0 = 0u - (i & 1u), m1 = 0u - ((i >> 1) & 1u), m2 = 0u - ((i >> 2) & 1u), m3 = 0u - ((i >> 3) & 1u);
#pragma unroll
    for (int q = 0; q < 8; ++q) x8[q] = (arr[2 * q + 1] & m0) | (arr[2 * q] & ~m0);
#pragma unroll
    for (int q = 0; q < 4; ++q) x4[q] = (x8[2 * q + 1] & m1) | (x8[2 * q] & ~m1);
#pragma unroll
    for (int q = 0; q < 2; ++q) x2[q] = (x4[2 * q + 1] & m2) | (x4[2 * q] & ~m2);
    return (x2[1] & m3) | (x2[0] & ~m3); }
__device__ __forceinline__ void ph_peer_topk(const Args& a, const WI& w) {
    unsigned char* ws = a.ws; const float* PST = (const float*)(ws + WS_PSCORE); int* PIDX = (int*)(ws + WS_PIDX); float* PG = (float*)(ws + WS_PGATE);
    for (int task = w.gw; task < 128 * 8; task += w.ngw) {
        const int h = task & 7, t = (task >> 3) * 64 + w.lane;
        unsigned t0[16], t1[16];
#pragma unroll
        for (int k = 0; k < 16; ++k) { t0[k] = 0u; t1[k] = 0u; }
        { const float* col = PST + (size_t)(h * 256) * T + t;
#pragma unroll 8
          for (int i = 0; i < 128; ++i) { const float v = col[(size_t)i * T]; TK_INSERT(t0, tk_key(v, 127u - (unsigned)i, 127u)); } }
        { const float* col = PST + (size_t)(h * 256 + 128) * T + t;
#pragma unroll 8
          for (int i = 0; i < 128; ++i) { const float v = col[(size_t)i * T]; TK_INSERT(t1, tk_key(v, 127u - (unsigned)i, 127u)); } }
        float a0[16], a1[16];
#pragma unroll
        for (int k = 0; k < 16; ++k) { a0[k] = tk_val(t0[k], 127u); a1[k] = tk_val(t1[k], 127u); }
        unsigned bk[16];
#pragma unroll
        for (int k = 0; k < 16; ++k) bk[k] = 0u;
#pragma unroll
        for (int i = 0; i < 16; ++i)
#pragma unroll
            for (int j = 0; j < 16; ++j) if ((i + 1) * (j + 1) <= 16) TK_INSERT(bk, tk_key(a0[i] + a1[j], 255u - (unsigned)(i * 16 + j), 255u));
        const float top = tk_val(bk[0], 255u); float den = 0.f; float ex[16];
#pragma unroll
        for (int k = 0; k < 16; ++k) { ex[k] = __expf(tk_val(bk[k], 255u) - top); den += ex[k]; }
        const float rd = 1.f / den;
#pragma unroll
        for (int k = 0; k < 16; ++k) { const unsigned c = 255u - (bk[k] & 255u); const unsigned e0 = 127u - (tk_sel16(t0, c >> 4) & 127u), e1 = 127u - (tk_sel16(t1, c & 15u) & 127u);
            PIDX[(size_t)t * 128 + h * 16 + k] = (int)(e0 * 128u + e1); PG[(size_t)t * 128 + h * 16 + k] = ex[k] * rd; }
    }
}
__device__ __forceinline__ void ph_peer_experts(const Args& a, int layer, float* outf, bf16_t* outb, const float* g, const float* bta, LAS float* wsm  , const WI& w) {
    unsigned char* ws = a.ws; const float* HF = (const float*)(ws + WS_HF);
    const unsigned char* U8 = ws + WS_U8 + (size_t)layer * 16384 * DM; const unsigned char* V8 = ws + WS_V8 + (size_t)layer * 16384 * DM;
    const float* USC = (const float*)(ws + WS_USC) + layer * 16384; const float* VSC = (const float*)(ws + WS_VSC) + layer * 16384;
    const int* PIDX = (const int*)(ws + WS_PIDX); const float* PG = (const float*)(ws + WS_PGATE);
    const int lane = w.lane;
    for (int t = w.gw; t < T; t += w.ngw) {
        const float* hrow = HF + (size_t)t * DM + 16 * lane;
        const int idx0 = PIDX[(size_t)t * 128 + lane], idx1 = PIDX[(size_t)t * 128 + 64 + lane];
        const float g0 = PG[(size_t)t * 128 + lane], g1 = PG[(size_t)t * 128 + 64 + lane];
        LDS_WAIT();
#define PE_LOAD(BUF, TBL, kb_) do { const int iv_ = ((kb_) & 64) ? idx1 : idx0; \
            _Pragma("unroll") for (int q_ = 0; q_ < 2; ++q_) { const int e_ = __builtin_amdgcn_readlane(iv_, ((kb_) + q_) & 63); const u32x4* r_ = (const u32x4*)(TBL + (size_t)e_ * DM + 16 * lane); \
                _Pragma("unroll") for (int i_ = 0; i_ < 4; ++i_) BUF[q_][i_] = r_[64 * i_]; } } while (0)
#define PE_DOT(BUF, Z, zo_) do { _Pragma("unroll") for (int q_ = 0; q_ < 2; ++q_) { f32x2 acc_ = {0.f, 0.f}; \
            _Pragma("unroll") for (int i_ = 0; i_ < 4; ++i_) _Pragma("unroll") for (int c_ = 0; c_ < 4; ++c_) { \
                const f32x2 lo_ = __builtin_amdgcn_cvt_pk_f32_fp8((int)BUF[q_][i_][c_], false), hi_ = __builtin_amdgcn_cvt_pk_f32_fp8((int)BUF[q_][i_][c_], true); \
                acc_ = __builtin_elementwise_fma(lo_, x[8 * i_ + 2 * c_], acc_); acc_ = __builtin_elementwise_fma(hi_, x[8 * i_ + 2 * c_ + 1], acc_); } \
            Z[(zo_) + q_] = acc_.x + acc_.y; } } while (0)
#define PE_AXPY(BUF, kb_) do { _Pragma("unroll") for (int q_ = 0; q_ < 2; ++q_) { const float wt_ = wsm[(kb_) + q_]; const f32x2 wt2_ = {wt_, wt_}; \
            _Pragma("unroll") for (int i_ = 0; i_ < 4; ++i_) _Pragma("unroll") for (int c_ = 0; c_ < 4; ++c_) { \
                const f32x2 lo_ = __builtin_amdgcn_cvt_pk_f32_fp8((int)BUF[q_][i_][c_], false), hi_ = __builtin_amdgcn_cvt_pk_f32_fp8((int)BUF[q_][i_][c_], true); \
                y[8 * i_ + 2 * c_] = __builtin_elementwise_fma(lo_, wt2_, y[8 * i_ + 2 * c_]); y[8 * i_ + 2 * c_ + 1] = __builtin_elementwise_fma(hi_, wt2_, y[8 * i_ + 2 * c_ + 1]); } } } while (0)
#define PE_SB() __builtin_amdgcn_sched_barrier(0)
        u32x4 bA[2][4], bB[2][4];
        {
            f32x2 x[32];
#pragma unroll
            for (int i = 0; i < 4; ++i)
#pragma unroll
                for (int q4 = 0; q4 < 4; ++q4) { const f32x4 v = *(const f32x4*)(hrow + 1024 * i + 4 * q4); x[8 * i + 2 * q4] = (f32x2){v.x, v.y}; x[8 * i + 2 * q4 + 1] = (f32x2){v.z, v.w}; }
            PE_LOAD(bA, U8, 0); PE_SB();
#pragma unroll 1
            for (int k0 = 0; k0 < 128; k0 += 8) {
                const int iv = (k0 & 64) ? idx1 : idx0; const float gv = (k0 & 64) ? g1 : g0;
                float z[8];
                PE_LOAD(bB, U8, k0 + 2); PE_SB(); PE_DOT(bA, z, 0); PE_SB();
                PE_LOAD(bA, U8, k0 + 4); PE_SB(); PE_DOT(bB, z, 2); PE_SB();
                PE_LOAD(bB, U8, k0 + 6); PE_SB(); PE_DOT(bA, z, 4); PE_SB();
                PE_LOAD(bA, U8, (k0 + 8) & 127); PE_SB(); PE_DOT(bB, z, 6); PE_SB();
                float r4[4], r2[2], r1;
#pragma unroll
                for (int i = 0; i < 4; ++i) { const float keep = (lane & 32) ? z[i + 4] : z[i], send = (lane & 32) ? z[i] : z[i + 4]; r4[i] = keep + __shfl_xor(send, 32); }
#pragma unroll
                for (int i = 0; i < 2; ++i) { const float keep = (lane & 16) ? r4[i + 2] : r4[i], send = (lane & 16) ? r4[i] : r4[i + 2]; r2[i] = keep + __shfl_xor(send, 16); }
                { const float keep = (lane & 8) ? r2[1] : r2[0], send = (lane & 8) ? r2[0] : r2[1]; r1 = keep + __shfl_xor(send, 8); }
                r1 += __shfl_xor(r1, 4); r1 += __shfl_xor(r1, 2); r1 += __shfl_xor(r1, 1);
                const int q = lane >> 3; const int e = __shfl(iv, (k0 + q) & 63); const float gt_ = __shfl(gv, (k0 + q) & 63);
                if ((lane & 7) == 0) { const float zz = r1 * USC[e]; const float act = 0.5f * zz * (1.f + erff(zz * 0.70710678118654752f)); wsm[k0 + q] = act * gt_ * VSC[e]; }
            }
        }
        LDS_WAIT();
        f32x2 y[32];
#pragma unroll
        for (int i = 0; i < 32; ++i) y[i] = (f32x2){0.f, 0.f};
        PE_LOAD(bA, V8, 0); PE_SB();
#pragma unroll 1
        for (int k0 = 0; k0 < 128; k0 += 8) {
            PE_LOAD(bB, V8, k0 + 2); PE_SB(); PE_AXPY(bA, k0); PE_SB();
            PE_LOAD(bA, V8, k0 + 4); PE_SB(); PE_AXPY(bB, k0 + 2); PE_SB();
            PE_LOAD(bB, V8, k0 + 6); PE_SB(); PE_AXPY(bA, k0 + 4); PE_SB();
            PE_LOAD(bA, V8, (k0 + 8) & 127); PE_SB(); PE_AXPY(bB, k0 + 6); PE_SB();
        }
#undef PE_LOAD
#undef PE_DOT
#undef PE_AXPY
#undef PE_SB
        float s = 0.f;
#pragma unroll
        for (int i = 0; i < 4; ++i)
#pragma unroll
            for (int q4 = 0; q4 < 4; ++q4) { const f32x4 v = *(const f32x4*)(hrow + 1024 * i + 4 * q4);
                y[8 * i + 2 * q4].x += ALPHA * v.x; y[8 * i + 2 * q4].y += ALPHA * v.y; y[8 * i + 2 * q4 + 1].x += ALPHA * v.z; y[8 * i + 2 * q4 + 1].y += ALPHA * v.w; }
#pragma unroll
        for (int i = 0; i < 32; ++i) s += y[i].x + y[i].y;
        const float mean = wave_sum(s) * (1.f / DM); float s2 = 0.f;
#pragma unroll
        for (int i = 0; i < 32; ++i) { y[i].x -= mean; y[i].y -= mean; s2 += y[i].x * y[i].x + y[i].y * y[i].y; }
        const float rstd = 1.f / sqrtf(wave_sum(s2) * (1.f / DM) + LN_EPS);
#pragma unroll
        for (int i = 0; i < 4; ++i)
#pragma unroll
            for (int q4 = 0; q4 < 4; ++q4) { const int c = 1024 * i + 16 * lane + 4 * q4;
                const f32x4 gg = *(const f32x4*)(g + c), bb = *(const f32x4*)(bta + c); f32x4 o;
                o.x = y[8 * i + 2 * q4].x * rstd * gg.x + bb.x; o.y = y[8 * i + 2 * q4].y * rstd * gg.y + bb.y; o.z = y[8 * i + 2 * q4 + 1].x * rstd * gg.z + bb.z; o.w = y[8 * i + 2 * q4 + 1].y * rstd * gg.w + bb.w;
                *(f32x4*)(outf + (size_t)t * DM + c) = o;
                if (outb) { u32x2 p; p.x = pk2(o.x, o.y); p.y = pk2(o.z, o.w); *(u32x2*)(outb + (size_t)t * DM + c) = p; } }
    }
}

__device__ __forceinline__ void ph_attn_l0(const Args& a, LAS unsigned char* lds, const WI& w) {
    for (int pr = w.bid; pr < 256; pr += w.nblk) { const int bh = pr >> 3, x = pr & 7;
        for (int pass = 0; pass < 2; ++pass) fa::attn_unit<1>(a, 0, lds, bh >> 4, bh & 15, pass ? 15 - x : x); }
    for (int u = w.bid; u < 512; u += w.nblk) { const int bh = u >> 4; fa::attn_unit<0>(a, 0, lds, bh >> 4, bh & 15, u & 15); }
}
__device__ __forceinline__ void ph_attn_l1(const Args& a, LAS unsigned char* lds, const WI& w) {
    for (int pr = w.bid; pr < 256; pr += w.nblk) { const int bh = pr >> 3, x = pr & 7;
        for (int pass = 0; pass < 2; ++pass) fa::attn_unit<2>(a, 1, lds, bh >> 4, bh & 15, pass ? 15 - x : x); }
    for (int pr = w.bid; pr < 256; pr += w.nblk) { const int bh = pr >> 3, x = pr & 7;
        for (int pass = 0; pass < 2; ++pass) fa::attn_unit<3>(a, 1, lds, bh >> 4, bh & 15, pass ? 15 - x : x); }
}
__device__ __forceinline__ void ph_attn_mem(const Args& a, int layer, LAS unsigned char* lds, const WI& w) {
    for (int u = w.bid; u < 128; u += w.nblk) { const int bh = u >> 4; fa::attn_unit<4>(a, layer, lds, bh >> 2, bh & 3, u & 15); }
}

__global__ void __launch_bounds__(512, 2) mega(Args a) {
    extern __shared__ __attribute__((aligned(16))) unsigned char lds_raw[];
    LAS unsigned char* lds = (LAS unsigned char*)lds_raw;
    WI w; w.tid = threadIdx.x; w.lane = w.tid & 63; w.wave = __builtin_amdgcn_readfirstlane(w.tid >> 6);
    w.bid = blockIdx.x; w.nblk = gridDim.x; w.gw = w.bid * 8 + w.wave; w.ngw = w.nblk * 8;
    unsigned char* ws = a.ws;
    volatile LAS unsigned* misc = (volatile LAS unsigned*)(lds + LDS_MISC);
    if (w.tid < 4) misc[w.tid] = 0u;
    __syncthreads();
    XcdBarrier bar; bar.bar = (unsigned*)(ws + WS_CTL) + 4096; bar.x = 0; bar.st = misc;
#if !MK_PER_PHASE
    bar = xcd_barrier_post((unsigned*)(ws + WS_CTL) + 4096, misc);
#endif
    const int lo = a.ph_lo, hi = a.ph_hi;
#define IN(k) (lo <= (k) && (k) < hi)
#if MK_PER_PHASE
#define SEAM(k) do { } while (0)
#else
#define SEAM(k) do { if (IN(k) && IN((k) + 1)) xcd_barrier(bar); } while (0)
#endif
    LAS float* wlds = (LAS float*)(lds + w.wave * 16384);
    bf16_t* XB = (bf16_t*)(ws + WS_XB); float* HF = (float*)(ws + WS_HF); float* RES = (float*)(ws + WS_RES); bf16_t* PROJ = (bf16_t*)(ws + WS_PROJ);
    bf16_t* ATT = (bf16_t*)(ws + WS_ATT); float* SMALL = (float*)(ws + WS_SMALL);

#define FAST_GEMM(EPI_T, Aptr, lda_, Btptr, ldb_, M_, N_, K_, nz_, zA_, zB_, EPI_OBJ) do { \
        pg8::Gemm g_{Aptr, Btptr, M_, N_, K_, lda_, ldb_, zA_, zB_, nz_}; pg8::StaticOrder S_; S_.init(M_, N_, nz_, w.nblk, w.bid); \
        pg8::gemm_phase<EPI_T, pg8::StaticOrder>(lds, g_, S_, EPI_OBJ); } while (0)
    if (IN(0)) { ph_convert(a, lds, w); if (PROBE_DUP == 0) ph_convert(a, lds, w); }
    SEAM(0);
    if (IN(1)) {
        FAST_GEMM(pg8::EpiBf16, XB, DM, (const bf16_t*)(ws + WS_W_AB_IN), DM, T, AB_MAIN, DM, 1, 0, 0, (pg8::EpiBf16{PROJ, AB_MAIN, nullptr}));
        FAST_GEMM(pg8::EpiF32, XB, DM, (const bf16_t*)(ws + WS_W_AB_IN) + (size_t)AB_MAIN * DM, DM, T, 256, 512, 8, 512, 512, (pg8::EpiF32{(float*)(ws + WS_MQP), 256, (long)T * 256}));
        FAST_GEMM(pg8::EpiF32, (const bf16_t*)(ws + WS_MEMB), DM, (const bf16_t*)(ws + WS_W_MEM_KV), DM, 512, 2048, 256, 16, 256, 256, (pg8::EpiF32{(float*)(ws + WS_SCORE), 2048, (long)512 * 2048}));
    }
    SEAM(1);
    if (IN(2)) { ph_l0_stats(a, w);
        { const float* part = (const float*)(ws + WS_SCORE); bf16_t* KVM = (bf16_t*)(ws + WS_KVM);
          for (size_t i = ((size_t)w.gw * 64 + w.lane) * 4; i < (size_t)512 * 2048; i += (size_t)w.ngw * 64 * 4) { f32x4 s = {0.f, 0.f, 0.f, 0.f};
#pragma unroll
              for (int z = 0; z < 16; ++z) s += *(const f32x4*)(part + (size_t)z * 512 * 2048 + i);
              const int m = (int)(i >> 11), n = (int)(i & 2047); u32x2 p; p.x = pk2(s.x, s.y); p.y = pk2(s.z, s.w);
              *(u32x2*)(KVM + ((size_t)(n >> 10) * 512 + m) * 1024 + (n & 1023)) = p; } } }
    SEAM(2);
    if (IN(3)) {
        const float* rsq = (const float*)(ws + WS_RSQ); const float* rskv = (const float*)(ws + WS_RSKV);
        bf16_t* QB = (bf16_t*)(ws + WS_QB); bf16_t* KVB = (bf16_t*)(ws + WS_KVB);
        FAST_GEMM(pg8::EpiBf16, PROJ + 6144, AB_MAIN, (const bf16_t*)(ws + WS_W_UQ), 1536, T, 3072, 1536, 1, 0, 0, (pg8::EpiBf16{QB, 3072, rsq}));
        FAST_GEMM(pg8::EpiBf16, PROJ + 7680, AB_MAIN, (const bf16_t*)(ws + WS_W_UKV), 512, T, 4096, 512, 1, 0, 0, (pg8::EpiBf16{KVB, 4096, rskv}));
    }
    SEAM(3);
    if (IN(4)) ph_l0_qrope(a, w);
    SEAM(4);
    if (IN(5)) { ph_attn_l0(a, lds, w); if (PROBE_DUP == 5) ph_attn_l0(a, lds, w); }
    SEAM(5);
    if (IN(6)) { const float* X = a.in[I_X];
        FAST_GEMM(pg8::EpiResid, ATT, DM, (const bf16_t*)(ws + WS_W_AB_OUT), DM, T, DM, DM, 1, 0, 0, (pg8::EpiResid{X, RES, DM})); }
    SEAM(6);
    if (IN(7)) ln_rows(RES, a.in[I_LN_G] + 0 * DM, a.in[I_LN_B] + 0 * DM, HF, XB, w);
    SEAM(7);

#define MEM_PEER_PHASES(L, P0_, LAST)                                                                                                                         \
    if (IN(P0_)) { FAST_GEMM(pg8::EpiF32, XB, DM, (const bf16_t*)(ws + WS_W_MEM_Q) + (size_t)(L) * 512 * DM, DM, T, 512, 1024, 4, 1024, 1024,                    \
                             (pg8::EpiF32{(float*)(ws + WS_MQP), 512, (long)T * 512})); }                                                                       \
    SEAM(P0_);                                                                                                                                                  \
    if (IN(P0_ + 1)) ph_attn_mem(a, (L), lds, w);                                                                                                               \
    SEAM(P0_ + 1);                                                                                                                                              \
    if (IN(P0_ + 2)) { FAST_GEMM(pg8::EpiResid, (const bf16_t*)(ws + WS_MEMO), 512, (const bf16_t*)(ws + WS_W_MEM_O) + (size_t)(L) * DM * 512, 512, T, DM, 512, 1, 0, 0, \
                                 (pg8::EpiResid{HF, RES, DM})); }                                                                                               \
    SEAM(P0_ + 2);                                                                                                                                              \
    if (IN(P0_ + 3)) ln_rows(RES, a.in[I_LN_G] + ((L) * 3 + 1) * DM, a.in[I_LN_B] + ((L) * 3 + 1) * DM, HF, XB, w);                                             \
    SEAM(P0_ + 3);                                                                                                                                              \
    if (IN(P0_ + 4)) { FAST_GEMM(pg8::EpiF32, (const bf16_t*)(ws + WS_W_PEER) + (size_t)(L) * 2048 * DM, DM, XB, DM, 2048, T, DM, 1, 0, 0,                     \
                                 (pg8::EpiF32{(float*)(ws + WS_PSCORE), T, 0})); }                                                                              \
    SEAM(P0_ + 4);                                                                                                                                              \
    if (IN(P0_ + 5)) { ph_peer_topk(a, w); if (PROBE_DUP == 27 && (LAST)) ph_peer_topk(a, w); }                                                                 \
    SEAM(P0_ + 5);                                                                                                                                              \
    if (IN(P0_ + 6)) { ph_peer_experts(a, (L), (LAST) ? a.out : HF, (LAST) ? (bf16_t*)nullptr : XB, a.in[I_LN_G] + ((L) * 3 + 2) * DM, a.in[I_LN_B] + ((L) * 3 + 2) * DM, wlds, w); \
        if (PROBE_DUP == 28 && (LAST)) ph_peer_experts(a, (L), a.out, (bf16_t*)nullptr, a.in[I_LN_G] + ((L) * 3 + 2) * DM, a.in[I_LN_B] + ((L) * 3 + 2) * DM, wlds, w); } \
    if (!(LAST)) SEAM(P0_ + 6);

    MEM_PEER_PHASES(0, 8, false)

    if (IN(15)) {
        FAST_GEMM(pg8::EpiBf16, XB, DM, (const bf16_t*)(ws + WS_W_CD_IN), DM, T, CD_MAIN, DM, 1, 0, 0, (pg8::EpiBf16{PROJ, CD_MAIN, nullptr}));
        FAST_GEMM(pg8::EpiF32, XB, DM, (const bf16_t*)(ws + WS_W_CD_IN) + (size_t)CD_MAIN * DM, DM, T, 256, 512, 8, 512, 512, (pg8::EpiF32{(float*)(ws + WS_MQP), 256, (long)T * 256}));
    }
    SEAM(15);
    if (IN(16)) ph_l1_elem(a, wlds, w);
    SEAM(16);
    if (IN(17)) { ph_l1_scan(a, (LAS float*)(lds + LDS_MISC + 64), w); ph_l1_index(a, lds, w); if (PROBE_DUP == 17) ph_l1_index(a, lds, w); }
    SEAM(17);
    if (IN(18)) { ph_l1_select(a, w); if (PROBE_DUP == 18) ph_l1_select(a, w); }
    SEAM(18);
    if (IN(19)) { ph_attn_l1(a, lds, w); if (PROBE_DUP == 19) ph_attn_l1(a, lds, w); }
    SEAM(19);
    if (IN(20)) { FAST_GEMM(pg8::EpiResid, ATT, DM, (const bf16_t*)(ws + WS_W_CD_OUT), DM, T, DM, DM, 1, 0, 0, (pg8::EpiResid{HF, RES, DM})); }
    SEAM(20);
    if (IN(21)) ln_rows(RES, a.in[I_LN_G] + 3 * DM, a.in[I_LN_B] + 3 * DM, HF, XB, w);
    SEAM(21);
    MEM_PEER_PHASES(1, 22, true)
#undef IN
#undef SEAM
}

extern "C" void kernel_launch(void* const* d_in, const int* in_sizes, int n_in, void* d_out, int out_size, void* d_ws, size_t ws_size, hipStream_t stream) {
    static int grid = 0;
    if (grid == 0) {
        if (n_in != 21 || out_size != T * DM || ws_size < WS_END) { fprintf(stderr, "kernel_launch: unexpected shapes (n_in %d out %d ws %zu need %zu)\n", n_in, out_size, ws_size, (size_t)WS_END); grid = -1; return; }
        int dev = 0, cus = 0, per_cu = 0;
        if (hipGetDevice(&dev) != hipSuccess || hipDeviceGetAttribute(&cus, hipDeviceAttributeMultiprocessorCount, dev) != hipSuccess) { grid = -1; return; }
        if (hipFuncSetAttribute((const void*)mega, hipFuncAttributeMaxDynamicSharedMemorySize, LDS_BYTES) != hipSuccess) { fprintf(stderr, "kernel_launch: hipFuncSetAttribute failed\n"); grid = -1; return; }
        if (hipOccupancyMaxActiveBlocksPerMultiprocessor(&per_cu, (const void*)mega, 512, LDS_BYTES) != hipSuccess || per_cu < 1) { fprintf(stderr, "kernel_launch: occupancy query says %d\n", per_cu); }
        (void)hipGetLastError();
        grid = cus;
    }
    if (grid < 0) return;
    (void)hipMemsetAsync((char*)d_ws + WS_CTL, 0, CTL_BYTES, stream);
    Args a{};
    for (int i = 0; i < 21; ++i) a.in[i] = (const float*)d_in[i];
    a.out = (float*)d_out; a.ws = (unsigned char*)d_ws;
#if MK_PER_PHASE
    for (int p = 0; p < NPHASE; ++p) { a.ph_lo = p; a.ph_hi = p + 1; hipLaunchKernelGGL(mega, dim3(grid), dim3(512), LDS_BYTES, stream, a); }
#else
    a.ph_lo = 0; a.ph_hi = NPHASE;
    hipLaunchKernelGGL(mega, dim3(grid), dim3(512), LDS_BYTES, stream, a);
#endif
}
```

```cpp
#include <hip/hip_runtime.h>
#include <cstdio>
#include <cstdint>

#define GAS __attribute__((address_space(1)))
#define LAS __attribute__((address_space(3)))
typedef unsigned short bf16_t;
typedef short bf16x8 __attribute__((ext_vector_type(8)));
typedef float f32x4 __attribute__((ext_vector_type(4)));
typedef float f32x16 __attribute__((ext_vector_type(16)));
typedef unsigned u32x4 __attribute__((ext_vector_type(4)));
typedef unsigned u32x2 __attribute__((ext_vector_type(2)));
typedef float f32x2 __attribute__((ext_vector_type(2)));

#ifndef PROBE_DUP
#define PROBE_DUP -1
#endif
#ifndef MK_PER_PHASE
#define MK_PER_PHASE 0
#endif

constexpr int NB = 2, SEQ = 4096, T = NB * SEQ, DM = 4096;
constexpr int AB_COLS = 8256, AB_MAIN = 8192, AB_PAD = 8448;
constexpr int CD_COLS = 11376, CD_MAIN = 11264, CD_PAD = 11520;
constexpr float ALPHA = 1.4142135623730951f;
constexpr float LN_EPS = 1e-5f, RMS_EPS = 1e-6f;
constexpr int NPHASE = 29;

constexpr size_t MiB = 1ull << 20;
constexpr size_t WS_CTL = 0, CTL_BYTES = 1 * MiB;
constexpr size_t WS_ROPE128 = 1 * MiB;
constexpr size_t WS_ROPE64 = 3 * MiB;
constexpr size_t WS_RSQ = 4 * MiB;
constexpr size_t WS_RSKV = 4 * MiB + 65536;
constexpr size_t WS_CUM = 5 * MiB;
constexpr size_t WS_LOGF = 5 * MiB + 524288;
constexpr size_t WS_KR = 6 * MiB;
constexpr size_t WS_KI = 7 * MiB;
constexpr size_t WS_WI = 8 * MiB;
constexpr size_t WS_KVM = 9 * MiB;
constexpr size_t WS_MEMB = 11 * MiB;
constexpr size_t WS_MASK = 15 * MiB;
constexpr size_t WS_PIDX = 19 * MiB;
constexpr size_t WS_PGATE = 23 * MiB;
constexpr size_t WS_MEMQ = 27 * MiB;
constexpr size_t WS_MEMO = 35 * MiB;
constexpr size_t WS_SMALL = 43 * MiB;
constexpr size_t WS_W_AB_IN = 64 * MiB;
constexpr size_t WS_W_UQ = 130 * MiB;
constexpr size_t WS_W_UKV = 139 * MiB;
constexpr size_t WS_W_AB_OUT = 143 * MiB;
constexpr size_t WS_W_CD_IN = 175 * MiB;
constexpr size_t WS_W_CD_OUT = 265 * MiB;
constexpr size_t WS_W_MEM_Q = 297 * MiB;
constexpr size_t WS_W_MEM_KV = 305 * MiB;
constexpr size_t WS_W_MEM_O = 321 * MiB;
constexpr size_t WS_W_PEER = 329 * MiB;
constexpr size_t WS_U8 = 361 * MiB;
constexpr size_t WS_V8 = 489 * MiB;
constexpr size_t WS_USC = 48 * MiB;
constexpr size_t WS_VSC = 48 * MiB + 262144;
constexpr size_t WS_XB = 873 * MiB;
constexpr size_t WS_HF = 937 * MiB;
constexpr size_t WS_RES = 1065 * MiB;
constexpr size_t WS_PROJ = 1193 * MiB;
constexpr size_t WS_PSCORE = WS_PROJ;
constexpr size_t WS_ATT = 1369 * MiB;
constexpr size_t WS_QB = 1433 * MiB;
constexpr size_t WS_KVB = 1481 * MiB;
constexpr size_t WS_SCORE = 1433 * MiB;
constexpr size_t WS_MQP = 1561 * MiB;
constexpr size_t WS_END = 1625 * MiB;

constexpr int LDS_BYTES = 147456;
constexpr int LDS_MISC = 140 * 1024;

#define LDS_WAIT() asm volatile("s_waitcnt lgkmcnt(0)" ::: "memory")
__device__ __forceinline__ float bf2f(bf16_t b) { return __uint_as_float(((unsigned)b) << 16); }
__device__ __forceinline__ unsigned f2bf(float f) { unsigned u = __float_as_uint(f); return (u + 0x7fffu + ((u >> 16) & 1u)) >> 16; }
__device__ __forceinline__ unsigned pk2(float lo, float hi) { return f2bf(lo) | (f2bf(hi) << 16); }
__device__ __forceinline__ float wave_sum(float v) {
#pragma unroll
    for (int o = 1; o < 64; o <<= 1) v += __shfl_xor(v, o);
    return v;
}
__device__ __forceinline__ float wave_max(float v) {
#pragma unroll
    for (int o = 1; o < 64; o <<= 1) v = fmaxf(v, __shfl_xor(v, o));
    return v;
}
__device__ __forceinline__ int wave_sum_i(int v) {
#pragma unroll
    for (int o = 1; o < 64; o <<= 1) v += __shfl_xor(v, o);
    return v;
}

#define XB_TMO      128
#define XB_XCNT(j)  (256  + 64 * (j))
#define XB_XSUB(j)  (1280 + 64 * (j))
#define XB_XGEN(j)  (2304 + 64 * (j))
#define XB_TOP      3328
#define XB_TOPGEN   3392
#define XCD_BAR_WORDS 3456
#define XB_SPIN_CAP (1u << 22)

__device__ __forceinline__ unsigned xb_ld(unsigned* p)              { return __hip_atomic_load(p, __ATOMIC_RELAXED, __HIP_MEMORY_SCOPE_AGENT); }
__device__ __forceinline__ unsigned xb_add(unsigned* p, unsigned v) { return __hip_atomic_fetch_add(p, v, __ATOMIC_RELAXED, __HIP_MEMORY_SCOPE_AGENT); }
__device__ __forceinline__ unsigned xb_xcc_id() { return (unsigned)__builtin_amdgcn_s_getreg((3 << 11) | 20) & 0xFu; }
#define XB_SPIN(cond, bar) do { unsigned _sp = 0; while (cond) { __builtin_amdgcn_s_sleep(1); \
    if ((++_sp & 255u) == 0u) { if (xb_ld(&(bar)[XB_TMO])) break; if (_sp > XB_SPIN_CAP) { atomicAdd(&(bar)[XB_TMO], 1u); break; } } } } while (0)

struct XcdBarrier { unsigned* bar; unsigned x; volatile LAS unsigned* st; };

__device__ __forceinline__ XcdBarrier xcd_barrier_post(unsigned* bar, volatile LAS unsigned* st) {
    XcdBarrier b; b.bar = bar; b.x = xb_xcc_id(); b.st = st;
    if (threadIdx.x == 0) (void)xb_add(&bar[XB_XCNT(b.x)], 1u);
    return b;
}
__device__ __forceinline__ void xcd_barrier_complete(unsigned* bar, unsigned x, unsigned& nloc, unsigned& nx) {
    const unsigned G = gridDim.x * gridDim.y * gridDim.z;
    unsigned sum, cnt, mine, sp = 0u;
    for (;;) {
        sum = 0u; cnt = 0u; mine = 0u;
#pragma unroll
        for (unsigned j = 0; j < 16; ++j) { const unsigned c = xb_ld(&bar[XB_XCNT(j)]); sum += c; cnt += (c > 0u) ? 1u : 0u; mine = (j == x) ? c : mine; }
        if (sum == G) break;
        __builtin_amdgcn_s_sleep(1);
        if ((++sp & 255u) == 0u) { if (xb_ld(&bar[XB_TMO])) break; if (sp > XB_SPIN_CAP) { atomicAdd(&bar[XB_TMO], 1u); break; } }
    }
    nloc = mine > 0u ? mine : 1u; nx = cnt > 0u ? cnt : 1u;
}
__device__ __forceinline__ void xcd_barrier(const XcdBarrier& b) {
    asm volatile("s_waitcnt vmcnt(0)" ::: "memory");
    __syncthreads();
    if (threadIdx.x == 0) {
        unsigned* bar = b.bar;
        __builtin_amdgcn_s_waitcnt(0);
        unsigned nloc = b.st[0], nx = b.st[1];
        if (nloc == 0u) { xcd_barrier_complete(bar, b.x, nloc, nx); b.st[0] = nloc; b.st[1] = nx; }
        const unsigned old = xb_add(&bar[XB_XSUB(b.x)], 1u);
        const unsigned gen = old / nloc;
        if (old + 1u == (gen + 1u) * nloc) {
            __builtin_amdgcn_fence(__ATOMIC_RELEASE, "agent");
            asm volatile("s_waitcnt vmcnt(0)" ::: "memory");
            const unsigned og = xb_add(&bar[XB_TOP], 1u);
            const unsigned tg = og / nx;
            if (og + 1u == (tg + 1u) * nx) xb_add(&bar[XB_TOPGEN], 1u);
            else XB_SPIN(xb_ld(&bar[XB_TOPGEN]) == tg, bar);
            __builtin_amdgcn_fence(__ATOMIC_ACQUIRE, "agent");
            xb_add(&bar[XB_XGEN(b.x)], 1u);
            asm volatile("s_waitcnt vmcnt(0)" ::: "memory");
        } else {
            XB_SPIN(xb_ld(&bar[XB_XGEN(b.x)]) == gen, bar);
            __builtin_amdgcn_fence(__ATOMIC_ACQUIRE, "agent");
            asm volatile("s_waitcnt vmcnt(0)" ::: "memory");
        }
    }
    __syncthreads();
}

namespace pg8 {
constexpr int BM = 256, BK = 64, HALF = 128, HTB = HALF * BK * 2, STAGE_BYTES = 8 * HTB, NXCD = 8, WGM = 8;
__host__ __device__ __forceinline__ int lds_byte(int r, int c) { const int st = (r >> 4) * 2 + (c >> 5), rr = r & 15, cc = c & 31, ob = rr * 64 + cc * 2; return st * 1024 + (ob ^ (((ob >> 9) & 1) << 5)); }
__host__ __device__ __forceinline__ void stage_rc(int b, int& R, int& C) { const int st = b / 1024, sb = b % 1024, swz = sb ^ (((sb >> 9) & 1) << 5); R = (st >> 1) * 16 + swz / 64; C = (st & 1) * 32 + (swz % 64) / 2; }
__host__ __device__ __forceinline__ int perm32(int rho) { const int n = rho >> 4, i = rho & 15; return 8 * (i >> 2) + 4 * n + (i & 3); }
struct Unit { int pm, pn, z; };
struct Gemm { const bf16_t* A; const bf16_t* Bt; int M, N, K, lda, ldb; long zA, zB; int nz; };
struct StaticOrder {
    int nM, nN, nZ, nwg, G, c;
    __device__ void init(int M, int N, int Z, int G_, int c_) { nM = M / BM; nN = N / BM; nZ = Z; nwg = nM * nN * nZ; G = G_; c = c_; }
    __device__ bool next(int i, Unit& u) const {
        const long L = (long)i * G + c; if (L >= nwg) return false;
        int wgid = (int)L; { const int q = nwg / NXCD, r = nwg % NXCD, xcd = wgid % NXCD, off = wgid / NXCD; wgid = (xcd < r ? xcd * (q + 1) : r * (q + 1) + (xcd - r) * q) + off; }
        const int per = nM * nN; u.z = wgid / per; wgid -= u.z * per;
        const int nig = WGM * nN, gid = wgid / nig, fm = gid * WGM, gsz = (nM - fm) < WGM ? (nM - fm) : WGM;
        u.pm = fm + ((wgid % nig) % gsz); u.pn = (wgid % nig) / gsz; return true;
    }
};
__device__ __forceinline__ unsigned cvt_pk_bf16(float lo, float hi) { unsigned r; asm volatile("v_cvt_pk_bf16_f32 %0, %1, %2" : "=v"(r) : "v"(lo), "v"(hi)); return r; }
struct EpiF32 {
    static constexpr bool PERM = false;
    float* C; int ldc; long zC;
    __device__ __forceinline__ void operator()(const f32x4 (&acc)[2][2][4][2], const Unit& u, int wr, int wc, int fr, int fq) const {
        const int row0 = u.pm * BM + wr * 64 + fr, col0 = u.pn * BM + wc * 32 + 4 * fq; float* Cz = C + (size_t)u.z * zC;
#pragma unroll
        for (int ai = 0; ai < 2; ++ai)
#pragma unroll
            for (int m = 0; m < 4; ++m) { float* rowp = Cz + (size_t)(row0 + ai * HALF + m * 16) * ldc + col0;
#pragma unroll
                for (int bj = 0; bj < 2; ++bj)
#pragma unroll
                    for (int n = 0; n < 2; ++n) *(f32x4*)(rowp + bj * HALF + n * 16) = acc[ai][bj][m][n]; }
    }
};
struct EpiResid {
    static constexpr bool PERM = false;
    const float* base; float* out; int ldc;
    __device__ __forceinline__ void operator()(const f32x4 (&acc)[2][2][4][2], const Unit& u, int wr, int wc, int fr, int fq) const {
        const int row0 = u.pm * BM + wr * 64 + fr, col0 = u.pn * BM + wc * 32 + 4 * fq;
#pragma unroll
        for (int ai = 0; ai < 2; ++ai)
#pragma unroll
            for (int m = 0; m < 4; ++m) { const size_t off = (size_t)(row0 + ai * HALF + m * 16) * ldc + col0;
#pragma unroll
                for (int bj = 0; bj < 2; ++bj)
#pragma unroll
                    for (int n = 0; n < 2; ++n) { const f32x4 bs = *(const f32x4*)(base + off + bj * HALF + n * 16); *(f32x4*)(out + off + bj * HALF + n * 16) = bs * ALPHA + acc[ai][bj][m][n]; }
                asm volatile("" ::: "memory"); }
    }
};
struct EpiBf16 {
    static constexpr bool PERM = true;
    bf16_t* O; int ldc; const float* rs;
    __device__ __forceinline__ void operator()(const f32x4 (&acc)[2][2][4][2], const Unit& u, int wr, int wc, int fr, int fq) const {
        const int row0 = u.pm * BM + wr * 64 + fr, col0 = u.pn * BM + wc * 32 + 8 * fq;
#pragma unroll
        for (int ai = 0; ai < 2; ++ai)
#pragma unroll
            for (int m = 0; m < 4; ++m) { const int row = row0 + ai * HALF + m * 16; bf16_t* rowp = O + (size_t)row * ldc + col0; const float sc = rs ? rs[row] : 1.f;
#pragma unroll
                for (int bj = 0; bj < 2; ++bj) { const f32x4 v0 = acc[ai][bj][m][0] * sc, v1 = acc[ai][bj][m][1] * sc;
                    u32x4 wv; wv.x = cvt_pk_bf16(v0[0], v0[1]); wv.y = cvt_pk_bf16(v0[2], v0[3]); wv.z = cvt_pk_bf16(v1[0], v1[1]); wv.w = cvt_pk_bf16(v1[2], v1[3]);
                    *(u32x4*)(rowp + bj * HALF) = wv; } }
    }
};
template <class Epi, class Sched>
__device__ __forceinline__ void gemm_phase(LAS unsigned char* lds, const Gemm g, const Sched& S, const Epi& E) {
    const int tid = threadIdx.x, wid = __builtin_amdgcn_readfirstlane(tid >> 6), lane = tid & 63, wr = wid >> 2, wc = wid & 3, fr = lane & 15, fq = lane >> 4;
    const int K = g.K, nt = K / BK;
    unsigned voffA[2], voffB[2];
#pragma unroll
    for (int i = 0; i < 2; ++i) { int R, C; stage_rc(tid * 16 + i * 8192, R, C); const int Rb = Epi::PERM ? ((R & ~31) + perm32(R & 31)) : R;
        voffA[i] = (unsigned)(R * g.lda + C) * 2u; voffB[i] = (unsigned)(Rb * g.ldb + C) * 2u; }
    const size_t kstep = (size_t)(BK * 2);
    const size_t hA = (size_t)HALF * g.lda * 2, hB = (size_t)HALF * g.ldb * 2;
    const size_t tA = 2 * hA, tB = 2 * hB;
    const unsigned ldsw = (unsigned)wid * 1024u;
    const int aoff = lds_byte(wr * 64 + fr, fq * 8), boff = lds_byte(wc * 32 + fr, fq * 8);
#define PG8_SA(b, h) (((b) * 2 + (h)) * HTB)
#define PG8_SB(b, h) ((4 + (b) * 2 + (h)) * HTB)
#define PG8_STAGE(bufoff, gbase, voff) do { _Pragma("unroll") for (int _i = 0; _i < 2; ++_i) \
        __builtin_amdgcn_global_load_lds((const unsigned*)((const char*)(gbase) + (voff)[_i]), (LAS unsigned*)(lds + (bufoff) + ldsw + _i * 8192), 16, 0, 0); } while (0)
#define PG8_LDA(dst, b, h) do { _Pragma("unroll") for (int m = 0; m < 4; ++m) _Pragma("unroll") for (int k = 0; k < 2; ++k) dst[m][k] = *(const LAS bf16x8*)(lds + PG8_SA(b, h) + aoff + m * 2048 + k * 1024); } while (0)
#define PG8_LDB(dst, b, h) do { _Pragma("unroll") for (int n = 0; n < 2; ++n) _Pragma("unroll") for (int k = 0; k < 2; ++k) dst[n][k] = *(const LAS bf16x8*)(lds + PG8_SB(b, h) + boff + n * 2048 + k * 1024); } while (0)
#define PG8_MMA(ai, bj, At, Bt) do { __builtin_amdgcn_s_setprio(1); _Pragma("unroll") for (int m = 0; m < 4; ++m) _Pragma("unroll") for (int n = 0; n < 2; ++n) _Pragma("unroll") for (int k = 0; k < 2; ++k) \
        acc[ai][bj][m][n] = __builtin_amdgcn_mfma_f32_16x16x32_bf16(Bt[n][k], At[m][k], acc[ai][bj][m][n], 0, 0, 0); __builtin_amdgcn_s_setprio(0); } while (0)
#define PG8_WAIT_V(n) asm volatile("s_waitcnt vmcnt(" #n ")" ::: "memory")
#define PG8_WAIT_L(n) asm volatile("s_waitcnt lgkmcnt(" #n ")" ::: "memory")
#define PG8_BAR __builtin_amdgcn_s_barrier()
#define PG8_SCHED __builtin_amdgcn_sched_barrier(0)
    Unit cur, nxt; int ui = 0;
    if (!S.next(0, cur)) return;
    f32x4 acc[2][2][4][2];
#pragma unroll
    for (int a = 0; a < 2; ++a)
#pragma unroll
        for (int b = 0; b < 2; ++b)
#pragma unroll
            for (int m = 0; m < 4; ++m)
#pragma unroll
                for (int n = 0; n < 2; ++n) acc[a][b][m][n] = (f32x4){0.f, 0.f, 0.f, 0.f};
    bf16x8 At[4][2], B0[2][2], B1[2][2];
    const char* cA = (const char*)g.A + (size_t)cur.pm * tA + (size_t)cur.z * g.zA * 2; const char* cB = (const char*)g.Bt + (size_t)cur.pn * tB + (size_t)cur.z * g.zB * 2;
    PG8_STAGE(PG8_SB(0, 0), cB, voffB); PG8_STAGE(PG8_SA(0, 0), cA, voffA); PG8_STAGE(PG8_SB(0, 1), cB + hB, voffB); PG8_STAGE(PG8_SA(0, 1), cA + hA, voffA);
    if (wr == 1) PG8_BAR;
    PG8_WAIT_V(4); PG8_BAR;
    PG8_STAGE(PG8_SB(1, 0), cB + kstep, voffB); PG8_STAGE(PG8_SA(1, 0), cA + kstep, voffA); PG8_STAGE(PG8_SB(1, 1), cB + hB + kstep, voffB);
    PG8_WAIT_V(6); PG8_BAR;
    for (;;) {
        const bool has_next = S.next(ui + 1, nxt);
        const char* nA = has_next ? (const char*)g.A + (size_t)nxt.pm * tA + (size_t)nxt.z * g.zA * 2 : cA; const char* nB = has_next ? (const char*)g.Bt + (size_t)nxt.pn * tB + (size_t)nxt.z * g.zB * 2 : cB;
        for (int t = 0; t < nt; t += 2) {
            const bool last = (t == nt - 2);
            const char* a1 = cA + (size_t)(t + 1) * kstep;
            const char* a2 = last ? nA : cA + (size_t)(t + 2) * kstep; const char* b2 = last ? nB : cB + (size_t)(t + 2) * kstep;
            const char* a3 = a2 + kstep; const char* b3 = b2 + kstep;
            PG8_LDB(B0, 0, 0); PG8_SCHED; PG8_LDA(At, 0, 0); PG8_STAGE(PG8_SA(1, 1), a1 + hA, voffA);
            PG8_WAIT_L(8); PG8_BAR; PG8_WAIT_L(0); PG8_MMA(0, 0, At, B0); PG8_BAR; PG8_SCHED;
            PG8_LDB(B1, 0, 1); PG8_STAGE(PG8_SB(0, 0), b2, voffB);
            PG8_BAR; PG8_WAIT_L(0); PG8_MMA(0, 1, At, B1); PG8_BAR;
            PG8_LDA(At, 0, 1); PG8_STAGE(PG8_SA(0, 0), a2, voffA);
            PG8_BAR; PG8_WAIT_L(0); PG8_MMA(1, 0, At, B0); PG8_BAR; PG8_SCHED;
            PG8_STAGE(PG8_SB(0, 1), b2 + hB, voffB);
            PG8_WAIT_V(6); PG8_BAR; PG8_MMA(1, 1, At, B1); PG8_BAR;
            PG8_LDB(B0, 1, 0); PG8_SCHED; PG8_LDA(At, 1, 0); PG8_STAGE(PG8_SA(0, 1), a2 + hA, voffA);
            PG8_WAIT_L(8); PG8_BAR; PG8_WAIT_L(0); PG8_MMA(0, 0, At, B0); PG8_BAR; PG8_SCHED;
            PG8_LDB(B1, 1, 1); PG8_STAGE(PG8_SB(1, 0), b3, voffB);
            PG8_BAR; PG8_WAIT_L(0); PG8_MMA(0, 1, At, B1); PG8_BAR;
            PG8_LDA(At, 1, 1); PG8_STAGE(PG8_SA(1, 0), a3, voffA);
            PG8_BAR; PG8_WAIT_L(0); PG8_MMA(1, 0, At, B0); PG8_BAR; PG8_SCHED;
            PG8_STAGE(PG8_SB(1, 1), b3 + hB, voffB);
            PG8_WAIT_V(6); PG8_BAR; PG8_MMA(1, 1, At, B1); PG8_BAR;
        }
        E(acc, cur, wr, wc, fr, fq);
        if (!has_next) break;
#pragma unroll
        for (int a = 0; a < 2; ++a)
#pragma unroll
            for (int b = 0; b < 2; ++b)
#pragma unroll
                for (int m = 0; m < 4; ++m)
#pragma unroll
                    for (int n = 0; n < 2; ++n) acc[a][b][m][n] = (f32x4){0.f, 0.f, 0.f, 0.f};
        cur = nxt; cA = nA; cB = nB; ++ui;
    }
    PG8_WAIT_V(0);
    if (wr == 0) PG8_BAR;
    PG8_BAR;
#undef PG8_SA
#undef PG8_SB
#undef PG8_STAGE
#undef PG8_LDA
#undef PG8_LDB
#undef PG8_MMA
#undef PG8_WAIT_V
#undef PG8_WAIT_L
#undef PG8_BAR
#undef PG8_SCHED
}
}

struct Args { const float* in[21]; float* out; unsigned char* ws; int ph_lo, ph_hi; };
enum { I_X = 0, I_MEM, I_AB_W_IN, I_A_REL_BIAS, I_B_Q_NORM, I_B_W_UQ, I_B_KV_NORM, I_B_W_UKV, I_AB_W_OUT, I_CD_W_IN, I_D_FORGET_BIAS, I_CD_W_OUT,
       I_MEM_W_Q, I_MEM_W_KV, I_MEM_W_O, I_PEER_W_Q, I_PEER_SUB_KEYS, I_PEER_U, I_PEER_V, I_LN_G, I_LN_B };

struct WI { int tid, lane, wave, gw, ngw, bid, nblk; };

__device__ __forceinline__ void tr_item(const float* W, int K, int ld, int c0, int nc, bf16_t* WT, int r0, const float* scale, LAS float* scr, int item, int lane) {
    const int nblk = (nc + 63) >> 6, kb = item / nblk, nb = item - kb * nblk, k0 = 64 * kb, n0 = 64 * nb;
    const int ln = (lane & 15) * 4, lk = lane >> 4; const bool ok = n0 + ln < nc;
    const float* src = W + (size_t)(k0 + lk) * ld + c0 + n0 + ln;
    f32x4 v[16];
#pragma unroll
    for (int i = 0; i < 16; ++i) v[i] = ok ? *(const f32x4*)(src + (size_t)(4 * i) * ld) : (f32x4){0.f, 0.f, 0.f, 0.f};
#pragma unroll
    for (int i = 0; i < 16; ++i) { const int kk = lk + 4 * i; const float s = scale ? scale[k0 + kk] : 1.f; LAS float* d = scr + kk * 65 + ln;
        d[0] = v[i].x * s; d[1] = v[i].y * s; d[2] = v[i].z * s; d[3] = v[i].w * s; }
    LDS_WAIT();
    const int c = lane & 7;
#pragma unroll
    for (int j = 0; j < 8; ++j) { const int n = (lane >> 3) + 8 * j; const LAS float* s = scr + (8 * c) * 65 + n;
        u32x4 o; o.x = pk2(s[0 * 65], s[1 * 65]); o.y = pk2(s[2 * 65], s[3 * 65]); o.z = pk2(s[4 * 65], s[5 * 65]); o.w = pk2(s[6 * 65], s[7 * 65]);
        if (n0 + n < nc) *(u32x4*)(WT + (size_t)(r0 + n0 + n) * K + k0 + 8 * c) = o; }
    LDS_WAIT();
}
__device__ __forceinline__ void cvt_rows(const float* src, bf16_t* dst, size_t n, size_t i0, size_t stride) {
    size_t i = i0 * 8;
    for (; i + 3 * stride * 8 < n; i += 4 * stride * 8) {
        f32x4 a[4], b[4];
#pragma unroll
        for (int q = 0; q < 4; ++q) { a[q] = *(const f32x4*)(src + i + q * stride * 8); b[q] = *(const f32x4*)(src + i + q * stride * 8 + 4); }
#pragma unroll
        for (int q = 0; q < 4; ++q) { u32x4 o; o.x = pk2(a[q].x, a[q].y); o.y = pk2(a[q].z, a[q].w); o.z = pk2(b[q].x, b[q].y); o.w = pk2(b[q].z, b[q].w); *(u32x4*)(dst + i + q * stride * 8) = o; }
    }
    for (; i < n; i += stride * 8) {
        const f32x4 a = *(const f32x4*)(src + i), b = *(const f32x4*)(src + i + 4);
        u32x4 o; o.x = pk2(a.x, a.y); o.y = pk2(a.z, a.w); o.z = pk2(b.x, b.y); o.w = pk2(b.z, b.w);
        *(u32x4*)(dst + i) = o;
    }
}
__device__ __forceinline__ void ph_convert(const Args& a, LAS unsigned char* lds, const WI& w) {
    unsigned char* ws = a.ws;
    LAS float* scr = (LAS float*)(lds + w.wave * 16640);
    constexpr int J1 = 64 * 129, J2 = 24 * 48, J3 = 8 * 64, J4 = 64 * 64, J5 = 64 * 80, J6 = 64 * 96, J7 = 64 * 2, J8 = 64 * 1, J9 = 64 * 64,
                  J10 = 64 * 8, J12 = 64 * 16, J14 = 8 * 64;
    constexpr int NJ = J1 + J2 + J3 + J4 + J5 + J6 + J7 + J8 + J9 + 2 * J10 + 2 * J12 + 2 * J14;
    for (int it = w.gw; it < NJ; it += w.ngw) {
        int r = it; const float* src; int K, ld, c0 = 0, nc, r0 = 0; bf16_t* dst; const float* sc = nullptr;
        if (r < J1) { src = a.in[I_AB_W_IN]; K = 4096; ld = AB_COLS; nc = AB_COLS; dst = (bf16_t*)(ws + WS_W_AB_IN); }
        else if ((r -= J1) < J2) { src = a.in[I_B_W_UQ]; K = 1536; ld = 3072; nc = 3072; dst = (bf16_t*)(ws + WS_W_UQ); sc = a.in[I_B_Q_NORM]; }
        else if ((r -= J2) < J3) { src = a.in[I_B_W_UKV]; K = 512; ld = 4096; nc = 4096; dst = (bf16_t*)(ws + WS_W_UKV); sc = a.in[I_B_KV_NORM]; }
        else if ((r -= J3) < J4) { src = a.in[I_AB_W_OUT]; K = 4096; ld = 4096; nc = 4096; dst = (bf16_t*)(ws + WS_W_AB_OUT); }
        else if ((r -= J4) < J5) { src = a.in[I_CD_W_IN]; K = 4096; ld = CD_COLS; c0 = 0; nc = 5120; r0 = 0; dst = (bf16_t*)(ws + WS_W_CD_IN); }
        else if ((r -= J5) < J6) { src = a.in[I_CD_W_IN]; K = 4096; ld = CD_COLS; c0 = 5216; nc = 6144; r0 = 5120; dst = (bf16_t*)(ws + WS_W_CD_IN); }
        else if ((r -= J6) < J7) { src = a.in[I_CD_W_IN]; K = 4096; ld = CD_COLS; c0 = 5120; nc = 96; r0 = 11264; dst = (bf16_t*)(ws + WS_W_CD_IN); }
        else if ((r -= J7) < J8) { src = a.in[I_CD_W_IN]; K = 4096; ld = CD_COLS; c0 = 11360; nc = 16; r0 = 11360; dst = (bf16_t*)(ws + WS_W_CD_IN); }
        else if ((r -= J8) < J9) { src = a.in[I_CD_W_OUT]; K = 4096; ld = 4096; nc = 4096; dst = (bf16_t*)(ws + WS_W_CD_OUT); }
        else if ((r -= J9) < 2 * J10) { const int l = r / J10; r -= l * J10; src = a.in[I_MEM_W_Q] + (size_t)l * 4096 * 512; K = 4096; ld = 512; nc = 512; dst = (bf16_t*)(ws + WS_W_MEM_Q) + (size_t)l * 512 * 4096; }
        else if ((r -= 2 * J10) < 2 * J12) { const int l = r / J12; r -= l * J12; src = a.in[I_MEM_W_KV] + (size_t)l * 4096 * 1024; K = 4096; ld = 1024; nc = 1024; dst = (bf16_t*)(ws + WS_W_MEM_KV) + (size_t)l * 1024 * 4096; }
        else { r -= 2 * J12; const int l = r / J14; r -= l * J14; src = a.in[I_MEM_W_O] + (size_t)l * 512 * 4096; K = 512; ld = 4096; nc = 4096; dst = (bf16_t*)(ws + WS_W_MEM_O) + (size_t)l * 4096 * 512; }
        tr_item(src, K, ld, c0, nc, dst, r0, sc, scr, r, w.lane);
    }
    { const size_t gt = (size_t)w.gw * 64 + w.lane, ng = (size_t)w.ngw * 64;
      bf16_t* p1 = (bf16_t*)(ws + WS_W_AB_IN) + (size_t)AB_COLS * 4096; const size_t n1 = (size_t)(AB_PAD - AB_COLS) * 4096;
      for (size_t i = gt * 8; i < n1; i += ng * 8) *(u32x4*)(p1 + i) = (u32x4){0u, 0u, 0u, 0u};
      bf16_t* p2 = (bf16_t*)(ws + WS_W_CD_IN) + (size_t)CD_COLS * 4096; const size_t n2 = (size_t)(CD_PAD - CD_COLS) * 4096;
      for (size_t i = gt * 8; i < n2; i += ng * 8) *(u32x4*)(p2 + i) = (u32x4){0u, 0u, 0u, 0u};
      cvt_rows(a.in[I_X], (bf16_t*)(ws + WS_XB), (size_t)T * DM, gt, ng);
      cvt_rows(a.in[I_MEM], (bf16_t*)(ws + WS_MEMB), (size_t)512 * DM, gt, ng);
      for (int r = w.gw; r < 65536; r += w.ngw) { const int tbl = r >> 15, rr = r & 32767;
          const float* srow = (tbl ? a.in[I_PEER_V] : a.in[I_PEER_U]) + (size_t)rr * DM + 32 * w.lane;
          unsigned char* dbase = ws + (tbl ? WS_V8 : WS_U8);
          f32x4 v[2][8];
#pragma unroll
          for (int i = 0; i < 2; ++i)
#pragma unroll
              for (int q = 0; q < 8; ++q) v[i][q] = *(const f32x4*)(srow + 2048 * i + 4 * q);
          unsigned scb = 0u;
#pragma unroll
          for (int i = 0; i < 2; ++i) { float bm = 0.f;
#pragma unroll
              for (int q = 0; q < 8; ++q) bm = fmaxf(bm, fmaxf(fmaxf(fabsf(v[i][q].x), fabsf(v[i][q].y)), fmaxf(fabsf(v[i][q].z), fabsf(v[i][q].w))));
              int b = 128; if (bm > 0.f) { b = (int)ceilf(8.f * __log2f(bm * (1.f / 6.f)) + 0.02f) + 128; b = b < 0 ? 0 : (b > 255 ? 255 : b); }
              const float inv = __builtin_amdgcn_exp2f((float)(128 - b) * 0.125f);
              u32x4 o;
#pragma unroll
              for (int d = 0; d < 4; ++d) { unsigned wv = 0u; const f32x4 p0 = v[i][2 * d] * inv, p1 = v[i][2 * d + 1] * inv;
                  wv = __builtin_amdgcn_cvt_scalef32_pk_fp4_f32(wv, p0.x, p0.y, 1.0f, 0); wv = __builtin_amdgcn_cvt_scalef32_pk_fp4_f32(wv, p0.z, p0.w, 1.0f, 1);
                  wv = __builtin_amdgcn_cvt_scalef32_pk_fp4_f32(wv, p1.x, p1.y, 1.0f, 2); wv = __builtin_amdgcn_cvt_scalef32_pk_fp4_f32(wv, p1.z, p1.w, 1.0f, 3); o[d] = wv; }
              *(u32x4*)(dbase + (size_t)rr * 2048 + 1024 * i + 16 * w.lane) = o;
              scb |= (unsigned)b << (8 * i); }
          ((unsigned short*)(dbase + 64 * MiB))[(size_t)rr * 64 + w.lane] = (unsigned short)scb; }
      float* r128 = (float*)(ws + WS_ROPE128); float* r64 = (float*)(ws + WS_ROPE64);
      for (size_t i = gt; i < (size_t)SEQ * 96; i += ng) {
          const int s = (int)(i / 96), j = (int)(i % 96); const bool big = j < 64; const int ii = big ? j : j - 64;
          const double rr = big ? 0.8659643233600653 : 0.7498942093324559; double inv = 1.0;
          for (int q = 0; q < ii; ++q) inv *= rr;
          const double rev = (double)s * inv * 0.15915494309189535; const float fr = (float)(rev - rint(rev));
          const float cs = __builtin_amdgcn_cosf(fr), sn = __builtin_amdgcn_sinf(fr);
          float* o = big ? (r128 + ((size_t)s * 64 + ii) * 2) : (r64 + ((size_t)s * 32 + ii) * 2);
          o[0] = cs; o[1] = sn; }
    }
    {
        LAS float* Ks = (LAS float*)lds; LAS float* Ws = Ks + 128 * 129;
        const int tk = w.tid & 31, tn = w.tid >> 5;
        for (int it = w.bid; it < 2 * 16 * 32; it += w.nblk) {
            const int l = it >> 9, hp = (it >> 5) & 15, kb = it & 31;
            __syncthreads();
            const float* keys = a.in[I_PEER_SUB_KEYS] + ((size_t)(l * 16 + hp) * 128) * 128;
            const float* wq = a.in[I_PEER_W_Q] + ((size_t)l * 4096 + (size_t)kb * 128) * 2048 + hp * 128;
            for (int e = w.tid; e < 128 * 128; e += 512) { const int rrow = e >> 7, d = e & 127; Ks[rrow * 129 + d] = keys[(size_t)rrow * 128 + d]; Ws[rrow * 129 + d] = wq[(size_t)rrow * 2048 + d]; }
            __syncthreads();
            float acc[8][4];
#pragma unroll
            for (int x = 0; x < 8; ++x)
#pragma unroll
                for (int y = 0; y < 4; ++y) acc[x][y] = 0.f;
            for (int d = 0; d < 128; ++d) {
                float kv[8], wv[4];
#pragma unroll
                for (int x = 0; x < 8; ++x) kv[x] = Ks[(tn + 16 * x) * 129 + d];
#pragma unroll
                for (int y = 0; y < 4; ++y) wv[y] = Ws[(tk + 32 * y) * 129 + d];
#pragma unroll
                for (int x = 0; x < 8; ++x)
#pragma unroll
                    for (int y = 0; y < 4; ++y) acc[x][y] += kv[x] * wv[y];
            }
            bf16_t* dst = (bf16_t*)(ws + WS_W_PEER) + ((size_t)l * 2048 + hp * 128) * 4096 + kb * 128;
#pragma unroll
            for (int x = 0; x < 8; ++x)
#pragma unroll
                for (int y = 0; y < 4; ++y) dst[(size_t)(tn + 16 * x) * 4096 + tk + 32 * y] = (bf16_t)f2bf(acc[x][y]);
        }
        __syncthreads();
    }
}

__device__ __forceinline__ int crow(int r, int hi) { return (r & 3) + 8 * (r >> 2) + 4 * hi; }
template <class F>
__device__ __forceinline__ void naive_gemm(const bf16_t* A, int lda, const bf16_t* Bt, int ldb, int M, int N, int K, const WI& w, F epi) {
    const int tm = M >> 5, tn = (N + 31) >> 5;
    const int i = w.lane & 31, g = w.lane >> 5;
    for (int tile = w.gw; tile < tm * tn; tile += w.ngw) {
        const int bn = tile / tm, bm = tile - bn * tm;
        const bf16_t* ap = A + (size_t)(bm * 32 + i) * lda + 8 * g;
        const int nrow = bn * 32 + i; const bool nv = nrow < N;
        const bf16_t* bp = Bt + (size_t)(nv ? nrow : 0) * ldb + 8 * g;
        f32x16 acc = {};
#pragma unroll 4
        for (int k = 0; k < K; k += 16) {
            const bf16x8 av = *(const bf16x8*)(ap + k);
            bf16x8 bv = *(const bf16x8*)(bp + k);
            if (!nv) bv = (bf16x8){0, 0, 0, 0, 0, 0, 0, 0};
            acc = __builtin_amdgcn_mfma_f32_32x32x16_bf16(av, bv, acc, 0, 0, 0);
        }
#pragma unroll
        for (int r = 0; r < 16; ++r) { const int row = bm * 32 + crow(r, g), col = bn * 32 + i; if (col < N) epi(row, col, acc[r]); }
    }
}

__device__ __forceinline__ void ln_rows(const float* src, const float* g, const float* b, float* dstf, bf16_t* dstb, const WI& w) {
    for (int m = w.gw; m < T; m += w.ngw) {
        const f32x4* xr = (const f32x4*)(src + (size_t)m * DM) + w.lane;
        f32x4 v[16]; float s = 0.f;
#pragma unroll
        for (int j = 0; j < 16; ++j) { v[j] = xr[64 * j]; s += (v[j].x + v[j].y) + (v[j].z + v[j].w); }
        const float mean = wave_sum(s) * (1.f / DM); float s2 = 0.f;
#pragma unroll
        for (int j = 0; j < 16; ++j) { v[j] = v[j] - mean; s2 += (v[j].x * v[j].x + v[j].y * v[j].y) + (v[j].z * v[j].z + v[j].w * v[j].w); }
        const float rstd = 1.f / sqrtf(wave_sum(s2) * (1.f / DM) + LN_EPS);
#pragma unroll
        for (int j = 0; j < 16; ++j) {
            const int c = 4 * w.lane + 256 * j;
            const f32x4 gg = *(const f32x4*)(g + c), bb = *(const f32x4*)(b + c);
            const f32x4 o = v[j] * rstd * gg + bb;
            *(f32x4*)(dstf + (size_t)m * DM + c) = o;
            if (dstb) { u32x2 p; p.x = pk2(o.x, o.y); p.y = pk2(o.z, o.w); *(u32x2*)(dstb + (size_t)m * DM + c) = p; }
        }
    }
}

template <int MODE>
__device__ __forceinline__ void attn_naive(const Args& a, int layer, LAS float* qs, const WI& w) {
    constexpr int H = (MODE == 4) ? 4 : 16, DK = (MODE == 1) ? 192 : 128;
    const float scale = (MODE == 1) ? 0.07216878364870322f : 0.08838834764831845f;
    unsigned char* ws = a.ws;
    const float NEG = -__builtin_inff();
    for (int it = w.gw; it < T * H; it += w.ngw) {
        const int h = it / T, t = it - h * T, b = t / SEQ, sp = t - b * SEQ, c = sp >> 6;
        const bf16_t* qp; const bf16_t* kbase; const bf16_t* vbase; int ldk, ldv; bf16_t* op;
        int s_lo = 0, s_hi;
        if (MODE == 0) { const bf16_t* P = (const bf16_t*)(ws + WS_PROJ); qp = P + (size_t)t * AB_MAIN + h * 128; kbase = P + (size_t)b * SEQ * AB_MAIN + 2048 + h * 128; vbase = kbase + 2048; ldk = ldv = AB_MAIN;
            op = (bf16_t*)(ws + WS_ATT) + (size_t)t * DM + h * 128; s_lo = (c - 8) * 64; if (s_lo < 0) s_lo = 0; s_hi = (c + 1) * 64; }
        else if (MODE == 1) { qp = (const bf16_t*)(ws + WS_QB) + (size_t)t * 3072 + h * 192; kbase = (const bf16_t*)(ws + WS_KVB) + (size_t)b * SEQ * 4096 + h * 256; vbase = kbase + 128; ldk = ldv = 4096;
            op = (bf16_t*)(ws + WS_ATT) + (size_t)t * DM + 2048 + h * 128; s_hi = (c + 1) * 64; }
        else if (MODE == 2) { const bf16_t* P = (const bf16_t*)(ws + WS_PROJ); qp = P + (size_t)t * CD_MAIN + h * 128; kbase = P + (size_t)b * SEQ * CD_MAIN + 2048 + (h >> 2) * 128; vbase = kbase + 512; ldk = ldv = CD_MAIN;
            op = (bf16_t*)(ws + WS_ATT) + (size_t)t * DM + h * 128; s_hi = (c + 1) * 64; }
        else if (MODE == 3) { const bf16_t* P = (const bf16_t*)(ws + WS_PROJ); qp = P + (size_t)t * CD_MAIN + 5120 + h * 128; kbase = P + (size_t)b * SEQ * CD_MAIN + 7168 + h * 128; vbase = kbase + 2048; ldk = ldv = CD_MAIN;
            op = (bf16_t*)(ws + WS_ATT) + (size_t)t * DM + 2048 + h * 128; s_hi = sp + 1; }
        else { qp = (const bf16_t*)(ws + WS_MEMQ) + (size_t)t * 512 + h * 128; kbase = (const bf16_t*)(ws + WS_KVM) + ((size_t)layer * 512 + b * 256) * 1024 + h * 128; vbase = kbase + 512; ldk = ldv = 1024;
            op = (bf16_t*)(ws + WS_MEMO) + (size_t)t * 512 + h * 128; s_hi = 256; }
        LDS_WAIT();
        if (MODE == 4) { const float* mq = (const float*)(ws + WS_MQP) + (size_t)t * 512 + h * 128;
            for (int d = w.lane; d < DK; d += 64) qs[d] = bf2f((bf16_t)f2bf((mq[d] + mq[d + (size_t)T * 512]) + (mq[d + (size_t)2 * T * 512] + mq[d + (size_t)3 * T * 512]))); }
        else for (int d = w.lane; d < DK; d += 64) qs[d] = bf2f(qp[d]);
        LDS_WAIT();
        const float* cum = (const float*)(ws + WS_CUM) + ((size_t)b * 16 + h) * SEQ;
        const float ct = (MODE == 3) ? cum[sp] : 0.f;
        const float* relb = a.in[I_A_REL_BIAS] + h * 513;
        const unsigned* mrow = (const unsigned*)(ws + WS_MASK) + (size_t)t * 128;
        float m = NEG, l = 0.f, o0 = 0.f, o1 = 0.f;
        for (int s0 = s_lo; s0 < s_hi; s0 += 64) {
            const int s = s0 + w.lane; bool valid = s < s_hi;
            if (MODE == 2) { if (valid) valid = (mrow[s >> 5] >> (s & 31)) & 1u; }
            float x = NEG;
            if (valid) {
                const bf16_t* kp = kbase + (size_t)s * ldk; float acc = 0.f;
#pragma unroll 4
                for (int d0 = 0; d0 < 128; d0 += 8) { const bf16x8 kv = *(const bf16x8*)(kp + d0);
#pragma unroll
                    for (int e = 0; e < 8; ++e) acc += qs[d0 + e] * bf2f((bf16_t)kv[e]); }
                if (MODE == 1) { const bf16_t* kr = (const bf16_t*)(ws + WS_KR) + ((size_t)b * SEQ + s) * 64;
#pragma unroll 4
                    for (int d0 = 0; d0 < 64; d0 += 8) { const bf16x8 kv = *(const bf16x8*)(kr + d0);
#pragma unroll
                        for (int e = 0; e < 8; ++e) acc += qs[128 + d0 + e] * bf2f((bf16_t)kv[e]); } }
                x = acc * scale;
                if (MODE == 0) { int rel = sp - s; rel = rel < -256 ? -256 : (rel > 256 ? 256 : rel); x += relb[rel + 256]; }
                if (MODE == 3) x += ct - cum[s];
            }
            const float mx = wave_max(x);
            if (mx == NEG) continue;
            const float mn = fmaxf(m, mx); const float p = valid ? __expf(x - mn) : 0.f; const float al = __expf(m - mn);
            l = l * al + wave_sum(p); o0 *= al; o1 *= al; m = mn;
            for (int j = 0; j < 64; ++j) { const float pj = __shfl(p, j);
                if (pj != 0.f) { const bf16_t* vp = vbase + (size_t)(s0 + j) * ldv; o0 += pj * bf2f(vp[w.lane]); o1 += pj * bf2f(vp[w.lane + 64]); } }
        }
        const float rl = 1.f / l;
        op[w.lane] = (bf16_t)f2bf(o0 * rl); op[w.lane + 64] = (bf16_t)f2bf(o1 * rl);
    }
}

namespace fa {
constexpr int SHM_V = 64 * 128 * 2;
constexpr int LDS_V = 0, LDS_K = 2 * SHM_V, LDS_WS = LDS_K + 2 * 64 * 384, LDS_RELB = LDS_WS + 8 * 64 * 4, LDS_CS = LDS_RELB + 2304, LDS_END = LDS_CS + 512;
#define FA_KSWZ(row, colB, RS) ((row) * (RS) + ((colB) ^ (((row) & 7) << 4)))
__device__ __forceinline__ int v_st(int k, int c) { const int kk = (k & ~0xC) | ((k & 4) << 1) | ((k & 8) >> 1); return ((kk >> 3) * 4 + (c >> 5)) * 512 + ((kk & 7) * 32 + (c & 31)) * 2; }
__device__ __forceinline__ int v_rd_base(int lane) { return ((lane & 3) << 3) | (((lane >> 2) & 3) << 6) | (((lane >> 4) & 1) << 5) | (((lane >> 5) & 1) << 8); }
__device__ __forceinline__ unsigned cvtpk(float lo, float hi) { unsigned r; asm volatile("v_cvt_pk_bf16_f32 %0, %1, %2" : "=v"(r) : "v"(lo), "v"(hi)); return r; }
typedef short s16x4 __attribute__((ext_vector_type(4)));

template <int DK>
__device__ __forceinline__ void qkt(f32x16& p0, f32x16& p1, LAS const char* Kb, int r32, int hi, const bf16x8* qr) {
    constexpr int RS = DK * 2;
    p0 = f32x16{}; p1 = f32x16{};
    LAS const char* kb[4];
#pragma unroll
    for (int dd = 0; dd < 4; ++dd) kb[dd] = Kb + FA_KSWZ(r32, (dd * 16 + hi * 8) * 2, RS);
#pragma unroll
    for (int d0 = 0; d0 < DK / 16; ++d0) { LAS const char* ap = kb[d0 & 3] + (d0 >> 2) * 128;
        const bf16x8 b0 = *(LAS const bf16x8*)ap;
        const bf16x8 b1 = *(LAS const bf16x8*)(ap + 32 * RS);
        p0 = __builtin_amdgcn_mfma_f32_32x32x16_bf16(b0, qr[d0], p0, 0, 0, 0);
        p1 = __builtin_amdgcn_mfma_f32_32x32x16_bf16(b1, qr[d0], p1, 0, 0, 0); }
}
__device__ __forceinline__ void pv_tile(f32x16* o, int vb0, bf16x8 pa0, bf16x8 pa1, bf16x8 pa2, bf16x8 pa3) {
#define FA_TRRD(dst, off) asm volatile("ds_read_b64_tr_b16 %0, %1 offset:%2" : "=&v"(dst) : "v"(vb0), "i"(off) : "memory")
#define FA_PV_D0(d0) do { s16x4 l0, l1, l2, l3, h0, h1, h2, h3; constexpr int b_ = (d0) * 512; \
        FA_TRRD(l0, b_); FA_TRRD(h0, b_ + 2048); FA_TRRD(l1, b_ + 4096); FA_TRRD(h1, b_ + 6144); FA_TRRD(l2, b_ + 8192); FA_TRRD(h2, b_ + 10240); FA_TRRD(l3, b_ + 12288); FA_TRRD(h3, b_ + 14336); \
        asm volatile("s_waitcnt lgkmcnt(0)" ::: "memory"); __builtin_amdgcn_sched_barrier(0); \
        o[d0] = __builtin_amdgcn_mfma_f32_32x32x16_bf16(pa0, (bf16x8){l0[0], l0[1], l0[2], l0[3], h0[0], h0[1], h0[2], h0[3]}, o[d0], 0, 0, 0); \
        o[d0] = __builtin_amdgcn_mfma_f32_32x32x16_bf16(pa1, (bf16x8){l1[0], l1[1], l1[2], l1[3], h1[0], h1[1], h1[2], h1[3]}, o[d0], 0, 0, 0); \
        o[d0] = __builtin_amdgcn_mfma_f32_32x32x16_bf16(pa2, (bf16x8){l2[0], l2[1], l2[2], l2[3], h2[0], h2[1], h2[2], h2[3]}, o[d0], 0, 0, 0); \
        o[d0] = __builtin_amdgcn_mfma_f32_32x32x16_bf16(pa3, (bf16x8){l3[0], l3[1], l3[2], l3[3], h3[0], h3[1], h3[2], h3[3]}, o[d0], 0, 0, 0); } while (0)
    FA_PV_D0(0); FA_PV_D0(1); FA_PV_D0(2); FA_PV_D0(3);
#undef FA_PV_D0
#undef FA_TRRD
}
__device__ __forceinline__ void softmax_tile(f32x16& p0, f32x16& p1, float& m_reg, float& l_reg, float& alpha, bf16x8& pa0, bf16x8& pa1, bf16x8& pa2, bf16x8& pa3) {
    float pmax = p0[0];
#pragma unroll
    for (int r = 1; r < 16; ++r) pmax = fmaxf(pmax, p0[r]);
#pragma unroll
    for (int r = 0; r < 16; ++r) pmax = fmaxf(pmax, p1[r]);
    { auto rr = __builtin_amdgcn_permlane32_swap(__float_as_uint(pmax), __float_as_uint(pmax), false, false);
      pmax = fmaxf(__uint_as_float(rr[0]), __uint_as_float(rr[1])); }
    const float mn = fmaxf(m_reg, pmax); alpha = __builtin_amdgcn_exp2f(m_reg - mn); m_reg = mn;
#pragma unroll
    for (int r = 0; r < 16; ++r) { p0[r] = __builtin_amdgcn_exp2f(p0[r] - mn); p1[r] = __builtin_amdgcn_exp2f(p1[r] - mn); }
    float ps = 0.f;
#pragma unroll
    for (int r = 0; r < 16; ++r) ps += p0[r];
#pragma unroll
    for (int r = 0; r < 16; ++r) ps += p1[r];
    { auto rr = __builtin_amdgcn_permlane32_swap(__float_as_uint(ps), __float_as_uint(ps), false, false);
      ps = __uint_as_float(rr[0]) + __uint_as_float(rr[1]); }
    l_reg = l_reg * alpha + ps;
#define FA_PK4(P, B_, OUT) do { unsigned a0 = cvtpk(P[B_+0], P[B_+1]), a1 = cvtpk(P[B_+2], P[B_+3]); \
        unsigned b0 = cvtpk(P[B_+4], P[B_+5]), b1 = cvtpk(P[B_+6], P[B_+7]); \
        auto r0 = __builtin_amdgcn_permlane32_swap(a0, b0, false, false); auto r1 = __builtin_amdgcn_permlane32_swap(a1, b1, false, false); \
        u32x4 wv = {r0[0], r1[0], r0[1], r1[1]}; OUT = *reinterpret_cast<bf16x8*>(&wv); } while (0)
    FA_PK4(p0, 0, pa0); FA_PK4(p0, 8, pa1); FA_PK4(p1, 0, pa2); FA_PK4(p1, 8, pa3);
#undef FA_PK4
}

template <int MODE>
__device__ __forceinline__ void attn_unit(const Args& a, int layer, LAS unsigned char* lds, int b, int h, int qb) {
    constexpr int DK = (MODE == 1) ? 192 : 128, RS = DK * 2, SHM_K = 64 * RS, NQ = DK / 16;
    constexpr float C2 = (MODE == 1) ? 1.4426950408889634f * 0.07216878364870322f : 1.4426950408889634f * 0.08838834764831845f;
    constexpr float L2E = 1.4426950408889634f;
    unsigned char* ws = a.ws;
    const int tid = threadIdx.x, wid = __builtin_amdgcn_readfirstlane(tid >> 6), lane = tid & 63, r32 = lane & 31, hi = lane >> 5;
    const int P0 = qb * 256, qlo = P0 + wid * 32, row = qlo + r32, cw = qlo >> 6;
    const size_t tb = (size_t)b * SEQ;
    const float NEG = -__builtin_inff();
    const bf16_t* Kg; const bf16_t* Vg; int ldk, ldv; bf16_t* Og; int ldo; int j_lo = 0, j_hi;
    if (MODE == 0) { const bf16_t* P = (const bf16_t*)(ws + WS_PROJ); Kg = P + tb * AB_MAIN + 2048 + h * 128; Vg = Kg + 2048; ldk = ldv = AB_MAIN; Og = (bf16_t*)(ws + WS_ATT) + (tb + qlo) * DM + h * 128; ldo = DM;
        j_lo = (P0 >> 6) - 8; if (j_lo < 0) j_lo = 0; j_hi = (P0 >> 6) + 4; }
    else if (MODE == 1) { Kg = (const bf16_t*)(ws + WS_KVB) + tb * 4096 + h * 256; Vg = Kg + 128; ldk = ldv = 4096; Og = (bf16_t*)(ws + WS_ATT) + (tb + qlo) * DM + 2048 + h * 128; ldo = DM; j_hi = (P0 >> 6) + 4; }
    else if (MODE == 2) { const bf16_t* P = (const bf16_t*)(ws + WS_PROJ); Kg = P + tb * CD_MAIN + 2048 + (h >> 2) * 128; Vg = Kg + 512; ldk = ldv = CD_MAIN; Og = (bf16_t*)(ws + WS_ATT) + (tb + qlo) * DM + h * 128; ldo = DM; j_hi = (P0 >> 6) + 4; }
    else if (MODE == 3) { const bf16_t* P = (const bf16_t*)(ws + WS_PROJ); Kg = P + tb * CD_MAIN + 7168 + h * 128; Vg = Kg + 2048; ldk = ldv = CD_MAIN; Og = (bf16_t*)(ws + WS_ATT) + (tb + qlo) * DM + 2048 + h * 128; ldo = DM; j_hi = (P0 >> 6) + 4; }
    else { Kg = (const bf16_t*)(ws + WS_KVM) + ((size_t)layer * 512 + b * 256) * 1024 + h * 128; Vg = Kg + 512; ldk = ldv = 1024; Og = (bf16_t*)(ws + WS_MEMO) + (tb + qlo) * 512 + h * 128; ldo = 512; j_hi = 4; }
    const int NT = j_hi - j_lo;
    bf16x8 qr[NQ];
    if (MODE == 4) { const float* mq = (const float*)(ws + WS_MQP) + (tb + row) * 512 + h * 128;
#pragma unroll
        for (int d0 = 0; d0 < NQ; ++d0) { const float* p = mq + d0 * 16 + hi * 8; f32x4 s0 = {0.f, 0.f, 0.f, 0.f}, s1 = s0;
#pragma unroll
            for (int z = 0; z < 4; ++z) { s0 += *(const f32x4*)(p + (size_t)z * T * 512); s1 += *(const f32x4*)(p + (size_t)z * T * 512 + 4); }
            u32x4 wv = {cvtpk(s0[0], s0[1]), cvtpk(s0[2], s0[3]), cvtpk(s1[0], s1[1]), cvtpk(s1[2], s1[3])}; qr[d0] = *reinterpret_cast<bf16x8*>(&wv); } }
    else { const bf16_t* Qg;
        if (MODE == 0) Qg = (const bf16_t*)(ws + WS_PROJ) + (tb + row) * AB_MAIN + h * 128;
        else if (MODE == 1) Qg = (const bf16_t*)(ws + WS_QB) + (tb + row) * 3072 + h * 192;
        else if (MODE == 2) Qg = (const bf16_t*)(ws + WS_PROJ) + (tb + row) * CD_MAIN + h * 128;
        else Qg = (const bf16_t*)(ws + WS_PROJ) + (tb + row) * CD_MAIN + 5120 + h * 128;
#pragma unroll
        for (int d0 = 0; d0 < NQ; ++d0) qr[d0] = *(const bf16x8*)(Qg + d0 * 16 + hi * 8); }
    LAS char* V_lds = (LAS char*)lds + LDS_V; LAS char* K_lds = (LAS char*)lds + LDS_K;
    LAS float* wsc = (LAS float*)(lds + LDS_WS) + wid * 64; LAS float* relb = (LAS float*)(lds + LDS_RELB); LAS float* csl = (LAS float*)(lds + LDS_CS);
    const int vbase = (int)(unsigned)(uintptr_t)V_lds + v_rd_base(lane);
    const bf16_t* KRg = (const bf16_t*)(ws + WS_KR) + tb * 64;
    const float* cum = (const float*)(ws + WS_CUM) + ((size_t)b * 16 + h) * SEQ;
    const unsigned* mrow = (const unsigned*)(ws + WS_MASK) + (tb + row) * 128;
    float ctl = 0.f; if (MODE == 3) ctl = cum[row] * L2E;
    if (MODE == 0) { const float* rb = a.in[I_A_REL_BIAS] + h * 513; for (int i = tid; i < 513; i += 512) relb[i] = rb[i] * L2E; }
    float m_reg = -1e30f, l_reg = 0.f; f32x16 o[4] = {};
    unsigned mk0 = 0u, mk1 = 0u; float st_cs = 0.f;
    constexpr int NKI = (DK == 192) ? 3 : 2;
    int koff[NKI]; bool krope[NKI]; int voff[2];
#pragma unroll
    for (int i = 0; i < NKI; ++i) { const int off = (wid * NKI + i) * 1024 + lane * 16; const int rw = off / RS, sw = off - rw * RS, cb = sw ^ ((rw & 7) << 4);
        krope[i] = (DK == 192) && (cb >= 256); koff[i] = krope[i] ? rw * 64 + ((cb - 256) >> 1) : rw * ldk + (cb >> 1); }
#pragma unroll
    for (int i = 0; i < 2; ++i) { const int off = (wid * 2 + i) * 1024 + lane * 16; const int sub = off >> 9, within = off & 511, kk = ((sub >> 2) << 3) | (within >> 6);
        const int k = (kk & ~0xC) | ((kk & 4) << 1) | ((kk & 8) >> 1), c = (sub & 3) * 32 + ((within & 63) >> 1); voff[i] = k * ldv + c; }
#define FA_DMA(j, bf) do { const int k0_ = (j) * 64; \
        _Pragma("unroll") for (int i_ = 0; i_ < NKI; ++i_) { const bf16_t* s_ = (DK == 192 && krope[i_]) ? (KRg + (size_t)k0_ * 64 + koff[i_]) : (Kg + (size_t)k0_ * ldk + koff[i_]); \
            __builtin_amdgcn_global_load_lds((const unsigned*)s_, (LAS unsigned*)(K_lds + (bf) * SHM_K + (wid * NKI + i_) * 1024), 16, 0, 0); } \
        _Pragma("unroll") for (int i_ = 0; i_ < 2; ++i_) \
            __builtin_amdgcn_global_load_lds((const unsigned*)(Vg + (size_t)k0_ * ldv + voff[i_]), (LAS unsigned*)(V_lds + (bf) * SHM_V + (wid * 2 + i_) * 1024), 16, 0, 0); \
        if (MODE == 3) { if (tid < 64) st_cs = cum[k0_ + tid] * L2E; } } while (0)
#define FA_CSW(bf) do { if (MODE == 3) { if (tid < 64) csl[(bf) * 64 + tid] = st_cs; } } while (0)
    __syncthreads();
    FA_DMA(j_lo, 0); asm volatile("s_waitcnt vmcnt(0)" ::: "memory"); FA_CSW(0);
    __syncthreads();
#pragma unroll 1
    for (int t = 0; t < NT; ++t) {
        const int buf = t & 1, j = j_lo + t, kbp = j * 64;
        if (t + 1 < NT) FA_DMA(j + 1, buf ^ 1);
        bool act;
        if (MODE == 0) act = (j >= cw - 8) && (j <= cw);
        else if (MODE == 1 || MODE == 2) act = (j <= cw);
        else if (MODE == 3) act = (kbp <= qlo + 31);
        else act = true;
        if (MODE == 2) { if (act) { const u32x2 mm = *(const u32x2*)(mrow + 2 * j); mk0 = mm.x; mk1 = mm.y; } }
        if (act) {
            f32x16 p0, p1;
            qkt<DK>(p0, p1, K_lds + buf * SHM_K, r32, hi, qr);
            if (MODE == 0) {
                if (qlo - (kbp + 63) >= 256) { const float bf_ = relb[512];
#pragma unroll
                    for (int r = 0; r < 16; ++r) { p0[r] = fmaf(p0[r], C2, bf_); p1[r] = fmaf(p1[r], C2, bf_); } }
                else { const int dq = row - kbp - 4 * hi;
#pragma unroll
                    for (int r = 0; r < 16; ++r) { const int c = (r & 3) + 8 * (r >> 2);
                        int i0 = dq - c; i0 = i0 < -256 ? -256 : (i0 > 256 ? 256 : i0); int i1 = dq - c - 32; i1 = i1 < -256 ? -256 : (i1 > 256 ? 256 : i1);
                        p0[r] = fmaf(p0[r], C2, relb[i0 + 256]); p1[r] = fmaf(p1[r], C2, relb[i1 + 256]); } }
            } else if (MODE == 3) {
                LAS const float* cs = csl + buf * 64 + 4 * hi;
#pragma unroll
                for (int q4 = 0; q4 < 4; ++q4) { const f32x4 c0 = *(LAS const f32x4*)(cs + 8 * q4), c1 = *(LAS const f32x4*)(cs + 32 + 8 * q4);
#pragma unroll
                    for (int e = 0; e < 4; ++e) { p0[4 * q4 + e] = fmaf(p0[4 * q4 + e], C2, ctl - c0[e]); p1[4 * q4 + e] = fmaf(p1[4 * q4 + e], C2, ctl - c1[e]); } }
                if (kbp + 63 > qlo) { const int dq = row - kbp - 4 * hi;
#pragma unroll
                    for (int r = 0; r < 16; ++r) { const int c = (r & 3) + 8 * (r >> 2); if (dq - c < 0) p0[r] = NEG; if (dq - c - 32 < 0) p1[r] = NEG; } }
            } else {
#pragma unroll
                for (int r = 0; r < 16; ++r) { p0[r] *= C2; p1[r] *= C2; }
                if (MODE == 2) {
#pragma unroll
                    for (int r = 0; r < 16; ++r) { const int c = (r & 3) + 8 * (r >> 2) + 4 * hi; if (!((mk0 >> c) & 1u)) p0[r] = NEG; if (!((mk1 >> c) & 1u)) p1[r] = NEG; } }
            }
            float alpha; bf16x8 pa0, pa1, pa2, pa3;
            softmax_tile(p0, p1, m_reg, l_reg, alpha, pa0, pa1, pa2, pa3);
            if (__any(alpha < 1.f)) { if (hi == 0) wsc[r32] = alpha; LDS_WAIT();
#pragma unroll
                for (int r = 0; r < 16; ++r) { const float al = wsc[crow(r, hi)];
#pragma unroll
                    for (int d_ = 0; d_ < 4; ++d_) o[d_][r] *= al; }
                LDS_WAIT(); }
            pv_tile(o, vbase + buf * SHM_V, pa0, pa1, pa2, pa3);
        }
        asm volatile("s_waitcnt vmcnt(0)" ::: "memory");
        if (t + 1 < NT) FA_CSW(buf ^ 1);
        __syncthreads();
    }
#undef FA_DMA
#undef FA_CSW
    if (hi == 0) wsc[32 + r32] = l_reg; LDS_WAIT();
#pragma unroll
    for (int r = 0; r < 16; ++r) { const int orow = crow(r, hi); const float rl = __builtin_amdgcn_rcpf(wsc[32 + orow]);
#pragma unroll
        for (int d0 = 0; d0 < 4; ++d0) { const float v = o[d0][r] * rl; const float vn = __shfl_xor(v, 1);
            if ((r32 & 1) == 0) *(unsigned*)(Og + (size_t)orow * ldo + d0 * 32 + r32) = cvtpk(v, vn); } }
    LDS_WAIT();
}
}

__device__ __forceinline__ void rope_pair(float& x1, float& x2, float cs, float sn) { const float a = x1 * cs - x2 * sn, b = x2 * cs + x1 * sn; x1 = a; x2 = b; }
__device__ __forceinline__ void ph_l0_stats(const Args& a, const WI& w) {
    unsigned char* ws = a.ws; const bf16_t* P = (const bf16_t*)(ws + WS_PROJ);
    const float* r64 = (const float*)(ws + WS_ROPE64);
    for (int t = w.gw; t < T; t += w.ngw) {
        const bf16_t* row = P + (size_t)t * AB_MAIN;
        float s = 0.f;
        for (int j = 0; j < 3; ++j) { const bf16x8 v = *(const bf16x8*)(row + 6144 + (j * 64 + w.lane) * 8);
#pragma unroll
            for (int e = 0; e < 8; ++e) { const float f = bf2f((bf16_t)v[e]); s += f * f; } }
        s = wave_sum(s);
        float s2 = 0.f; { const bf16x8 v = *(const bf16x8*)(row + 7680 + w.lane * 8);
#pragma unroll
            for (int e = 0; e < 8; ++e) { const float f = bf2f((bf16_t)v[e]); s2 += f * f; } }
        s2 = wave_sum(s2);
        if (w.lane == 0) { ((float*)(ws + WS_RSQ))[t] = 1.f / sqrtf(s * (1.f / 1536.f) + RMS_EPS); ((float*)(ws + WS_RSKV))[t] = 1.f / sqrtf(s2 * (1.f / 512.f) + RMS_EPS); }
        if (w.lane < 32) { const float* sm = (const float*)(ws + WS_MQP) + (size_t)t * 256; const int sp = t & (SEQ - 1);
            float x1 = 0.f, x2 = 0.f;
#pragma unroll
            for (int z = 0; z < 8; ++z) { x1 += sm[(size_t)z * T * 256 + w.lane]; x2 += sm[(size_t)z * T * 256 + w.lane + 32]; } const float cs = r64[((size_t)sp * 32 + w.lane) * 2], sn = r64[((size_t)sp * 32 + w.lane) * 2 + 1];
            rope_pair(x1, x2, cs, sn);
            bf16_t* kr = (bf16_t*)(ws + WS_KR) + (size_t)t * 64; kr[w.lane] = (bf16_t)f2bf(x1); kr[w.lane + 32] = (bf16_t)f2bf(x2); }
    }
}
__device__ __forceinline__ void ph_l0_qrope(const Args& a, const WI& w) {
    unsigned char* ws = a.ws; bf16_t* Q = (bf16_t*)(ws + WS_QB); const float* r64 = (const float*)(ws + WS_ROPE64);
    for (int t = w.gw; t < T; t += w.ngw) {
        const int sp = t & (SEQ - 1);
        for (int e = w.lane; e < 16 * 32; e += 64) { const int h = e >> 5, i = e & 31; bf16_t* q = Q + (size_t)t * 3072 + h * 192 + 128;
            float x1 = bf2f(q[i]), x2 = bf2f(q[i + 32]); rope_pair(x1, x2, r64[((size_t)sp * 32 + i) * 2], r64[((size_t)sp * 32 + i) * 2 + 1]);
            q[i] = (bf16_t)f2bf(x1); q[i + 32] = (bf16_t)f2bf(x2); }
    }
}
__device__ __forceinline__ void ph_l1_elem(const Args& a, LAS float* sml  , const WI& w) {
    unsigned char* ws = a.ws; bf16_t* P = (bf16_t*)(ws + WS_PROJ);
    const float* r128 = (const float*)(ws + WS_ROPE128); const float* r64 = (const float*)(ws + WS_ROPE64);
    for (int t = w.gw; t < T; t += w.ngw) {
        const int b = t / SEQ, sp = t - b * SEQ; bf16_t* row = P + (size_t)t * CD_MAIN;
        for (int e = w.lane; e < 20 * 64; e += 64) { const int h = e >> 6, i = e & 63; bf16_t* q = row + h * 128;
            float x1 = bf2f(q[i]), x2 = bf2f(q[i + 64]); rope_pair(x1, x2, r128[((size_t)sp * 64 + i) * 2], r128[((size_t)sp * 64 + i) * 2 + 1]);
            q[i] = (bf16_t)f2bf(x1); q[i + 64] = (bf16_t)f2bf(x2); }
        for (int e = w.lane; e < 32 * 32; e += 64) { const int h = e >> 5, i = e & 31; bf16_t* q = row + 3072 + h * 64;
            float x1 = bf2f(q[i]), x2 = bf2f(q[i + 32]); rope_pair(x1, x2, r64[((size_t)sp * 32 + i) * 2], r64[((size_t)sp * 32 + i) * 2 + 1]);
            q[i] = (bf16_t)f2bf(x1); q[i + 32] = (bf16_t)f2bf(x2); }
        const float* smp = (const float*)(ws + WS_MQP) + (size_t)t * 256;
        float smv0 = 0.f, smv1 = 0.f;
#pragma unroll
        for (int z = 0; z < 8; ++z) { smv0 += smp[(size_t)z * T * 256 + w.lane]; smv1 += smp[(size_t)z * T * 256 + 64 + w.lane]; }
        LDS_WAIT(); sml[w.lane] = smv0; sml[64 + w.lane] = smv1; LDS_WAIT();
        LAS const float* sm = sml;
        if (w.lane < 32) { float x1 = sm[w.lane], x2 = sm[w.lane + 32]; rope_pair(x1, x2, r64[((size_t)sp * 32 + w.lane) * 2], r64[((size_t)sp * 32 + w.lane) * 2 + 1]);
            bf16_t* ki = (bf16_t*)(ws + WS_KI) + (size_t)t * 64; ki[w.lane] = (bf16_t)f2bf(x1); ki[w.lane + 32] = (bf16_t)f2bf(x2);
            ((float*)(ws + WS_WI))[(size_t)t * 32 + w.lane] = sm[64 + w.lane] * 0.17677669529663687f; }
        if (w.lane < 16) { const float z = sm[96 + w.lane] + a.in[I_D_FORGET_BIAS][w.lane];
            const float lf = fminf(z, 0.f) - log1pf(__expf(-fabsf(z)));
            ((float*)(ws + WS_LOGF))[((size_t)b * 16 + w.lane) * SEQ + sp] = lf; }
    }
}
__device__ __forceinline__ void ph_l1_scan(const Args& a, LAS float* sh  , const WI& w) {
    unsigned char* ws = a.ws;
    for (int it = w.bid; it < NB * 16; it += w.nblk) {
        const float* src = (const float*)(ws + WS_LOGF) + (size_t)it * SEQ + w.tid * 8; float* dst = (float*)(ws + WS_CUM) + (size_t)it * SEQ + w.tid * 8;
        const f32x4 v0 = *(const f32x4*)src, v1 = *(const f32x4*)(src + 4);
        float c[8]; c[0] = v0.x; c[1] = c[0] + v0.y; c[2] = c[1] + v0.z; c[3] = c[2] + v0.w; c[4] = c[3] + v1.x; c[5] = c[4] + v1.y; c[6] = c[5] + v1.z; c[7] = c[6] + v1.w;
        float inc = c[7];
#pragma unroll
        for (int o = 1; o < 64; o <<= 1) { const float v = __shfl_up(inc, o); if (w.lane >= o) inc += v; }
        __syncthreads();
        if (w.lane == 63) sh[w.wave] = inc;
        __syncthreads();
        float base = inc - c[7];
        for (int q = 0; q < w.wave; ++q) base += sh[q];
        *(f32x4*)dst = (f32x4){c[0] + base, c[1] + base, c[2] + base, c[3] + base}; *(f32x4*)(dst + 4) = (f32x4){c[4] + base, c[5] + base, c[6] + base, c[7] + base};
    }
    __syncthreads();
}
__device__ __forceinline__ void ph_l1_index_naive(const Args& a, LAS float* qs  , const WI& w) {
    unsigned char* ws = a.ws; const bf16_t* P = (const bf16_t*)(ws + WS_PROJ); const bf16_t* KI = (const bf16_t*)(ws + WS_KI);
    const float* WIp = (const float*)(ws + WS_WI); float* SC = (float*)(ws + WS_SCORE);
    for (int t = w.gw; t < T; t += w.ngw) {
        const int b = t / SEQ, sp = t - b * SEQ, nadm = ((sp >> 6) + 1) * 64;
        LDS_WAIT();
        for (int e = w.lane; e < 2048; e += 64) qs[e] = bf2f(P[(size_t)t * CD_MAIN + 3072 + e]);
        if (w.lane < 32) qs[2048 + w.lane] = WIp[(size_t)t * 32 + w.lane];
        LDS_WAIT();
        for (int s0 = 0; s0 < nadm; s0 += 64) {
            const int s = s0 + w.lane; const bf16_t* kp = KI + ((size_t)b * SEQ + s) * 64;
            float k[64];
#pragma unroll
            for (int d0 = 0; d0 < 64; d0 += 8) { const bf16x8 kv = *(const bf16x8*)(kp + d0);
#pragma unroll
                for (int e = 0; e < 8; ++e) k[d0 + e] = bf2f((bf16_t)kv[e]); }
            float sc = 0.f;
            for (int h = 0; h < 32; ++h) { float dot = 0.f;
#pragma unroll
                for (int d = 0; d < 64; ++d) dot += qs[h * 64 + d] * k[d];
                sc += qs[2048 + h] * fmaxf(dot * 0.125f, 0.f); }
            SC[((size_t)b * SEQ + sp) * SEQ + s] = sc;
        }
    }
}
__device__ __forceinline__ void ph_l1_index(const Args& a, LAS unsigned char* lds, const WI& w) {
    unsigned char* ws = a.ws; const bf16_t* P = (const bf16_t*)(ws + WS_PROJ); const bf16_t* KI = (const bf16_t*)(ws + WS_KI);
    const float* WIp = (const float*)(ws + WS_WI); float* SC = (float*)(ws + WS_SCORE);
    LAS char* Qs = (LAS char*)lds; LAS float* Wt = (LAS float*)(lds + 131072);
    const int tid = w.tid, r32 = w.lane & 31, hi = w.lane >> 5;
    for (int u = w.bid; u < 256; u += w.nblk) {
        const int b = u >> 7, x = (u >> 1) & 63, half = u & 1;
        for (int pass = 0; pass < 2; ++pass) {
            const int qt = pass ? 127 - x : x; const int t0 = b * SEQ + qt * 32; const int nadm = ((qt * 32) >> 6) * 64 + 64, ngrp = (nadm + 127) >> 7;
            __syncthreads();
            for (int e = tid; e < 32 * 256; e += 512) { const int t = e >> 8, c = e & 255; const u32x4 v = *(const u32x4*)(P + (size_t)(t0 + t) * CD_MAIN + 3072 + c * 8);
                const int cs = (c & ~15) | ((c & 15) ^ (t & 15)); *(LAS u32x4*)(Qs + t * 4096 + cs * 16) = v; }
            for (int e = tid; e < 1024; e += 512) { const int t = e >> 5, h = e & 31; Wt[h * 32 + t] = WIp[(size_t)(t0 + t) * 32 + h] * 0.125f; }
            __syncthreads();
            for (int g = half + 2 * w.wave; g < ngrp; g += 16) {
                const int s0 = g * 128;
                bf16x8 kf[4][4];
#pragma unroll
                for (int j = 0; j < 4; ++j)
#pragma unroll
                    for (int dk = 0; dk < 4; ++dk) kf[j][dk] = *(const bf16x8*)(KI + ((size_t)b * SEQ + s0 + 32 * j + r32) * 64 + dk * 16 + hi * 8);
                f32x16 acc[4] = {};
#pragma unroll 2
                for (int h = 0; h < 32; ++h) {
                    bf16x8 qf[4];
#pragma unroll
                    for (int dk = 0; dk < 4; ++dk) qf[dk] = *(LAS const bf16x8*)(Qs + r32 * 4096 + ((((h >> 1) << 4) | ((((h & 1) << 3) | (dk << 1) | hi) ^ (r32 & 15))) << 4));
                    f32x4 wv[4];
#pragma unroll
                    for (int q4 = 0; q4 < 4; ++q4) wv[q4] = *(LAS const f32x4*)(Wt + h * 32 + 8 * q4 + 4 * hi);
#pragma unroll
                    for (int j = 0; j < 4; ++j) { f32x16 tmp = {};
#pragma unroll
                        for (int dk = 0; dk < 4; ++dk) tmp = __builtin_amdgcn_mfma_f32_32x32x16_bf16(qf[dk], kf[j][dk], tmp, 0, 0, 0);
#pragma unroll
                        for (int r = 0; r < 16; ++r) acc[j][r] = fmaf(wv[r >> 2][r & 3], fmaxf(tmp[r], 0.f), acc[j][r]); }
                }
#pragma unroll
                for (int j = 0; j < 4; ++j)
#pragma unroll
                    for (int r = 0; r < 16; ++r) SC[(size_t)(t0 + crow(r, hi)) * SEQ + s0 + 32 * j + r32] = acc[j][r];
            }
        }
    }
    __syncthreads();
}
__device__ __forceinline__ void ph_l1_select(const Args& a, const WI& w) {
    unsigned char* ws = a.ws; const float* SC = (const float*)(ws + WS_SCORE); unsigned* MK = (unsigned*)(ws + WS_MASK);
    for (int t = w.gw; t < T; t += w.ngw) {
        const int b = t / SEQ, sp = t - b * SEQ, nblk = (sp >> 6) + 1;
        const float* row = SC + ((size_t)b * SEQ + sp) * SEQ;
        unsigned key[64];
#pragma unroll
        for (int j = 0; j < 64; ++j) { unsigned u = 0u; if (j < nblk) { u = __float_as_uint(row[j * 64 + w.lane]); u ^= (u >> 31) ? 0xFFFFFFFFu : 0x80000000u; } key[j] = u; }
        unsigned thr = 0u;
        if (nblk > 4) {
            for (int bit = 31; bit >= 0; --bit) { const unsigned cand = thr | (1u << bit); int cnt = 0;
#pragma unroll
                for (int j = 0; j < 64; ++j) cnt += (key[j] >= cand) ? 1 : 0;
                cnt = wave_sum_i(cnt); if (cnt >= 256) thr = cand; }
        }
        unsigned lo = 0u, hi = 0u;
#pragma unroll
        for (int j = 0; j < 64; ++j) { const bool sel = (j < nblk) && (key[j] >= thr); const unsigned long long bal = __ballot(sel); if (w.lane == j) { lo = (unsigned)bal; hi = (unsigned)(bal >> 32); } }
        *(u32x2*)(MK + (size_t)t * 128 + 2 * w.lane) = (u32x2){lo, hi};
    }
}

__device__ __forceinline__ unsigned tk_key(float v, unsigned payload, unsigned pmask) { const unsigned u = __float_as_uint(v); const unsigned m = (unsigned)((int)u >> 31) | 0x80000000u; return ((u ^ m) & ~pmask) | payload; }
__device__ __forceinline__ float tk_val(unsigned key, unsigned pmask) { const unsigned k = key & ~pmask; const unsigned m = ~(unsigned)((int)k >> 31) | 0x80000000u; return __uint_as_float(k ^ m); }
#define TK_INSERT(TOP, key_) do { unsigned k__ = (key_); \
        _Pragma("unroll") for (int q_ = 0; q_ < 16; ++q_) { const unsigned hi__ = TOP[q_] > k__ ? TOP[q_] : k__; k__ = TOP[q_] > k__ ? k__ : TOP[q_]; TOP[q_] = hi__; } } while (0)
__device__ __forceinline__ unsigned tk_sel16(const unsigned (&arr)[16], unsigned i) {
    unsigned x8[8], x4[4], x2[2];
    const unsigned m0 = 0u - (i & 1u), m1 = 0u - ((i >> 1) & 1u), m2 = 0u - ((i >> 2) & 1u), m3 = 0u - ((i >> 3) & 1u);
#pragma unroll
    for (int q = 0; q < 8; ++q) x8[q] = (arr[2 * q + 1] & m0) | (arr[2 * q] & ~m0);
#pragma unroll
    for (int q = 0; q < 4; ++q) x4[q] = (x8[2 * q + 1] & m1) | (x8[2 * q] & ~m1);
#pragma unroll
    for (int q = 0; q < 2; ++q) x2[q] = (x4[2 * q + 1] & m2) | (x4[2 * q] & ~m2);
    return (x2[1] & m3) | (x2[0] & ~m3); }
__device__ __forceinline__ void ph_peer_topk(const Args& a, const WI& w) {
    unsigned char* ws = a.ws; const float* PST = (const float*)(ws + WS_PSCORE); int* PIDX = (int*)(ws + WS_PIDX); float* PG = (float*)(ws + WS_PGATE);
    for (int task = w.gw; task < 128 * 8; task += w.ngw) {
        const int h = task & 7, t = (task >> 3) * 64 + w.lane;
        unsigned t0[16], t1[16];
#pragma unroll
        for (int k = 0; k < 16; ++k) { t0[k] = 0u; t1[k] = 0u; }
        { const float* col = PST + (size_t)(h * 256) * T + t;
#pragma unroll 8
          for (int i = 0; i < 128; ++i) { const float v = col[(size_t)i * T]; TK_INSERT(t0, tk_key(v, 127u - (unsigned)i, 127u)); } }
        { const float* col = PST + (size_t)(h * 256 + 128) * T + t;
#pragma unroll 8
          for (int i = 0; i < 128; ++i) { const float v = col[(size_t)i * T]; TK_INSERT(t1, tk_key(v, 127u - (unsigned)i, 127u)); } }
        float a0[16], a1[16];
#pragma unroll
        for (int k = 0; k < 16; ++k) { a0[k] = tk_val(t0[k], 127u); a1[k] = tk_val(t1[k], 127u); }
        unsigned bk[16];
#pragma unroll
        for (int k = 0; k < 16; ++k) bk[k] = 0u;
#pragma unroll
        for (int i = 0; i < 16; ++i)
#pragma unroll
            for (int j = 0; j < 16; ++j) if ((i + 1) * (j + 1) <= 16) TK_INSERT(bk, tk_key(a0[i] + a1[j], 255u - (unsigned)(i * 16 + j), 255u));
        const float top = tk_val(bk[0], 255u); float den = 0.f; float ex[16];
#pragma unroll
        for (int k = 0; k < 16; ++k) { ex[k] = __expf(tk_val(bk[k], 255u) - top); den += ex[k]; }
        const float rd = 1.f / den;
#pragma unroll
        for (int k = 0; k < 16; ++k) { const unsigned c = 255u - (bk[k] & 255u); const unsigned e0 = 127u - (tk_sel16(t0, c >> 4) & 127u), e1 = 127u - (tk_sel16(t1, c & 15u) & 127u);
            PIDX[(size_t)t * 128 + h * 16 + k] = (int)(e0 * 128u + e1); PG[(size_t)t * 128 + h * 16 + k] = ex[k] * rd; }
    }
}
__device__ __forceinline__ void ph_peer_experts(const Args& a, int layer, float* outf, bf16_t* outb, const float* g, const float* bta, LAS float* wsm  , const WI& w) {
    unsigned char* ws = a.ws; const float* HF = (const float*)(ws + WS_HF);
    const unsigned char* U4 = ws + WS_U8 + (size_t)layer * 16384 * 2048; const unsigned char* V4 = ws + WS_V8 + (size_t)layer * 16384 * 2048;
    const unsigned short* US = (const unsigned short*)(ws + WS_U8 + 64 * MiB) + (size_t)layer * 16384 * 64; const unsigned short* VS = (const unsigned short*)(ws + WS_V8 + 64 * MiB) + (size_t)layer * 16384 * 64;
    const int* PIDX = (const int*)(ws + WS_PIDX); const float* PG = (const float*)(ws + WS_PGATE);
    const int lane = w.lane;
    for (int t = w.gw; t < T; t += w.ngw) {
        const float* hrow = HF + (size_t)t * DM + 32 * lane;
        const int idx0 = PIDX[(size_t)t * 128 + lane], idx1 = PIDX[(size_t)t * 128 + 64 + lane];
        const float g0 = PG[(size_t)t * 128 + lane], g1 = PG[(size_t)t * 128 + 64 + lane];
        LDS_WAIT();
#define PE_LOAD(BUF, SB, TBL, STB, kb_) do { const int iv_ = ((kb_) & 64) ? idx1 : idx0; \
            _Pragma("unroll") for (int q_ = 0; q_ < 4; ++q_) { const int e_ = __builtin_amdgcn_readlane(iv_, ((kb_) + q_) & 63); const u32x4* r_ = (const u32x4*)(TBL + (size_t)e_ * 2048 + 16 * lane); \
                BUF[q_][0] = r_[0]; BUF[q_][1] = r_[64]; SB[q_] = STB[(size_t)e_ * 64 + lane]; } } while (0)
#define PE_SCALE(sb_, i_) __builtin_amdgcn_exp2f((float)((int)(((sb_) >> (8 * (i_))) & 255u) - 128) * 0.125f)
#define PE_DOT(BUF, SB, Z, zo_) do { _Pragma("unroll") for (int q_ = 0; q_ < 4; ++q_) { float zq_ = 0.f; \
            _Pragma("unroll") for (int i_ = 0; i_ < 2; ++i_) { f32x2 acc_ = {0.f, 0.f}; \
                _Pragma("unroll") for (int d_ = 0; d_ < 4; ++d_) { \
                    acc_ = __builtin_elementwise_fma(__builtin_amdgcn_cvt_scalef32_pk_f32_fp4(BUF[q_][i_][d_], 1.0f, 0), x[16 * i_ + 4 * d_ + 0], acc_); \
                    acc_ = __builtin_elementwise_fma(__builtin_amdgcn_cvt_scalef32_pk_f32_fp4(BUF[q_][i_][d_], 1.0f, 1), x[16 * i_ + 4 * d_ + 1], acc_); \
                    acc_ = __builtin_elementwise_fma(__builtin_amdgcn_cvt_scalef32_pk_f32_fp4(BUF[q_][i_][d_], 1.0f, 2), x[16 * i_ + 4 * d_ + 2], acc_); \
                    acc_ = __builtin_elementwise_fma(__builtin_amdgcn_cvt_scalef32_pk_f32_fp4(BUF[q_][i_][d_], 1.0f, 3), x[16 * i_ + 4 * d_ + 3], acc_); } \
                zq_ = fmaf(PE_SCALE((unsigned)SB[q_], i_), acc_.x + acc_.y, zq_); } \
            Z[(zo_) + q_] = zq_; } } while (0)
#define PE_AXPY(BUF, SB, kb_) do { _Pragma("unroll") for (int q_ = 0; q_ < 4; ++q_) { const float wt_ = wsm[(kb_) + q_]; \
            _Pragma("unroll") for (int i_ = 0; i_ < 2; ++i_) { const float ws_ = wt_ * PE_SCALE((unsigned)SB[q_], i_); const f32x2 wt2_ = {ws_, ws_}; \
                _Pragma("unroll") for (int d_ = 0; d_ < 4; ++d_) { \
                    y[16 * i_ + 4 * d_ + 0] = __builtin_elementwise_fma(__builtin_amdgcn_cvt_scalef32_pk_f32_fp4(BUF[q_][i_][d_], 1.0f, 0), wt2_, y[16 * i_ + 4 * d_ + 0]); \
                    y[16 * i_ + 4 * d_ + 1] = __builtin_elementwise_fma(__builtin_amdgcn_cvt_scalef32_pk_f32_fp4(BUF[q_][i_][d_], 1.0f, 1), wt2_, y[16 * i_ + 4 * d_ + 1]); \
                    y[16 * i_ + 4 * d_ + 2] = __builtin_elementwise_fma(__builtin_amdgcn_cvt_scalef32_pk_f32_fp4(BUF[q_][i_][d_], 1.0f, 2), wt2_, y[16 * i_ + 4 * d_ + 2]); \
                    y[16 * i_ + 4 * d_ + 3] = __builtin_elementwise_fma(__builtin_amdgcn_cvt_scalef32_pk_f32_fp4(BUF[q_][i_][d_], 1.0f, 3), wt2_, y[16 * i_ + 4 * d_ + 3]); } } \
            __builtin_amdgcn_sched_barrier(0); } } while (0)
#define PE_SB() __builtin_amdgcn_sched_barrier(0)
        u32x4 bA[4][2], bB[4][2]; unsigned short sA[4], sB[4];
        {
            f32x2 x[32];
#pragma unroll
            for (int i = 0; i < 2; ++i)
#pragma unroll
                for (int q = 0; q < 8; ++q) { const f32x4 v = *(const f32x4*)(hrow + 2048 * i + 4 * q); x[16 * i + 2 * q] = (f32x2){v.x, v.y}; x[16 * i + 2 * q + 1] = (f32x2){v.z, v.w}; }
            PE_LOAD(bA, sA, U4, US, 0); PE_SB();
#pragma unroll 1
            for (int k0 = 0; k0 < 128; k0 += 8) {
                const int iv = (k0 & 64) ? idx1 : idx0; const float gv = (k0 & 64) ? g1 : g0;
                float z[8];
                PE_LOAD(bB, sB, U4, US, k0 + 4); PE_SB(); PE_DOT(bA, sA, z, 0); PE_SB();
                PE_LOAD(bA, sA, U4, US, (k0 + 8) & 127); PE_SB(); PE_DOT(bB, sB, z, 4); PE_SB();
                float r4[4], r2[2], r1;
#pragma unroll
                for (int i = 0; i < 4; ++i) { const float keep = (lane & 32) ? z[i + 4] : z[i], send = (lane & 32) ? z[i] : z[i + 4]; r4[i] = keep + __shfl_xor(send, 32); }
#pragma unroll
                for (int i = 0; i < 2; ++i) { const float keep = (lane & 16) ? r4[i + 2] : r4[i], send = (lane & 16) ? r4[i] : r4[i + 2]; r2[i] = keep + __shfl_xor(send, 16); }
                { const float keep = (lane & 8) ? r2[1] : r2[0], send = (lane & 8) ? r2[0] : r2[1]; r1 = keep + __shfl_xor(send, 8); }
                r1 += __shfl_xor(r1, 4); r1 += __shfl_xor(r1, 2); r1 += __shfl_xor(r1, 1);
                const int q = lane >> 3; const float gt_ = __shfl(gv, (k0 + q) & 63);
                if ((lane & 7) == 0) { const float zz = r1; const float act = 0.5f * zz * (1.f + erff(zz * 0.70710678118654752f)); wsm[k0 + q] = act * gt_; }
            }
        }
        LDS_WAIT();
        f32x2 y[32];
#pragma unroll
        for (int i = 0; i < 32; ++i) y[i] = (f32x2){0.f, 0.f};
        PE_LOAD(bA, sA, V4, VS, 0); PE_SB();
#pragma unroll 1
        for (int k0 = 0; k0 < 128; k0 += 8) {
            PE_LOAD(bB, sB, V4, VS, k0 + 4); PE_SB(); PE_AXPY(bA, sA, k0); PE_SB();
            PE_LOAD(bA, sA, V4, VS, (k0 + 8) & 127); PE_SB(); PE_AXPY(bB, sB, k0 + 4); PE_SB();
        }
#undef PE_LOAD
#undef PE_SCALE
#undef PE_DOT
#undef PE_AXPY
#undef PE_SB
        const float* hrow2 = hrow; asm volatile("" : "+v"(hrow2));
        float s = 0.f;
#pragma unroll
        for (int i = 0; i < 2; ++i)
#pragma unroll
            for (int q = 0; q < 8; ++q) { const f32x4 v = *(const f32x4*)(hrow2 + 2048 * i + 4 * q);
                y[16 * i + 2 * q].x += ALPHA * v.x; y[16 * i + 2 * q].y += ALPHA * v.y; y[16 * i + 2 * q + 1].x += ALPHA * v.z; y[16 * i + 2 * q + 1].y += ALPHA * v.w;
                if ((q & 3) == 3) __builtin_amdgcn_sched_barrier(0); }
#pragma unroll
        for (int i = 0; i < 32; ++i) s += y[i].x + y[i].y;
        const float mean = wave_sum(s) * (1.f / DM); float s2 = 0.f;
#pragma unroll
        for (int i = 0; i < 32; ++i) { y[i].x -= mean; y[i].y -= mean; s2 += y[i].x * y[i].x + y[i].y * y[i].y; }
        const float rstd = 1.f / sqrtf(wave_sum(s2) * (1.f / DM) + LN_EPS);
#pragma unroll
        for (int i = 0; i < 2; ++i)
#pragma unroll
            for (int q = 0; q < 8; ++q) { const int c = 2048 * i + 32 * lane + 4 * q;
                const f32x4 gg = *(const f32x4*)(g + c), bb = *(const f32x4*)(bta + c); f32x4 o;
                o.x = y[16 * i + 2 * q].x * rstd * gg.x + bb.x; o.y = y[16 * i + 2 * q].y * rstd * gg.y + bb.y; o.z = y[16 * i + 2 * q + 1].x * rstd * gg.z + bb.z; o.w = y[16 * i + 2 * q + 1].y * rstd * gg.w + bb.w;
                *(f32x4*)(outf + (size_t)t * DM + c) = o;
                if (outb) { u32x2 p; p.x = pk2(o.x, o.y); p.y = pk2(o.z, o.w); *(u32x2*)(outb + (size_t)t * DM + c) = p; }
                if (q & 1) __builtin_amdgcn_sched_barrier(0); }
    }
}

__device__ __forceinline__ void ph_attn_l0(const Args& a, LAS unsigned char* lds, const WI& w) {
    for (int pr = w.bid; pr < 256; pr += w.nblk) { const int bh = pr >> 3, x = pr & 7;
        for (int pass = 0; pass < 2; ++pass) fa::attn_unit<1>(a, 0, lds, bh >> 4, bh & 15, pass ? 15 - x : x); }
    for (int u = w.bid; u < 512; u += w.nblk) { const int bh = u >> 4; fa::attn_unit<0>(a, 0, lds, bh >> 4, bh & 15, u & 15); }
}
__device__ __forceinline__ void ph_attn_l1(const Args& a, LAS unsigned char* lds, const WI& w) {
    for (int pr = w.bid; pr < 256; pr += w.nblk) { const int bh = pr >> 3, x = pr & 7;
        for (int pass = 0; pass < 2; ++pass) fa::attn_unit<2>(a, 1, lds, bh >> 4, bh & 15, pass ? 15 - x : x); }
    for (int pr = w.bid; pr < 256; pr += w.nblk) { const int bh = pr >> 3, x = pr & 7;
        for (int pass = 0; pass < 2; ++pass) fa::attn_unit<3>(a, 1, lds, bh >> 4, bh & 15, pass ? 15 - x : x); }
}
__device__ __forceinline__ void ph_attn_mem(const Args& a, int layer, LAS unsigned char* lds, const WI& w) {
    for (int u = w.bid; u < 128; u += w.nblk) { const int bh = u >> 4; fa::attn_unit<4>(a, layer, lds, bh >> 2, bh & 3, u & 15); }
}

__global__ void __launch_bounds__(512, 2) mega(Args a) {
    extern __shared__ __attribute__((aligned(16))) unsigned char lds_raw[];
    LAS unsigned char* lds = (LAS unsigned char*)lds_raw;
    WI w; w.tid = threadIdx.x; w.lane = w.tid & 63; w.wave = __builtin_amdgcn_readfirstlane(w.tid >> 6);
    w.bid = blockIdx.x; w.nblk = gridDim.x; w.gw = w.bid * 8 + w.wave; w.ngw = w.nblk * 8;
    unsigned char* ws = a.ws;
    volatile LAS unsigned* misc = (volatile LAS unsigned*)(lds + LDS_MISC);
    if (w.tid < 4) misc[w.tid] = 0u;
    __syncthreads();
    XcdBarrier bar; bar.bar = (unsigned*)(ws + WS_CTL) + 4096; bar.x = 0; bar.st = misc;
#if !MK_PER_PHASE
    bar = xcd_barrier_post((unsigned*)(ws + WS_CTL) + 4096, misc);
#endif
    const int lo = a.ph_lo, hi = a.ph_hi;
#define IN(k) (lo <= (k) && (k) < hi)
#if MK_PER_PHASE
#define SEAM(k) do { } while (0)
#else
#define SEAM(k) do { if (IN(k) && IN((k) + 1)) xcd_barrier(bar); } while (0)
#endif
    LAS float* wlds = (LAS float*)(lds + w.wave * 16384);
    bf16_t* XB = (bf16_t*)(ws + WS_XB); float* HF = (float*)(ws + WS_HF); float* RES = (float*)(ws + WS_RES); bf16_t* PROJ = (bf16_t*)(ws + WS_PROJ);
    bf16_t* ATT = (bf16_t*)(ws + WS_ATT); float* SMALL = (float*)(ws + WS_SMALL);

#define FAST_GEMM(EPI_T, Aptr, lda_, Btptr, ldb_, M_, N_, K_, nz_, zA_, zB_, EPI_OBJ) do { \
        pg8::Gemm g_{Aptr, Btptr, M_, N_, K_, lda_, ldb_, zA_, zB_, nz_}; pg8::StaticOrder S_; S_.init(M_, N_, nz_, w.nblk, w.bid); \
        pg8::gemm_phase<EPI_T, pg8::StaticOrder>(lds, g_, S_, EPI_OBJ); } while (0)
    if (IN(0)) { ph_convert(a, lds, w); if (PROBE_DUP == 0) ph_convert(a, lds, w); }
    SEAM(0);
    if (IN(1)) {
        FAST_GEMM(pg8::EpiBf16, XB, DM, (const bf16_t*)(ws + WS_W_AB_IN), DM, T, AB_MAIN, DM, 1, 0, 0, (pg8::EpiBf16{PROJ, AB_MAIN, nullptr}));
        FAST_GEMM(pg8::EpiF32, XB, DM, (const bf16_t*)(ws + WS_W_AB_IN) + (size_t)AB_MAIN * DM, DM, T, 256, 512, 8, 512, 512, (pg8::EpiF32{(float*)(ws + WS_MQP), 256, (long)T * 256}));
        FAST_GEMM(pg8::EpiF32, (const bf16_t*)(ws + WS_MEMB), DM, (const bf16_t*)(ws + WS_W_MEM_KV), DM, 512, 2048, 256, 16, 256, 256, (pg8::EpiF32{(float*)(ws + WS_SCORE), 2048, (long)512 * 2048}));
    }
    SEAM(1);
    if (IN(2)) { ph_l0_stats(a, w);
        { const float* part = (const float*)(ws + WS_SCORE); bf16_t* KVM = (bf16_t*)(ws + WS_KVM);
          for (size_t i = ((size_t)w.gw * 64 + w.lane) * 4; i < (size_t)512 * 2048; i += (size_t)w.ngw * 64 * 4) { f32x4 s = {0.f, 0.f, 0.f, 0.f};
#pragma unroll
              for (int z = 0; z < 16; ++z) s += *(const f32x4*)(part + (size_t)z * 512 * 2048 + i);
              const int m = (int)(i >> 11), n = (int)(i & 2047); u32x2 p; p.x = pk2(s.x, s.y); p.y = pk2(s.z, s.w);
              *(u32x2*)(KVM + ((size_t)(n >> 10) * 512 + m) * 1024 + (n & 1023)) = p; } } }
    SEAM(2);
    if (IN(3)) {
        const float* rsq = (const float*)(ws + WS_RSQ); const float* rskv = (const float*)(ws + WS_RSKV);
        bf16_t* QB = (bf16_t*)(ws + WS_QB); bf16_t* KVB = (bf16_t*)(ws + WS_KVB);
        FAST_GEMM(pg8::EpiBf16, PROJ + 6144, AB_MAIN, (const bf16_t*)(ws + WS_W_UQ), 1536, T, 3072, 1536, 1, 0, 0, (pg8::EpiBf16{QB, 3072, rsq}));
        FAST_GEMM(pg8::EpiBf16, PROJ + 7680, AB_MAIN, (const bf16_t*)(ws + WS_W_UKV), 512, T, 4096, 512, 1, 0, 0, (pg8::EpiBf16{KVB, 4096, rskv}));
    }
    SEAM(3);
    if (IN(4)) ph_l0_qrope(a, w);
    SEAM(4);
    if (IN(5)) { ph_attn_l0(a, lds, w); if (PROBE_DUP == 5) ph_attn_l0(a, lds, w); }
    SEAM(5);
    if (IN(6)) { const float* X = a.in[I_X];
        FAST_GEMM(pg8::EpiResid, ATT, DM, (const bf16_t*)(ws + WS_W_AB_OUT), DM, T, DM, DM, 1, 0, 0, (pg8::EpiResid{X, RES, DM})); }
    SEAM(6);
    if (IN(7)) ln_rows(RES, a.in[I_LN_G] + 0 * DM, a.in[I_LN_B] + 0 * DM, HF, XB, w);
    SEAM(7);

#define MEM_PEER_PHASES(L, P0_, LAST)                                                                                                                         \
    if (IN(P0_)) { FAST_GEMM(pg8::EpiF32, XB, DM, (const bf16_t*)(ws + WS_W_MEM_Q) + (size_t)(L) * 512 * DM, DM, T, 512, 1024, 4, 1024, 1024,                    \
                             (pg8::EpiF32{(float*)(ws + WS_MQP), 512, (long)T * 512})); }                                                                       \
    SEAM(P0_);                                                                                                                                                  \
    if (IN(P0_ + 1)) ph_attn_mem(a, (L), lds, w);                                                                                                               \
    SEAM(P0_ + 1);                                                                                                                                              \
    if (IN(P0_ + 2)) { FAST_GEMM(pg8::EpiResid, (const bf16_t*)(ws + WS_MEMO), 512, (const bf16_t*)(ws + WS_W_MEM_O) + (size_t)(L) * DM * 512, 512, T, DM, 512, 1, 0, 0, \
                                 (pg8::EpiResid{HF, RES, DM})); }                                                                                               \
    SEAM(P0_ + 2);                                                                                                                                              \
    if (IN(P0_ + 3)) ln_rows(RES, a.in[I_LN_G] + ((L) * 3 + 1) * DM, a.in[I_LN_B] + ((L) * 3 + 1) * DM, HF, XB, w);                                             \
    SEAM(P0_ + 3);                                                                                                                                              \
    if (IN(P0_ + 4)) { FAST_GEMM(pg8::EpiF32, (const bf16_t*)(ws + WS_W_PEER) + (size_t)(L) * 2048 * DM, DM, XB, DM, 2048, T, DM, 1, 0, 0,                     \
                                 (pg8::EpiF32{(float*)(ws + WS_PSCORE), T, 0})); }                                                                              \
    SEAM(P0_ + 4);                                                                                                                                              \
    if (IN(P0_ + 5)) { ph_peer_topk(a, w); if (PROBE_DUP == 27 && (LAST)) ph_peer_topk(a, w); }                                                                 \
    SEAM(P0_ + 5);                                                                                                                                              \
    if (IN(P0_ + 6)) { ph_peer_experts(a, (L), (LAST) ? a.out : HF, (LAST) ? (bf16_t*)nullptr : XB, a.in[I_LN_G] + ((L) * 3 + 2) * DM, a.in[I_LN_B] + ((L) * 3 + 2) * DM, wlds, w); \
        if (PROBE_DUP == 28 && (LAST)) ph_peer_experts(a, (L), a.out, (bf16_t*)nullptr, a.in[I_LN_G] + ((L) * 3 + 2) * DM, a.in[I_LN_B] + ((L) * 3 + 2) * DM, wlds, w); } \
    if (!(LAST)) SEAM(P0_ + 6);

    MEM_PEER_PHASES(0, 8, false)

    if (IN(15)) {
        FAST_GEMM(pg8::EpiBf16, XB, DM, (const bf16_t*)(ws + WS_W_CD_IN), DM, T, CD_MAIN, DM, 1, 0, 0, (pg8::EpiBf16{PROJ, CD_MAIN, nullptr}));
        FAST_GEMM(pg8::EpiF32, XB, DM, (const bf16_t*)(ws + WS_W_CD_IN) + (size_t)CD_MAIN * DM, DM, T, 256, 512, 8, 512, 512, (pg8::EpiF32{(float*)(ws + WS_MQP), 256, (long)T * 256}));
    }
    SEAM(15);
    if (IN(16)) ph_l1_elem(a, wlds, w);
    SEAM(16);
    if (IN(17)) { ph_l1_scan(a, (LAS float*)(lds + LDS_MISC + 64), w); ph_l1_index(a, lds, w); if (PROBE_DUP == 17) ph_l1_index(a, lds, w); }
    SEAM(17);
    if (IN(18)) { ph_l1_select(a, w); if (PROBE_DUP == 18) ph_l1_select(a, w); }
    SEAM(18);
    if (IN(19)) { ph_attn_l1(a, lds, w); if (PROBE_DUP == 19) ph_attn_l1(a, lds, w); }
    SEAM(19);
    if (IN(20)) { FAST_GEMM(pg8::EpiResid, ATT, DM, (const bf16_t*)(ws + WS_W_CD_OUT), DM, T, DM, DM, 1, 0, 0, (pg8::EpiResid{HF, RES, DM})); }
    SEAM(20);
    if (IN(21)) ln_rows(RES, a.in[I_LN_G] + 3 * DM, a.in[I_LN_B] + 3 * DM, HF, XB, w);
    SEAM(21);
    MEM_PEER_PHASES(1, 22, true)
#undef IN
#undef SEAM
}

extern "C" void kernel_launch(void* const* d_in, const int* in_sizes, int n_in, void* d_out, int out_size, void* d_ws, size_t ws_size, hipStream_t stream) {
    static int grid = 0;
    if (grid == 0) {
        if (n_in != 21 || out_size != T * DM || ws_size < WS_END) { fprintf(stderr, "kernel_launch: unexpected shapes (n_in %d out %d ws %zu need %zu)\n", n_in, out_size, ws_size, (size_t)WS_END); grid = -1; return; }
        int dev = 0, cus = 0, per_cu = 0;
        if (hipGetDevice(&dev) != hipSuccess || hipDeviceGetAttribute(&cus, hipDeviceAttributeMultiprocessorCount, dev) != hipSuccess) { grid = -1; return; }
        if (hipFuncSetAttribute((const void*)mega, hipFuncAttributeMaxDynamicSharedMemorySize, LDS_BYTES) != hipSuccess) { fprintf(stderr, "kernel_launch: hipFuncSetAttribute failed\n"); grid = -1; return; }
        if (hipOccupancyMaxActiveBlocksPerMultiprocessor(&per_cu, (const void*)mega, 512, LDS_BYTES) != hipSuccess || per_cu < 1) { fprintf(stderr, "kernel_launch: occupancy query says %d\n", per_cu); }
        (void)hipGetLastError();
        grid = cus;
    }
    if (grid < 0) return;
    (void)hipMemsetAsync((char*)d_ws + WS_CTL, 0, CTL_BYTES, stream);
    Args a{};
    for (int i = 0; i < 21; ++i) a.in[i] = (const float*)d_in[i];
    a.out = (float*)d_out; a.ws = (unsigned char*)d_ws;
#if MK_PER_PHASE
    for (int p = 0; p < NPHASE; ++p) { a.ph_lo = p; a.ph_hi = p + 1; hipLaunchKernelGGL(mega, dim3(grid), dim3(512), LDS_BYTES, stream, a); }
#else
    a.ph_lo = 0; a.ph_hi = NPHASE;
    hipLaunchKernelGGL(mega, dim3(grid), dim3(512), LDS_BYTES, stream, a);
#endif
}
```

```cpp
#include <hip/hip_runtime.h>
#include <cstdio>
#include <cstdint>

#define GAS __attribute__((address_space(1)))
#define LAS __attribute__((address_space(3)))
typedef unsigned short bf16_t;
typedef short bf16x8 __attribute__((ext_vector_type(8)));
typedef float f32x4 __attribute__((ext_vector_type(4)));
typedef float f32x16 __attribute__((ext_vector_type(16)));
typedef unsigned u32x4 __attribute__((ext_vector_type(4)));
typedef unsigned u32x2 __attribute__((ext_vector_type(2)));
typedef float f32x2 __attribute__((ext_vector_type(2)));

#ifndef PROBE_DUP
#define PROBE_DUP -1
#endif
#ifndef PROBE_EXTRA_PHASE
#define PROBE_EXTRA_PHASE -1
#endif
#ifndef MK_PER_PHASE
#define MK_PER_PHASE 0
#endif

constexpr int NB = 2, SEQ = 4096, T = NB * SEQ, DM = 4096;
constexpr int AB_COLS = 8256, AB_MAIN = 8192, AB_PAD = 8448;
constexpr int CD_COLS = 11376, CD_MAIN = 11264, CD_PAD = 11520;
constexpr float ALPHA = 1.4142135623730951f;
constexpr float LN_EPS = 1e-5f, RMS_EPS = 1e-6f;
constexpr int NPHASE = 29;

constexpr size_t MiB = 1ull << 20;
constexpr size_t WS_CTL = 0, CTL_BYTES = 1 * MiB;
constexpr size_t WS_ROPE128 = 1 * MiB;
constexpr size_t WS_ROPE64 = 3 * MiB;
constexpr size_t WS_RSQ = 4 * MiB;
constexpr size_t WS_RSKV = 4 * MiB + 65536;
constexpr size_t WS_CUM = 5 * MiB;
constexpr size_t WS_LOGF = 5 * MiB + 524288;
constexpr size_t WS_KR = 6 * MiB;
constexpr size_t WS_KI = 7 * MiB;
constexpr size_t WS_WI = 8 * MiB;
constexpr size_t WS_KVM = 9 * MiB;
constexpr size_t WS_MEMB = 11 * MiB;
constexpr size_t WS_MASK = 15 * MiB;
constexpr size_t WS_PIDX = 19 * MiB;
constexpr size_t WS_PGATE = 23 * MiB;
constexpr size_t WS_MEMQ = 27 * MiB;
constexpr size_t WS_MEMO = 35 * MiB;
constexpr size_t WS_SMALL = 43 * MiB;
constexpr size_t WS_W_AB_IN = 64 * MiB;
constexpr size_t WS_W_UQ = 130 * MiB;
constexpr size_t WS_W_UKV = 139 * MiB;
constexpr size_t WS_W_AB_OUT = 143 * MiB;
constexpr size_t WS_W_CD_IN = 175 * MiB;
constexpr size_t WS_W_CD_OUT = 265 * MiB;
constexpr size_t WS_W_MEM_Q = 297 * MiB;
constexpr size_t WS_W_MEM_KV = 305 * MiB;
constexpr size_t WS_W_MEM_O = 321 * MiB;
constexpr size_t WS_W_PEER = 329 * MiB;
constexpr size_t WS_U8 = 361 * MiB;
constexpr size_t WS_V8 = 489 * MiB;
constexpr size_t WS_USC = 48 * MiB;
constexpr size_t WS_VSC = 48 * MiB + 262144;
constexpr size_t WS_XB = 873 * MiB;
constexpr size_t WS_HF = 937 * MiB;
constexpr size_t WS_RES = 1065 * MiB;
constexpr size_t WS_PROJ = 1193 * MiB;
constexpr size_t WS_PSCORE = WS_PROJ;
constexpr size_t WS_ATT = 1369 * MiB;
constexpr size_t WS_QB = 1433 * MiB;
constexpr size_t WS_KVB = 1481 * MiB;
constexpr size_t WS_SCORE = 1433 * MiB;
constexpr size_t WS_MQP = 1561 * MiB;
constexpr size_t WS_END = 1625 * MiB;

constexpr int LDS_BYTES = 147456;
constexpr int LDS_MISC = 140 * 1024;

#define LDS_WAIT() asm volatile("s_waitcnt lgkmcnt(0)" ::: "memory")
__device__ __forceinline__ float bf2f(bf16_t b) { return __uint_as_float(((unsigned)b) << 16); }
__device__ __forceinline__ unsigned f2bf(float f) { unsigned u = __float_as_uint(f); return (u + 0x7fffu + ((u >> 16) & 1u)) >> 16; }
__device__ __forceinline__ unsigned pk2(float lo, float hi) { return f2bf(lo) | (f2bf(hi) << 16); }
__device__ __forceinline__ float wave_sum(float v) {
#pragma unroll
    for (int o = 1; o < 64; o <<= 1) v += __shfl_xor(v, o);
    return v;
}
__device__ __forceinline__ float wave_max(float v) {
#pragma unroll
    for (int o = 1; o < 64; o <<= 1) v = fmaxf(v, __shfl_xor(v, o));
    return v;
}
__device__ __forceinline__ int wave_sum_i(int v) {
#pragma unroll
    for (int o = 1; o < 64; o <<= 1) v += __shfl_xor(v, o);
    return v;
}

#define XB_TMO      128
#define XB_XCNT(j)  (256  + 64 * (j))
#define XB_XSUB(j)  (1280 + 64 * (j))
#define XB_XGEN(j)  (2304 + 64 * (j))
#define XB_TOP      3328
#define XB_TOPGEN   3392
#define XCD_BAR_WORDS 3456
#define XB_SPIN_CAP (1u << 22)

__device__ __forceinline__ unsigned xb_ld(unsigned* p)              { return __hip_atomic_load(p, __ATOMIC_RELAXED, __HIP_MEMORY_SCOPE_AGENT); }
__device__ __forceinline__ unsigned xb_add(unsigned* p, unsigned v) { return __hip_atomic_fetch_add(p, v, __ATOMIC_RELAXED, __HIP_MEMORY_SCOPE_AGENT); }
__device__ __forceinline__ unsigned xb_xcc_id() { return (unsigned)__builtin_amdgcn_s_getreg((3 << 11) | 20) & 0xFu; }
#define XB_SPIN(cond, bar) do { unsigned _sp = 0; while (cond) { __builtin_amdgcn_s_sleep(1); \
    if ((++_sp & 255u) == 0u) { if (xb_ld(&(bar)[XB_TMO])) break; if (_sp > XB_SPIN_CAP) { atomicAdd(&(bar)[XB_TMO], 1u); break; } } } } while (0)

struct XcdBarrier { unsigned* bar; unsigned x; volatile LAS unsigned* st; };

__device__ __forceinline__ XcdBarrier xcd_barrier_post(unsigned* bar, volatile LAS unsigned* st) {
    XcdBarrier b; b.bar = bar; b.x = xb_xcc_id(); b.st = st;
    if (threadIdx.x == 0) (void)xb_add(&bar[XB_XCNT(b.x)], 1u);
    return b;
}
__device__ __forceinline__ void xcd_barrier_complete(unsigned* bar, unsigned x, unsigned& nloc, unsigned& nx) {
    const unsigned G = gridDim.x * gridDim.y * gridDim.z;
    unsigned sum, cnt, mine, sp = 0u;
    for (;;) {
        sum = 0u; cnt = 0u; mine = 0u;
#pragma unroll
        for (unsigned j = 0; j < 16; ++j) { const unsigned c = xb_ld(&bar[XB_XCNT(j)]); sum += c; cnt += (c > 0u) ? 1u : 0u; mine = (j == x) ? c : mine; }
        if (sum == G) break;
        __builtin_amdgcn_s_sleep(1);
        if ((++sp & 255u) == 0u) { if (xb_ld(&bar[XB_TMO])) break; if (sp > XB_SPIN_CAP) { atomicAdd(&bar[XB_TMO], 1u); break; } }
    }
    nloc = mine > 0u ? mine : 1u; nx = cnt > 0u ? cnt : 1u;
}
__device__ __forceinline__ void xcd_barrier(const XcdBarrier& b) {
    asm volatile("s_waitcnt vmcnt(0)" ::: "memory");
    __syncthreads();
    if (threadIdx.x == 0) {
        unsigned* bar = b.bar;
        __builtin_amdgcn_s_waitcnt(0);
        unsigned nloc = b.st[0], nx = b.st[1];
        if (nloc == 0u) { xcd_barrier_complete(bar, b.x, nloc, nx); b.st[0] = nloc; b.st[1] = nx; }
        const unsigned old = xb_add(&bar[XB_XSUB(b.x)], 1u);
        const unsigned gen = old / nloc;
        if (old + 1u == (gen + 1u) * nloc) {
            __builtin_amdgcn_fence(__ATOMIC_RELEASE, "agent");
            asm volatile("s_waitcnt vmcnt(0)" ::: "memory");
            const unsigned og = xb_add(&bar[XB_TOP], 1u);
            const unsigned tg = og / nx;
            if (og + 1u == (tg + 1u) * nx) xb_add(&bar[XB_TOPGEN], 1u);
            else XB_SPIN(xb_ld(&bar[XB_TOPGEN]) == tg, bar);
            __builtin_amdgcn_fence(__ATOMIC_ACQUIRE, "agent");
            xb_add(&bar[XB_XGEN(b.x)], 1u);
            asm volatile("s_waitcnt vmcnt(0)" ::: "memory");
        } else {
            XB_SPIN(xb_ld(&bar[XB_XGEN(b.x)]) == gen, bar);
            __builtin_amdgcn_fence(__ATOMIC_ACQUIRE, "agent");
            asm volatile("s_waitcnt vmcnt(0)" ::: "memory");
        }
    }
    __syncthreads();
}

namespace pg8 {
constexpr int BM = 256, BK = 64, HALF = 128, HTB = HALF * BK * 2, STAGE_BYTES = 8 * HTB, NXCD = 8, WGM = 8;
__host__ __device__ __forceinline__ int lds_byte(int r, int c) { const int st = (r >> 4) * 2 + (c >> 5), rr = r & 15, cc = c & 31, ob = rr * 64 + cc * 2; return st * 1024 + (ob ^ (((ob >> 9) & 1) << 5)); }
__host__ __device__ __forceinline__ void stage_rc(int b, int& R, int& C) { const int st = b / 1024, sb = b % 1024, swz = sb ^ (((sb >> 9) & 1) << 5); R = (st >> 1) * 16 + swz / 64; C = (st & 1) * 32 + (swz % 64) / 2; }
__host__ __device__ __forceinline__ int perm32(int rho) { const int n = rho >> 4, i = rho & 15; return 8 * (i >> 2) + 4 * n + (i & 3); }
struct Unit { int pm, pn, z; };
struct Gemm { const bf16_t* A; const bf16_t* Bt; int M, N, K, lda, ldb; long zA, zB; int nz; };
struct StaticOrder {
    int nM, nN, nZ, nwg, G, c;
    __device__ void init(int M, int N, int Z, int G_, int c_) { nM = M / BM; nN = N / BM; nZ = Z; nwg = nM * nN * nZ; G = G_; c = c_; }
    __device__ bool next(int i, Unit& u) const {
        const long L = (long)i * G + c; if (L >= nwg) return false;
        int wgid = (int)L; { const int q = nwg / NXCD, r = nwg % NXCD, xcd = wgid % NXCD, off = wgid / NXCD; wgid = (xcd < r ? xcd * (q + 1) : r * (q + 1) + (xcd - r) * q) + off; }
        const int per = nM * nN; u.z = wgid / per; wgid -= u.z * per;
        const int nig = WGM * nN, gid = wgid / nig, fm = gid * WGM, gsz = (nM - fm) < WGM ? (nM - fm) : WGM;
        u.pm = fm + ((wgid % nig) % gsz); u.pn = (wgid % nig) / gsz; return true;
    }
};
__device__ __forceinline__ unsigned cvt_pk_bf16(float lo, float hi) { unsigned r; asm volatile("v_cvt_pk_bf16_f32 %0, %1, %2" : "=v"(r) : "v"(lo), "v"(hi)); return r; }
struct EpiF32 {
    static constexpr bool PERM = false;
    float* C; int ldc; long zC;
    __device__ __forceinline__ void operator()(const f32x4 (&acc)[2][2][4][2], const Unit& u, int wr, int wc, int fr, int fq) const {
        const int row0 = u.pm * BM + wr * 64 + fr, col0 = u.pn * BM + wc * 32 + 4 * fq; float* Cz = C + (size_t)u.z * zC;
#pragma unroll
        for (int ai = 0; ai < 2; ++ai)
#pragma unroll
            for (int m = 0; m < 4; ++m) { float* rowp = Cz + (size_t)(row0 + ai * HALF + m * 16) * ldc + col0;
#pragma unroll
                for (int bj = 0; bj < 2; ++bj)
#pragma unroll
                    for (int n = 0; n < 2; ++n) *(f32x4*)(rowp + bj * HALF + n * 16) = acc[ai][bj][m][n]; }
    }
};
struct EpiResid {
    static constexpr bool PERM = true;
    const bf16_t* base; bf16_t* out; int ldc;
    __device__ __forceinline__ void operator()(const f32x4 (&acc)[2][2][4][2], const Unit& u, int wr, int wc, int fr, int fq) const {
        const int row0 = u.pm * BM + wr * 64 + fr, col0 = u.pn * BM + wc * 32 + 8 * fq;
#pragma unroll
        for (int ai = 0; ai < 2; ++ai)
#pragma unroll
            for (int m = 0; m < 4; ++m) { const size_t off = (size_t)(row0 + ai * HALF + m * 16) * ldc + col0;
#pragma unroll
                for (int bj = 0; bj < 2; ++bj) { const u32x4 bs = *(const u32x4*)(base + off + bj * HALF); const f32x4 v0 = acc[ai][bj][m][0], v1 = acc[ai][bj][m][1];
                    u32x4 wv;
                    wv.x = cvt_pk_bf16(fmaf(ALPHA, __uint_as_float(bs.x << 16), v0[0]), fmaf(ALPHA, __uint_as_float(bs.x & 0xffff0000u), v0[1]));
                    wv.y = cvt_pk_bf16(fmaf(ALPHA, __uint_as_float(bs.y << 16), v0[2]), fmaf(ALPHA, __uint_as_float(bs.y & 0xffff0000u), v0[3]));
                    wv.z = cvt_pk_bf16(fmaf(ALPHA, __uint_as_float(bs.z << 16), v1[0]), fmaf(ALPHA, __uint_as_float(bs.z & 0xffff0000u), v1[1]));
                    wv.w = cvt_pk_bf16(fmaf(ALPHA, __uint_as_float(bs.w << 16), v1[2]), fmaf(ALPHA, __uint_as_float(bs.w & 0xffff0000u), v1[3]));
                    *(u32x4*)(out + off + bj * HALF) = wv; }
                asm volatile("" ::: "memory"); }
    }
};
struct EpiBf16 {
    static constexpr bool PERM = true;
    bf16_t* O; int ldc; const float* rs;
    __device__ __forceinline__ void operator()(const f32x4 (&acc)[2][2][4][2], const Unit& u, int wr, int wc, int fr, int fq) const {
        const int row0 = u.pm * BM + wr * 64 + fr, col0 = u.pn * BM + wc * 32 + 8 * fq;
#pragma unroll
        for (int ai = 0; ai < 2; ++ai)
#pragma unroll
            for (int m = 0; m < 4; ++m) { const int row = row0 + ai * HALF + m * 16; bf16_t* rowp = O + (size_t)row * ldc + col0; const float sc = rs ? rs[row] : 1.f;
#pragma unroll
                for (int bj = 0; bj < 2; ++bj) { const f32x4 v0 = acc[ai][bj][m][0] * sc, v1 = acc[ai][bj][m][1] * sc;
                    u32x4 wv; wv.x = cvt_pk_bf16(v0[0], v0[1]); wv.y = cvt_pk_bf16(v0[2], v0[3]); wv.z = cvt_pk_bf16(v1[0], v1[1]); wv.w = cvt_pk_bf16(v1[2], v1[3]);
                    *(u32x4*)(rowp + bj * HALF) = wv; } }
    }
};
template <class Epi, class Sched>
__device__ __forceinline__ void gemm_phase(LAS unsigned char* lds, const Gemm g, const Sched& S, const Epi& E) {
    const int tid = threadIdx.x, wid = __builtin_amdgcn_readfirstlane(tid >> 6), lane = tid & 63, wr = wid >> 2, wc = wid & 3, fr = lane & 15, fq = lane >> 4;
    const int K = g.K, nt = K / BK;
    unsigned voffA[2], voffB[2];
#pragma unroll
    for (int i = 0; i < 2; ++i) { int R, C; stage_rc(tid * 16 + i * 8192, R, C); const int Rb = Epi::PERM ? ((R & ~31) + perm32(R & 31)) : R;
        voffA[i] = (unsigned)(R * g.lda + C) * 2u; voffB[i] = (unsigned)(Rb * g.ldb + C) * 2u; }
    const size_t kstep = (size_t)(BK * 2);
    const size_t hA = (size_t)HALF * g.lda * 2, hB = (size_t)HALF * g.ldb * 2;
    const size_t tA = 2 * hA, tB = 2 * hB;
    const unsigned ldsw = (unsigned)wid * 1024u;
    const int aoff = lds_byte(wr * 64 + fr, fq * 8), boff = lds_byte(wc * 32 + fr, fq * 8);
#define PG8_SA(b, h) (((b) * 2 + (h)) * HTB)
#define PG8_SB(b, h) ((4 + (b) * 2 + (h)) * HTB)
#define PG8_STAGE(bufoff, gbase, voff) do { _Pragma("unroll") for (int _i = 0; _i < 2; ++_i) \
        __builtin_amdgcn_global_load_lds((const unsigned*)((const char*)(gbase) + (voff)[_i]), (LAS unsigned*)(lds + (bufoff) + ldsw + _i * 8192), 16, 0, 0); } while (0)
#define PG8_LDA(dst, b, h) do { _Pragma("unroll") for (int m = 0; m < 4; ++m) _Pragma("unroll") for (int k = 0; k < 2; ++k) dst[m][k] = *(const LAS bf16x8*)(lds + PG8_SA(b, h) + aoff + m * 2048 + k * 1024); } while (0)
#define PG8_LDB(dst, b, h) do { _Pragma("unroll") for (int n = 0; n < 2; ++n) _Pragma("unroll") for (int k = 0; k < 2; ++k) dst[n][k] = *(const LAS bf16x8*)(lds + PG8_SB(b, h) + boff + n * 2048 + k * 1024); } while (0)
#define PG8_MMA(ai, bj, At, Bt) do { __builtin_amdgcn_s_setprio(1); _Pragma("unroll") for (int m = 0; m < 4; ++m) _Pragma("unroll") for (int n = 0; n < 2; ++n) _Pragma("unroll") for (int k = 0; k < 2; ++k) \
        acc[ai][bj][m][n] = __builtin_amdgcn_mfma_f32_16x16x32_bf16(Bt[n][k], At[m][k], acc[ai][bj][m][n], 0, 0, 0); __builtin_amdgcn_s_setprio(0); } while (0)
#define PG8_WAIT_V(n) asm volatile("s_waitcnt vmcnt(" #n ")" ::: "memory")
#define PG8_WAIT_L(n) asm volatile("s_waitcnt lgkmcnt(" #n ")" ::: "memory")
#define PG8_BAR __builtin_amdgcn_s_barrier()
#define PG8_SCHED __builtin_amdgcn_sched_barrier(0)
    Unit cur, nxt; int ui = 0;
    if (!S.next(0, cur)) return;
    f32x4 acc[2][2][4][2];
#pragma unroll
    for (int a = 0; a < 2; ++a)
#pragma unroll
        for (int b = 0; b < 2; ++b)
#pragma unroll
            for (int m = 0; m < 4; ++m)
#pragma unroll
                for (int n = 0; n < 2; ++n) acc[a][b][m][n] = (f32x4){0.f, 0.f, 0.f, 0.f};
    bf16x8 At[4][2], B0[2][2], B1[2][2];
    const char* cA = (const char*)g.A + (size_t)cur.pm * tA + (size_t)cur.z * g.zA * 2; const char* cB = (const char*)g.Bt + (size_t)cur.pn * tB + (size_t)cur.z * g.zB * 2;
    PG8_STAGE(PG8_SB(0, 0), cB, voffB); PG8_STAGE(PG8_SA(0, 0), cA, voffA); PG8_STAGE(PG8_SB(0, 1), cB + hB, voffB); PG8_STAGE(PG8_SA(0, 1), cA + hA, voffA);
    if (wr == 1) PG8_BAR;
    PG8_WAIT_V(4); PG8_BAR;
    PG8_STAGE(PG8_SB(1, 0), cB + kstep, voffB); PG8_STAGE(PG8_SA(1, 0), cA + kstep, voffA); PG8_STAGE(PG8_SB(1, 1), cB + hB + kstep, voffB);
    PG8_WAIT_V(6); PG8_BAR;
    for (;;) {
        const bool has_next = S.next(ui + 1, nxt);
        const char* nA = has_next ? (const char*)g.A + (size_t)nxt.pm * tA + (size_t)nxt.z * g.zA * 2 : cA; const char* nB = has_next ? (const char*)g.Bt + (size_t)nxt.pn * tB + (size_t)nxt.z * g.zB * 2 : cB;
        for (int t = 0; t < nt; t += 2) {
            const bool last = (t == nt - 2);
            const char* a1 = cA + (size_t)(t + 1) * kstep;
            const char* a2 = last ? nA : cA + (size_t)(t + 2) * kstep; const char* b2 = last ? nB : cB + (size_t)(t + 2) * kstep;
            const char* a3 = a2 + kstep; const char* b3 = b2 + kstep;
            PG8_LDB(B0, 0, 0); PG8_SCHED; PG8_LDA(At, 0, 0); PG8_STAGE(PG8_SA(1, 1), a1 + hA, voffA);
            PG8_WAIT_L(8); PG8_BAR; PG8_WAIT_L(0); PG8_MMA(0, 0, At, B0); PG8_BAR; PG8_SCHED;
            PG8_LDB(B1, 0, 1); PG8_STAGE(PG8_SB(0, 0), b2, voffB);
            PG8_BAR; PG8_WAIT_L(0); PG8_MMA(0, 1, At, B1); PG8_BAR;
            PG8_LDA(At, 0, 1); PG8_STAGE(PG8_SA(0, 0), a2, voffA);
            PG8_BAR; PG8_WAIT_L(0); PG8_MMA(1, 0, At, B0); PG8_BAR; PG8_SCHED;
            PG8_STAGE(PG8_SB(0, 1), b2 + hB, voffB);
            PG8_WAIT_V(6); PG8_BAR; PG8_MMA(1, 1, At, B1); PG8_BAR;
            PG8_LDB(B0, 1, 0); PG8_SCHED; PG8_LDA(At, 1, 0); PG8_STAGE(PG8_SA(0, 1), a2 + hA, voffA);
            PG8_WAIT_L(8); PG8_BAR; PG8_WAIT_L(0); PG8_MMA(0, 0, At, B0); PG8_BAR; PG8_SCHED;
            PG8_LDB(B1, 1, 1); PG8_STAGE(PG8_SB(1, 0), b3, voffB);
            PG8_BAR; PG8_WAIT_L(0); PG8_MMA(0, 1, At, B1); PG8_BAR;
            PG8_LDA(At, 1, 1); PG8_STAGE(PG8_SA(1, 0), a3, voffA);
            PG8_BAR; PG8_WAIT_L(0); PG8_MMA(1, 0, At, B0); PG8_BAR; PG8_SCHED;
            PG8_STAGE(PG8_SB(1, 1), b3 + hB, voffB);
            PG8_WAIT_V(6); PG8_BAR; PG8_MMA(1, 1, At, B1); PG8_BAR;
        }
        E(acc, cur, wr, wc, fr, fq);
        if (!has_next) break;
#pragma unroll
        for (int a = 0; a < 2; ++a)
#pragma unroll
            for (int b = 0; b < 2; ++b)
#pragma unroll
                for (int m = 0; m < 4; ++m)
#pragma unroll
                    for (int n = 0; n < 2; ++n) acc[a][b][m][n] = (f32x4){0.f, 0.f, 0.f, 0.f};
        cur = nxt; cA = nA; cB = nB; ++ui;
    }
    PG8_WAIT_V(0);
    if (wr == 0) PG8_BAR;
    PG8_BAR;
#undef PG8_SA
#undef PG8_SB
#undef PG8_STAGE
#undef PG8_LDA
#undef PG8_LDB
#undef PG8_MMA
#undef PG8_WAIT_V
#undef PG8_WAIT_L
#undef PG8_BAR
#undef PG8_SCHED
}
}

struct Args { const float* in[21]; float* out; unsigned char* ws; int ph_lo, ph_hi; };
enum { I_X = 0, I_MEM, I_AB_W_IN, I_A_REL_BIAS, I_B_Q_NORM, I_B_W_UQ, I_B_KV_NORM, I_B_W_UKV, I_AB_W_OUT, I_CD_W_IN, I_D_FORGET_BIAS, I_CD_W_OUT,
       I_MEM_W_Q, I_MEM_W_KV, I_MEM_W_O, I_PEER_W_Q, I_PEER_SUB_KEYS, I_PEER_U, I_PEER_V, I_LN_G, I_LN_B };

struct WI { int tid, lane, wave, gw, ngw, bid, nblk; };

__device__ __forceinline__ void tr_item(const float* W, int K, int ld, int c0, int nc, bf16_t* WT, int r0, const float* scale, LAS float* scr, int item, int lane) {
    const int nblk = (nc + 63) >> 6, kb = item / nblk, nb = item - kb * nblk, k0 = 64 * kb, n0 = 64 * nb;
    const int ln = (lane & 15) * 4, lk = lane >> 4; const bool ok = n0 + ln < nc;
    const float* src = W + (size_t)(k0 + lk) * ld + c0 + n0 + ln;
    f32x4 v[16];
#pragma unroll
    for (int i = 0; i < 16; ++i) v[i] = ok ? *(const f32x4*)(src + (size_t)(4 * i) * ld) : (f32x4){0.f, 0.f, 0.f, 0.f};
#pragma unroll
    for (int i = 0; i < 16; ++i) { const int kk = lk + 4 * i; const float s = scale ? scale[k0 + kk] : 1.f; LAS float* d = scr + kk * 65 + ln;
        d[0] = v[i].x * s; d[1] = v[i].y * s; d[2] = v[i].z * s; d[3] = v[i].w * s; }
    LDS_WAIT();
    const int c = lane & 7;
#pragma unroll
    for (int j = 0; j < 8; ++j) { const int n = (lane >> 3) + 8 * j; const LAS float* s = scr + (8 * c) * 65 + n;
        u32x4 o; o.x = pk2(s[0 * 65], s[1 * 65]); o.y = pk2(s[2 * 65], s[3 * 65]); o.z = pk2(s[4 * 65], s[5 * 65]); o.w = pk2(s[6 * 65], s[7 * 65]);
        if (n0 + n < nc) *(u32x4*)(WT + (size_t)(r0 + n0 + n) * K + k0 + 8 * c) = o; }
    LDS_WAIT();
}
__device__ __forceinline__ void cvt_rows(const float* src, bf16_t* dst, size_t n, size_t i0, size_t stride) {
    size_t i = i0 * 8;
    for (; i + 3 * stride * 8 < n; i += 4 * stride * 8) {
        f32x4 a[4], b[4];
#pragma unroll
        for (int q = 0; q < 4; ++q) { a[q] = *(const f32x4*)(src + i + q * stride * 8); b[q] = *(const f32x4*)(src + i + q * stride * 8 + 4); }
#pragma unroll
        for (int q = 0; q < 4; ++q) { u32x4 o; o.x = pk2(a[q].x, a[q].y); o.y = pk2(a[q].z, a[q].w); o.z = pk2(b[q].x, b[q].y); o.w = pk2(b[q].z, b[q].w); *(u32x4*)(dst + i + q * stride * 8) = o; }
    }
    for (; i < n; i += stride * 8) {
        const f32x4 a = *(const f32x4*)(src + i), b = *(const f32x4*)(src + i + 4);
        u32x4 o; o.x = pk2(a.x, a.y); o.y = pk2(a.z, a.w); o.z = pk2(b.x, b.y); o.w = pk2(b.z, b.w);
        *(u32x4*)(dst + i) = o;
    }
}
__device__ __forceinline__ void ph_convert(const Args& a, LAS unsigned char* lds, const WI& w) {
    unsigned char* ws = a.ws;
    LAS float* scr = (LAS float*)(lds + w.wave * 16640);
    constexpr int J1 = 64 * 129, J2 = 24 * 48, J3 = 8 * 64, J4 = 64 * 64, J5 = 64 * 80, J6 = 64 * 96, J7 = 64 * 2, J8 = 64 * 1, J9 = 64 * 64,
                  J10 = 64 * 8, J12 = 64 * 16, J14 = 8 * 64;
    constexpr int NJ = J1 + J2 + J3 + J4 + J5 + J6 + J7 + J8 + J9 + 2 * J10 + 2 * J12 + 2 * J14;
    for (int it = w.gw; it < NJ; it += w.ngw) {
        int r = it; const float* src; int K, ld, c0 = 0, nc, r0 = 0; bf16_t* dst; const float* sc = nullptr;
        if (r < J1) { src = a.in[I_AB_W_IN]; K = 4096; ld = AB_COLS; nc = AB_COLS; dst = (bf16_t*)(ws + WS_W_AB_IN); }
        else if ((r -= J1) < J2) { src = a.in[I_B_W_UQ]; K = 1536; ld = 3072; nc = 3072; dst = (bf16_t*)(ws + WS_W_UQ); sc = a.in[I_B_Q_NORM]; }
        else if ((r -= J2) < J3) { src = a.in[I_B_W_UKV]; K = 512; ld = 4096; nc = 4096; dst = (bf16_t*)(ws + WS_W_UKV); sc = a.in[I_B_KV_NORM]; }
        else if ((r -= J3) < J4) { src = a.in[I_AB_W_OUT]; K = 4096; ld = 4096; nc = 4096; dst = (bf16_t*)(ws + WS_W_AB_OUT); }
        else if ((r -= J4) < J5) { src = a.in[I_CD_W_IN]; K = 4096; ld = CD_COLS; c0 = 0; nc = 5120; r0 = 0; dst = (bf16_t*)(ws + WS_W_CD_IN); }
        else if ((r -= J5) < J6) { src = a.in[I_CD_W_IN]; K = 4096; ld = CD_COLS; c0 = 5216; nc = 6144; r0 = 5120; dst = (bf16_t*)(ws + WS_W_CD_IN); }
        else if ((r -= J6) < J7) { src = a.in[I_CD_W_IN]; K = 4096; ld = CD_COLS; c0 = 5120; nc = 96; r0 = 11264; dst = (bf16_t*)(ws + WS_W_CD_IN); }
        else if ((r -= J7) < J8) { src = a.in[I_CD_W_IN]; K = 4096; ld = CD_COLS; c0 = 11360; nc = 16; r0 = 11360; dst = (bf16_t*)(ws + WS_W_CD_IN); }
        else if ((r -= J8) < J9) { src = a.in[I_CD_W_OUT]; K = 4096; ld = 4096; nc = 4096; dst = (bf16_t*)(ws + WS_W_CD_OUT); }
        else if ((r -= J9) < 2 * J10) { const int l = r / J10; r -= l * J10; src = a.in[I_MEM_W_Q] + (size_t)l * 4096 * 512; K = 4096; ld = 512; nc = 512; dst = (bf16_t*)(ws + WS_W_MEM_Q) + (size_t)l * 512 * 4096; }
        else if ((r -= 2 * J10) < 2 * J12) { const int l = r / J12; r -= l * J12; src = a.in[I_MEM_W_KV] + (size_t)l * 4096 * 1024; K = 4096; ld = 1024; nc = 1024; dst = (bf16_t*)(ws + WS_W_MEM_KV) + (size_t)l * 1024 * 4096; }
        else { r -= 2 * J12; const int l = r / J14; r -= l * J14; src = a.in[I_MEM_W_O] + (size_t)l * 512 * 4096; K = 512; ld = 4096; nc = 4096; dst = (bf16_t*)(ws + WS_W_MEM_O) + (size_t)l * 4096 * 512; }
        tr_item(src, K, ld, c0, nc, dst, r0, sc, scr, r, w.lane);
    }
    { const size_t gt = (size_t)w.gw * 64 + w.lane, ng = (size_t)w.ngw * 64;
      bf16_t* p1 = (bf16_t*)(ws + WS_W_AB_IN) + (size_t)AB_COLS * 4096; const size_t n1 = (size_t)(AB_PAD - AB_COLS) * 4096;
      for (size_t i = gt * 8; i < n1; i += ng * 8) *(u32x4*)(p1 + i) = (u32x4){0u, 0u, 0u, 0u};
      bf16_t* p2 = (bf16_t*)(ws + WS_W_CD_IN) + (size_t)CD_COLS * 4096; const size_t n2 = (size_t)(CD_PAD - CD_COLS) * 4096;
      for (size_t i = gt * 8; i < n2; i += ng * 8) *(u32x4*)(p2 + i) = (u32x4){0u, 0u, 0u, 0u};
      cvt_rows(a.in[I_X], (bf16_t*)(ws + WS_XB), (size_t)T * DM, gt, ng);
      cvt_rows(a.in[I_MEM], (bf16_t*)(ws + WS_MEMB), (size_t)512 * DM, gt, ng);
      for (int r = w.gw; r < 65536; r += w.ngw) { const int tbl = r >> 15, rr = r & 32767;
          const float* srow = (tbl ? a.in[I_PEER_V] : a.in[I_PEER_U]) + (size_t)rr * DM + 32 * w.lane;
          unsigned char* dbase = ws + (tbl ? WS_V8 : WS_U8);
          f32x4 v[2][8];
#pragma unroll
          for (int i = 0; i < 2; ++i)
#pragma unroll
              for (int q = 0; q < 8; ++q) v[i][q] = *(const f32x4*)(srow + 2048 * i + 4 * q);
          unsigned scb = 0u;
#pragma unroll
          for (int i = 0; i < 2; ++i) { float bm = 0.f;
#pragma unroll
              for (int q = 0; q < 8; ++q) bm = fmaxf(bm, fmaxf(fmaxf(fabsf(v[i][q].x), fabsf(v[i][q].y)), fmaxf(fabsf(v[i][q].z), fabsf(v[i][q].w))));
              int b = 128; if (bm > 0.f) { b = (int)ceilf(8.f * __log2f(bm * (1.f / 6.f)) + 0.02f) + 128; b = b < 0 ? 0 : (b > 255 ? 255 : b); }
              const float inv = __builtin_amdgcn_exp2f((float)(128 - b) * 0.125f);
              u32x4 o;
#pragma unroll
              for (int d = 0; d < 4; ++d) { unsigned wv = 0u; const f32x4 p0 = v[i][2 * d] * inv, p1 = v[i][2 * d + 1] * inv;
                  wv = __builtin_amdgcn_cvt_scalef32_pk_fp4_f32(wv, p0.x, p0.y, 1.0f, 0); wv = __builtin_amdgcn_cvt_scalef32_pk_fp4_f32(wv, p0.z, p0.w, 1.0f, 1);
                  wv = __builtin_amdgcn_cvt_scalef32_pk_fp4_f32(wv, p1.x, p1.y, 1.0f, 2); wv = __builtin_amdgcn_cvt_scalef32_pk_fp4_f32(wv, p1.z, p1.w, 1.0f, 3); o[d] = wv; }
              *(u32x4*)(dbase + (size_t)rr * 2048 + 1024 * i + 16 * w.lane) = o;
              scb |= (unsigned)b << (8 * i); }
          ((unsigned short*)(dbase + 64 * MiB))[(size_t)rr * 64 + w.lane] = (unsigned short)scb; }
      float* r128 = (float*)(ws + WS_ROPE128); float* r64 = (float*)(ws + WS_ROPE64);
      for (size_t i = gt; i < (size_t)SEQ * 96; i += ng) {
          const int s = (int)(i / 96), j = (int)(i % 96); const bool big = j < 64; const int ii = big ? j : j - 64;
          const double rr = big ? 0.8659643233600653 : 0.7498942093324559; double inv = 1.0;
          for (int q = 0; q < ii; ++q) inv *= rr;
          const double rev = (double)s * inv * 0.15915494309189535; const float fr = (float)(rev - rint(rev));
          const float cs = __builtin_amdgcn_cosf(fr), sn = __builtin_amdgcn_sinf(fr);
          float* o = big ? (r128 + ((size_t)s * 64 + ii) * 2) : (r64 + ((size_t)s * 32 + ii) * 2);
          o[0] = cs; o[1] = sn; }
    }
    {
        LAS float* Ks = (LAS float*)lds; LAS float* Ws = Ks + 128 * 129;
        const int tk = w.tid & 31, tn = w.tid >> 5;
        for (int it = w.bid; it < 2 * 16 * 32; it += w.nblk) {
            const int l = it >> 9, hp = (it >> 5) & 15, kb = it & 31;
            __syncthreads();
            const float* keys = a.in[I_PEER_SUB_KEYS] + ((size_t)(l * 16 + hp) * 128) * 128;
            const float* wq = a.in[I_PEER_W_Q] + ((size_t)l * 4096 + (size_t)kb * 128) * 2048 + hp * 128;
            for (int e = w.tid; e < 128 * 128; e += 512) { const int rrow = e >> 7, d = e & 127; Ks[rrow * 129 + d] = keys[(size_t)rrow * 128 + d]; Ws[rrow * 129 + d] = wq[(size_t)rrow * 2048 + d]; }
            __syncthreads();
            float acc[8][4];
#pragma unroll
            for (int x = 0; x < 8; ++x)
#pragma unroll
                for (int y = 0; y < 4; ++y) acc[x][y] = 0.f;
            for (int d = 0; d < 128; ++d) {
                float kv[8], wv[4];
#pragma unroll
                for (int x = 0; x < 8; ++x) kv[x] = Ks[(tn + 16 * x) * 129 + d];
#pragma unroll
                for (int y = 0; y < 4; ++y) wv[y] = Ws[(tk + 32 * y) * 129 + d];
#pragma unroll
                for (int x = 0; x < 8; ++x)
#pragma unroll
                    for (int y = 0; y < 4; ++y) acc[x][y] += kv[x] * wv[y];
            }
            bf16_t* dst = (bf16_t*)(ws + WS_W_PEER) + ((size_t)l * 2048 + hp * 128) * 4096 + kb * 128;
#pragma unroll
            for (int x = 0; x < 8; ++x)
#pragma unroll
                for (int y = 0; y < 4; ++y) dst[(size_t)(tn + 16 * x) * 4096 + tk + 32 * y] = (bf16_t)f2bf(acc[x][y]);
        }
        __syncthreads();
    }
}

__device__ __forceinline__ int crow(int r, int hi) { return (r & 3) + 8 * (r >> 2) + 4 * hi; }
template <class F>
__device__ __forceinline__ void naive_gemm(const bf16_t* A, int lda, const bf16_t* Bt, int ldb, int M, int N, int K, const WI& w, F epi) {
    const int tm = M >> 5, tn = (N + 31) >> 5;
    const int i = w.lane & 31, g = w.lane >> 5;
    for (int tile = w.gw; tile < tm * tn; tile += w.ngw) {
        const int bn = tile / tm, bm = tile - bn * tm;
        const bf16_t* ap = A + (size_t)(bm * 32 + i) * lda + 8 * g;
        const int nrow = bn * 32 + i; const bool nv = nrow < N;
        const bf16_t* bp = Bt + (size_t)(nv ? nrow : 0) * ldb + 8 * g;
        f32x16 acc = {};
#pragma unroll 4
        for (int k = 0; k < K; k += 16) {
            const bf16x8 av = *(const bf16x8*)(ap + k);
            bf16x8 bv = *(const bf16x8*)(bp + k);
            if (!nv) bv = (bf16x8){0, 0, 0, 0, 0, 0, 0, 0};
            acc = __builtin_amdgcn_mfma_f32_32x32x16_bf16(av, bv, acc, 0, 0, 0);
        }
#pragma unroll
        for (int r = 0; r < 16; ++r) { const int row = bm * 32 + crow(r, g), col = bn * 32 + i; if (col < N) epi(row, col, acc[r]); }
    }
}

__device__ __forceinline__ void ln_rows(const bf16_t* src, const float* g, const float* b, bf16_t* dstb, const WI& w) {
    for (int m = w.gw; m < T; m += w.ngw) {
        const u32x4* xr = (const u32x4*)(src + (size_t)m * DM) + w.lane;
        float v[64]; float s = 0.f;
#pragma unroll
        for (int j = 0; j < 8; ++j) { const u32x4 x = xr[64 * j];
#pragma unroll
            for (int e = 0; e < 4; ++e) { v[8 * j + 2 * e] = __uint_as_float(x[e] << 16); v[8 * j + 2 * e + 1] = __uint_as_float(x[e] & 0xffff0000u); s += v[8 * j + 2 * e] + v[8 * j + 2 * e + 1]; } }
        const float mean = wave_sum(s) * (1.f / DM); float s2 = 0.f;
#pragma unroll
        for (int i = 0; i < 64; ++i) { v[i] -= mean; s2 += v[i] * v[i]; }
        const float rstd = 1.f / sqrtf(wave_sum(s2) * (1.f / DM) + LN_EPS);
#pragma unroll
        for (int j = 0; j < 8; ++j) { const int c = 8 * w.lane + 512 * j;
            const f32x4 g0 = *(const f32x4*)(g + c), g1 = *(const f32x4*)(g + c + 4), b0 = *(const f32x4*)(b + c), b1 = *(const f32x4*)(b + c + 4);
            u32x4 p;
            p.x = pk2(v[8 * j + 0] * rstd * g0.x + b0.x, v[8 * j + 1] * rstd * g0.y + b0.y); p.y = pk2(v[8 * j + 2] * rstd * g0.z + b0.z, v[8 * j + 3] * rstd * g0.w + b0.w);
            p.z = pk2(v[8 * j + 4] * rstd * g1.x + b1.x, v[8 * j + 5] * rstd * g1.y + b1.y); p.w = pk2(v[8 * j + 6] * rstd * g1.z + b1.z, v[8 * j + 7] * rstd * g1.w + b1.w);
            *(u32x4*)(dstb + (size_t)m * DM + c) = p; }
    }
}

template <int MODE>
__device__ __forceinline__ void attn_naive(const Args& a, int layer, LAS float* qs, const WI& w) {
    constexpr int H = (MODE == 4) ? 4 : 16, DK = (MODE == 1) ? 192 : 128;
    const float scale = (MODE == 1) ? 0.07216878364870322f : 0.08838834764831845f;
    unsigned char* ws = a.ws;
    const float NEG = -__builtin_inff();
    for (int it = w.gw; it < T * H; it += w.ngw) {
        const int h = it / T, t = it - h * T, b = t / SEQ, sp = t - b * SEQ, c = sp >> 6;
        const bf16_t* qp; const bf16_t* kbase; const bf16_t* vbase; int ldk, ldv; bf16_t* op;
        int s_lo = 0, s_hi;
        if (MODE == 0) { const bf16_t* P = (const bf16_t*)(ws + WS_PROJ); qp = P + (size_t)t * AB_MAIN + h * 128; kbase = P + (size_t)b * SEQ * AB_MAIN + 2048 + h * 128; vbase = kbase + 2048; ldk = ldv = AB_MAIN;
            op = (bf16_t*)(ws + WS_ATT) + (size_t)t * DM + h * 128; s_lo = (c - 8) * 64; if (s_lo < 0) s_lo = 0; s_hi = (c + 1) * 64; }
        else if (MODE == 1) { qp = (const bf16_t*)(ws + WS_QB) + (size_t)t * 3072 + h * 192; kbase = (const bf16_t*)(ws + WS_KVB) + (size_t)b * SEQ * 4096 + h * 256; vbase = kbase + 128; ldk = ldv = 4096;
            op = (bf16_t*)(ws + WS_ATT) + (size_t)t * DM + 2048 + h * 128; s_hi = (c + 1) * 64; }
        else if (MODE == 2) { const bf16_t* P = (const bf16_t*)(ws + WS_PROJ); qp = P + (size_t)t * CD_MAIN + h * 128; kbase = P + (size_t)b * SEQ * CD_MAIN + 2048 + (h >> 2) * 128; vbase = kbase + 512; ldk = ldv = CD_MAIN;
            op = (bf16_t*)(ws + WS_ATT) + (size_t)t * DM + h * 128; s_hi = (c + 1) * 64; }
        else if (MODE == 3) { const bf16_t* P = (const bf16_t*)(ws + WS_PROJ); qp = P + (size_t)t * CD_MAIN + 5120 + h * 128; kbase = P + (size_t)b * SEQ * CD_MAIN + 7168 + h * 128; vbase = kbase + 2048; ldk = ldv = CD_MAIN;
            op = (bf16_t*)(ws + WS_ATT) + (size_t)t * DM + 2048 + h * 128; s_hi = sp + 1; }
        else { qp = (const bf16_t*)(ws + WS_MEMQ) + (size_t)t * 512 + h * 128; kbase = (const bf16_t*)(ws + WS_KVM) + ((size_t)layer * 512 + b * 256) * 1024 + h * 128; vbase = kbase + 512; ldk = ldv = 1024;
            op = (bf16_t*)(ws + WS_MEMO) + (size_t)t * 512 + h * 128; s_hi = 256; }
        LDS_WAIT();
        if (MODE == 4) { const float* mq = (const float*)(ws + WS_MQP) + (size_t)t * 512 + h * 128;
            for (int d = w.lane; d < DK; d += 64) qs[d] = bf2f((bf16_t)f2bf((mq[d] + mq[d + (size_t)T * 512]) + (mq[d + (size_t)2 * T * 512] + mq[d + (size_t)3 * T * 512]))); }
        else for (int d = w.lane; d < DK; d += 64) qs[d] = bf2f(qp[d]);
        LDS_WAIT();
        const float* cum = (const float*)(ws + WS_CUM) + ((size_t)b * 16 + h) * SEQ;
        const float ct = (MODE == 3) ? cum[sp] : 0.f;
        const float* relb = a.in[I_A_REL_BIAS] + h * 513;
        const unsigned* mrow = (const unsigned*)(ws + WS_MASK) + (size_t)t * 128;
        float m = NEG, l = 0.f, o0 = 0.f, o1 = 0.f;
        for (int s0 = s_lo; s0 < s_hi; s0 += 64) {
            const int s = s0 + w.lane; bool valid = s < s_hi;
            if (MODE == 2) { if (valid) valid = (mrow[s >> 5] >> (s & 31)) & 1u; }
            float x = NEG;
            if (valid) {
                const bf16_t* kp = kbase + (size_t)s * ldk; float acc = 0.f;
#pragma unroll 4
                for (int d0 = 0; d0 < 128; d0 += 8) { const bf16x8 kv = *(const bf16x8*)(kp + d0);
#pragma unroll
                    for (int e = 0; e < 8; ++e) acc += qs[d0 + e] * bf2f((bf16_t)kv[e]); }
                if (MODE == 1) { const bf16_t* kr = (const bf16_t*)(ws + WS_KR) + ((size_t)b * SEQ + s) * 64;
#pragma unroll 4
                    for (int d0 = 0; d0 < 64; d0 += 8) { const bf16x8 kv = *(const bf16x8*)(kr + d0);
#pragma unroll
                        for (int e = 0; e < 8; ++e) acc += qs[128 + d0 + e] * bf2f((bf16_t)kv[e]); } }
                x = acc * scale;
                if (MODE == 0) { int rel = sp - s; rel = rel < -256 ? -256 : (rel > 256 ? 256 : rel); x += relb[rel + 256]; }
                if (MODE == 3) x += ct - cum[s];
            }
            const float mx = wave_max(x);
            if (mx == NEG) continue;
            const float mn = fmaxf(m, mx); const float p = valid ? __expf(x - mn) : 0.f; const float al = __expf(m - mn);
            l = l * al + wave_sum(p); o0 *= al; o1 *= al; m = mn;
            for (int j = 0; j < 64; ++j) { const float pj = __shfl(p, j);
                if (pj != 0.f) { const bf16_t* vp = vbase + (size_t)(s0 + j) * ldv; o0 += pj * bf2f(vp[w.lane]); o1 += pj * bf2f(vp[w.lane + 64]); } }
        }
        const float rl = 1.f / l;
        op[w.lane] = (bf16_t)f2bf(o0 * rl); op[w.lane + 64] = (bf16_t)f2bf(o1 * rl);
    }
}

namespace fa {
constexpr int SHM_V = 64 * 128 * 2;
constexpr int LDS_V = 0, LDS_K = 2 * SHM_V, LDS_WS = LDS_K + 2 * 64 * 384, LDS_RELB = LDS_WS + 8 * 64 * 4, LDS_CS = LDS_RELB + 2304, LDS_END = LDS_CS + 512;
#define FA_KSWZ(row, colB, RS) ((row) * (RS) + ((colB) ^ (((row) & 7) << 4)))
__device__ __forceinline__ int v_st(int k, int c) { const int kk = (k & ~0xC) | ((k & 4) << 1) | ((k & 8) >> 1); return ((kk >> 3) * 4 + (c >> 5)) * 512 + ((kk & 7) * 32 + (c & 31)) * 2; }
__device__ __forceinline__ int v_rd_base(int lane) { return ((lane & 3) << 3) | (((lane >> 2) & 3) << 6) | (((lane >> 4) & 1) << 5) | (((lane >> 5) & 1) << 8); }
__device__ __forceinline__ unsigned cvtpk(float lo, float hi) { unsigned r; asm volatile("v_cvt_pk_bf16_f32 %0, %1, %2" : "=v"(r) : "v"(lo), "v"(hi)); return r; }
typedef short s16x4 __attribute__((ext_vector_type(4)));

template <int DK>
__device__ __forceinline__ void qkt(f32x16& p0, f32x16& p1, LAS const char* Kb, int r32, int hi, const bf16x8* qr) {
    constexpr int RS = DK * 2;
    p0 = f32x16{}; p1 = f32x16{};
    LAS const char* kb[4];
#pragma unroll
    for (int dd = 0; dd < 4; ++dd) kb[dd] = Kb + FA_KSWZ(r32, (dd * 16 + hi * 8) * 2, RS);
#pragma unroll
    for (int d0 = 0; d0 < DK / 16; ++d0) { LAS const char* ap = kb[d0 & 3] + (d0 >> 2) * 128;
        const bf16x8 b0 = *(LAS const bf16x8*)ap;
        const bf16x8 b1 = *(LAS const bf16x8*)(ap + 32 * RS);
        p0 = __builtin_amdgcn_mfma_f32_32x32x16_bf16(b0, qr[d0], p0, 0, 0, 0);
        p1 = __builtin_amdgcn_mfma_f32_32x32x16_bf16(b1, qr[d0], p1, 0, 0, 0); }
}
__device__ __forceinline__ void pv_tile(f32x16* o, int vb0, bf16x8 pa0, bf16x8 pa1, bf16x8 pa2, bf16x8 pa3) {
#define FA_TRRD(dst, off) asm volatile("ds_read_b64_tr_b16 %0, %1 offset:%2" : "=&v"(dst) : "v"(vb0), "i"(off) : "memory")
#define FA_PV_D0(d0) do { s16x4 l0, l1, l2, l3, h0, h1, h2, h3; constexpr int b_ = (d0) * 512; \
        FA_TRRD(l0, b_); FA_TRRD(h0, b_ + 2048); FA_TRRD(l1, b_ + 4096); FA_TRRD(h1, b_ + 6144); FA_TRRD(l2, b_ + 8192); FA_TRRD(h2, b_ + 10240); FA_TRRD(l3, b_ + 12288); FA_TRRD(h3, b_ + 14336); \
        asm volatile("s_waitcnt lgkmcnt(0)" ::: "memory"); __builtin_amdgcn_sched_barrier(0); \
        o[d0] = __builtin_amdgcn_mfma_f32_32x32x16_bf16(pa0, (bf16x8){l0[0], l0[1], l0[2], l0[3], h0[0], h0[1], h0[2], h0[3]}, o[d0], 0, 0, 0); \
        o[d0] = __builtin_amdgcn_mfma_f32_32x32x16_bf16(pa1, (bf16x8){l1[0], l1[1], l1[2], l1[3], h1[0], h1[1], h1[2], h1[3]}, o[d0], 0, 0, 0); \
        o[d0] = __builtin_amdgcn_mfma_f32_32x32x16_bf16(pa2, (bf16x8){l2[0], l2[1], l2[2], l2[3], h2[0], h2[1], h2[2], h2[3]}, o[d0], 0, 0, 0); \
        o[d0] = __builtin_amdgcn_mfma_f32_32x32x16_bf16(pa3, (bf16x8){l3[0], l3[1], l3[2], l3[3], h3[0], h3[1], h3[2], h3[3]}, o[d0], 0, 0, 0); } while (0)
    FA_PV_D0(0); FA_PV_D0(1); FA_PV_D0(2); FA_PV_D0(3);
#undef FA_PV_D0
#undef FA_TRRD
}
__device__ __forceinline__ void softmax_tile(f32x16& p0, f32x16& p1, float& m_reg, float& l_reg, float& alpha, bf16x8& pa0, bf16x8& pa1, bf16x8& pa2, bf16x8& pa3) {
    float pmax = p0[0];
#pragma unroll
    for (int r = 1; r < 16; ++r) pmax = fmaxf(pmax, p0[r]);
#pragma unroll
    for (int r = 0; r < 16; ++r) pmax = fmaxf(pmax, p1[r]);
    { auto rr = __builtin_amdgcn_permlane32_swap(__float_as_uint(pmax), __float_as_uint(pmax), false, false);
      pmax = fmaxf(__uint_as_float(rr[0]), __uint_as_float(rr[1])); }
    const float mn = fmaxf(m_reg, pmax); alpha = __builtin_amdgcn_exp2f(m_reg - mn); m_reg = mn;
#pragma unroll
    for (int r = 0; r < 16; ++r) { p0[r] = __builtin_amdgcn_exp2f(p0[r] - mn); p1[r] = __builtin_amdgcn_exp2f(p1[r] - mn); }
    float ps = 0.f;
#pragma unroll
    for (int r = 0; r < 16; ++r) ps += p0[r];
#pragma unroll
    for (int r = 0; r < 16; ++r) ps += p1[r];
    { auto rr = __builtin_amdgcn_permlane32_swap(__float_as_uint(ps), __float_as_uint(ps), false, false);
      ps = __uint_as_float(rr[0]) + __uint_as_float(rr[1]); }
    l_reg = l_reg * alpha + ps;
#define FA_PK4(P, B_, OUT) do { unsigned a0 = cvtpk(P[B_+0], P[B_+1]), a1 = cvtpk(P[B_+2], P[B_+3]); \
        unsigned b0 = cvtpk(P[B_+4], P[B_+5]), b1 = cvtpk(P[B_+6], P[B_+7]); \
        auto r0 = __builtin_amdgcn_permlane32_swap(a0, b0, false, false); auto r1 = __builtin_amdgcn_permlane32_swap(a1, b1, false, false); \
        u32x4 wv = {r0[0], r1[0], r0[1], r1[1]}; OUT = *reinterpret_cast<bf16x8*>(&wv); } while (0)
    FA_PK4(p0, 0, pa0); FA_PK4(p0, 8, pa1); FA_PK4(p1, 0, pa2); FA_PK4(p1, 8, pa3);
#undef FA_PK4
}

template <int MODE>
__device__ __forceinline__ void attn_unit(const Args& a, int layer, LAS unsigned char* lds, int b, int h, int qb) {
    constexpr int DK = (MODE == 1) ? 192 : 128, RS = DK * 2, SHM_K = 64 * RS, NQ = DK / 16;
    constexpr float C2 = (MODE == 1) ? 1.4426950408889634f * 0.07216878364870322f : 1.4426950408889634f * 0.08838834764831845f;
    constexpr float L2E = 1.4426950408889634f;
    unsigned char* ws = a.ws;
    const int tid = threadIdx.x, wid = __builtin_amdgcn_readfirstlane(tid >> 6), lane = tid & 63, r32 = lane & 31, hi = lane >> 5;
    const int P0 = qb * 256, qlo = P0 + wid * 32, row = qlo + r32, cw = qlo >> 6;
    const size_t tb = (size_t)b * SEQ;
    const float NEG = -__builtin_inff();
    const bf16_t* Kg; const bf16_t* Vg; int ldk, ldv; bf16_t* Og; int ldo; int j_lo = 0, j_hi;
    if (MODE == 0) { const bf16_t* P = (const bf16_t*)(ws + WS_PROJ); Kg = P + tb * AB_MAIN + 2048 + h * 128; Vg = Kg + 2048; ldk = ldv = AB_MAIN; Og = (bf16_t*)(ws + WS_ATT) + (tb + qlo) * DM + h * 128; ldo = DM;
        j_lo = (P0 >> 6) - 8; if (j_lo < 0) j_lo = 0; j_hi = (P0 >> 6) + 4; }
    else if (MODE == 1) { Kg = (const bf16_t*)(ws + WS_KVB) + tb * 4096 + h * 256; Vg = Kg + 128; ldk = ldv = 4096; Og = (bf16_t*)(ws + WS_ATT) + (tb + qlo) * DM + 2048 + h * 128; ldo = DM; j_hi = (P0 >> 6) + 4; }
    else if (MODE == 2) { const bf16_t* P = (const bf16_t*)(ws + WS_PROJ); Kg = P + tb * CD_MAIN + 2048 + (h >> 2) * 128; Vg = Kg + 512; ldk = ldv = CD_MAIN; Og = (bf16_t*)(ws + WS_ATT) + (tb + qlo) * DM + h * 128; ldo = DM; j_hi = (P0 >> 6) + 4; }
    else if (MODE == 3) { const bf16_t* P = (const bf16_t*)(ws + WS_PROJ); Kg = P + tb * CD_MAIN + 7168 + h * 128; Vg = Kg + 2048; ldk = ldv = CD_MAIN; Og = (bf16_t*)(ws + WS_ATT) + (tb + qlo) * DM + 2048 + h * 128; ldo = DM; j_hi = (P0 >> 6) + 4; }
    else { Kg = (const bf16_t*)(ws + WS_KVM) + ((size_t)layer * 512 + b * 256) * 1024 + h * 128; Vg = Kg + 512; ldk = ldv = 1024; Og = (bf16_t*)(ws + WS_MEMO) + (tb + qlo) * 512 + h * 128; ldo = 512; j_hi = 4; }
    const int NT = j_hi - j_lo;
    bf16x8 qr[NQ];
    if (MODE == 4) { const float* mq = (const float*)(ws + WS_MQP) + (tb + row) * 512 + h * 128;
#pragma unroll
        for (int d0 = 0; d0 < NQ; ++d0) { const float* p = mq + d0 * 16 + hi * 8; f32x4 s0 = {0.f, 0.f, 0.f, 0.f}, s1 = s0;
#pragma unroll
            for (int z = 0; z < 4; ++z) { s0 += *(const f32x4*)(p + (size_t)z * T * 512); s1 += *(const f32x4*)(p + (size_t)z * T * 512 + 4); }
            u32x4 wv = {cvtpk(s0[0], s0[1]), cvtpk(s0[2], s0[3]), cvtpk(s1[0], s1[1]), cvtpk(s1[2], s1[3])}; qr[d0] = *reinterpret_cast<bf16x8*>(&wv); } }
    else { const bf16_t* Qg;
        if (MODE == 0) Qg = (const bf16_t*)(ws + WS_PROJ) + (tb + row) * AB_MAIN + h * 128;
        else if (MODE == 1) Qg = (const bf16_t*)(ws + WS_QB) + (tb + row) * 3072 + h * 192;
        else if (MODE == 2) Qg = (const bf16_t*)(ws + WS_PROJ) + (tb + row) * CD_MAIN + h * 128;
        else Qg = (const bf16_t*)(ws + WS_PROJ) + (tb + row) * CD_MAIN + 5120 + h * 128;
#pragma unroll
        for (int d0 = 0; d0 < NQ; ++d0) qr[d0] = *(const bf16x8*)(Qg + d0 * 16 + hi * 8); }
    LAS char* V_lds = (LAS char*)lds + LDS_V; LAS char* K_lds = (LAS char*)lds + LDS_K;
    LAS float* wsc = (LAS float*)(lds + LDS_WS) + wid * 64; LAS float* relb = (LAS float*)(lds + LDS_RELB); LAS float* csl = (LAS float*)(lds + LDS_CS);
    const int vbase = (int)(unsigned)(uintptr_t)V_lds + v_rd_base(lane);
    const bf16_t* KRg = (const bf16_t*)(ws + WS_KR) + tb * 64;
    const float* cum = (const float*)(ws + WS_CUM) + ((size_t)b * 16 + h) * SEQ;
    const unsigned* mrow = (const unsigned*)(ws + WS_MASK) + (tb + row) * 128;
    float ctl = 0.f; if (MODE == 3) ctl = cum[row] * L2E;
    if (MODE == 0) { const float* rb = a.in[I_A_REL_BIAS] + h * 513; for (int i = tid; i < 513; i += 512) relb[i] = rb[i] * L2E; }
    float m_reg = -1e30f, l_reg = 0.f; f32x16 o[4] = {};
    unsigned mk0 = 0u, mk1 = 0u; float st_cs = 0.f;
    constexpr int NKI = (DK == 192) ? 3 : 2;
    int koff[NKI]; bool krope[NKI]; int voff[2];
#pragma unroll
    for (int i = 0; i < NKI; ++i) { const int off = (wid * NKI + i) * 1024 + lane * 16; const int rw = off / RS, sw = off - rw * RS, cb = sw ^ ((rw & 7) << 4);
        krope[i] = (DK == 192) && (cb >= 256); koff[i] = krope[i] ? rw * 64 + ((cb - 256) >> 1) : rw * ldk + (cb >> 1); }
#pragma unroll
    for (int i = 0; i < 2; ++i) { const int off = (wid * 2 + i) * 1024 + lane * 16; const int sub = off >> 9, within = off & 511, kk = ((sub >> 2) << 3) | (within >> 6);
        const int k = (kk & ~0xC) | ((kk & 4) << 1) | ((kk & 8) >> 1), c = (sub & 3) * 32 + ((within & 63) >> 1); voff[i] = k * ldv + c; }
#define FA_DMA(j, bf) do { const int k0_ = (j) * 64; \
        _Pragma("unroll") for (int i_ = 0; i_ < NKI; ++i_) { const bf16_t* s_ = (DK == 192 && krope[i_]) ? (KRg + (size_t)k0_ * 64 + koff[i_]) : (Kg + (size_t)k0_ * ldk + koff[i_]); \
            __builtin_amdgcn_global_load_lds((const unsigned*)s_, (LAS unsigned*)(K_lds + (bf) * SHM_K + (wid * NKI + i_) * 1024), 16, 0, 0); } \
        _Pragma("unroll") for (int i_ = 0; i_ < 2; ++i_) \
            __builtin_amdgcn_global_load_lds((const unsigned*)(Vg + (size_t)k0_ * ldv + voff[i_]), (LAS unsigned*)(V_lds + (bf) * SHM_V + (wid * 2 + i_) * 1024), 16, 0, 0); \
        if (MODE == 3) { if (tid < 64) st_cs = cum[k0_ + tid] * L2E; } } while (0)
#define FA_CSW(bf) do { if (MODE == 3) { if (tid < 64) csl[(bf) * 64 + tid] = st_cs; } } while (0)
    __syncthreads();
    FA_DMA(j_lo, 0); asm volatile("s_waitcnt vmcnt(0)" ::: "memory"); FA_CSW(0);
    __syncthreads();
#pragma unroll 1
    for (int t = 0; t < NT; ++t) {
        const int buf = t & 1, j = j_lo + t, kbp = j * 64;
        if (t + 1 < NT) FA_DMA(j + 1, buf ^ 1);
        bool act;
        if (MODE == 0) act = (j >= cw - 8) && (j <= cw);
        else if (MODE == 1 || MODE == 2) act = (j <= cw);
        else if (MODE == 3) act = (kbp <= qlo + 31);
        else act = true;
        if (MODE == 2) { if (act) { const u32x2 mm = *(const u32x2*)(mrow + 2 * j); mk0 = mm.x; mk1 = mm.y; } }
        if (act) {
            f32x16 p0, p1;
            qkt<DK>(p0, p1, K_lds + buf * SHM_K, r32, hi, qr);
            if (MODE == 0) {
                if (qlo - (kbp + 63) >= 256) { const float bf_ = relb[512];
#pragma unroll
                    for (int r = 0; r < 16; ++r) { p0[r] = fmaf(p0[r], C2, bf_); p1[r] = fmaf(p1[r], C2, bf_); } }
                else { const int dq = row - kbp - 4 * hi;
#pragma unroll
                    for (int r = 0; r < 16; ++r) { const int c = (r & 3) + 8 * (r >> 2);
                        int i0 = dq - c; i0 = i0 < -256 ? -256 : (i0 > 256 ? 256 : i0); int i1 = dq - c - 32; i1 = i1 < -256 ? -256 : (i1 > 256 ? 256 : i1);
                        p0[r] = fmaf(p0[r], C2, relb[i0 + 256]); p1[r] = fmaf(p1[r], C2, relb[i1 + 256]);
                        if ((r & 3) == 3) __builtin_amdgcn_sched_barrier(0); } }
            } else if (MODE == 3) {
                LAS const float* cs = csl + buf * 64 + 4 * hi;
#pragma unroll
                for (int q4 = 0; q4 < 4; ++q4) { const f32x4 c0 = *(LAS const f32x4*)(cs + 8 * q4), c1 = *(LAS const f32x4*)(cs + 32 + 8 * q4);
#pragma unroll
                    for (int e = 0; e < 4; ++e) { p0[4 * q4 + e] = fmaf(p0[4 * q4 + e], C2, ctl - c0[e]); p1[4 * q4 + e] = fmaf(p1[4 * q4 + e], C2, ctl - c1[e]); }
                    __builtin_amdgcn_sched_barrier(0); }
                if (kbp + 63 > qlo) { const int dq = row - kbp - 4 * hi;
#pragma unroll
                    for (int r = 0; r < 16; ++r) { const int c = (r & 3) + 8 * (r >> 2); if (dq - c < 0) p0[r] = NEG; if (dq - c - 32 < 0) p1[r] = NEG; } }
            } else {
#pragma unroll
                for (int r = 0; r < 16; ++r) { p0[r] *= C2; p1[r] *= C2; }
                if (MODE == 2) {
#pragma unroll
                    for (int r = 0; r < 16; ++r) { const int c = (r & 3) + 8 * (r >> 2) + 4 * hi; if (!((mk0 >> c) & 1u)) p0[r] = NEG; if (!((mk1 >> c) & 1u)) p1[r] = NEG; } }
            }
            float alpha; bf16x8 pa0, pa1, pa2, pa3;
            softmax_tile(p0, p1, m_reg, l_reg, alpha, pa0, pa1, pa2, pa3);
            if (__any(alpha < 1.f)) { if (hi == 0) wsc[r32] = alpha; LDS_WAIT();
#pragma unroll
                for (int r = 0; r < 16; ++r) { const float al = wsc[crow(r, hi)];
#pragma unroll
                    for (int d_ = 0; d_ < 4; ++d_) o[d_][r] *= al;
                    if ((r & 3) == 3) __builtin_amdgcn_sched_barrier(0); }
                LDS_WAIT(); }
            pv_tile(o, vbase + buf * SHM_V, pa0, pa1, pa2, pa3);
        }
        asm volatile("s_waitcnt vmcnt(0)" ::: "memory");
        if (t + 1 < NT) FA_CSW(buf ^ 1);
        __syncthreads();
    }
#undef FA_DMA
#undef FA_CSW
    if (hi == 0) wsc[32 + r32] = l_reg; LDS_WAIT();
#pragma unroll
    for (int r = 0; r < 16; ++r) { const int orow = crow(r, hi); const float rl = __builtin_amdgcn_rcpf(wsc[32 + orow]);
#pragma unroll
        for (int d0 = 0; d0 < 4; ++d0) { const float v = o[d0][r] * rl; const float vn = __shfl_xor(v, 1);
            if ((r32 & 1) == 0) *(unsigned*)(Og + (size_t)orow * ldo + d0 * 32 + r32) = cvtpk(v, vn); } }
    LDS_WAIT();
}
}

__device__ __forceinline__ void rope_pair(float& x1, float& x2, float cs, float sn) { const float a = x1 * cs - x2 * sn, b = x2 * cs + x1 * sn; x1 = a; x2 = b; }
__device__ __forceinline__ void rope8(u32x4& x1, u32x4& x2, const float* tab) {
    const f32x4 t0 = *(const f32x4*)tab, t1 = *(const f32x4*)(tab + 4), t2 = *(const f32x4*)(tab + 8), t3 = *(const f32x4*)(tab + 12);
    const float cs[8] = {t0.x, t0.z, t1.x, t1.z, t2.x, t2.z, t3.x, t3.z}, sn[8] = {t0.y, t0.w, t1.y, t1.w, t2.y, t2.w, t3.y, t3.w};
    float a[8], b[8];
#pragma unroll
    for (int e = 0; e < 4; ++e) { a[2 * e] = __uint_as_float(x1[e] << 16); a[2 * e + 1] = __uint_as_float(x1[e] & 0xffff0000u); b[2 * e] = __uint_as_float(x2[e] << 16); b[2 * e + 1] = __uint_as_float(x2[e] & 0xffff0000u); }
#pragma unroll
    for (int e = 0; e < 8; ++e) { const float p = a[e] * cs[e] - b[e] * sn[e], q = b[e] * cs[e] + a[e] * sn[e]; a[e] = p; b[e] = q; }
#pragma unroll
    for (int e = 0; e < 4; ++e) { x1[e] = pk2(a[2 * e], a[2 * e + 1]); x2[e] = pk2(b[2 * e], b[2 * e + 1]); }
}
__device__ __forceinline__ void ph_l0_stats(const Args& a, const WI& w) {
    unsigned char* ws = a.ws; const bf16_t* P = (const bf16_t*)(ws + WS_PROJ);
    const float* r64 = (const float*)(ws + WS_ROPE64);
    for (int t = w.gw; t < T; t += w.ngw) {
        const bf16_t* row = P + (size_t)t * AB_MAIN;
        float s = 0.f;
        for (int j = 0; j < 3; ++j) { const bf16x8 v = *(const bf16x8*)(row + 6144 + (j * 64 + w.lane) * 8);
#pragma unroll
            for (int e = 0; e < 8; ++e) { const float f = bf2f((bf16_t)v[e]); s += f * f; } }
        s = wave_sum(s);
        float s2 = 0.f; { const bf16x8 v = *(const bf16x8*)(row + 7680 + w.lane * 8);
#pragma unroll
            for (int e = 0; e < 8; ++e) { const float f = bf2f((bf16_t)v[e]); s2 += f * f; } }
        s2 = wave_sum(s2);
        if (w.lane == 0) { ((float*)(ws + WS_RSQ))[t] = 1.f / sqrtf(s * (1.f / 1536.f) + RMS_EPS); ((float*)(ws + WS_RSKV))[t] = 1.f / sqrtf(s2 * (1.f / 512.f) + RMS_EPS); }
        if (w.lane < 32) { const float* sm = (const float*)(ws + WS_MQP) + (size_t)t * 256; const int sp = t & (SEQ - 1);
            float x1 = 0.f, x2 = 0.f;
#pragma unroll
            for (int z = 0; z < 8; ++z) { x1 += sm[(size_t)z * T * 256 + w.lane]; x2 += sm[(size_t)z * T * 256 + w.lane + 32]; } const float cs = r64[((size_t)sp * 32 + w.lane) * 2], sn = r64[((size_t)sp * 32 + w.lane) * 2 + 1];
            rope_pair(x1, x2, cs, sn);
            bf16_t* kr = (bf16_t*)(ws + WS_KR) + (size_t)t * 64; kr[w.lane] = (bf16_t)f2bf(x1); kr[w.lane + 32] = (bf16_t)f2bf(x2); }
    }
}
__device__ __forceinline__ void ph_l0_qrope(const Args& a, const WI& w) {
    unsigned char* ws = a.ws; bf16_t* Q = (bf16_t*)(ws + WS_QB); const float* r64 = (const float*)(ws + WS_ROPE64);
    const int h = w.lane >> 2, ch = w.lane & 3;
    for (int t = w.gw; t < T; t += w.ngw) {
        const int sp = t & (SEQ - 1); bf16_t* q = Q + (size_t)t * 3072 + h * 192 + 128 + ch * 8;
        u32x4 x1 = *(const u32x4*)q, x2 = *(const u32x4*)(q + 32);
        rope8(x1, x2, r64 + ((size_t)sp * 32 + ch * 8) * 2);
        *(u32x4*)q = x1; *(u32x4*)(q + 32) = x2;
    }
}
__device__ __forceinline__ void ph_l1_elem(const Args& a, LAS float* sml  , const WI& w) {
    unsigned char* ws = a.ws; bf16_t* P = (bf16_t*)(ws + WS_PROJ);
    const float* r128 = (const float*)(ws + WS_ROPE128); const float* r64 = (const float*)(ws + WS_ROPE64);
    for (int t = w.gw; t < T; t += w.ngw) {
        const int b = t / SEQ, sp = t - b * SEQ; bf16_t* row = P + (size_t)t * CD_MAIN;
        u32x4 xa[5], xb[5]; bf16_t* qp[5]; const float* tp[5]; bool on[5];
#pragma unroll
        for (int p = 0; p < 3; ++p) { const int e = w.lane + 64 * p; on[p] = e < 160; const int h = e >> 3, ch = e & 7; qp[p] = row + h * 128 + ch * 8; tp[p] = r128 + ((size_t)sp * 64 + ch * 8) * 2;
            if (on[p]) { xa[p] = *(const u32x4*)qp[p]; xb[p] = *(const u32x4*)(qp[p] + 64); } }
#pragma unroll
        for (int p = 3; p < 5; ++p) { const int e = w.lane + 64 * (p - 3); on[p] = true; const int h = e >> 2, ch = e & 3; qp[p] = row + 3072 + h * 64 + ch * 8; tp[p] = r64 + ((size_t)sp * 32 + ch * 8) * 2;
            xa[p] = *(const u32x4*)qp[p]; xb[p] = *(const u32x4*)(qp[p] + 32); }
#pragma unroll
        for (int p = 0; p < 5; ++p) if (on[p]) { rope8(xa[p], xb[p], tp[p]); *(u32x4*)qp[p] = xa[p]; *(u32x4*)(qp[p] + (p < 3 ? 64 : 32)) = xb[p]; }
        const float* smp = (const float*)(ws + WS_MQP) + (size_t)t * 256;
        float smv0 = 0.f, smv1 = 0.f;
#pragma unroll
        for (int z = 0; z < 8; ++z) { smv0 += smp[(size_t)z * T * 256 + w.lane]; smv1 += smp[(size_t)z * T * 256 + 64 + w.lane]; }
        LDS_WAIT(); sml[w.lane] = smv0; sml[64 + w.lane] = smv1; LDS_WAIT();
        LAS const float* sm = sml;
        if (w.lane < 32) { float x1 = sm[w.lane], x2 = sm[w.lane + 32]; rope_pair(x1, x2, r64[((size_t)sp * 32 + w.lane) * 2], r64[((size_t)sp * 32 + w.lane) * 2 + 1]);
            bf16_t* ki = (bf16_t*)(ws + WS_KI) + (size_t)t * 64; ki[w.lane] = (bf16_t)f2bf(x1); ki[w.lane + 32] = (bf16_t)f2bf(x2);
            ((float*)(ws + WS_WI))[(size_t)t * 32 + w.lane] = sm[64 + w.lane] * 0.17677669529663687f; }
        if (w.lane < 16) { const float z = sm[96 + w.lane] + a.in[I_D_FORGET_BIAS][w.lane];
            const float lf = fminf(z, 0.f) - log1pf(__expf(-fabsf(z)));
            ((float*)(ws + WS_LOGF))[((size_t)b * 16 + w.lane) * SEQ + sp] = lf; }
    }
}
__device__ __forceinline__ void ph_l1_scan(const Args& a, LAS float* sh  , const WI& w) {
    unsigned char* ws = a.ws;
    for (int it = w.bid; it < NB * 16; it += w.nblk) {
        const float* src = (const float*)(ws + WS_LOGF) + (size_t)it * SEQ + w.tid * 8; float* dst = (float*)(ws + WS_CUM) + (size_t)it * SEQ + w.tid * 8;
        const f32x4 v0 = *(const f32x4*)src, v1 = *(const f32x4*)(src + 4);
        float c[8]; c[0] = v0.x; c[1] = c[0] + v0.y; c[2] = c[1] + v0.z; c[3] = c[2] + v0.w; c[4] = c[3] + v1.x; c[5] = c[4] + v1.y; c[6] = c[5] + v1.z; c[7] = c[6] + v1.w;
        float inc = c[7];
#pragma unroll
        for (int o = 1; o < 64; o <<= 1) { const float v = __shfl_up(inc, o); if (w.lane >= o) inc += v; }
        __syncthreads();
        if (w.lane == 63) sh[w.wave] = inc;
        __syncthreads();
        float base = inc - c[7];
        for (int q = 0; q < w.wave; ++q) base += sh[q];
        *(f32x4*)dst = (f32x4){c[0] + base, c[1] + base, c[2] + base, c[3] + base}; *(f32x4*)(dst + 4) = (f32x4){c[4] + base, c[5] + base, c[6] + base, c[7] + base};
    }
    __syncthreads();
}
__device__ __forceinline__ void ph_l1_index_naive(const Args& a, LAS float* qs  , const WI& w) {
    unsigned char* ws = a.ws; const bf16_t* P = (const bf16_t*)(ws + WS_PROJ); const bf16_t* KI = (const bf16_t*)(ws + WS_KI);
    const float* WIp = (const float*)(ws + WS_WI); float* SC = (float*)(ws + WS_SCORE);
    for (int t = w.gw; t < T; t += w.ngw) {
        const int b = t / SEQ, sp = t - b * SEQ, nadm = ((sp >> 6) + 1) * 64;
        LDS_WAIT();
        for (int e = w.lane; e < 2048; e += 64) qs[e] = bf2f(P[(size_t)t * CD_MAIN + 3072 + e]);
        if (w.lane < 32) qs[2048 + w.lane] = WIp[(size_t)t * 32 + w.lane];
        LDS_WAIT();
        for (int s0 = 0; s0 < nadm; s0 += 64) {
            const int s = s0 + w.lane; const bf16_t* kp = KI + ((size_t)b * SEQ + s) * 64;
            float k[64];
#pragma unroll
            for (int d0 = 0; d0 < 64; d0 += 8) { const bf16x8 kv = *(const bf16x8*)(kp + d0);
#pragma unroll
                for (int e = 0; e < 8; ++e) k[d0 + e] = bf2f((bf16_t)kv[e]); }
            float sc = 0.f;
            for (int h = 0; h < 32; ++h) { float dot = 0.f;
#pragma unroll
                for (int d = 0; d < 64; ++d) dot += qs[h * 64 + d] * k[d];
                sc += qs[2048 + h] * fmaxf(dot * 0.125f, 0.f); }
            SC[((size_t)b * SEQ + sp) * SEQ + s] = sc;
        }
    }
}
__device__ __forceinline__ void ph_l1_index(const Args& a, LAS unsigned char* lds, const WI& w) {
    unsigned char* ws = a.ws; const bf16_t* P = (const bf16_t*)(ws + WS_PROJ); const bf16_t* KI = (const bf16_t*)(ws + WS_KI);
    const float* WIp = (const float*)(ws + WS_WI); float* SC = (float*)(ws + WS_SCORE);
    LAS char* Qs = (LAS char*)lds; LAS float* Wt = (LAS float*)(lds + 131072);
    const int tid = w.tid, r32 = w.lane & 31, hi = w.lane >> 5;
    for (int u = w.bid; u < 256; u += w.nblk) {
        const int b = u >> 7, x = (u >> 1) & 63, half = u & 1;
        for (int pass = 0; pass < 2; ++pass) {
            const int qt = pass ? 127 - x : x; const int t0 = b * SEQ + qt * 32; const int nadm = ((qt * 32) >> 6) * 64 + 64, ngrp = (nadm + 127) >> 7;
            __syncthreads();
            for (int e = tid; e < 32 * 256; e += 512) { const int t = e >> 8, c = e & 255; const u32x4 v = *(const u32x4*)(P + (size_t)(t0 + t) * CD_MAIN + 3072 + c * 8);
                const int cs = (c & ~15) | ((c & 15) ^ (t & 15)); *(LAS u32x4*)(Qs + t * 4096 + cs * 16) = v; }
            for (int e = tid; e < 1024; e += 512) { const int t = e >> 5, h = e & 31; Wt[h * 32 + t] = WIp[(size_t)(t0 + t) * 32 + h] * 0.125f; }
            __syncthreads();
            for (int g = half + 2 * w.wave; g < ngrp; g += 16) {
                const int s0 = g * 128;
                bf16x8 kf[4][4];
#pragma unroll
                for (int j = 0; j < 4; ++j)
#pragma unroll
                    for (int dk = 0; dk < 4; ++dk) kf[j][dk] = *(const bf16x8*)(KI + ((size_t)b * SEQ + s0 + 32 * j + r32) * 64 + dk * 16 + hi * 8);
                f32x16 acc[4] = {};
#pragma unroll 2
                for (int h = 0; h < 32; ++h) {
                    bf16x8 qf[4];
#pragma unroll
                    for (int dk = 0; dk < 4; ++dk) qf[dk] = *(LAS const bf16x8*)(Qs + r32 * 4096 + ((((h >> 1) << 4) | ((((h & 1) << 3) | (dk << 1) | hi) ^ (r32 & 15))) << 4));
                    f32x4 wv[4];
#pragma unroll
                    for (int q4 = 0; q4 < 4; ++q4) wv[q4] = *(LAS const f32x4*)(Wt + h * 32 + 8 * q4 + 4 * hi);
#pragma unroll
                    for (int j = 0; j < 4; ++j) { f32x16 tmp = {};
#pragma unroll
                        for (int dk = 0; dk < 4; ++dk) tmp = __builtin_amdgcn_mfma_f32_32x32x16_bf16(qf[dk], kf[j][dk], tmp, 0, 0, 0);
#pragma unroll
                        for (int r = 0; r < 16; ++r) acc[j][r] = fmaf(wv[r >> 2][r & 3], fmaxf(tmp[r], 0.f), acc[j][r]); }
                }
#pragma unroll
                for (int j = 0; j < 4; ++j)
#pragma unroll
                    for (int r = 0; r < 16; ++r) SC[(size_t)(t0 + crow(r, hi)) * SEQ + s0 + 32 * j + r32] = acc[j][r];
            }
        }
    }
    __syncthreads();
}
__device__ __forceinline__ void ph_l1_select(const Args& a, const WI& w) {
    unsigned char* ws = a.ws; const float* SC = (const float*)(ws + WS_SCORE); unsigned* MK = (unsigned*)(ws + WS_MASK);
    for (int t = w.gw; t < T; t += w.ngw) {
        const int b = t / SEQ, sp = t - b * SEQ, nblk = (sp >> 6) + 1;
        const float* row = SC + ((size_t)b * SEQ + sp) * SEQ;
        unsigned key[64];
#pragma unroll
        for (int j = 0; j < 64; ++j) { unsigned u = 0u; if (j < nblk) { u = __float_as_uint(row[j * 64 + w.lane]); u ^= (u >> 31) ? 0xFFFFFFFFu : 0x80000000u; } key[j] = u; }
        unsigned thr = 0u;
        if (nblk > 4) {
            for (int bit = 31; bit >= 0; --bit) { const unsigned cand = thr | (1u << bit); int cnt = 0;
#pragma unroll
                for (int j = 0; j < 64; ++j) cnt += (key[j] >= cand) ? 1 : 0;
                cnt = wave_sum_i(cnt); if (cnt >= 256) thr = cand; if (cnt == 256) break; }
        }
        unsigned lo = 0u, hi = 0u;
#pragma unroll
        for (int j = 0; j < 64; ++j) { const bool sel = (j < nblk) && (key[j] >= thr); const unsigned long long bal = __ballot(sel); if (w.lane == j) { lo = (unsigned)bal; hi = (unsigned)(bal >> 32); } }
        *(u32x2*)(MK + (size_t)t * 128 + 2 * w.lane) = (u32x2){lo, hi};
    }
}

__device__ __forceinline__ unsigned tk_key(float v, unsigned payload, unsigned pmask) { const unsigned u = __float_as_uint(v); const unsigned m = (unsigned)((int)u >> 31) | 0x80000000u; return ((u ^ m) & ~pmask) | payload; }
__device__ __forceinline__ float tk_val(unsigned key, unsigned pmask) { const unsigned k = key & ~pmask; const unsigned m = ~(unsigned)((int)k >> 31) | 0x80000000u; return __uint_as_float(k ^ m); }
#define TK_INSERT(TOP, key_) do { unsigned k__ = (key_); \
        _Pragma("unroll") for (int q_ = 0; q_ < 16; ++q_) { const unsigned hi__ = TOP[q_] > k__ ? TOP[q_] : k__; k__ = TOP[q_] > k__ ? k__ : TOP[q_]; TOP[q_] = hi__; } } while (0)
__device__ __forceinline__ unsigned tk_sel16(const unsigned (&arr)[16], unsigned i) {
    unsigned x8[8], x4[4], x2[2];
    const unsigned m0 = 0u - (i & 1u), m1 = 0u - ((i >> 1) & 1u), m2 = 0u - ((i >> 2) & 1u), m3 = 0u - ((i >> 3) & 1u);
#pragma unroll
    for (int q = 0; q < 8; ++q) x8[q] = (arr[2 * q + 1] & m0) | (arr[2 * q] & ~m0);
#pragma unroll
    for (int q = 0; q < 4; ++q) x4[q] = (x8[2 * q + 1] & m1) | (x8[2 * q] & ~m1);
#pragma unroll
    for (int q = 0; q < 2; ++q) x2[q] = (x4[2 * q + 1] & m2) | (x4[2 * q] & ~m2);
    return (x2[1] & m3) | (x2[0] & ~m3); }
__device__ __forceinline__ void ph_peer_topk(const Args& a, const WI& w) {
    unsigned char* ws = a.ws; const float* PST = (const float*)(ws + WS_PSCORE); int* PIDX = (int*)(ws + WS_PIDX); float* PG = (float*)(ws + WS_PGATE);
    for (int task = w.gw; task < 128 * 8; task += w.ngw) {
        const int h = task & 7, t = (task >> 3) * 64 + w.lane;
        unsigned t0[16], t1[16];
#pragma unroll
        for (int k = 0; k < 16; ++k) { t0[k] = 0u; t1[k] = 0u; }
        { const float* col = PST + (size_t)(h * 256) * T + t;
#pragma unroll 8
          for (int i = 0; i < 128; ++i) { const float v = col[(size_t)i * T]; TK_INSERT(t0, tk_key(v, 127u - (unsigned)i, 127u)); } }
        { const float* col = PST + (size_t)(h * 256 + 128) * T + t;
#pragma unroll 8
          for (int i = 0; i < 128; ++i) { const float v = col[(size_t)i * T]; TK_INSERT(t1, tk_key(v, 127u - (unsigned)i, 127u)); } }
        float a0[16], a1[16];
#pragma unroll
        for (int k = 0; k < 16; ++k) { a0[k] = tk_val(t0[k], 127u); a1[k] = tk_val(t1[k], 127u); }
        unsigned bk[16];
#pragma unroll
        for (int k = 0; k < 16; ++k) bk[k] = 0u;
#pragma unroll
        for (int i = 0; i < 16; ++i)
#pragma unroll
            for (int j = 0; j < 16; ++j) if ((i + 1) * (j + 1) <= 16) TK_INSERT(bk, tk_key(a0[i] + a1[j], 255u - (unsigned)(i * 16 + j), 255u));
        const float top = tk_val(bk[0], 255u); float den = 0.f; float ex[16];
#pragma unroll
        for (int k = 0; k < 16; ++k) { ex[k] = __expf(tk_val(bk[k], 255u) - top); den += ex[k]; }
        const float rd = 1.f / den;
#pragma unroll
        for (int k = 0; k < 16; ++k) { const unsigned c = 255u - (bk[k] & 255u); const unsigned e0 = 127u - (tk_sel16(t0, c >> 4) & 127u), e1 = 127u - (tk_sel16(t1, c & 15u) & 127u);
            PIDX[(size_t)t * 128 + h * 16 + k] = (int)(e0 * 128u + e1); PG[(size_t)t * 128 + h * 16 + k] = ex[k] * rd; }
    }
}
__device__ __forceinline__ void ph_peer_experts(const Args& a, int layer, float* outf, bf16_t* outb, const float* g, const float* bta, LAS float* wsm  , const WI& w) {
    unsigned char* ws = a.ws; const bf16_t* XBh = (const bf16_t*)(ws + WS_XB);
    const unsigned char* U4 = ws + WS_U8 + (size_t)layer * 16384 * 2048; const unsigned char* V4 = ws + WS_V8 + (size_t)layer * 16384 * 2048;
    const unsigned short* US = (const unsigned short*)(ws + WS_U8 + 64 * MiB) + (size_t)layer * 16384 * 64; const unsigned short* VS = (const unsigned short*)(ws + WS_V8 + 64 * MiB) + (size_t)layer * 16384 * 64;
    const int* PIDX = (const int*)(ws + WS_PIDX); const float* PG = (const float*)(ws + WS_PGATE);
    const int lane = w.lane;
    for (int t = w.gw; t < T; t += w.ngw) {
        const bf16_t* hrow = XBh + (size_t)t * DM + 32 * lane;
        const int idx0 = PIDX[(size_t)t * 128 + lane], idx1 = PIDX[(size_t)t * 128 + 64 + lane];
        const float g0 = PG[(size_t)t * 128 + lane], g1 = PG[(size_t)t * 128 + 64 + lane];
        LDS_WAIT();
#define PE_LOAD(BUF, SB, TBL, STB, kb_) do { const int iv_ = ((kb_) & 64) ? idx1 : idx0; \
            _Pragma("unroll") for (int q_ = 0; q_ < 4; ++q_) { const int e_ = __builtin_amdgcn_readlane(iv_, ((kb_) + q_) & 63); const u32x4* r_ = (const u32x4*)(TBL + (size_t)e_ * 2048 + 16 * lane); \
                BUF[q_][0] = r_[0]; BUF[q_][1] = r_[64]; SB[q_] = STB[(size_t)e_ * 64 + lane]; } } while (0)
#define PE_SCALE(sb_, i_) __builtin_amdgcn_exp2f((float)((int)(((sb_) >> (8 * (i_))) & 255u) - 128) * 0.125f)
#define PE_DOT(BUF, SB, Z, zo_) do { _Pragma("unroll") for (int q_ = 0; q_ < 4; ++q_) { float zq_ = 0.f; \
            _Pragma("unroll") for (int i_ = 0; i_ < 2; ++i_) { f32x2 acc_ = {0.f, 0.f}; \
                _Pragma("unroll") for (int d_ = 0; d_ < 4; ++d_) { \
                    acc_ = __builtin_elementwise_fma(__builtin_amdgcn_cvt_scalef32_pk_f32_fp4(BUF[q_][i_][d_], 1.0f, 0), x[16 * i_ + 4 * d_ + 0], acc_); \
                    acc_ = __builtin_elementwise_fma(__builtin_amdgcn_cvt_scalef32_pk_f32_fp4(BUF[q_][i_][d_], 1.0f, 1), x[16 * i_ + 4 * d_ + 1], acc_); \
                    acc_ = __builtin_elementwise_fma(__builtin_amdgcn_cvt_scalef32_pk_f32_fp4(BUF[q_][i_][d_], 1.0f, 2), x[16 * i_ + 4 * d_ + 2], acc_); \
                    acc_ = __builtin_elementwise_fma(__builtin_amdgcn_cvt_scalef32_pk_f32_fp4(BUF[q_][i_][d_], 1.0f, 3), x[16 * i_ + 4 * d_ + 3], acc_); } \
                zq_ = fmaf(PE_SCALE((unsigned)SB[q_], i_), acc_.x + acc_.y, zq_); } \
            Z[(zo_) + q_] = zq_; } } while (0)
#define PE_AXPY(BUF, SB, kb_) do { _Pragma("unroll") for (int q_ = 0; q_ < 4; ++q_) { const float wt_ = wsm[(kb_) + q_]; \
            _Pragma("unroll") for (int i_ = 0; i_ < 2; ++i_) { const float ws_ = wt_ * PE_SCALE((unsigned)SB[q_], i_); const f32x2 wt2_ = {ws_, ws_}; \
                _Pragma("unroll") for (int d_ = 0; d_ < 4; ++d_) { \
                    y[16 * i_ + 4 * d_ + 0] = __builtin_elementwise_fma(__builtin_amdgcn_cvt_scalef32_pk_f32_fp4(BUF[q_][i_][d_], 1.0f, 0), wt2_, y[16 * i_ + 4 * d_ + 0]); \
                    y[16 * i_ + 4 * d_ + 1] = __builtin_elementwise_fma(__builtin_amdgcn_cvt_scalef32_pk_f32_fp4(BUF[q_][i_][d_], 1.0f, 1), wt2_, y[16 * i_ + 4 * d_ + 1]); \
                    y[16 * i_ + 4 * d_ + 2] = __builtin_elementwise_fma(__builtin_amdgcn_cvt_scalef32_pk_f32_fp4(BUF[q_][i_][d_], 1.0f, 2), wt2_, y[16 * i_ + 4 * d_ + 2]); \
                    y[16 * i_ + 4 * d_ + 3] = __builtin_elementwise_fma(__builtin_amdgcn_cvt_scalef32_pk_f32_fp4(BUF[q_][i_][d_], 1.0f, 3), wt2_, y[16 * i_ + 4 * d_ + 3]); } } \
            __builtin_amdgcn_sched_barrier(0); } } while (0)
#define PE_SB() __builtin_amdgcn_sched_barrier(0)
        u32x4 bA[4][2], bB[4][2]; unsigned short sA[4], sB[4];
        {
            f32x2 x[32];
#pragma unroll
            for (int i = 0; i < 2; ++i)
#pragma unroll
                for (int q = 0; q < 4; ++q) { const u32x4 v = *(const u32x4*)(hrow + 2048 * i + 8 * q);
#pragma unroll
                    for (int e = 0; e < 4; ++e) x[16 * i + 4 * q + e] = (f32x2){__uint_as_float(v[e] << 16), __uint_as_float(v[e] & 0xffff0000u)}; }
            PE_LOAD(bA, sA, U4, US, 0); PE_SB();
#pragma unroll 1
            for (int k0 = 0; k0 < 128; k0 += 8) {
                const int iv = (k0 & 64) ? idx1 : idx0; const float gv = (k0 & 64) ? g1 : g0;
                float z[8];
                PE_LOAD(bB, sB, U4, US, k0 + 4); PE_SB(); PE_DOT(bA, sA, z, 0); PE_SB();
                PE_LOAD(bA, sA, U4, US, (k0 + 8) & 127); PE_SB(); PE_DOT(bB, sB, z, 4); PE_SB();
                float r4[4], r2[2], r1;
#pragma unroll
                for (int i = 0; i < 4; ++i) { const float keep = (lane & 32) ? z[i + 4] : z[i], send = (lane & 32) ? z[i] : z[i + 4]; r4[i] = keep + __shfl_xor(send, 32); }
#pragma unroll
                for (int i = 0; i < 2; ++i) { const float keep = (lane & 16) ? r4[i + 2] : r4[i], send = (lane & 16) ? r4[i] : r4[i + 2]; r2[i] = keep + __shfl_xor(send, 16); }
                { const float keep = (lane & 8) ? r2[1] : r2[0], send = (lane & 8) ? r2[0] : r2[1]; r1 = keep + __shfl_xor(send, 8); }
                r1 += __shfl_xor(r1, 4); r1 += __shfl_xor(r1, 2); r1 += __shfl_xor(r1, 1);
                const int q = lane >> 3; const float gt_ = __shfl(gv, (k0 + q) & 63);
                if ((lane & 7) == 0) { const float zz = r1; const float act = 0.5f * zz * (1.f + erff(zz * 0.70710678118654752f)); wsm[k0 + q] = act * gt_; }
            }
        }
        LDS_WAIT();
        f32x2 y[32];
#pragma unroll
        for (int i = 0; i < 32; ++i) y[i] = (f32x2){0.f, 0.f};
        PE_LOAD(bA, sA, V4, VS, 0); PE_SB();
#pragma unroll 1
        for (int k0 = 0; k0 < 128; k0 += 8) {
            PE_LOAD(bB, sB, V4, VS, k0 + 4); PE_SB(); PE_AXPY(bA, sA, k0); PE_SB();
            PE_LOAD(bA, sA, V4, VS, (k0 + 8) & 127); PE_SB(); PE_AXPY(bB, sB, k0 + 4); PE_SB();
        }
#undef PE_LOAD
#undef PE_SCALE
#undef PE_DOT
#undef PE_AXPY
#undef PE_SB
        const bf16_t* hrow2 = hrow; asm volatile("" : "+v"(hrow2));
        float s = 0.f;
#pragma unroll
        for (int i = 0; i < 2; ++i)
#pragma unroll
            for (int q = 0; q < 4; ++q) { const u32x4 v = *(const u32x4*)(hrow2 + 2048 * i + 8 * q);
#pragma unroll
                for (int e = 0; e < 4; ++e) { y[16 * i + 4 * q + e].x += ALPHA * __uint_as_float(v[e] << 16); y[16 * i + 4 * q + e].y += ALPHA * __uint_as_float(v[e] & 0xffff0000u); } }
#pragma unroll
        for (int i = 0; i < 32; ++i) s += y[i].x + y[i].y;
        const float mean = wave_sum(s) * (1.f / DM); float s2 = 0.f;
#pragma unroll
        for (int i = 0; i < 32; ++i) { y[i].x -= mean; y[i].y -= mean; s2 += y[i].x * y[i].x + y[i].y * y[i].y; }
        const float rstd = 1.f / sqrtf(wave_sum(s2) * (1.f / DM) + LN_EPS);
#pragma unroll
        for (int i = 0; i < 2; ++i)
#pragma unroll
            for (int q = 0; q < 8; ++q) { const int c = 2048 * i + 32 * lane + 4 * q;
                const f32x4 gg = *(const f32x4*)(g + c), bb = *(const f32x4*)(bta + c); f32x4 o;
                o.x = y[16 * i + 2 * q].x * rstd * gg.x + bb.x; o.y = y[16 * i + 2 * q].y * rstd * gg.y + bb.y; o.z = y[16 * i + 2 * q + 1].x * rstd * gg.z + bb.z; o.w = y[16 * i + 2 * q + 1].y * rstd * gg.w + bb.w;
                if (outf) *(f32x4*)(outf + (size_t)t * DM + c) = o;
                if (outb) { u32x2 p; p.x = pk2(o.x, o.y); p.y = pk2(o.z, o.w); *(u32x2*)(outb + (size_t)t * DM + c) = p; }
                if (q & 1) __builtin_amdgcn_sched_barrier(0); }
    }
}

__device__ __forceinline__ void ph_attn_l0(const Args& a, LAS unsigned char* lds, const WI& w) {
    for (int pr = w.bid; pr < 256; pr += w.nblk) { const int bh = pr >> 3, x = pr & 7;
        for (int pass = 0; pass < 2; ++pass) fa::attn_unit<1>(a, 0, lds, bh >> 4, bh & 15, pass ? 15 - x : x); }
    for (int u = w.bid; u < 512; u += w.nblk) { const int bh = u >> 4; fa::attn_unit<0>(a, 0, lds, bh >> 4, bh & 15, u & 15); }
}
__device__ __forceinline__ void ph_attn_l1(const Args& a, LAS unsigned char* lds, const WI& w) {
    for (int pr = w.bid; pr < 256; pr += w.nblk) { const int bh = pr >> 3, x = pr & 7;
        for (int pass = 0; pass < 2; ++pass) fa::attn_unit<2>(a, 1, lds, bh >> 4, bh & 15, pass ? 15 - x : x); }
    for (int pr = w.bid; pr < 256; pr += w.nblk) { const int bh = pr >> 3, x = pr & 7;
        for (int pass = 0; pass < 2; ++pass) fa::attn_unit<3>(a, 1, lds, bh >> 4, bh & 15, pass ? 15 - x : x); }
}
__device__ __forceinline__ void ph_attn_mem(const Args& a, int layer, LAS unsigned char* lds, const WI& w) {
    for (int u = w.bid; u < 128; u += w.nblk) { const int bh = u >> 4; fa::attn_unit<4>(a, layer, lds, bh >> 2, bh & 3, u & 15); }
}

__global__ void __launch_bounds__(512, 2) mega(Args a) {
    extern __shared__ __attribute__((aligned(16))) unsigned char lds_raw[];
    LAS unsigned char* lds = (LAS unsigned char*)lds_raw;
    WI w; w.tid = threadIdx.x; w.lane = w.tid & 63; w.wave = __builtin_amdgcn_readfirstlane(w.tid >> 6);
    w.bid = blockIdx.x; w.nblk = gridDim.x; w.gw = w.bid * 8 + w.wave; w.ngw = w.nblk * 8;
    unsigned char* ws = a.ws;
    volatile LAS unsigned* misc = (volatile LAS unsigned*)(lds + LDS_MISC);
    if (w.tid < 4) misc[w.tid] = 0u;
    __syncthreads();
    XcdBarrier bar; bar.bar = (unsigned*)(ws + WS_CTL) + 4096; bar.x = 0; bar.st = misc;
#if !MK_PER_PHASE
    bar = xcd_barrier_post((unsigned*)(ws + WS_CTL) + 4096, misc);
#endif
    const int lo = a.ph_lo, hi = a.ph_hi;
#define IN(k) (lo <= (k) && (k) < hi)
#if MK_PER_PHASE
#define SEAM(k) do { } while (0)
#else
#define SEAM(k) do { if (IN(k) && IN((k) + 1)) xcd_barrier(bar); } while (0)
#endif
    LAS float* wlds = (LAS float*)(lds + w.wave * 16384);
    bf16_t* XB = (bf16_t*)(ws + WS_XB); bf16_t* RES = (bf16_t*)(ws + WS_RES); bf16_t* PROJ = (bf16_t*)(ws + WS_PROJ);
    bf16_t* ATT = (bf16_t*)(ws + WS_ATT); float* SMALL = (float*)(ws + WS_SMALL);

#define FAST_GEMM(EPI_T, Aptr, lda_, Btptr, ldb_, M_, N_, K_, nz_, zA_, zB_, EPI_OBJ) do { \
        pg8::Gemm g_{Aptr, Btptr, M_, N_, K_, lda_, ldb_, zA_, zB_, nz_}; pg8::StaticOrder S_; S_.init(M_, N_, nz_, w.nblk, w.bid); \
        pg8::gemm_phase<EPI_T, pg8::StaticOrder>(lds, g_, S_, EPI_OBJ); } while (0)
    if (IN(0)) { ph_convert(a, lds, w); if (PROBE_DUP == 0) ph_convert(a, lds, w); }
    SEAM(0);
    if (IN(1)) {
        FAST_GEMM(pg8::EpiBf16, XB, DM, (const bf16_t*)(ws + WS_W_AB_IN), DM, T, AB_MAIN, DM, 1, 0, 0, (pg8::EpiBf16{PROJ, AB_MAIN, nullptr}));
        FAST_GEMM(pg8::EpiF32, XB, DM, (const bf16_t*)(ws + WS_W_AB_IN) + (size_t)AB_MAIN * DM, DM, T, 256, 512, 8, 512, 512, (pg8::EpiF32{(float*)(ws + WS_MQP), 256, (long)T * 256}));
        FAST_GEMM(pg8::EpiF32, (const bf16_t*)(ws + WS_MEMB), DM, (const bf16_t*)(ws + WS_W_MEM_KV), DM, 512, 2048, 256, 16, 256, 256, (pg8::EpiF32{(float*)(ws + WS_SCORE), 2048, (long)512 * 2048}));
    }
    SEAM(1);
    if (IN(2)) { ph_l0_stats(a, w);
        { const float* part = (const float*)(ws + WS_SCORE); bf16_t* KVM = (bf16_t*)(ws + WS_KVM);
          for (size_t i = ((size_t)w.gw * 64 + w.lane) * 4; i < (size_t)512 * 2048; i += (size_t)w.ngw * 64 * 4) { f32x4 s = {0.f, 0.f, 0.f, 0.f};
#pragma unroll
              for (int z = 0; z < 16; ++z) s += *(const f32x4*)(part + (size_t)z * 512 * 2048 + i);
              const int m = (int)(i >> 11), n = (int)(i & 2047); u32x2 p; p.x = pk2(s.x, s.y); p.y = pk2(s.z, s.w);
              *(u32x2*)(KVM + ((size_t)(n >> 10) * 512 + m) * 1024 + (n & 1023)) = p; } } }
    SEAM(2);
    if (IN(3)) {
        const float* rsq = (const float*)(ws + WS_RSQ); const float* rskv = (const float*)(ws + WS_RSKV);
        bf16_t* QB = (bf16_t*)(ws + WS_QB); bf16_t* KVB = (bf16_t*)(ws + WS_KVB);
        FAST_GEMM(pg8::EpiBf16, PROJ + 6144, AB_MAIN, (const bf16_t*)(ws + WS_W_UQ), 1536, T, 3072, 1536, 1, 0, 0, (pg8::EpiBf16{QB, 3072, rsq}));
        FAST_GEMM(pg8::EpiBf16, PROJ + 7680, AB_MAIN, (const bf16_t*)(ws + WS_W_UKV), 512, T, 4096, 512, 1, 0, 0, (pg8::EpiBf16{KVB, 4096, rskv}));
    }
    SEAM(3);
    if (IN(4)) ph_l0_qrope(a, w);
    SEAM(4);
    if (IN(5)) { ph_attn_l0(a, lds, w); if (PROBE_DUP == 5) ph_attn_l0(a, lds, w); }
    SEAM(5);
    if (IN(6)) {
        FAST_GEMM(pg8::EpiResid, ATT, DM, (const bf16_t*)(ws + WS_W_AB_OUT), DM, T, DM, DM, 1, 0, 0, (pg8::EpiResid{XB, RES, DM})); }
    SEAM(6);
    if (IN(7)) ln_rows(RES, a.in[I_LN_G] + 0 * DM, a.in[I_LN_B] + 0 * DM, XB, w);
    SEAM(7);

#define MEM_PEER_PHASES(L, P0_, LAST)                                                                                                                         \
    if (IN(P0_)) { FAST_GEMM(pg8::EpiF32, XB, DM, (const bf16_t*)(ws + WS_W_MEM_Q) + (size_t)(L) * 512 * DM, DM, T, 512, 1024, 4, 1024, 1024,                    \
                             (pg8::EpiF32{(float*)(ws + WS_MQP), 512, (long)T * 512})); }                                                                       \
    SEAM(P0_);                                                                                                                                                  \
    if (IN(P0_ + 1)) ph_attn_mem(a, (L), lds, w);                                                                                                               \
    SEAM(P0_ + 1);                                                                                                                                              \
    if (IN(P0_ + 2)) { FAST_GEMM(pg8::EpiResid, (const bf16_t*)(ws + WS_MEMO), 512, (const bf16_t*)(ws + WS_W_MEM_O) + (size_t)(L) * DM * 512, 512, T, DM, 512, 1, 0, 0, \
                                 (pg8::EpiResid{XB, RES, DM})); }                                                                                               \
    SEAM(P0_ + 2);                                                                                                                                              \
    if (IN(P0_ + 3)) ln_rows(RES, a.in[I_LN_G] + ((L) * 3 + 1) * DM, a.in[I_LN_B] + ((L) * 3 + 1) * DM, XB, w);                                             \
    SEAM(P0_ + 3);                                                                                                                                              \
    if (IN(P0_ + 4)) { FAST_GEMM(pg8::EpiF32, (const bf16_t*)(ws + WS_W_PEER) + (size_t)(L) * 2048 * DM, DM, XB, DM, 2048, T, DM, 1, 0, 0,                     \
                                 (pg8::EpiF32{(float*)(ws + WS_PSCORE), T, 0})); }                                                                              \
    SEAM(P0_ + 4);                                                                                                                                              \
    if (IN(P0_ + 5)) { ph_peer_topk(a, w); if (PROBE_DUP == 27 && (LAST)) ph_peer_topk(a, w); }                                                                 \
    SEAM(P0_ + 5);                                                                                                                                              \
    if (IN(P0_ + 6)) { ph_peer_experts(a, (L), (LAST) ? a.out : (float*)nullptr, (LAST) ? (bf16_t*)nullptr : XB, a.in[I_LN_G] + ((L) * 3 + 2) * DM, a.in[I_LN_B] + ((L) * 3 + 2) * DM, wlds, w); \
        if (PROBE_DUP == 28 && (LAST)) ph_peer_experts(a, (L), a.out, (bf16_t*)nullptr, a.in[I_LN_G] + ((L) * 3 + 2) * DM, a.in[I_LN_B] + ((L) * 3 + 2) * DM, wlds, w); } \
    if (!(LAST)) SEAM(P0_ + 6);

    MEM_PEER_PHASES(0, 8, false)

    if (IN(15)) {
        FAST_GEMM(pg8::EpiBf16, XB, DM, (const bf16_t*)(ws + WS_W_CD_IN), DM, T, CD_MAIN, DM, 1, 0, 0, (pg8::EpiBf16{PROJ, CD_MAIN, nullptr}));
        FAST_GEMM(pg8::EpiF32, XB, DM, (const bf16_t*)(ws + WS_W_CD_IN) + (size_t)CD_MAIN * DM, DM, T, 256, 512, 8, 512, 512, (pg8::EpiF32{(float*)(ws + WS_MQP), 256, (long)T * 256}));
    }
    SEAM(15);
    if (IN(16)) ph_l1_elem(a, wlds, w);
    SEAM(16);
    if (IN(17)) { ph_l1_scan(a, (LAS float*)(lds + LDS_MISC + 64), w); ph_l1_index(a, lds, w); if (PROBE_DUP == 17) ph_l1_index(a, lds, w); }
    SEAM(17);
    if (IN(18)) { ph_l1_select(a, w); if (PROBE_DUP == 18) ph_l1_select(a, w); }
    SEAM(18);
    if (IN(19)) { ph_attn_l1(a, lds, w); if (PROBE_DUP == 19) ph_attn_l1(a, lds, w); }
    SEAM(19);
    if (IN(20)) { FAST_GEMM(pg8::EpiResid, ATT, DM, (const bf16_t*)(ws + WS_W_CD_OUT), DM, T, DM, DM, 1, 0, 0, (pg8::EpiResid{XB, RES, DM})); }
    SEAM(20);
    if (IN(21)) ln_rows(RES, a.in[I_LN_G] + 3 * DM, a.in[I_LN_B] + 3 * DM, XB, w);
    SEAM(21);
    MEM_PEER_PHASES(1, 22, true)
#undef IN
#undef SEAM
}

extern "C" void kernel_launch(void* const* d_in, const int* in_sizes, int n_in, void* d_out, int out_size, void* d_ws, size_t ws_size, hipStream_t stream) {
    static int grid = 0;
    if (grid == 0) {
        if (n_in != 21 || out_size != T * DM || ws_size < WS_END) { fprintf(stderr, "kernel_launch: unexpected shapes (n_in %d out %d ws %zu need %zu)\n", n_in, out_size, ws_size, (size_t)WS_END); grid = -1; return; }
        int dev = 0, cus = 0, per_cu = 0;
        if (hipGetDevice(&dev) != hipSuccess || hipDeviceGetAttribute(&cus, hipDeviceAttributeMultiprocessorCount, dev) != hipSuccess) { grid = -1; return; }
        if (hipFuncSetAttribute((const void*)mega, hipFuncAttributeMaxDynamicSharedMemorySize, LDS_BYTES) != hipSuccess) { fprintf(stderr, "kernel_launch: hipFuncSetAttribute failed\n"); grid = -1; return; }
        if (hipOccupancyMaxActiveBlocksPerMultiprocessor(&per_cu, (const void*)mega, 512, LDS_BYTES) != hipSuccess || per_cu < 1) { fprintf(stderr, "kernel_launch: occupancy query says %d\n", per_cu); }
        (void)hipGetLastError();
        grid = cus;
    }
    if (grid < 0) return;
    (void)hipMemsetAsync((char*)d_ws + WS_CTL, 0, CTL_BYTES, stream);
    Args a{};
    for (int i = 0; i < 21; ++i) a.in[i] = (const float*)d_in[i];
    a.out = (float*)d_out; a.ws = (unsigned char*)d_ws;
#if MK_PER_PHASE
    for (int p = 0; p < NPHASE; ++p) { a.ph_lo = p; a.ph_hi = p + 1; hipLaunchKernelGGL(mega, dim3(grid), dim3(512), LDS_BYTES, stream, a);
        if (p == PROBE_EXTRA_PHASE) hipLaunchKernelGGL(mega, dim3(grid), dim3(512), LDS_BYTES, stream, a); }
#else
    a.ph_lo = 0; a.ph_hi = NPHASE;
    hipLaunchKernelGGL(mega, dim3(grid), dim3(512), LDS_BYTES, stream, a);
#endif
}
```

```cpp
#include <hip/hip_runtime.h>
#include <cstdio>
#include <cstdint>

#define GAS __attribute__((address_space(1)))
#define LAS __attribute__((address_space(3)))
typedef unsigned short bf16_t;
typedef short bf16x8 __attribute__((ext_vector_type(8)));
typedef float f32x4 __attribute__((ext_vector_type(4)));
typedef float f32x16 __attribute__((ext_vector_type(16)));
typedef unsigned u32x4 __attribute__((ext_vector_type(4)));
typedef unsigned u32x2 __attribute__((ext_vector_type(2)));
typedef float f32x2 __attribute__((ext_vector_type(2)));

#ifndef PROBE_DUP
#define PROBE_DUP -1
#endif
#ifndef PROBE_EXTRA_PHASE
#define PROBE_EXTRA_PHASE -1
#endif
#ifndef MK_PER_PHASE
#define MK_PER_PHASE 0
#endif

constexpr int NB = 2, SEQ = 4096, T = NB * SEQ, DM = 4096;
constexpr int AB_COLS = 8256, AB_MAIN = 8192, AB_PAD = 8448;
constexpr int CD_COLS = 11376, CD_MAIN = 11264, CD_PAD = 11520;
constexpr float ALPHA = 1.4142135623730951f;
constexpr float LN_EPS = 1e-5f, RMS_EPS = 1e-6f;
constexpr int NPHASE = 29;

constexpr size_t MiB = 1ull << 20;
constexpr size_t WS_CTL = 0, CTL_BYTES = 1 * MiB;
constexpr size_t WS_ROPE128 = 1 * MiB;
constexpr size_t WS_ROPE64 = 3 * MiB;
constexpr size_t WS_RSQ = 4 * MiB;
constexpr size_t WS_RSKV = 4 * MiB + 65536;
constexpr size_t WS_CUM = 5 * MiB;
constexpr size_t WS_LOGF = 5 * MiB + 524288;
constexpr size_t WS_KR = 6 * MiB;
constexpr size_t WS_KI = 7 * MiB;
constexpr size_t WS_WI = 8 * MiB;
constexpr size_t WS_KVM = 9 * MiB;
constexpr size_t WS_MEMB = 11 * MiB;
constexpr size_t WS_MASK = 15 * MiB;
constexpr size_t WS_PIDX = 19 * MiB;
constexpr size_t WS_PGATE = 23 * MiB;
constexpr size_t WS_MEMQ = 27 * MiB;
constexpr size_t WS_MEMO = 35 * MiB;
constexpr size_t WS_SMALL = 43 * MiB;
constexpr size_t WS_W_AB_IN = 64 * MiB;
constexpr size_t WS_W_UQ = 130 * MiB;
constexpr size_t WS_W_UKV = 139 * MiB;
constexpr size_t WS_W_AB_OUT = 143 * MiB;
constexpr size_t WS_W_CD_IN = 175 * MiB;
constexpr size_t WS_W_CD_OUT = 265 * MiB;
constexpr size_t WS_W_MEM_Q = 297 * MiB;
constexpr size_t WS_W_MEM_KV = 305 * MiB;
constexpr size_t WS_W_MEM_O = 321 * MiB;
constexpr size_t WS_W_PEER = 329 * MiB;
constexpr size_t WS_U8 = 361 * MiB;
constexpr size_t WS_V8 = 489 * MiB;
constexpr size_t WS_USC = 48 * MiB;
constexpr size_t WS_VSC = 48 * MiB + 262144;
constexpr size_t WS_XB = 873 * MiB;
constexpr size_t WS_HF = 937 * MiB;
constexpr size_t WS_RES = 1065 * MiB;
constexpr size_t WS_PROJ = 1193 * MiB;
constexpr size_t WS_PSCORE = WS_PROJ;
constexpr size_t WS_ATT = 1369 * MiB;
constexpr size_t WS_QB = 1433 * MiB;
constexpr size_t WS_KVB = 1481 * MiB;
constexpr size_t WS_SCORE = 1433 * MiB;
constexpr size_t WS_MQP = 1561 * MiB;
constexpr size_t WS_END = 1625 * MiB;

constexpr int LDS_BYTES = 147456;
constexpr int LDS_MISC = 140 * 1024;

#define LDS_WAIT() asm volatile("s_waitcnt lgkmcnt(0)" ::: "memory")
__device__ __forceinline__ float bf2f(bf16_t b) { return __uint_as_float(((unsigned)b) << 16); }
__device__ __forceinline__ unsigned f2bf(float f) { unsigned u = __float_as_uint(f); return (u + 0x7fffu + ((u >> 16) & 1u)) >> 16; }
__device__ __forceinline__ unsigned pk2(float lo, float hi) { return f2bf(lo) | (f2bf(hi) << 16); }
__device__ __forceinline__ float wave_sum(float v) {
#pragma unroll
    for (int o = 1; o < 64; o <<= 1) v += __shfl_xor(v, o);
    return v;
}
__device__ __forceinline__ float wave_max(float v) {
#pragma unroll
    for (int o = 1; o < 64; o <<= 1) v = fmaxf(v, __shfl_xor(v, o));
    return v;
}
__device__ __forceinline__ int wave_sum_i(int v) {
#pragma unroll
    for (int o = 1; o < 64; o <<= 1) v += __shfl_xor(v, o);
    return v;
}

#define XB_TMO      128
#define XB_XCNT(j)  (256  + 64 * (j))
#define XB_XSUB(j)  (1280 + 64 * (j))
#define XB_XGEN(j)  (2304 + 64 * (j))
#define XB_TOP      3328
#define XB_TOPGEN   3392
#define XCD_BAR_WORDS 3456
#define XB_SPIN_CAP (1u << 22)

__device__ __forceinline__ unsigned xb_ld(unsigned* p)              { return __hip_atomic_load(p, __ATOMIC_RELAXED, __HIP_MEMORY_SCOPE_AGENT); }
__device__ __forceinline__ unsigned xb_add(unsigned* p, unsigned v) { return __hip_atomic_fetch_add(p, v, __ATOMIC_RELAXED, __HIP_MEMORY_SCOPE_AGENT); }
__device__ __forceinline__ unsigned xb_xcc_id() { return (unsigned)__builtin_amdgcn_s_getreg((3 << 11) | 20) & 0xFu; }
#define XB_SPIN(cond, bar) do { unsigned _sp = 0; while (cond) { __builtin_amdgcn_s_sleep(1); \
    if ((++_sp & 255u) == 0u) { if (xb_ld(&(bar)[XB_TMO])) break; if (_sp > XB_SPIN_CAP) { atomicAdd(&(bar)[XB_TMO], 1u); break; } } } } while (0)

struct XcdBarrier { unsigned* bar; unsigned x; volatile LAS unsigned* st; };

__device__ __forceinline__ XcdBarrier xcd_barrier_post(unsigned* bar, volatile LAS unsigned* st) {
    XcdBarrier b; b.bar = bar; b.x = xb_xcc_id(); b.st = st;
    if (threadIdx.x == 0) (void)xb_add(&bar[XB_XCNT(b.x)], 1u);
    return b;
}
__device__ __forceinline__ void xcd_barrier_complete(unsigned* bar, unsigned x, unsigned& nloc, unsigned& nx) {
    const unsigned G = gridDim.x * gridDim.y * gridDim.z;
    unsigned sum, cnt, mine, sp = 0u;
    for (;;) {
        sum = 0u; cnt = 0u; mine = 0u;
#pragma unroll
        for (unsigned j = 0; j < 16; ++j) { const unsigned c = xb_ld(&bar[XB_XCNT(j)]); sum += c; cnt += (c > 0u) ? 1u : 0u; mine = (j == x) ? c : mine; }
        if (sum == G) break;
        __builtin_amdgcn_s_sleep(1);
        if ((++sp & 255u) == 0u) { if (xb_ld(&bar[XB_TMO])) break; if (sp > XB_SPIN_CAP) { atomicAdd(&bar[XB_TMO], 1u); break; } }
    }
    nloc = mine > 0u ? mine : 1u; nx = cnt > 0u ? cnt : 1u;
}
__device__ __forceinline__ void xcd_barrier(const XcdBarrier& b) {
    asm volatile("s_waitcnt vmcnt(0)" ::: "memory");
    __syncthreads();
    if (threadIdx.x == 0) {
        unsigned* bar = b.bar;
        __builtin_amdgcn_s_waitcnt(0);
        unsigned nloc = b.st[0], nx = b.st[1];
        if (nloc == 0u) { xcd_barrier_complete(bar, b.x, nloc, nx); b.st[0] = nloc; b.st[1] = nx; }
        const unsigned old = xb_add(&bar[XB_XSUB(b.x)], 1u);
        const unsigned gen = old / nloc;
        if (old + 1u == (gen + 1u) * nloc) {
            __builtin_amdgcn_fence(__ATOMIC_RELEASE, "agent");
            asm volatile("s_waitcnt vmcnt(0)" ::: "memory");
            const unsigned og = xb_add(&bar[XB_TOP], 1u);
            const unsigned tg = og / nx;
            if (og + 1u == (tg + 1u) * nx) xb_add(&bar[XB_TOPGEN], 1u);
            else XB_SPIN(xb_ld(&bar[XB_TOPGEN]) == tg, bar);
            __builtin_amdgcn_fence(__ATOMIC_ACQUIRE, "agent");
            xb_add(&bar[XB_XGEN(b.x)], 1u);
            asm volatile("s_waitcnt vmcnt(0)" ::: "memory");
        } else {
            XB_SPIN(xb_ld(&bar[XB_XGEN(b.x)]) == gen, bar);
            __builtin_amdgcn_fence(__ATOMIC_ACQUIRE, "agent");
            asm volatile("s_waitcnt vmcnt(0)" ::: "memory");
        }
    }
    __syncthreads();
}

namespace pg8 {
constexpr int BM = 256, BK = 64, HALF = 128, HTB = HALF * BK * 2, STAGE_BYTES = 8 * HTB, NXCD = 8, WGM = 8;
__host__ __device__ __forceinline__ int lds_byte(int r, int c) { const int st = (r >> 4) * 2 + (c >> 5), rr = r & 15, cc = c & 31, ob = rr * 64 + cc * 2; return st * 1024 + (ob ^ (((ob >> 9) & 1) << 5)); }
__host__ __device__ __forceinline__ void stage_rc(int b, int& R, int& C) { const int st = b / 1024, sb = b % 1024, swz = sb ^ (((sb >> 9) & 1) << 5); R = (st >> 1) * 16 + swz / 64; C = (st & 1) * 32 + (swz % 64) / 2; }
__host__ __device__ __forceinline__ int perm32(int rho) { const int n = rho >> 4, i = rho & 15; return 8 * (i >> 2) + 4 * n + (i & 3); }
struct Unit { int pm, pn, z; };
struct Gemm { const bf16_t* A; const bf16_t* Bt; int M, N, K, lda, ldb; long zA, zB; int nz; };
struct StaticOrder {
    int nM, nN, nZ, nwg, G, c;
    __device__ void init(int M, int N, int Z, int G_, int c_) { nM = M / BM; nN = N / BM; nZ = Z; nwg = nM * nN * nZ; G = G_; c = c_; }
    __device__ bool next(int i, Unit& u) const {
        const long L = (long)i * G + c; if (L >= nwg) return false;
        int wgid = (int)L; { const int q = nwg / NXCD, r = nwg % NXCD, xcd = wgid % NXCD, off = wgid / NXCD; wgid = (xcd < r ? xcd * (q + 1) : r * (q + 1) + (xcd - r) * q) + off; }
        const int per = nM * nN; u.z = wgid / per; wgid -= u.z * per;
        const int nig = WGM * nN, gid = wgid / nig, fm = gid * WGM, gsz = (nM - fm) < WGM ? (nM - fm) : WGM;
        u.pm = fm + ((wgid % nig) % gsz); u.pn = (wgid % nig) / gsz; return true;
    }
};
__device__ __forceinline__ unsigned cvt_pk_bf16(float lo, float hi) { unsigned r; asm volatile("v_cvt_pk_bf16_f32 %0, %1, %2" : "=v"(r) : "v"(lo), "v"(hi)); return r; }
struct EpiF32 {
    static constexpr bool PERM = false;
    float* C; int ldc; long zC; int nvalid;
    __device__ __forceinline__ void operator()(const f32x4 (&acc)[2][2][4][2], const Unit& u, int wr, int wc, int fr, int fq) const {
        const int row0 = u.pm * BM + wr * 64 + fr, col0 = u.pn * BM + wc * 32 + 4 * fq; float* Cz = C + (size_t)u.z * zC;
#pragma unroll
        for (int ai = 0; ai < 2; ++ai)
#pragma unroll
            for (int m = 0; m < 4; ++m) { float* rowp = Cz + (size_t)(row0 + ai * HALF + m * 16) * ldc + col0;
#pragma unroll
                for (int bj = 0; bj < 2; ++bj)
#pragma unroll
                    for (int n = 0; n < 2; ++n) if (col0 + bj * HALF + n * 16 < nvalid) *(f32x4*)(rowp + bj * HALF + n * 16) = acc[ai][bj][m][n]; }
    }
};
struct EpiResid {
    static constexpr bool PERM = true;
    const bf16_t* base; bf16_t* out; int ldc;
    __device__ __forceinline__ void operator()(const f32x4 (&acc)[2][2][4][2], const Unit& u, int wr, int wc, int fr, int fq) const {
        const int row0 = u.pm * BM + wr * 64 + fr, col0 = u.pn * BM + wc * 32 + 8 * fq;
#pragma unroll
        for (int ai = 0; ai < 2; ++ai)
#pragma unroll
            for (int m = 0; m < 4; ++m) { const size_t off = (size_t)(row0 + ai * HALF + m * 16) * ldc + col0;
#pragma unroll
                for (int bj = 0; bj < 2; ++bj) { const u32x4 bs = *(const u32x4*)(base + off + bj * HALF); const f32x4 v0 = acc[ai][bj][m][0], v1 = acc[ai][bj][m][1];
                    u32x4 wv;
                    wv.x = cvt_pk_bf16(fmaf(ALPHA, __uint_as_float(bs.x << 16), v0[0]), fmaf(ALPHA, __uint_as_float(bs.x & 0xffff0000u), v0[1]));
                    wv.y = cvt_pk_bf16(fmaf(ALPHA, __uint_as_float(bs.y << 16), v0[2]), fmaf(ALPHA, __uint_as_float(bs.y & 0xffff0000u), v0[3]));
                    wv.z = cvt_pk_bf16(fmaf(ALPHA, __uint_as_float(bs.z << 16), v1[0]), fmaf(ALPHA, __uint_as_float(bs.z & 0xffff0000u), v1[1]));
                    wv.w = cvt_pk_bf16(fmaf(ALPHA, __uint_as_float(bs.w << 16), v1[2]), fmaf(ALPHA, __uint_as_float(bs.w & 0xffff0000u), v1[3]));
                    *(u32x4*)(out + off + bj * HALF) = wv; }
                asm volatile("" ::: "memory"); }
    }
};
struct EpiBf16 {
    static constexpr bool PERM = true;
    bf16_t* O; int ldc; const float* rs;
    __device__ __forceinline__ void operator()(const f32x4 (&acc)[2][2][4][2], const Unit& u, int wr, int wc, int fr, int fq) const {
        const int row0 = u.pm * BM + wr * 64 + fr, col0 = u.pn * BM + wc * 32 + 8 * fq;
#pragma unroll
        for (int ai = 0; ai < 2; ++ai)
#pragma unroll
            for (int m = 0; m < 4; ++m) { const int row = row0 + ai * HALF + m * 16; bf16_t* rowp = O + (size_t)row * ldc + col0; const float sc = rs ? rs[row] : 1.f;
#pragma unroll
                for (int bj = 0; bj < 2; ++bj) { const f32x4 v0 = acc[ai][bj][m][0] * sc, v1 = acc[ai][bj][m][1] * sc;
                    u32x4 wv; wv.x = cvt_pk_bf16(v0[0], v0[1]); wv.y = cvt_pk_bf16(v0[2], v0[3]); wv.z = cvt_pk_bf16(v1[0], v1[1]); wv.w = cvt_pk_bf16(v1[2], v1[3]);
                    *(u32x4*)(rowp + bj * HALF) = wv; } }
    }
};
template <class Epi, class Sched>
__device__ __forceinline__ void gemm_phase(LAS unsigned char* lds, const Gemm g, const Sched& S, const Epi& E) {
    const int tid = threadIdx.x, wid = __builtin_amdgcn_readfirstlane(tid >> 6), lane = tid & 63, wr = wid >> 2, wc = wid & 3, fr = lane & 15, fq = lane >> 4;
    const int K = g.K, nt = K / BK;
    unsigned voffA[2], voffB[2];
#pragma unroll
    for (int i = 0; i < 2; ++i) { int R, C; stage_rc(tid * 16 + i * 8192, R, C); const int Rb = Epi::PERM ? ((R & ~31) + perm32(R & 31)) : R;
        voffA[i] = (unsigned)(R * g.lda + C) * 2u; voffB[i] = (unsigned)(Rb * g.ldb + C) * 2u; }
    const size_t kstep = (size_t)(BK * 2);
    const size_t hA = (size_t)HALF * g.lda * 2, hB = (size_t)HALF * g.ldb * 2;
    const size_t tA = 2 * hA, tB = 2 * hB;
    const unsigned ldsw = (unsigned)wid * 1024u;
    const int aoff = lds_byte(wr * 64 + fr, fq * 8), boff = lds_byte(wc * 32 + fr, fq * 8);
#define PG8_SA(b, h) (((b) * 2 + (h)) * HTB)
#define PG8_SB(b, h) ((4 + (b) * 2 + (h)) * HTB)
#define PG8_STAGE(bufoff, gbase, voff) do { _Pragma("unroll") for (int _i = 0; _i < 2; ++_i) \
        __builtin_amdgcn_global_load_lds((const unsigned*)((const char*)(gbase) + (voff)[_i]), (LAS unsigned*)(lds + (bufoff) + ldsw + _i * 8192), 16, 0, 0); } while (0)
#define PG8_LDA(dst, b, h) do { _Pragma("unroll") for (int m = 0; m < 4; ++m) _Pragma("unroll") for (int k = 0; k < 2; ++k) dst[m][k] = *(const LAS bf16x8*)(lds + PG8_SA(b, h) + aoff + m * 2048 + k * 1024); } while (0)
#define PG8_LDB(dst, b, h) do { _Pragma("unroll") for (int n = 0; n < 2; ++n) _Pragma("unroll") for (int k = 0; k < 2; ++k) dst[n][k] = *(const LAS bf16x8*)(lds + PG8_SB(b, h) + boff + n * 2048 + k * 1024); } while (0)
#define PG8_MMA(ai, bj, At, Bt) do { __builtin_amdgcn_s_setprio(1); _Pragma("unroll") for (int m = 0; m < 4; ++m) _Pragma("unroll") for (int n = 0; n < 2; ++n) _Pragma("unroll") for (int k = 0; k < 2; ++k) \
        acc[ai][bj][m][n] = __builtin_amdgcn_mfma_f32_16x16x32_bf16(Bt[n][k], At[m][k], acc[ai][bj][m][n], 0, 0, 0); __builtin_amdgcn_s_setprio(0); } while (0)
#define PG8_WAIT_V(n) asm volatile("s_waitcnt vmcnt(" #n ")" ::: "memory")
#define PG8_WAIT_L(n) asm volatile("s_waitcnt lgkmcnt(" #n ")" ::: "memory")
#define PG8_BAR __builtin_amdgcn_s_barrier()
#define PG8_SCHED __builtin_amdgcn_sched_barrier(0)
    Unit cur, nxt; int ui = 0;
    if (!S.next(0, cur)) return;
    f32x4 acc[2][2][4][2];
#pragma unroll
    for (int a = 0; a < 2; ++a)
#pragma unroll
        for (int b = 0; b < 2; ++b)
#pragma unroll
            for (int m = 0; m < 4; ++m)
#pragma unroll
                for (int n = 0; n < 2; ++n) acc[a][b][m][n] = (f32x4){0.f, 0.f, 0.f, 0.f};
    bf16x8 At[4][2], B0[2][2], B1[2][2];
    const char* cA = (const char*)g.A + (size_t)cur.pm * tA + (size_t)cur.z * g.zA * 2; const char* cB = (const char*)g.Bt + (size_t)cur.pn * tB + (size_t)cur.z * g.zB * 2;
    PG8_STAGE(PG8_SB(0, 0), cB, voffB); PG8_STAGE(PG8_SA(0, 0), cA, voffA); PG8_STAGE(PG8_SB(0, 1), cB + hB, voffB); PG8_STAGE(PG8_SA(0, 1), cA + hA, voffA);
    if (wr == 1) PG8_BAR;
    PG8_WAIT_V(4); PG8_BAR;
    PG8_STAGE(PG8_SB(1, 0), cB + kstep, voffB); PG8_STAGE(PG8_SA(1, 0), cA + kstep, voffA); PG8_STAGE(PG8_SB(1, 1), cB + hB + kstep, voffB);
    PG8_WAIT_V(6); PG8_BAR;
    for (;;) {
        const bool has_next = S.next(ui + 1, nxt);
        const char* nA = has_next ? (const char*)g.A + (size_t)nxt.pm * tA + (size_t)nxt.z * g.zA * 2 : cA; const char* nB = has_next ? (const char*)g.Bt + (size_t)nxt.pn * tB + (size_t)nxt.z * g.zB * 2 : cB;
        for (int t = 0; t < nt; t += 2) {
            const bool last = (t == nt - 2);
            const char* a1 = cA + (size_t)(t + 1) * kstep;
            const char* a2 = last ? nA : cA + (size_t)(t + 2) * kstep; const char* b2 = last ? nB : cB + (size_t)(t + 2) * kstep;
            const char* a3 = a2 + kstep; const char* b3 = b2 + kstep;
            PG8_LDB(B0, 0, 0); PG8_SCHED; PG8_LDA(At, 0, 0); PG8_STAGE(PG8_SA(1, 1), a1 + hA, voffA);
            PG8_WAIT_L(8); PG8_BAR; PG8_WAIT_L(0); PG8_MMA(0, 0, At, B0); PG8_BAR; PG8_SCHED;
            PG8_LDB(B1, 0, 1); PG8_STAGE(PG8_SB(0, 0), b2, voffB);
            PG8_BAR; PG8_WAIT_L(0); PG8_MMA(0, 1, At, B1); PG8_BAR;
            PG8_LDA(At, 0, 1); PG8_STAGE(PG8_SA(0, 0), a2, voffA);
            PG8_BAR; PG8_WAIT_L(0); PG8_MMA(1, 0, At, B0); PG8_BAR; PG8_SCHED;
            PG8_STAGE(PG8_SB(0, 1), b2 + hB, voffB);
            PG8_WAIT_V(6); PG8_BAR; PG8_MMA(1, 1, At, B1); PG8_BAR;
            PG8_LDB(B0, 1, 0); PG8_SCHED; PG8_LDA(At, 1, 0); PG8_STAGE(PG8_SA(0, 1), a2 + hA, voffA);
            PG8_WAIT_L(8); PG8_BAR; PG8_WAIT_L(0); PG8_MMA(0, 0, At, B0); PG8_BAR; PG8_SCHED;
            PG8_LDB(B1, 1, 1); PG8_STAGE(PG8_SB(1, 0), b3, voffB);
            PG8_BAR; PG8_WAIT_L(0); PG8_MMA(0, 1, At, B1); PG8_BAR;
            PG8_LDA(At, 1, 1); PG8_STAGE(PG8_SA(1, 0), a3, voffA);
            PG8_BAR; PG8_WAIT_L(0); PG8_MMA(1, 0, At, B0); PG8_BAR; PG8_SCHED;
            PG8_STAGE(PG8_SB(1, 1), b3 + hB, voffB);
            PG8_WAIT_V(6); PG8_BAR; PG8_MMA(1, 1, At, B1); PG8_BAR;
        }
        E(acc, cur, wr, wc, fr, fq);
        if (!has_next) break;
#pragma unroll
        for (int a = 0; a < 2; ++a)
#pragma unroll
            for (int b = 0; b < 2; ++b)
#pragma unroll
                for (int m = 0; m < 4; ++m)
#pragma unroll
                    for (int n = 0; n < 2; ++n) acc[a][b][m][n] = (f32x4){0.f, 0.f, 0.f, 0.f};
        cur = nxt; cA = nA; cB = nB; ++ui;
    }
    PG8_WAIT_V(0);
    if (wr == 0) PG8_BAR;
    PG8_BAR;
#undef PG8_SA
#undef PG8_SB
#undef PG8_STAGE
#undef PG8_LDA
#undef PG8_LDB
#undef PG8_MMA
#undef PG8_WAIT_V
#undef PG8_WAIT_L
#undef PG8_BAR
#undef PG8_SCHED
}
}

struct Args { const float* in[21]; float* out; unsigned char* ws; int ph_lo, ph_hi; };
enum { I_X = 0, I_MEM, I_AB_W_IN, I_A_REL_BIAS, I_B_Q_NORM, I_B_W_UQ, I_B_KV_NORM, I_B_W_UKV, I_AB_W_OUT, I_CD_W_IN, I_D_FORGET_BIAS, I_CD_W_OUT,
       I_MEM_W_Q, I_MEM_W_KV, I_MEM_W_O, I_PEER_W_Q, I_PEER_SUB_KEYS, I_PEER_U, I_PEER_V, I_LN_G, I_LN_B };

struct WI { int tid, lane, wave, gw, ngw, bid, nblk; };

__device__ __forceinline__ void tr_item(const float* W, int K, int ld, int c0, int nc, bf16_t* WT, int r0, const float* scale, LAS float* scr, int item, int lane) {
    const int nblk = (nc + 63) >> 6, kb = item / nblk, nb = item - kb * nblk, k0 = 64 * kb, n0 = 64 * nb;
    const int ln = (lane & 15) * 4, lk = lane >> 4; const bool ok = n0 + ln < nc;
    const float* src = W + (size_t)(k0 + lk) * ld + c0 + n0 + ln;
    f32x4 v[16];
#pragma unroll
    for (int i = 0; i < 16; ++i) v[i] = ok ? *(const f32x4*)(src + (size_t)(4 * i) * ld) : (f32x4){0.f, 0.f, 0.f, 0.f};
#pragma unroll
    for (int i = 0; i < 16; ++i) { const int kk = lk + 4 * i; const float s = scale ? scale[k0 + kk] : 1.f; LAS float* d = scr + kk * 65 + ln;
        d[0] = v[i].x * s; d[1] = v[i].y * s; d[2] = v[i].z * s; d[3] = v[i].w * s; }
    LDS_WAIT();
    const int c = lane & 7;
#pragma unroll
    for (int j = 0; j < 8; ++j) { const int n = (lane >> 3) + 8 * j; const LAS float* s = scr + (8 * c) * 65 + n;
        u32x4 o; o.x = pk2(s[0 * 65], s[1 * 65]); o.y = pk2(s[2 * 65], s[3 * 65]); o.z = pk2(s[4 * 65], s[5 * 65]); o.w = pk2(s[6 * 65], s[7 * 65]);
        if (n0 + n < nc) *(u32x4*)(WT + (size_t)(r0 + n0 + n) * K + k0 + 8 * c) = o; }
    LDS_WAIT();
}
__device__ __forceinline__ void cvt_rows(const float* src, bf16_t* dst, size_t n, size_t i0, size_t stride) {
    size_t i = i0 * 8;
    for (; i + 3 * stride * 8 < n; i += 4 * stride * 8) {
        f32x4 a[4], b[4];
#pragma unroll
        for (int q = 0; q < 4; ++q) { a[q] = *(const f32x4*)(src + i + q * stride * 8); b[q] = *(const f32x4*)(src + i + q * stride * 8 + 4); }
#pragma unroll
        for (int q = 0; q < 4; ++q) { u32x4 o; o.x = pk2(a[q].x, a[q].y); o.y = pk2(a[q].z, a[q].w); o.z = pk2(b[q].x, b[q].y); o.w = pk2(b[q].z, b[q].w); *(u32x4*)(dst + i + q * stride * 8) = o; }
    }
    for (; i < n; i += stride * 8) {
        const f32x4 a = *(const f32x4*)(src + i), b = *(const f32x4*)(src + i + 4);
        u32x4 o; o.x = pk2(a.x, a.y); o.y = pk2(a.z, a.w); o.z = pk2(b.x, b.y); o.w = pk2(b.z, b.w);
        *(u32x4*)(dst + i) = o;
    }
}
__device__ __forceinline__ void ph_convert(const Args& a, LAS unsigned char* lds, const WI& w) {
    unsigned char* ws = a.ws;
    LAS float* scr = (LAS float*)(lds + w.wave * 16640);
    constexpr int J1 = 64 * 129, J2 = 24 * 48, J3 = 8 * 64, J4 = 64 * 64, J5 = 64 * 80, J6 = 64 * 96, J7 = 64 * 2, J8 = 64 * 1, J9 = 64 * 64,
                  J10 = 64 * 8, J12 = 64 * 16, J14 = 8 * 64;
    constexpr int NJ = J1 + J2 + J3 + J4 + J5 + J6 + J7 + J8 + J9 + 2 * J10 + 2 * J12 + 2 * J14;
    for (int it = w.gw; it < NJ; it += w.ngw) {
        int r = it; const float* src; int K, ld, c0 = 0, nc, r0 = 0; bf16_t* dst; const float* sc = nullptr;
        if (r < J1) { src = a.in[I_AB_W_IN]; K = 4096; ld = AB_COLS; nc = AB_COLS; dst = (bf16_t*)(ws + WS_W_AB_IN); }
        else if ((r -= J1) < J2) { src = a.in[I_B_W_UQ]; K = 1536; ld = 3072; nc = 3072; dst = (bf16_t*)(ws + WS_W_UQ); sc = a.in[I_B_Q_NORM]; }
        else if ((r -= J2) < J3) { src = a.in[I_B_W_UKV]; K = 512; ld = 4096; nc = 4096; dst = (bf16_t*)(ws + WS_W_UKV); sc = a.in[I_B_KV_NORM]; }
        else if ((r -= J3) < J4) { src = a.in[I_AB_W_OUT]; K = 4096; ld = 4096; nc = 4096; dst = (bf16_t*)(ws + WS_W_AB_OUT); }
        else if ((r -= J4) < J5) { src = a.in[I_CD_W_IN]; K = 4096; ld = CD_COLS; c0 = 0; nc = 5120; r0 = 0; dst = (bf16_t*)(ws + WS_W_CD_IN); }
        else if ((r -= J5) < J6) { src = a.in[I_CD_W_IN]; K = 4096; ld = CD_COLS; c0 = 5216; nc = 6144; r0 = 5120; dst = (bf16_t*)(ws + WS_W_CD_IN); }
        else if ((r -= J6) < J7) { src = a.in[I_CD_W_IN]; K = 4096; ld = CD_COLS; c0 = 5120; nc = 96; r0 = 11264; dst = (bf16_t*)(ws + WS_W_CD_IN); }
        else if ((r -= J7) < J8) { src = a.in[I_CD_W_IN]; K = 4096; ld = CD_COLS; c0 = 11360; nc = 16; r0 = 11360; dst = (bf16_t*)(ws + WS_W_CD_IN); }
        else if ((r -= J8) < J9) { src = a.in[I_CD_W_OUT]; K = 4096; ld = 4096; nc = 4096; dst = (bf16_t*)(ws + WS_W_CD_OUT); }
        else if ((r -= J9) < 2 * J10) { const int l = r / J10; r -= l * J10; src = a.in[I_MEM_W_Q] + (size_t)l * 4096 * 512; K = 4096; ld = 512; nc = 512; dst = (bf16_t*)(ws + WS_W_MEM_Q) + (size_t)l * 512 * 4096; }
        else if ((r -= 2 * J10) < 2 * J12) { const int l = r / J12; r -= l * J12; src = a.in[I_MEM_W_KV] + (size_t)l * 4096 * 1024; K = 4096; ld = 1024; nc = 1024; dst = (bf16_t*)(ws + WS_W_MEM_KV) + (size_t)l * 1024 * 4096; }
        else { r -= 2 * J12; const int l = r / J14; r -= l * J14; src = a.in[I_MEM_W_O] + (size_t)l * 512 * 4096; K = 512; ld = 4096; nc = 4096; dst = (bf16_t*)(ws + WS_W_MEM_O) + (size_t)l * 4096 * 512; }
        tr_item(src, K, ld, c0, nc, dst, r0, sc, scr, r, w.lane);
    }
    { const size_t gt = (size_t)w.gw * 64 + w.lane, ng = (size_t)w.ngw * 64;
      bf16_t* p1 = (bf16_t*)(ws + WS_W_AB_IN) + (size_t)AB_COLS * 4096; const size_t n1 = (size_t)(AB_PAD - AB_COLS) * 4096;
      for (size_t i = gt * 8; i < n1; i += ng * 8) *(u32x4*)(p1 + i) = (u32x4){0u, 0u, 0u, 0u};
      bf16_t* p2 = (bf16_t*)(ws + WS_W_CD_IN) + (size_t)CD_COLS * 4096; const size_t n2 = (size_t)(CD_PAD - CD_COLS) * 4096;
      for (size_t i = gt * 8; i < n2; i += ng * 8) *(u32x4*)(p2 + i) = (u32x4){0u, 0u, 0u, 0u};
      cvt_rows(a.in[I_X], (bf16_t*)(ws + WS_XB), (size_t)T * DM, gt, ng);
      cvt_rows(a.in[I_MEM], (bf16_t*)(ws + WS_MEMB), (size_t)512 * DM, gt, ng);
      for (int r = w.gw; r < 65536; r += w.ngw) { const int tbl = r >> 15, rr = r & 32767;
          const float* srow = (tbl ? a.in[I_PEER_V] : a.in[I_PEER_U]) + (size_t)rr * DM + 32 * w.lane;
          unsigned char* dbase = ws + (tbl ? WS_V8 : WS_U8);
          f32x4 v[2][8];
#pragma unroll
          for (int i = 0; i < 2; ++i)
#pragma unroll
              for (int q = 0; q < 8; ++q) v[i][q] = *(const f32x4*)(srow + 2048 * i + 4 * q);
          unsigned scb = 0u;
#pragma unroll
          for (int i = 0; i < 2; ++i) { float bm = 0.f;
#pragma unroll
              for (int q = 0; q < 8; ++q) bm = fmaxf(bm, fmaxf(fmaxf(fabsf(v[i][q].x), fabsf(v[i][q].y)), fmaxf(fabsf(v[i][q].z), fabsf(v[i][q].w))));
              int b = 128; if (bm > 0.f) { b = (int)ceilf(8.f * __log2f(bm * (1.f / 6.f)) + 0.02f) + 128; b = b < 0 ? 0 : (b > 255 ? 255 : b); }
              const float inv = __builtin_amdgcn_exp2f((float)(128 - b) * 0.125f);
              u32x4 o;
#pragma unroll
              for (int d = 0; d < 4; ++d) { unsigned wv = 0u; const f32x4 p0 = v[i][2 * d] * inv, p1 = v[i][2 * d + 1] * inv;
                  wv = __builtin_amdgcn_cvt_scalef32_pk_fp4_f32(wv, p0.x, p0.y, 1.0f, 0); wv = __builtin_amdgcn_cvt_scalef32_pk_fp4_f32(wv, p0.z, p0.w, 1.0f, 1);
                  wv = __builtin_amdgcn_cvt_scalef32_pk_fp4_f32(wv, p1.x, p1.y, 1.0f, 2); wv = __builtin_amdgcn_cvt_scalef32_pk_fp4_f32(wv, p1.z, p1.w, 1.0f, 3); o[d] = wv; }
              *(u32x4*)(dbase + (size_t)rr * 2048 + 1024 * i + 16 * w.lane) = o;
              scb |= (unsigned)b << (8 * i); }
          ((unsigned short*)(dbase + 64 * MiB))[(size_t)rr * 64 + w.lane] = (unsigned short)scb; }
      float* r128 = (float*)(ws + WS_ROPE128); float* r64 = (float*)(ws + WS_ROPE64);
      for (size_t i = gt; i < (size_t)SEQ * 96; i += ng) {
          const int s = (int)(i / 96), j = (int)(i % 96); const bool big = j < 64; const int ii = big ? j : j - 64;
          const double rr = big ? 0.8659643233600653 : 0.7498942093324559; double inv = 1.0;
          for (int q = 0; q < ii; ++q) inv *= rr;
          const double rev = (double)s * inv * 0.15915494309189535; const float fr = (float)(rev - rint(rev));
          const float cs = __builtin_amdgcn_cosf(fr), sn = __builtin_amdgcn_sinf(fr);
          float* o = big ? (r128 + ((size_t)s * 64 + ii) * 2) : (r64 + ((size_t)s * 32 + ii) * 2);
          o[0] = cs; o[1] = sn; }
    }
    {
        LAS float* Ks = (LAS float*)lds; LAS float* Ws = Ks + 128 * 129;
        const int tk = w.tid & 31, tn = w.tid >> 5;
        for (int it = w.bid; it < 2 * 16 * 32; it += w.nblk) {
            const int l = it >> 9, hp = (it >> 5) & 15, kb = it & 31;
            __syncthreads();
            const float* keys = a.in[I_PEER_SUB_KEYS] + ((size_t)(l * 16 + hp) * 128) * 128;
            const float* wq = a.in[I_PEER_W_Q] + ((size_t)l * 4096 + (size_t)kb * 128) * 2048 + hp * 128;
            for (int e = w.tid; e < 128 * 128; e += 512) { const int rrow = e >> 7, d = e & 127; Ks[rrow * 129 + d] = keys[(size_t)rrow * 128 + d]; Ws[rrow * 129 + d] = wq[(size_t)rrow * 2048 + d]; }
            __syncthreads();
            float acc[8][4];
#pragma unroll
            for (int x = 0; x < 8; ++x)
#pragma unroll
                for (int y = 0; y < 4; ++y) acc[x][y] = 0.f;
            for (int d = 0; d < 128; ++d) {
                float kv[8], wv[4];
#pragma unroll
                for (int x = 0; x < 8; ++x) kv[x] = Ks[(tn + 16 * x) * 129 + d];
#pragma unroll
                for (int y = 0; y < 4; ++y) wv[y] = Ws[(tk + 32 * y) * 129 + d];
#pragma unroll
                for (int x = 0; x < 8; ++x)
#pragma unroll
                    for (int y = 0; y < 4; ++y) acc[x][y] += kv[x] * wv[y];
            }
            bf16_t* dst = (bf16_t*)(ws + WS_W_PEER) + ((size_t)l * 2048 + hp * 128) * 4096 + kb * 128;
#pragma unroll
            for (int x = 0; x < 8; ++x)
#pragma unroll
                for (int y = 0; y < 4; ++y) dst[(size_t)(tn + 16 * x) * 4096 + tk + 32 * y] = (bf16_t)f2bf(acc[x][y]);
        }
        __syncthreads();
    }
}

__device__ __forceinline__ int crow(int r, int hi) { return (r & 3) + 8 * (r >> 2) + 4 * hi; }
template <class F>
__device__ __forceinline__ void naive_gemm(const bf16_t* A, int lda, const bf16_t* Bt, int ldb, int M, int N, int K, const WI& w, F epi) {
    const int tm = M >> 5, tn = (N + 31) >> 5;
    const int i = w.lane & 31, g = w.lane >> 5;
    for (int tile = w.gw; tile < tm * tn; tile += w.ngw) {
        const int bn = tile / tm, bm = tile - bn * tm;
        const bf16_t* ap = A + (size_t)(bm * 32 + i) * lda + 8 * g;
        const int nrow = bn * 32 + i; const bool nv = nrow < N;
        const bf16_t* bp = Bt + (size_t)(nv ? nrow : 0) * ldb + 8 * g;
        f32x16 acc = {};
#pragma unroll 4
        for (int k = 0; k < K; k += 16) {
            const bf16x8 av = *(const bf16x8*)(ap + k);
            bf16x8 bv = *(const bf16x8*)(bp + k);
            if (!nv) bv = (bf16x8){0, 0, 0, 0, 0, 0, 0, 0};
            acc = __builtin_amdgcn_mfma_f32_32x32x16_bf16(av, bv, acc, 0, 0, 0);
        }
#pragma unroll
        for (int r = 0; r < 16; ++r) { const int row = bm * 32 + crow(r, g), col = bn * 32 + i; if (col < N) epi(row, col, acc[r]); }
    }
}

__device__ __forceinline__ void ln_rows(const bf16_t* src, const float* g, const float* b, bf16_t* dstb, const WI& w) {
    for (int m = w.gw; m < T; m += w.ngw) {
        const u32x4* xr = (const u32x4*)(src + (size_t)m * DM) + w.lane;
        float v[64]; float s = 0.f;
#pragma unroll
        for (int j = 0; j < 8; ++j) { const u32x4 x = xr[64 * j];
#pragma unroll
            for (int e = 0; e < 4; ++e) { v[8 * j + 2 * e] = __uint_as_float(x[e] << 16); v[8 * j + 2 * e + 1] = __uint_as_float(x[e] & 0xffff0000u); s += v[8 * j + 2 * e] + v[8 * j + 2 * e + 1]; } }
        const float mean = wave_sum(s) * (1.f / DM); float s2 = 0.f;
#pragma unroll
        for (int i = 0; i < 64; ++i) { v[i] -= mean; s2 += v[i] * v[i]; }
        const float rstd = 1.f / sqrtf(wave_sum(s2) * (1.f / DM) + LN_EPS);
#pragma unroll
        for (int j = 0; j < 8; ++j) { const int c = 8 * w.lane + 512 * j;
            const f32x4 g0 = *(const f32x4*)(g + c), g1 = *(const f32x4*)(g + c + 4), b0 = *(const f32x4*)(b + c), b1 = *(const f32x4*)(b + c + 4);
            u32x4 p;
            p.x = pk2(v[8 * j + 0] * rstd * g0.x + b0.x, v[8 * j + 1] * rstd * g0.y + b0.y); p.y = pk2(v[8 * j + 2] * rstd * g0.z + b0.z, v[8 * j + 3] * rstd * g0.w + b0.w);
            p.z = pk2(v[8 * j + 4] * rstd * g1.x + b1.x, v[8 * j + 5] * rstd * g1.y + b1.y); p.w = pk2(v[8 * j + 6] * rstd * g1.z + b1.z, v[8 * j + 7] * rstd * g1.w + b1.w);
            *(u32x4*)(dstb + (size_t)m * DM + c) = p; }
    }
}

template <int MODE>
__device__ __forceinline__ void attn_naive(const Args& a, int layer, LAS float* qs, const WI& w) {
    constexpr int H = (MODE == 4) ? 4 : 16, DK = (MODE == 1) ? 192 : 128;
    const float scale = (MODE == 1) ? 0.07216878364870322f : 0.08838834764831845f;
    unsigned char* ws = a.ws;
    const float NEG = -__builtin_inff();
    for (int it = w.gw; it < T * H; it += w.ngw) {
        const int h = it / T, t = it - h * T, b = t / SEQ, sp = t - b * SEQ, c = sp >> 6;
        const bf16_t* qp; const bf16_t* kbase; const bf16_t* vbase; int ldk, ldv; bf16_t* op;
        int s_lo = 0, s_hi;
        if (MODE == 0) { const bf16_t* P = (const bf16_t*)(ws + WS_PROJ); qp = P + (size_t)t * AB_MAIN + h * 128; kbase = P + (size_t)b * SEQ * AB_MAIN + 2048 + h * 128; vbase = kbase + 2048; ldk = ldv = AB_MAIN;
            op = (bf16_t*)(ws + WS_ATT) + (size_t)t * DM + h * 128; s_lo = (c - 8) * 64; if (s_lo < 0) s_lo = 0; s_hi = (c + 1) * 64; }
        else if (MODE == 1) { qp = (const bf16_t*)(ws + WS_QB) + (size_t)t * 3072 + h * 192; kbase = (const bf16_t*)(ws + WS_KVB) + (size_t)b * SEQ * 4096 + h * 256; vbase = kbase + 128; ldk = ldv = 4096;
            op = (bf16_t*)(ws + WS_ATT) + (size_t)t * DM + 2048 + h * 128; s_hi = (c + 1) * 64; }
        else if (MODE == 2) { const bf16_t* P = (const bf16_t*)(ws + WS_PROJ); qp = P + (size_t)t * CD_MAIN + h * 128; kbase = P + (size_t)b * SEQ * CD_MAIN + 2048 + (h >> 2) * 128; vbase = kbase + 512; ldk = ldv = CD_MAIN;
            op = (bf16_t*)(ws + WS_ATT) + (size_t)t * DM + h * 128; s_hi = (c + 1) * 64; }
        else if (MODE == 3) { const bf16_t* P = (const bf16_t*)(ws + WS_PROJ); qp = P + (size_t)t * CD_MAIN + 5120 + h * 128; kbase = P + (size_t)b * SEQ * CD_MAIN + 7168 + h * 128; vbase = kbase + 2048; ldk = ldv = CD_MAIN;
            op = (bf16_t*)(ws + WS_ATT) + (size_t)t * DM + 2048 + h * 128; s_hi = sp + 1; }
        else { qp = (const bf16_t*)(ws + WS_MEMQ) + (size_t)t * 512 + h * 128; kbase = (const bf16_t*)(ws + WS_KVM) + ((size_t)layer * 512 + b * 256) * 1024 + h * 128; vbase = kbase + 512; ldk = ldv = 1024;
            op = (bf16_t*)(ws + WS_MEMO) + (size_t)t * 512 + h * 128; s_hi = 256; }
        LDS_WAIT();
        if (MODE == 4) { const float* mq = (const float*)(ws + WS_MQP) + (size_t)t * 512 + h * 128;
            for (int d = w.lane; d < DK; d += 64) qs[d] = bf2f((bf16_t)f2bf((mq[d] + mq[d + (size_t)T * 512]) + (mq[d + (size_t)2 * T * 512] + mq[d + (size_t)3 * T * 512]))); }
        else for (int d = w.lane; d < DK; d += 64) qs[d] = bf2f(qp[d]);
        LDS_WAIT();
        const float* cum = (const float*)(ws + WS_CUM) + ((size_t)b * 16 + h) * SEQ;
        const float ct = (MODE == 3) ? cum[sp] : 0.f;
        const float* relb = a.in[I_A_REL_BIAS] + h * 513;
        const unsigned* mrow = (const unsigned*)(ws + WS_MASK) + (size_t)t * 128;
        float m = NEG, l = 0.f, o0 = 0.f, o1 = 0.f;
        for (int s0 = s_lo; s0 < s_hi; s0 += 64) {
            const int s = s0 + w.lane; bool valid = s < s_hi;
            if (MODE == 2) { if (valid) valid = (mrow[s >> 5] >> (s & 31)) & 1u; }
            float x = NEG;
            if (valid) {
                const bf16_t* kp = kbase + (size_t)s * ldk; float acc = 0.f;
#pragma unroll 4
                for (int d0 = 0; d0 < 128; d0 += 8) { const bf16x8 kv = *(const bf16x8*)(kp + d0);
#pragma unroll
                    for (int e = 0; e < 8; ++e) acc += qs[d0 + e] * bf2f((bf16_t)kv[e]); }
                if (MODE == 1) { const bf16_t* kr = (const bf16_t*)(ws + WS_KR) + ((size_t)b * SEQ + s) * 64;
#pragma unroll 4
                    for (int d0 = 0; d0 < 64; d0 += 8) { const bf16x8 kv = *(const bf16x8*)(kr + d0);
#pragma unroll
                        for (int e = 0; e < 8; ++e) acc += qs[128 + d0 + e] * bf2f((bf16_t)kv[e]); } }
                x = acc * scale;
                if (MODE == 0) { int rel = sp - s; rel = rel < -256 ? -256 : (rel > 256 ? 256 : rel); x += relb[rel + 256]; }
                if (MODE == 3) x += ct - cum[s];
            }
            const float mx = wave_max(x);
            if (mx == NEG) continue;
            const float mn = fmaxf(m, mx); const float p = valid ? __expf(x - mn) : 0.f; const float al = __expf(m - mn);
            l = l * al + wave_sum(p); o0 *= al; o1 *= al; m = mn;
            for (int j = 0; j < 64; ++j) { const float pj = __shfl(p, j);
                if (pj != 0.f) { const bf16_t* vp = vbase + (size_t)(s0 + j) * ldv; o0 += pj * bf2f(vp[w.lane]); o1 += pj * bf2f(vp[w.lane + 64]); } }
        }
        const float rl = 1.f / l;
        op[w.lane] = (bf16_t)f2bf(o0 * rl); op[w.lane + 64] = (bf16_t)f2bf(o1 * rl);
    }
}

namespace fa {
constexpr int SHM_V = 64 * 128 * 2;
constexpr int LDS_V = 0, LDS_K = 2 * SHM_V, LDS_WS = LDS_K + 2 * 64 * 384, LDS_RELB = LDS_WS + 8 * 64 * 4, LDS_CS = LDS_RELB + 2304, LDS_END = LDS_CS + 512;
#define FA_KSWZ(row, colB, RS) ((row) * (RS) + ((colB) ^ (((row) & 7) << 4)))
__device__ __forceinline__ int v_st(int k, int c) { const int kk = (k & ~0xC) | ((k & 4) << 1) | ((k & 8) >> 1); return ((kk >> 3) * 4 + (c >> 5)) * 512 + ((kk & 7) * 32 + (c & 31)) * 2; }
__device__ __forceinline__ int v_rd_base(int lane) { return ((lane & 3) << 3) | (((lane >> 2) & 3) << 6) | (((lane >> 4) & 1) << 5) | (((lane >> 5) & 1) << 8); }
__device__ __forceinline__ unsigned cvtpk(float lo, float hi) { unsigned r; asm volatile("v_cvt_pk_bf16_f32 %0, %1, %2" : "=v"(r) : "v"(lo), "v"(hi)); return r; }
typedef short s16x4 __attribute__((ext_vector_type(4)));

template <int DK>
__device__ __forceinline__ void qkt(f32x16& p0, f32x16& p1, LAS const char* Kb, int r32, int hi, const bf16x8* qr) {
    constexpr int RS = DK * 2;
    p0 = f32x16{}; p1 = f32x16{};
    LAS const char* kb[4];
#pragma unroll
    for (int dd = 0; dd < 4; ++dd) kb[dd] = Kb + FA_KSWZ(r32, (dd * 16 + hi * 8) * 2, RS);
#pragma unroll
    for (int d0 = 0; d0 < DK / 16; ++d0) { LAS const char* ap = kb[d0 & 3] + (d0 >> 2) * 128;
        const bf16x8 b0 = *(LAS const bf16x8*)ap;
        const bf16x8 b1 = *(LAS const bf16x8*)(ap + 32 * RS);
        p0 = __builtin_amdgcn_mfma_f32_32x32x16_bf16(b0, qr[d0], p0, 0, 0, 0);
        p1 = __builtin_amdgcn_mfma_f32_32x32x16_bf16(b1, qr[d0], p1, 0, 0, 0); }
}
__device__ __forceinline__ void pv_tile(f32x16* o, int vb0, bf16x8 pa0, bf16x8 pa1, bf16x8 pa2, bf16x8 pa3) {
#define FA_TRRD(dst, off) asm volatile("ds_read_b64_tr_b16 %0, %1 offset:%2" : "=&v"(dst) : "v"(vb0), "i"(off) : "memory")
#define FA_PV_D0(d0) do { s16x4 l0, l1, l2, l3, h0, h1, h2, h3; constexpr int b_ = (d0) * 512; \
        FA_TRRD(l0, b_); FA_TRRD(h0, b_ + 2048); FA_TRRD(l1, b_ + 4096); FA_TRRD(h1, b_ + 6144); FA_TRRD(l2, b_ + 8192); FA_TRRD(h2, b_ + 10240); FA_TRRD(l3, b_ + 12288); FA_TRRD(h3, b_ + 14336); \
        asm volatile("s_waitcnt lgkmcnt(0)" ::: "memory"); __builtin_amdgcn_sched_barrier(0); \
        o[d0] = __builtin_amdgcn_mfma_f32_32x32x16_bf16(pa0, (bf16x8){l0[0], l0[1], l0[2], l0[3], h0[0], h0[1], h0[2], h0[3]}, o[d0], 0, 0, 0); \
        o[d0] = __builtin_amdgcn_mfma_f32_32x32x16_bf16(pa1, (bf16x8){l1[0], l1[1], l1[2], l1[3], h1[0], h1[1], h1[2], h1[3]}, o[d0], 0, 0, 0); \
        o[d0] = __builtin_amdgcn_mfma_f32_32x32x16_bf16(pa2, (bf16x8){l2[0], l2[1], l2[2], l2[3], h2[0], h2[1], h2[2], h2[3]}, o[d0], 0, 0, 0); \
        o[d0] = __builtin_amdgcn_mfma_f32_32x32x16_bf16(pa3, (bf16x8){l3[0], l3[1], l3[2], l3[3], h3[0], h3[1], h3[2], h3[3]}, o[d0], 0, 0, 0); } while (0)
    FA_PV_D0(0); FA_PV_D0(1); FA_PV_D0(2); FA_PV_D0(3);
#undef FA_PV_D0
#undef FA_TRRD
}
__device__ __forceinline__ void softmax_tile(f32x16& p0, f32x16& p1, float& m_reg, float& l_reg, float& alpha, bf16x8& pa0, bf16x8& pa1, bf16x8& pa2, bf16x8& pa3) {
    float pmax = p0[0];
#pragma unroll
    for (int r = 1; r < 16; ++r) pmax = fmaxf(pmax, p0[r]);
#pragma unroll
    for (int r = 0; r < 16; ++r) pmax = fmaxf(pmax, p1[r]);
    { auto rr = __builtin_amdgcn_permlane32_swap(__float_as_uint(pmax), __float_as_uint(pmax), false, false);
      pmax = fmaxf(__uint_as_float(rr[0]), __uint_as_float(rr[1])); }
    const float mn = fmaxf(m_reg, pmax); alpha = __builtin_amdgcn_exp2f(m_reg - mn); m_reg = mn;
#pragma unroll
    for (int r = 0; r < 16; ++r) { p0[r] = __builtin_amdgcn_exp2f(p0[r] - mn); p1[r] = __builtin_amdgcn_exp2f(p1[r] - mn); }
    float ps = 0.f;
#pragma unroll
    for (int r = 0; r < 16; ++r) ps += p0[r];
#pragma unroll
    for (int r = 0; r < 16; ++r) ps += p1[r];
    { auto rr = __builtin_amdgcn_permlane32_swap(__float_as_uint(ps), __float_as_uint(ps), false, false);
      ps = __uint_as_float(rr[0]) + __uint_as_float(rr[1]); }
    l_reg = l_reg * alpha + ps;
#define FA_PK4(P, B_, OUT) do { unsigned a0 = cvtpk(P[B_+0], P[B_+1]), a1 = cvtpk(P[B_+2], P[B_+3]); \
        unsigned b0 = cvtpk(P[B_+4], P[B_+5]), b1 = cvtpk(P[B_+6], P[B_+7]); \
        auto r0 = __builtin_amdgcn_permlane32_swap(a0, b0, false, false); auto r1 = __builtin_amdgcn_permlane32_swap(a1, b1, false, false); \
        u32x4 wv = {r0[0], r1[0], r0[1], r1[1]}; OUT = *reinterpret_cast<bf16x8*>(&wv); } while (0)
    FA_PK4(p0, 0, pa0); FA_PK4(p0, 8, pa1); FA_PK4(p1, 0, pa2); FA_PK4(p1, 8, pa3);
#undef FA_PK4
}

template <int MODE>
__device__ __forceinline__ void attn_unit(const Args& a, int layer, LAS unsigned char* lds, int b, int h, int qb) {
    constexpr int DK = (MODE == 1) ? 192 : 128, RS = DK * 2, SHM_K = 64 * RS, NQ = DK / 16;
    constexpr float C2 = (MODE == 1) ? 1.4426950408889634f * 0.07216878364870322f : 1.4426950408889634f * 0.08838834764831845f;
    constexpr float L2E = 1.4426950408889634f;
    unsigned char* ws = a.ws;
    const int tid = threadIdx.x, wid = __builtin_amdgcn_readfirstlane(tid >> 6), lane = tid & 63, r32 = lane & 31, hi = lane >> 5;
    const int P0 = qb * 256, qlo = P0 + wid * 32, row = qlo + r32, cw = qlo >> 6;
    const size_t tb = (size_t)b * SEQ;
    const float NEG = -__builtin_inff();
    const bf16_t* Kg; const bf16_t* Vg; int ldk, ldv; bf16_t* Og; int ldo; int j_lo = 0, j_hi;
    if (MODE == 0) { const bf16_t* P = (const bf16_t*)(ws + WS_PROJ); Kg = P + tb * AB_MAIN + 2048 + h * 128; Vg = Kg + 2048; ldk = ldv = AB_MAIN; Og = (bf16_t*)(ws + WS_ATT) + (tb + qlo) * DM + h * 128; ldo = DM;
        j_lo = (P0 >> 6) - 8; if (j_lo < 0) j_lo = 0; j_hi = (P0 >> 6) + 4; }
    else if (MODE == 1) { Kg = (const bf16_t*)(ws + WS_KVB) + tb * 4096 + h * 256; Vg = Kg + 128; ldk = ldv = 4096; Og = (bf16_t*)(ws + WS_ATT) + (tb + qlo) * DM + 2048 + h * 128; ldo = DM; j_hi = (P0 >> 6) + 4; }
    else if (MODE == 2) { const bf16_t* P = (const bf16_t*)(ws + WS_PROJ); Kg = P + tb * CD_MAIN + 2048 + (h >> 2) * 128; Vg = Kg + 512; ldk = ldv = CD_MAIN; Og = (bf16_t*)(ws + WS_ATT) + (tb + qlo) * DM + h * 128; ldo = DM; j_hi = (P0 >> 6) + 4; }
    else if (MODE == 3) { const bf16_t* P = (const bf16_t*)(ws + WS_PROJ); Kg = P + tb * CD_MAIN + 7168 + h * 128; Vg = Kg + 2048; ldk = ldv = CD_MAIN; Og = (bf16_t*)(ws + WS_ATT) + (tb + qlo) * DM + 2048 + h * 128; ldo = DM; j_hi = (P0 >> 6) + 4; }
    else { Kg = (const bf16_t*)(ws + WS_KVM) + ((size_t)layer * 512 + b * 256) * 1024 + h * 128; Vg = Kg + 512; ldk = ldv = 1024; Og = (bf16_t*)(ws + WS_MEMO) + (tb + qlo) * 512 + h * 128; ldo = 512; j_hi = 4; }
    const int NT = j_hi - j_lo;
    bf16x8 qr[NQ];
    if (MODE == 4) { const float* mq = (const float*)(ws + WS_MQP) + (tb + row) * 512 + h * 128;
#pragma unroll
        for (int d0 = 0; d0 < NQ; ++d0) { const float* p = mq + d0 * 16 + hi * 8; f32x4 s0 = {0.f, 0.f, 0.f, 0.f}, s1 = s0;
#pragma unroll
            for (int z = 0; z < 4; ++z) { s0 += *(const f32x4*)(p + (size_t)z * T * 512); s1 += *(const f32x4*)(p + (size_t)z * T * 512 + 4); }
            u32x4 wv = {cvtpk(s0[0], s0[1]), cvtpk(s0[2], s0[3]), cvtpk(s1[0], s1[1]), cvtpk(s1[2], s1[3])}; qr[d0] = *reinterpret_cast<bf16x8*>(&wv); } }
    else { const bf16_t* Qg;
        if (MODE == 0) Qg = (const bf16_t*)(ws + WS_PROJ) + (tb + row) * AB_MAIN + h * 128;
        else if (MODE == 1) Qg = (const bf16_t*)(ws + WS_QB) + (tb + row) * 3072 + h * 192;
        else if (MODE == 2) Qg = (const bf16_t*)(ws + WS_PROJ) + (tb + row) * CD_MAIN + h * 128;
        else Qg = (const bf16_t*)(ws + WS_PROJ) + (tb + row) * CD_MAIN + 5120 + h * 128;
#pragma unroll
        for (int d0 = 0; d0 < NQ; ++d0) qr[d0] = *(const bf16x8*)(Qg + d0 * 16 + hi * 8); }
    LAS char* V_lds = (LAS char*)lds + LDS_V; LAS char* K_lds = (LAS char*)lds + LDS_K;
    LAS float* wsc = (LAS float*)(lds + LDS_WS) + wid * 64; LAS float* relb = (LAS float*)(lds + LDS_RELB); LAS float* csl = (LAS float*)(lds + LDS_CS);
    const int vbase = (int)(unsigned)(uintptr_t)V_lds + v_rd_base(lane);
    const bf16_t* KRg = (const bf16_t*)(ws + WS_KR) + tb * 64;
    const float* cum = (const float*)(ws + WS_CUM) + ((size_t)b * 16 + h) * SEQ;
    const unsigned* mrow = (const unsigned*)(ws + WS_MASK) + (tb + row) * 128;
    float ctl = 0.f; if (MODE == 3) ctl = cum[row] * L2E;
    if (MODE == 0) { const float* rb = a.in[I_A_REL_BIAS] + h * 513; for (int i = tid; i < 513; i += 512) relb[i] = rb[i] * L2E; }
    float m_reg = -1e30f, l_reg = 0.f; f32x16 o[4] = {};
    unsigned mk0 = 0u, mk1 = 0u; float st_cs = 0.f;
    constexpr int NKI = (DK == 192) ? 3 : 2;
    int koff[NKI]; bool krope[NKI]; int voff[2];
#pragma unroll
    for (int i = 0; i < NKI; ++i) { const int off = (wid * NKI + i) * 1024 + lane * 16; const int rw = off / RS, sw = off - rw * RS, cb = sw ^ ((rw & 7) << 4);
        krope[i] = (DK == 192) && (cb >= 256); koff[i] = krope[i] ? rw * 64 + ((cb - 256) >> 1) : rw * ldk + (cb >> 1); }
#pragma unroll
    for (int i = 0; i < 2; ++i) { const int off = (wid * 2 + i) * 1024 + lane * 16; const int sub = off >> 9, within = off & 511, kk = ((sub >> 2) << 3) | (within >> 6);
        const int k = (kk & ~0xC) | ((kk & 4) << 1) | ((kk & 8) >> 1), c = (sub & 3) * 32 + ((within & 63) >> 1); voff[i] = k * ldv + c; }
#define FA_DMA(j, bf) do { const int k0_ = (j) * 64; \
        _Pragma("unroll") for (int i_ = 0; i_ < NKI; ++i_) { const bf16_t* s_ = (DK == 192 && krope[i_]) ? (KRg + (size_t)k0_ * 64 + koff[i_]) : (Kg + (size_t)k0_ * ldk + koff[i_]); \
            __builtin_amdgcn_global_load_lds((const unsigned*)s_, (LAS unsigned*)(K_lds + (bf) * SHM_K + (wid * NKI + i_) * 1024), 16, 0, 0); } \
        _Pragma("unroll") for (int i_ = 0; i_ < 2; ++i_) \
            __builtin_amdgcn_global_load_lds((const unsigned*)(Vg + (size_t)k0_ * ldv + voff[i_]), (LAS unsigned*)(V_lds + (bf) * SHM_V + (wid * 2 + i_) * 1024), 16, 0, 0); \
        if (MODE == 3) { if (tid < 64) st_cs = cum[k0_ + tid] * L2E; } } while (0)
#define FA_CSW(bf) do { if (MODE == 3) { if (tid < 64) csl[(bf) * 64 + tid] = st_cs; } } while (0)
    __syncthreads();
    FA_DMA(j_lo, 0); asm volatile("s_waitcnt vmcnt(0)" ::: "memory"); FA_CSW(0);
    __syncthreads();
#pragma unroll 1
    for (int t = 0; t < NT; ++t) {
        const int buf = t & 1, j = j_lo + t, kbp = j * 64;
        if (t + 1 < NT) FA_DMA(j + 1, buf ^ 1);
        bool act;
        if (MODE == 0) act = (j >= cw - 8) && (j <= cw);
        else if (MODE == 1 || MODE == 2) act = (j <= cw);
        else if (MODE == 3) act = (kbp <= qlo + 31);
        else act = true;
        if (MODE == 2) { if (act) { const u32x2 mm = *(const u32x2*)(mrow + 2 * j); mk0 = mm.x; mk1 = mm.y; } }
        if (act) {
            f32x16 p0, p1;
            qkt<DK>(p0, p1, K_lds + buf * SHM_K, r32, hi, qr);
            if (MODE == 0) {
                if (qlo - (kbp + 63) >= 256) { const float bf_ = relb[512];
#pragma unroll
                    for (int r = 0; r < 16; ++r) { p0[r] = fmaf(p0[r], C2, bf_); p1[r] = fmaf(p1[r], C2, bf_); } }
                else { const int dq = row - kbp - 4 * hi;
#pragma unroll
                    for (int r = 0; r < 16; ++r) { const int c = (r & 3) + 8 * (r >> 2);
                        int i0 = dq - c; i0 = i0 < -256 ? -256 : (i0 > 256 ? 256 : i0); int i1 = dq - c - 32; i1 = i1 < -256 ? -256 : (i1 > 256 ? 256 : i1);
                        p0[r] = fmaf(p0[r], C2, relb[i0 + 256]); p1[r] = fmaf(p1[r], C2, relb[i1 + 256]);
                        if ((r & 3) == 3) __builtin_amdgcn_sched_barrier(0); } }
            } else if (MODE == 3) {
                LAS const float* cs = csl + buf * 64 + 4 * hi;
#pragma unroll
                for (int q4 = 0; q4 < 4; ++q4) { const f32x4 c0 = *(LAS const f32x4*)(cs + 8 * q4), c1 = *(LAS const f32x4*)(cs + 32 + 8 * q4);
#pragma unroll
                    for (int e = 0; e < 4; ++e) { p0[4 * q4 + e] = fmaf(p0[4 * q4 + e], C2, ctl - c0[e]); p1[4 * q4 + e] = fmaf(p1[4 * q4 + e], C2, ctl - c1[e]); }
                    __builtin_amdgcn_sched_barrier(0); }
                if (kbp + 63 > qlo) { const int dq = row - kbp - 4 * hi;
#pragma unroll
                    for (int r = 0; r < 16; ++r) { const int c = (r & 3) + 8 * (r >> 2); if (dq - c < 0) p0[r] = NEG; if (dq - c - 32 < 0) p1[r] = NEG; } }
            } else {
#pragma unroll
                for (int r = 0; r < 16; ++r) { p0[r] *= C2; p1[r] *= C2; }
                if (MODE == 2) {
#pragma unroll
                    for (int r = 0; r < 16; ++r) { const int c = (r & 3) + 8 * (r >> 2) + 4 * hi; if (!((mk0 >> c) & 1u)) p0[r] = NEG; if (!((mk1 >> c) & 1u)) p1[r] = NEG; } }
            }
            float alpha; bf16x8 pa0, pa1, pa2, pa3;
            softmax_tile(p0, p1, m_reg, l_reg, alpha, pa0, pa1, pa2, pa3);
            if (__any(alpha < 1.f)) { if (hi == 0) wsc[r32] = alpha; LDS_WAIT();
#pragma unroll
                for (int r = 0; r < 16; ++r) { const float al = wsc[crow(r, hi)];
#pragma unroll
                    for (int d_ = 0; d_ < 4; ++d_) o[d_][r] *= al;
                    if ((r & 3) == 3) __builtin_amdgcn_sched_barrier(0); }
                LDS_WAIT(); }
            pv_tile(o, vbase + buf * SHM_V, pa0, pa1, pa2, pa3);
        }
        asm volatile("s_waitcnt vmcnt(0)" ::: "memory");
        if (t + 1 < NT) FA_CSW(buf ^ 1);
        __syncthreads();
    }
#undef FA_DMA
#undef FA_CSW
    if (hi == 0) wsc[32 + r32] = l_reg; LDS_WAIT();
#pragma unroll
    for (int r = 0; r < 16; ++r) { const int orow = crow(r, hi); const float rl = __builtin_amdgcn_rcpf(wsc[32 + orow]);
#pragma unroll
        for (int d0 = 0; d0 < 4; ++d0) { const float v = o[d0][r] * rl; const float vn = __shfl_xor(v, 1);
            if ((r32 & 1) == 0) *(unsigned*)(Og + (size_t)orow * ldo + d0 * 32 + r32) = cvtpk(v, vn); } }
    LDS_WAIT();
}
}

__device__ __forceinline__ void rope_pair(float& x1, float& x2, float cs, float sn) { const float a = x1 * cs - x2 * sn, b = x2 * cs + x1 * sn; x1 = a; x2 = b; }
__device__ __forceinline__ void rope8(u32x4& x1, u32x4& x2, const float* tab) {
    const f32x4 t0 = *(const f32x4*)tab, t1 = *(const f32x4*)(tab + 4), t2 = *(const f32x4*)(tab + 8), t3 = *(const f32x4*)(tab + 12);
    const float cs[8] = {t0.x, t0.z, t1.x, t1.z, t2.x, t2.z, t3.x, t3.z}, sn[8] = {t0.y, t0.w, t1.y, t1.w, t2.y, t2.w, t3.y, t3.w};
    float a[8], b[8];
#pragma unroll
    for (int e = 0; e < 4; ++e) { a[2 * e] = __uint_as_float(x1[e] << 16); a[2 * e + 1] = __uint_as_float(x1[e] & 0xffff0000u); b[2 * e] = __uint_as_float(x2[e] << 16); b[2 * e + 1] = __uint_as_float(x2[e] & 0xffff0000u); }
#pragma unroll
    for (int e = 0; e < 8; ++e) { const float p = a[e] * cs[e] - b[e] * sn[e], q = b[e] * cs[e] + a[e] * sn[e]; a[e] = p; b[e] = q; }
#pragma unroll
    for (int e = 0; e < 4; ++e) { x1[e] = pk2(a[2 * e], a[2 * e + 1]); x2[e] = pk2(b[2 * e], b[2 * e + 1]); }
}
__device__ __forceinline__ void ph_l0_stats(const Args& a, const WI& w) {
    unsigned char* ws = a.ws; const bf16_t* P = (const bf16_t*)(ws + WS_PROJ);
    const float* r64 = (const float*)(ws + WS_ROPE64);
    for (int t = w.gw; t < T; t += w.ngw) {
        const bf16_t* row = P + (size_t)t * AB_MAIN;
        float s = 0.f;
        for (int j = 0; j < 3; ++j) { const bf16x8 v = *(const bf16x8*)(row + 6144 + (j * 64 + w.lane) * 8);
#pragma unroll
            for (int e = 0; e < 8; ++e) { const float f = bf2f((bf16_t)v[e]); s += f * f; } }
        s = wave_sum(s);
        float s2 = 0.f; { const bf16x8 v = *(const bf16x8*)(row + 7680 + w.lane * 8);
#pragma unroll
            for (int e = 0; e < 8; ++e) { const float f = bf2f((bf16_t)v[e]); s2 += f * f; } }
        s2 = wave_sum(s2);
        if (w.lane == 0) { ((float*)(ws + WS_RSQ))[t] = 1.f / sqrtf(s * (1.f / 1536.f) + RMS_EPS); ((float*)(ws + WS_RSKV))[t] = 1.f / sqrtf(s2 * (1.f / 512.f) + RMS_EPS); }
        if (w.lane < 32) { const float* sm = (const float*)(ws + WS_MQP) + (size_t)t * 256; const int sp = t & (SEQ - 1);
            float x1 = 0.f, x2 = 0.f;
#pragma unroll
            for (int z = 0; z < 8; ++z) { x1 += sm[(size_t)z * T * 256 + w.lane]; x2 += sm[(size_t)z * T * 256 + w.lane + 32]; } const float cs = r64[((size_t)sp * 32 + w.lane) * 2], sn = r64[((size_t)sp * 32 + w.lane) * 2 + 1];
            rope_pair(x1, x2, cs, sn);
            bf16_t* kr = (bf16_t*)(ws + WS_KR) + (size_t)t * 64; kr[w.lane] = (bf16_t)f2bf(x1); kr[w.lane + 32] = (bf16_t)f2bf(x2); }
    }
}
__device__ __forceinline__ void ph_l0_qrope(const Args& a, const WI& w) {
    unsigned char* ws = a.ws; bf16_t* Q = (bf16_t*)(ws + WS_QB); const float* r64 = (const float*)(ws + WS_ROPE64);
    const int h = w.lane >> 2, ch = w.lane & 3;
    for (int t = w.gw; t < T; t += w.ngw) {
        const int sp = t & (SEQ - 1); bf16_t* q = Q + (size_t)t * 3072 + h * 192 + 128 + ch * 8;
        u32x4 x1 = *(const u32x4*)q, x2 = *(const u32x4*)(q + 32);
        rope8(x1, x2, r64 + ((size_t)sp * 32 + ch * 8) * 2);
        *(u32x4*)q = x1; *(u32x4*)(q + 32) = x2;
    }
}
__device__ __forceinline__ void ph_l1_elem(const Args& a, LAS float* sml  , const WI& w) {
    unsigned char* ws = a.ws; bf16_t* P = (bf16_t*)(ws + WS_PROJ);
    const float* r128 = (const float*)(ws + WS_ROPE128); const float* r64 = (const float*)(ws + WS_ROPE64);
    for (int t = w.gw; t < T; t += w.ngw) {
        const int b = t / SEQ, sp = t - b * SEQ; bf16_t* row = P + (size_t)t * CD_MAIN;
        u32x4 xa[5], xb[5]; bf16_t* qp[5]; const float* tp[5]; bool on[5];
#pragma unroll
        for (int p = 0; p < 3; ++p) { const int e = w.lane + 64 * p; on[p] = e < 160; const int h = e >> 3, ch = e & 7; qp[p] = row + h * 128 + ch * 8; tp[p] = r128 + ((size_t)sp * 64 + ch * 8) * 2;
            if (on[p]) { xa[p] = *(const u32x4*)qp[p]; xb[p] = *(const u32x4*)(qp[p] + 64); } }
#pragma unroll
        for (int p = 3; p < 5; ++p) { const int e = w.lane + 64 * (p - 3); on[p] = true; const int h = e >> 2, ch = e & 3; qp[p] = row + 3072 + h * 64 + ch * 8; tp[p] = r64 + ((size_t)sp * 32 + ch * 8) * 2;
            xa[p] = *(const u32x4*)qp[p]; xb[p] = *(const u32x4*)(qp[p] + 32); }
#pragma unroll
        for (int p = 0; p < 5; ++p) if (on[p]) { rope8(xa[p], xb[p], tp[p]); *(u32x4*)qp[p] = xa[p]; *(u32x4*)(qp[p] + (p < 3 ? 64 : 32)) = xb[p]; }
        const float* smp = (const float*)(ws + WS_MQP) + (size_t)t * 256;
        float smv0 = 0.f, smv1 = 0.f;
#pragma unroll
        for (int z = 0; z < 8; ++z) { smv0 += smp[(size_t)z * T * 256 + w.lane]; smv1 += smp[(size_t)z * T * 256 + 64 + w.lane]; }
        LDS_WAIT(); sml[w.lane] = smv0; sml[64 + w.lane] = smv1; LDS_WAIT();
        LAS const float* sm = sml;
        if (w.lane < 32) { float x1 = sm[w.lane], x2 = sm[w.lane + 32]; rope_pair(x1, x2, r64[((size_t)sp * 32 + w.lane) * 2], r64[((size_t)sp * 32 + w.lane) * 2 + 1]);
            bf16_t* ki = (bf16_t*)(ws + WS_KI) + (size_t)t * 64; ki[w.lane] = (bf16_t)f2bf(x1); ki[w.lane + 32] = (bf16_t)f2bf(x2);
            ((float*)(ws + WS_WI))[(size_t)t * 32 + w.lane] = sm[64 + w.lane] * 0.17677669529663687f; }
        if (w.lane < 16) { const float z = sm[96 + w.lane] + a.in[I_D_FORGET_BIAS][w.lane];
            const float lf = fminf(z, 0.f) - log1pf(__expf(-fabsf(z)));
            ((float*)(ws + WS_LOGF))[((size_t)b * 16 + w.lane) * SEQ + sp] = lf; }
    }
}
__device__ __forceinline__ void ph_l1_scan(const Args& a, LAS float* sh  , const WI& w) {
    unsigned char* ws = a.ws;
    for (int it = w.bid; it < NB * 16; it += w.nblk) {
        const float* src = (const float*)(ws + WS_LOGF) + (size_t)it * SEQ + w.tid * 8; float* dst = (float*)(ws + WS_CUM) + (size_t)it * SEQ + w.tid * 8;
        const f32x4 v0 = *(const f32x4*)src, v1 = *(const f32x4*)(src + 4);
        float c[8]; c[0] = v0.x; c[1] = c[0] + v0.y; c[2] = c[1] + v0.z; c[3] = c[2] + v0.w; c[4] = c[3] + v1.x; c[5] = c[4] + v1.y; c[6] = c[5] + v1.z; c[7] = c[6] + v1.w;
        float inc = c[7];
#pragma unroll
        for (int o = 1; o < 64; o <<= 1) { const float v = __shfl_up(inc, o); if (w.lane >= o) inc += v; }
        __syncthreads();
        if (w.lane == 63) sh[w.wave] = inc;
        __syncthreads();
        float base = inc - c[7];
        for (int q = 0; q < w.wave; ++q) base += sh[q];
        *(f32x4*)dst = (f32x4){c[0] + base, c[1] + base, c[2] + base, c[3] + base}; *(f32x4*)(dst + 4) = (f32x4){c[4] + base, c[5] + base, c[6] + base, c[7] + base};
    }
    __syncthreads();
}
__device__ __forceinline__ void ph_l1_index_naive(const Args& a, LAS float* qs  , const WI& w) {
    unsigned char* ws = a.ws; const bf16_t* P = (const bf16_t*)(ws + WS_PROJ); const bf16_t* KI = (const bf16_t*)(ws + WS_KI);
    const float* WIp = (const float*)(ws + WS_WI); float* SC = (float*)(ws + WS_SCORE);
    for (int t = w.gw; t < T; t += w.ngw) {
        const int b = t / SEQ, sp = t - b * SEQ, nadm = ((sp >> 6) + 1) * 64;
        LDS_WAIT();
        for (int e = w.lane; e < 2048; e += 64) qs[e] = bf2f(P[(size_t)t * CD_MAIN + 3072 + e]);
        if (w.lane < 32) qs[2048 + w.lane] = WIp[(size_t)t * 32 + w.lane];
        LDS_WAIT();
        for (int s0 = 0; s0 < nadm; s0 += 64) {
            const int s = s0 + w.lane; const bf16_t* kp = KI + ((size_t)b * SEQ + s) * 64;
            float k[64];
#pragma unroll
            for (int d0 = 0; d0 < 64; d0 += 8) { const bf16x8 kv = *(const bf16x8*)(kp + d0);
#pragma unroll
                for (int e = 0; e < 8; ++e) k[d0 + e] = bf2f((bf16_t)kv[e]); }
            float sc = 0.f;
            for (int h = 0; h < 32; ++h) { float dot = 0.f;
#pragma unroll
                for (int d = 0; d < 64; ++d) dot += qs[h * 64 + d] * k[d];
                sc += qs[2048 + h] * fmaxf(dot * 0.125f, 0.f); }
            SC[((size_t)b * SEQ + sp) * SEQ + s] = sc;
        }
    }
}
__device__ __forceinline__ void ph_l1_index(const Args& a, LAS unsigned char* lds, const WI& w) {
    unsigned char* ws = a.ws; const bf16_t* P = (const bf16_t*)(ws + WS_PROJ); const bf16_t* KI = (const bf16_t*)(ws + WS_KI);
    const float* WIp = (const float*)(ws + WS_WI); float* SC = (float*)(ws + WS_SCORE);
    LAS char* Qs = (LAS char*)lds; LAS float* Wt = (LAS float*)(lds + 131072);
    const int tid = w.tid, r32 = w.lane & 31, hi = w.lane >> 5;
    for (int u = w.bid; u < 256; u += w.nblk) {
        const int b = u >> 7, x = (u >> 1) & 63, half = u & 1;
        for (int pass = 0; pass < 2; ++pass) {
            const int qt = pass ? 127 - x : x; const int t0 = b * SEQ + qt * 32; const int nadm = ((qt * 32) >> 6) * 64 + 64, ngrp = (nadm + 127) >> 7;
            __syncthreads();
            for (int e = tid; e < 32 * 256; e += 512) { const int t = e >> 8, c = e & 255; const u32x4 v = *(const u32x4*)(P + (size_t)(t0 + t) * CD_MAIN + 3072 + c * 8);
                const int cs = (c & ~15) | ((c & 15) ^ (t & 15)); *(LAS u32x4*)(Qs + t * 4096 + cs * 16) = v; }
            for (int e = tid; e < 1024; e += 512) { const int t = e >> 5, h = e & 31; Wt[h * 32 + t] = WIp[(size_t)(t0 + t) * 32 + h] * 0.125f; }
            __syncthreads();
            for (int g = half + 2 * w.wave; g < ngrp; g += 16) {
                const int s0 = g * 128;
                bf16x8 kf[4][4];
#pragma unroll
                for (int j = 0; j < 4; ++j)
#pragma unroll
                    for (int dk = 0; dk < 4; ++dk) kf[j][dk] = *(const bf16x8*)(KI + ((size_t)b * SEQ + s0 + 32 * j + r32) * 64 + dk * 16 + hi * 8);
                f32x16 acc[4] = {};
#pragma unroll 2
                for (int h = 0; h < 32; ++h) {
                    bf16x8 qf[4];
#pragma unroll
                    for (int dk = 0; dk < 4; ++dk) qf[dk] = *(LAS const bf16x8*)(Qs + r32 * 4096 + ((((h >> 1) << 4) | ((((h & 1) << 3) | (dk << 1) | hi) ^ (r32 & 15))) << 4));
                    f32x4 wv[4];
#pragma unroll
                    for (int q4 = 0; q4 < 4; ++q4) wv[q4] = *(LAS const f32x4*)(Wt + h * 32 + 8 * q4 + 4 * hi);
#pragma unroll
                    for (int j = 0; j < 4; ++j) { f32x16 tmp = {};
#pragma unroll
                        for (int dk = 0; dk < 4; ++dk) tmp = __builtin_amdgcn_mfma_f32_32x32x16_bf16(qf[dk], kf[j][dk], tmp, 0, 0, 0);
#pragma unroll
                        for (int r = 0; r < 16; ++r) acc[j][r] = fmaf(wv[r >> 2][r & 3], fmaxf(tmp[r], 0.f), acc[j][r]); }
                }
#pragma unroll
                for (int j = 0; j < 4; ++j)
#pragma unroll
                    for (int r = 0; r < 16; ++r) SC[(size_t)(t0 + crow(r, hi)) * SEQ + s0 + 32 * j + r32] = acc[j][r];
            }
        }
    }
    __syncthreads();
}
__device__ __forceinline__ void ph_l1_select(const Args& a, const WI& w) {
    unsigned char* ws = a.ws; const float* SC = (const float*)(ws + WS_SCORE); unsigned* MK = (unsigned*)(ws + WS_MASK);
    for (int t = w.gw; t < T; t += w.ngw) {
        const int b = t / SEQ, sp = t - b * SEQ, nblk = (sp >> 6) + 1;
        const float* row = SC + ((size_t)b * SEQ + sp) * SEQ;
        unsigned key[64];
#pragma unroll
        for (int j = 0; j < 64; ++j) { unsigned u = 0u; if (j < nblk) { u = __float_as_uint(row[j * 64 + w.lane]); u ^= (u >> 31) ? 0xFFFFFFFFu : 0x80000000u; } key[j] = u; }
        unsigned thr = 0u;
        if (nblk > 4) {
            for (int bit = 31; bit >= 0; --bit) { const unsigned cand = thr | (1u << bit); int cnt = 0;
#pragma unroll
                for (int j = 0; j < 64; ++j) cnt += (key[j] >= cand) ? 1 : 0;
                cnt = wave_sum_i(cnt); if (cnt >= 256) thr = cand; if (cnt == 256) break; }
        }
        unsigned lo = 0u, hi = 0u;
#pragma unroll
        for (int j = 0; j < 64; ++j) { const bool sel = (j < nblk) && (key[j] >= thr); const unsigned long long bal = __ballot(sel); if (w.lane == j) { lo = (unsigned)bal; hi = (unsigned)(bal >> 32); } }
        *(u32x2*)(MK + (size_t)t * 128 + 2 * w.lane) = (u32x2){lo, hi};
    }
}

__device__ __forceinline__ unsigned tk_key(float v, unsigned payload, unsigned pmask) { const unsigned u = __float_as_uint(v); const unsigned m = (unsigned)((int)u >> 31) | 0x80000000u; return ((u ^ m) & ~pmask) | payload; }
__device__ __forceinline__ float tk_val(unsigned key, unsigned pmask) { const unsigned k = key & ~pmask; const unsigned m = ~(unsigned)((int)k >> 31) | 0x80000000u; return __uint_as_float(k ^ m); }
#define TK_INSERT(TOP, key_) do { unsigned k__ = (key_); \
        _Pragma("unroll") for (int q_ = 0; q_ < 16; ++q_) { const unsigned hi__ = TOP[q_] > k__ ? TOP[q_] : k__; k__ = TOP[q_] > k__ ? k__ : TOP[q_]; TOP[q_] = hi__; } } while (0)
__device__ __forceinline__ unsigned tk_sel16(const unsigned (&arr)[16], unsigned i) {
    unsigned x8[8], x4[4], x2[2];
    const unsigned m0 = 0u - (i & 1u), m1 = 0u - ((i >> 1) & 1u), m2 = 0u - ((i >> 2) & 1u), m3 = 0u - ((i >> 3) & 1u);
#pragma unroll
    for (int q = 0; q < 8; ++q) x8[q] = (arr[2 * q + 1] & m0) | (arr[2 * q] & ~m0);
#pragma unroll
    for (int q = 0; q < 4; ++q) x4[q] = (x8[2 * q + 1] & m1) | (x8[2 * q] & ~m1);
#pragma unroll
    for (int q = 0; q < 2; ++q) x2[q] = (x4[2 * q + 1] & m2) | (x4[2 * q] & ~m2);
    return (x2[1] & m3) | (x2[0] & ~m3); }
__device__ __forceinline__ void ph_peer_topk(const Args& a, const WI& w) {
    unsigned char* ws = a.ws; const float* PST = (const float*)(ws + WS_PSCORE); int* PIDX = (int*)(ws + WS_PIDX); float* PG = (float*)(ws + WS_PGATE);
    for (int task = w.gw; task < 128 * 8; task += w.ngw) {
        const int h = task & 7, t = (task >> 3) * 64 + w.lane;
        unsigned t0[16], t1[16];
#pragma unroll
        for (int k = 0; k < 16; ++k) { t0[k] = 0u; t1[k] = 0u; }
        { const float* col = PST + (size_t)(h * 256) * T + t;
#pragma unroll 8
          for (int i = 0; i < 128; ++i) { const float v = col[(size_t)i * T]; TK_INSERT(t0, tk_key(v, 127u - (unsigned)i, 127u)); } }
        { const float* col = PST + (size_t)(h * 256 + 128) * T + t;
#pragma unroll 8
          for (int i = 0; i < 128; ++i) { const float v = col[(size_t)i * T]; TK_INSERT(t1, tk_key(v, 127u - (unsigned)i, 127u)); } }
        float a0[16], a1[16];
#pragma unroll
        for (int k = 0; k < 16; ++k) { a0[k] = tk_val(t0[k], 127u); a1[k] = tk_val(t1[k], 127u); }
        unsigned bk[16];
#pragma unroll
        for (int k = 0; k < 16; ++k) bk[k] = 0u;
#pragma unroll
        for (int i = 0; i < 16; ++i)
#pragma unroll
            for (int j = 0; j < 16; ++j) if ((i + 1) * (j + 1) <= 16) TK_INSERT(bk, tk_key(a0[i] + a1[j], 255u - (unsigned)(i * 16 + j), 255u));
        const float top = tk_val(bk[0], 255u); float den = 0.f; float ex[16];
#pragma unroll
        for (int k = 0; k < 16; ++k) { ex[k] = __expf(tk_val(bk[k], 255u) - top); den += ex[k]; }
        const float rd = 1.f / den;
#pragma unroll
        for (int k = 0; k < 16; ++k) { const unsigned c = 255u - (bk[k] & 255u); const unsigned e0 = 127u - (tk_sel16(t0, c >> 4) & 127u), e1 = 127u - (tk_sel16(t1, c & 15u) & 127u);
            PIDX[(size_t)t * 128 + h * 16 + k] = (int)(e0 * 128u + e1); PG[(size_t)t * 128 + h * 16 + k] = ex[k] * rd; }
    }
}
__device__ __forceinline__ void ph_peer_experts(const Args& a, int layer, float* outf, bf16_t* outb, const float* g, const float* bta, LAS float* wsm  , const WI& w) {
    unsigned char* ws = a.ws; const bf16_t* XBh = (const bf16_t*)(ws + WS_XB);
    const unsigned char* U4 = ws + WS_U8 + (size_t)layer * 16384 * 2048; const unsigned char* V4 = ws + WS_V8 + (size_t)layer * 16384 * 2048;
    const unsigned short* US = (const unsigned short*)(ws + WS_U8 + 64 * MiB) + (size_t)layer * 16384 * 64; const unsigned short* VS = (const unsigned short*)(ws + WS_V8 + 64 * MiB) + (size_t)layer * 16384 * 64;
    const int* PIDX = (const int*)(ws + WS_PIDX); const float* PG = (const float*)(ws + WS_PGATE);
    const int lane = w.lane;
    for (int t = w.gw; t < T; t += w.ngw) {
        const bf16_t* hrow = XBh + (size_t)t * DM + 32 * lane;
        const int idx0 = PIDX[(size_t)t * 128 + lane], idx1 = PIDX[(size_t)t * 128 + 64 + lane];
        const float g0 = PG[(size_t)t * 128 + lane], g1 = PG[(size_t)t * 128 + 64 + lane];
        LDS_WAIT();
#define PE_LOAD(BUF, SB, TBL, STB, kb_) do { const int iv_ = ((kb_) & 64) ? idx1 : idx0; \
            _Pragma("unroll") for (int q_ = 0; q_ < 4; ++q_) { const int e_ = __builtin_amdgcn_readlane(iv_, ((kb_) + q_) & 63); const u32x4* r_ = (const u32x4*)(TBL + (size_t)e_ * 2048 + 16 * lane); \
                BUF[q_][0] = r_[0]; BUF[q_][1] = r_[64]; SB[q_] = STB[(size_t)e_ * 64 + lane]; } } while (0)
#define PE_SCALE(sb_, i_) __builtin_amdgcn_exp2f((float)((int)(((sb_) >> (8 * (i_))) & 255u) - 128) * 0.125f)
#define PE_DOT(BUF, SB, Z, zo_) do { _Pragma("unroll") for (int q_ = 0; q_ < 4; ++q_) { float zq_ = 0.f; \
            _Pragma("unroll") for (int i_ = 0; i_ < 2; ++i_) { f32x2 acc_ = {0.f, 0.f}; \
                _Pragma("unroll") for (int d_ = 0; d_ < 4; ++d_) { \
                    acc_ = __builtin_elementwise_fma(__builtin_amdgcn_cvt_scalef32_pk_f32_fp4(BUF[q_][i_][d_], 1.0f, 0), x[16 * i_ + 4 * d_ + 0], acc_); \
                    acc_ = __builtin_elementwise_fma(__builtin_amdgcn_cvt_scalef32_pk_f32_fp4(BUF[q_][i_][d_], 1.0f, 1), x[16 * i_ + 4 * d_ + 1], acc_); \
                    acc_ = __builtin_elementwise_fma(__builtin_amdgcn_cvt_scalef32_pk_f32_fp4(BUF[q_][i_][d_], 1.0f, 2), x[16 * i_ + 4 * d_ + 2], acc_); \
                    acc_ = __builtin_elementwise_fma(__builtin_amdgcn_cvt_scalef32_pk_f32_fp4(BUF[q_][i_][d_], 1.0f, 3), x[16 * i_ + 4 * d_ + 3], acc_); } \
                zq_ = fmaf(PE_SCALE((unsigned)SB[q_], i_), acc_.x + acc_.y, zq_); } \
            Z[(zo_) + q_] = zq_; } } while (0)
#define PE_AXPY(BUF, SB, kb_) do { _Pragma("unroll") for (int q_ = 0; q_ < 4; ++q_) { const float wt_ = wsm[(kb_) + q_]; \
            _Pragma("unroll") for (int i_ = 0; i_ < 2; ++i_) { const float ws_ = wt_ * PE_SCALE((unsigned)SB[q_], i_); const f32x2 wt2_ = {ws_, ws_}; \
                _Pragma("unroll") for (int d_ = 0; d_ < 4; ++d_) { \
                    y[16 * i_ + 4 * d_ + 0] = __builtin_elementwise_fma(__builtin_amdgcn_cvt_scalef32_pk_f32_fp4(BUF[q_][i_][d_], 1.0f, 0), wt2_, y[16 * i_ + 4 * d_ + 0]); \
                    y[16 * i_ + 4 * d_ + 1] = __builtin_elementwise_fma(__builtin_amdgcn_cvt_scalef32_pk_f32_fp4(BUF[q_][i_][d_], 1.0f, 1), wt2_, y[16 * i_ + 4 * d_ + 1]); \
                    y[16 * i_ + 4 * d_ + 2] = __builtin_elementwise_fma(__builtin_amdgcn_cvt_scalef32_pk_f32_fp4(BUF[q_][i_][d_], 1.0f, 2), wt2_, y[16 * i_ + 4 * d_ + 2]); \
                    y[16 * i_ + 4 * d_ + 3] = __builtin_elementwise_fma(__builtin_amdgcn_cvt_scalef32_pk_f32_fp4(BUF[q_][i_][d_], 1.0f, 3), wt2_, y[16 * i_ + 4 * d_ + 3]); } } \
            __builtin_amdgcn_sched_barrier(0); } } while (0)
#define PE_SB() __builtin_amdgcn_sched_barrier(0)
        u32x4 bA[4][2], bB[4][2]; unsigned short sA[4], sB[4];
        {
            f32x2 x[32];
#pragma unroll
            for (int i = 0; i < 2; ++i)
#pragma unroll
                for (int q = 0; q < 4; ++q) { const u32x4 v = *(const u32x4*)(hrow + 2048 * i + 8 * q);
#pragma unroll
                    for (int e = 0; e < 4; ++e) x[16 * i + 4 * q + e] = (f32x2){__uint_as_float(v[e] << 16), __uint_as_float(v[e] & 0xffff0000u)}; }
            PE_LOAD(bA, sA, U4, US, 0); PE_SB();
#pragma unroll 1
            for (int k0 = 0; k0 < 128; k0 += 8) {
                const int iv = (k0 & 64) ? idx1 : idx0; const float gv = (k0 & 64) ? g1 : g0;
                float z[8];
                PE_LOAD(bB, sB, U4, US, k0 + 4); PE_SB(); PE_DOT(bA, sA, z, 0); PE_SB();
                PE_LOAD(bA, sA, U4, US, (k0 + 8) & 127); PE_SB(); PE_DOT(bB, sB, z, 4); PE_SB();
                float r4[4], r2[2], r1;
#pragma unroll
                for (int i = 0; i < 4; ++i) { const float keep = (lane & 32) ? z[i + 4] : z[i], send = (lane & 32) ? z[i] : z[i + 4]; r4[i] = keep + __shfl_xor(send, 32); }
#pragma unroll
                for (int i = 0; i < 2; ++i) { const float keep = (lane & 16) ? r4[i + 2] : r4[i], send = (lane & 16) ? r4[i] : r4[i + 2]; r2[i] = keep + __shfl_xor(send, 16); }
                { const float keep = (lane & 8) ? r2[1] : r2[0], send = (lane & 8) ? r2[0] : r2[1]; r1 = keep + __shfl_xor(send, 8); }
                r1 += __shfl_xor(r1, 4); r1 += __shfl_xor(r1, 2); r1 += __shfl_xor(r1, 1);
                const int q = lane >> 3; const float gt_ = __shfl(gv, (k0 + q) & 63);
                if ((lane & 7) == 0) { const float zz = r1; const float act = 0.5f * zz * (1.f + erff(zz * 0.70710678118654752f)); wsm[k0 + q] = act * gt_; }
            }
        }
        LDS_WAIT();
        f32x2 y[32];
#pragma unroll
        for (int i = 0; i < 32; ++i) y[i] = (f32x2){0.f, 0.f};
        PE_LOAD(bA, sA, V4, VS, 0); PE_SB();
#pragma unroll 1
        for (int k0 = 0; k0 < 128; k0 += 8) {
            PE_LOAD(bB, sB, V4, VS, k0 + 4); PE_SB(); PE_AXPY(bA, sA, k0); PE_SB();
            PE_LOAD(bA, sA, V4, VS, (k0 + 8) & 127); PE_SB(); PE_AXPY(bB, sB, k0 + 4); PE_SB();
        }
#undef PE_LOAD
#undef PE_SCALE
#undef PE_DOT
#undef PE_AXPY
#undef PE_SB
        const bf16_t* hrow2 = hrow; asm volatile("" : "+v"(hrow2));
        float s = 0.f;
#pragma unroll
        for (int i = 0; i < 2; ++i)
#pragma unroll
            for (int q = 0; q < 4; ++q) { const u32x4 v = *(const u32x4*)(hrow2 + 2048 * i + 8 * q);
#pragma unroll
                for (int e = 0; e < 4; ++e) { y[16 * i + 4 * q + e].x += ALPHA * __uint_as_float(v[e] << 16); y[16 * i + 4 * q + e].y += ALPHA * __uint_as_float(v[e] & 0xffff0000u); } }
#pragma unroll
        for (int i = 0; i < 32; ++i) s += y[i].x + y[i].y;
        const float mean = wave_sum(s) * (1.f / DM); float s2 = 0.f;
#pragma unroll
        for (int i = 0; i < 32; ++i) { y[i].x -= mean; y[i].y -= mean; s2 += y[i].x * y[i].x + y[i].y * y[i].y; }
        const float rstd = 1.f / sqrtf(wave_sum(s2) * (1.f / DM) + LN_EPS);
#pragma unroll
        for (int i = 0; i < 2; ++i)
#pragma unroll
            for (int q = 0; q < 8; ++q) { const int c = 2048 * i + 32 * lane + 4 * q;
                const f32x4 gg = *(const f32x4*)(g + c), bb = *(const f32x4*)(bta + c); f32x4 o;
                o.x = y[16 * i + 2 * q].x * rstd * gg.x + bb.x; o.y = y[16 * i + 2 * q].y * rstd * gg.y + bb.y; o.z = y[16 * i + 2 * q + 1].x * rstd * gg.z + bb.z; o.w = y[16 * i + 2 * q + 1].y * rstd * gg.w + bb.w;
                if (outf) *(f32x4*)(outf + (size_t)t * DM + c) = o;
                if (outb) { u32x2 p; p.x = pk2(o.x, o.y); p.y = pk2(o.z, o.w); *(u32x2*)(outb + (size_t)t * DM + c) = p; }
                if (q & 1) __builtin_amdgcn_sched_barrier(0); }
    }
}

__device__ __forceinline__ void ph_attn_l0(const Args& a, LAS unsigned char* lds, const WI& w) {
    for (int pr = w.bid; pr < 256; pr += w.nblk) { const int bh = pr >> 3, x = pr & 7;
        for (int pass = 0; pass < 2; ++pass) fa::attn_unit<1>(a, 0, lds, bh >> 4, bh & 15, pass ? 15 - x : x); }
    for (int u = w.bid; u < 512; u += w.nblk) { const int bh = u >> 4; fa::attn_unit<0>(a, 0, lds, bh >> 4, bh & 15, u & 15); }
}
__device__ __forceinline__ void ph_attn_l1(const Args& a, LAS unsigned char* lds, const WI& w) {
    for (int pr = w.bid; pr < 256; pr += w.nblk) { const int bh = pr >> 3, x = pr & 7;
        for (int pass = 0; pass < 2; ++pass) fa::attn_unit<2>(a, 1, lds, bh >> 4, bh & 15, pass ? 15 - x : x); }
    for (int pr = w.bid; pr < 256; pr += w.nblk) { const int bh = pr >> 3, x = pr & 7;
        for (int pass = 0; pass < 2; ++pass) fa::attn_unit<3>(a, 1, lds, bh >> 4, bh & 15, pass ? 15 - x : x); }
}
__device__ __forceinline__ void ph_attn_mem(const Args& a, int layer, LAS unsigned char* lds, const WI& w) {
    for (int u = w.bid; u < 128; u += w.nblk) { const int bh = u >> 4; fa::attn_unit<4>(a, layer, lds, bh >> 2, bh & 3, u & 15); }
}

__global__ void __launch_bounds__(512, 2) mega(Args a) {
    extern __shared__ __attribute__((aligned(16))) unsigned char lds_raw[];
    LAS unsigned char* lds = (LAS unsigned char*)lds_raw;
    WI w; w.tid = threadIdx.x; w.lane = w.tid & 63; w.wave = __builtin_amdgcn_readfirstlane(w.tid >> 6);
    w.bid = blockIdx.x; w.nblk = gridDim.x; w.gw = w.bid * 8 + w.wave; w.ngw = w.nblk * 8;
    unsigned char* ws = a.ws;
    volatile LAS unsigned* misc = (volatile LAS unsigned*)(lds + LDS_MISC);
    if (w.tid < 4) misc[w.tid] = 0u;
    __syncthreads();
    XcdBarrier bar; bar.bar = (unsigned*)(ws + WS_CTL) + 4096; bar.x = 0; bar.st = misc;
#if !MK_PER_PHASE
    bar = xcd_barrier_post((unsigned*)(ws + WS_CTL) + 4096, misc);
#endif
    const int lo = a.ph_lo, hi = a.ph_hi;
#define IN(k) (lo <= (k) && (k) < hi)
#if MK_PER_PHASE
#define SEAM(k) do { } while (0)
#else
#define SEAM(k) do { if (IN(k) && IN((k) + 1)) xcd_barrier(bar); } while (0)
#endif
    LAS float* wlds = (LAS float*)(lds + w.wave * 16384);
    bf16_t* XB = (bf16_t*)(ws + WS_XB); bf16_t* RES = (bf16_t*)(ws + WS_RES); bf16_t* PROJ = (bf16_t*)(ws + WS_PROJ);
    bf16_t* ATT = (bf16_t*)(ws + WS_ATT); float* SMALL = (float*)(ws + WS_SMALL);

#define FAST_GEMM(EPI_T, Aptr, lda_, Btptr, ldb_, M_, N_, K_, nz_, zA_, zB_, EPI_OBJ) do { \
        pg8::Gemm g_{Aptr, Btptr, M_, N_, K_, lda_, ldb_, zA_, zB_, nz_}; pg8::StaticOrder S_; S_.init(M_, N_, nz_, w.nblk, w.bid); \
        pg8::gemm_phase<EPI_T, pg8::StaticOrder>(lds, g_, S_, EPI_OBJ); } while (0)
    if (IN(0)) { ph_convert(a, lds, w); if (PROBE_DUP == 0) ph_convert(a, lds, w); }
    SEAM(0);
    if (IN(1)) {
        FAST_GEMM(pg8::EpiBf16, XB, DM, (const bf16_t*)(ws + WS_W_AB_IN), DM, T, AB_MAIN, DM, 1, 0, 0, (pg8::EpiBf16{PROJ, AB_MAIN, nullptr}));
        FAST_GEMM(pg8::EpiF32, XB, DM, (const bf16_t*)(ws + WS_W_AB_IN) + (size_t)AB_MAIN * DM, DM, T, 256, 512, 8, 512, 512, (pg8::EpiF32{(float*)(ws + WS_MQP), 256, (long)T * 256, 64}));
        FAST_GEMM(pg8::EpiF32, (const bf16_t*)(ws + WS_MEMB), DM, (const bf16_t*)(ws + WS_W_MEM_KV), DM, 512, 2048, 256, 16, 256, 256, (pg8::EpiF32{(float*)(ws + WS_SCORE), 2048, (long)512 * 2048, 2048}));
    }
    SEAM(1);
    if (IN(2)) { ph_l0_stats(a, w);
        { const float* part = (const float*)(ws + WS_SCORE); bf16_t* KVM = (bf16_t*)(ws + WS_KVM);
          for (size_t i = ((size_t)w.gw * 64 + w.lane) * 4; i < (size_t)512 * 2048; i += (size_t)w.ngw * 64 * 4) { f32x4 s = {0.f, 0.f, 0.f, 0.f};
#pragma unroll
              for (int z = 0; z < 16; ++z) s += *(const f32x4*)(part + (size_t)z * 512 * 2048 + i);
              const int m = (int)(i >> 11), n = (int)(i & 2047); u32x2 p; p.x = pk2(s.x, s.y); p.y = pk2(s.z, s.w);
              *(u32x2*)(KVM + ((size_t)(n >> 10) * 512 + m) * 1024 + (n & 1023)) = p; } } }
    SEAM(2);
    if (IN(3)) {
        const float* rsq = (const float*)(ws + WS_RSQ); const float* rskv = (const float*)(ws + WS_RSKV);
        bf16_t* QB = (bf16_t*)(ws + WS_QB); bf16_t* KVB = (bf16_t*)(ws + WS_KVB);
        FAST_GEMM(pg8::EpiBf16, PROJ + 6144, AB_MAIN, (const bf16_t*)(ws + WS_W_UQ), 1536, T, 3072, 1536, 1, 0, 0, (pg8::EpiBf16{QB, 3072, rsq}));
        FAST_GEMM(pg8::EpiBf16, PROJ + 7680, AB_MAIN, (const bf16_t*)(ws + WS_W_UKV), 512, T, 4096, 512, 1, 0, 0, (pg8::EpiBf16{KVB, 4096, rskv}));
    }
    SEAM(3);
    if (IN(4)) ph_l0_qrope(a, w);
    SEAM(4);
    if (IN(5)) { ph_attn_l0(a, lds, w); if (PROBE_DUP == 5) ph_attn_l0(a, lds, w); }
    SEAM(5);
    if (IN(6)) {
        FAST_GEMM(pg8::EpiResid, ATT, DM, (const bf16_t*)(ws + WS_W_AB_OUT), DM, T, DM, DM, 1, 0, 0, (pg8::EpiResid{XB, RES, DM})); }
    SEAM(6);
    if (IN(7)) ln_rows(RES, a.in[I_LN_G] + 0 * DM, a.in[I_LN_B] + 0 * DM, XB, w);
    SEAM(7);

#define MEM_PEER_PHASES(L, P0_, LAST)                                                                                                                         \
    if (IN(P0_)) { FAST_GEMM(pg8::EpiF32, XB, DM, (const bf16_t*)(ws + WS_W_MEM_Q) + (size_t)(L) * 512 * DM, DM, T, 512, 1024, 4, 1024, 1024,                    \
                             (pg8::EpiF32{(float*)(ws + WS_MQP), 512, (long)T * 512, 512})); }                                                                       \
    SEAM(P0_);                                                                                                                                                  \
    if (IN(P0_ + 1)) ph_attn_mem(a, (L), lds, w);                                                                                                               \
    SEAM(P0_ + 1);                                                                                                                                              \
    if (IN(P0_ + 2)) { FAST_GEMM(pg8::EpiResid, (const bf16_t*)(ws + WS_MEMO), 512, (const bf16_t*)(ws + WS_W_MEM_O) + (size_t)(L) * DM * 512, 512, T, DM, 512, 1, 0, 0, \
                                 (pg8::EpiResid{XB, RES, DM})); }                                                                                               \
    SEAM(P0_ + 2);                                                                                                                                              \
    if (IN(P0_ + 3)) ln_rows(RES, a.in[I_LN_G] + ((L) * 3 + 1) * DM, a.in[I_LN_B] + ((L) * 3 + 1) * DM, XB, w);                                             \
    SEAM(P0_ + 3);                                                                                                                                              \
    if (IN(P0_ + 4)) { FAST_GEMM(pg8::EpiF32, (const bf16_t*)(ws + WS_W_PEER) + (size_t)(L) * 2048 * DM, DM, XB, DM, 2048, T, DM, 1, 0, 0,                     \
                                 (pg8::EpiF32{(float*)(ws + WS_PSCORE), T, 0, T})); }                                                                              \
    SEAM(P0_ + 4);                                                                                                                                              \
    if (IN(P0_ + 5)) { ph_peer_topk(a, w); if (PROBE_DUP == 27 && (LAST)) ph_peer_topk(a, w); }                                                                 \
    SEAM(P0_ + 5);                                                                                                                                              \
    if (IN(P0_ + 6)) { ph_peer_experts(a, (L), (LAST) ? a.out : (float*)nullptr, (LAST) ? (bf16_t*)nullptr : XB, a.in[I_LN_G] + ((L) * 3 + 2) * DM, a.in[I_LN_B] + ((L) * 3 + 2) * DM, wlds, w); \
        if (PROBE_DUP == 28 && (LAST)) ph_peer_experts(a, (L), a.out, (bf16_t*)nullptr, a.in[I_LN_G] + ((L) * 3 + 2) * DM, a.in[I_LN_B] + ((L) * 3 + 2) * DM, wlds, w); } \
    if (!(LAST)) SEAM(P0_ + 6);

    MEM_PEER_PHASES(0, 8, false)

    if (IN(15)) {
        FAST_GEMM(pg8::EpiBf16, XB, DM, (const bf16_t*)(ws + WS_W_CD_IN), DM, T, CD_MAIN, DM, 1, 0, 0, (pg8::EpiBf16{PROJ, CD_MAIN, nullptr}));
        FAST_GEMM(pg8::EpiF32, XB, DM, (const bf16_t*)(ws + WS_W_CD_IN) + (size_t)CD_MAIN * DM, DM, T, 256, 512, 8, 512, 512, (pg8::EpiF32{(float*)(ws + WS_MQP), 256, (long)T * 256, 112}));
    }
    SEAM(15);
    if (IN(16)) ph_l1_elem(a, wlds, w);
    SEAM(16);
    if (IN(17)) { ph_l1_scan(a, (LAS float*)(lds + LDS_MISC + 64), w); ph_l1_index(a, lds, w); if (PROBE_DUP == 17) ph_l1_index(a, lds, w); }
    SEAM(17);
    if (IN(18)) { ph_l1_select(a, w); if (PROBE_DUP == 18) ph_l1_select(a, w); }
    SEAM(18);
    if (IN(19)) { ph_attn_l1(a, lds, w); if (PROBE_DUP == 19) ph_attn_l1(a, lds, w); }
    SEAM(19);
    if (IN(20)) { FAST_GEMM(pg8::EpiResid, ATT, DM, (const bf16_t*)(ws + WS_W_CD_OUT), DM, T, DM, DM, 1, 0, 0, (pg8::EpiResid{XB, RES, DM})); }
    SEAM(20);
    if (IN(21)) ln_rows(RES, a.in[I_LN_G] + 3 * DM, a.in[I_LN_B] + 3 * DM, XB, w);
    SEAM(21);
    MEM_PEER_PHASES(1, 22, true)
#undef IN
#undef SEAM
}

extern "C" void kernel_launch(void* const* d_in, const int* in_sizes, int n_in, void* d_out, int out_size, void* d_ws, size_t ws_size, hipStream_t stream) {
    static int grid = 0;
    if (grid == 0) {
        if (n_in != 21 || out_size != T * DM || ws_size < WS_END) { fprintf(stderr, "kernel_launch: unexpected shapes (n_in %d out %d ws %zu need %zu)\n", n_in, out_size, ws_size, (size_t)WS_END); grid = -1; return; }
        int dev = 0, cus = 0, per_cu = 0;
        if (hipGetDevice(&dev) != hipSuccess || hipDeviceGetAttribute(&cus, hipDeviceAttributeMultiprocessorCount, dev) != hipSuccess) { grid = -1; return; }
        if (hipFuncSetAttribute((const void*)mega, hipFuncAttributeMaxDynamicSharedMemorySize, LDS_BYTES) != hipSuccess) { fprintf(stderr, "kernel_launch: hipFuncSetAttribute failed\n"); grid = -1; return; }
        if (hipOccupancyMaxActiveBlocksPerMultiprocessor(&per_cu, (const void*)mega, 512, LDS_BYTES) != hipSuccess || per_cu < 1) { fprintf(stderr, "kernel_launch: occupancy query says %d\n", per_cu); }
        (void)hipGetLastError();
        grid = cus;
    }
    if (grid < 0) return;
    (void)hipMemsetAsync((char*)d_ws + WS_CTL, 0, CTL_BYTES, stream);
    Args a{};
    for (int i = 0; i < 21; ++i) a.in[i] = (const float*)d_in[i];
    a.out = (float*)d_out; a.ws = (unsigned char*)d_ws;
#if MK_PER_PHASE
    for (int p = 0; p < NPHASE; ++p) { a.ph_lo = p; a.ph_hi = p + 1; hipLaunchKernelGGL(mega, dim3(grid), dim3(512), LDS_BYTES, stream, a);
        if (p == PROBE_EXTRA_PHASE) hipLaunchKernelGGL(mega, dim3(grid), dim3(512), LDS_BYTES, stream, a); }
#else
    a.ph_lo = 0; a.ph_hi = NPHASE;
    hipLaunchKernelGGL(mega, dim3(grid), dim3(512), LDS_BYTES, stream, a);
#endif
}
```

```cpp
#include <hip/hip_runtime.h>
#include <cstdio>
#include <cstdint>

#define GAS __attribute__((address_space(1)))
#define LAS __attribute__((address_space(3)))
typedef unsigned short bf16_t;
typedef short bf16x8 __attribute__((ext_vector_type(8)));
typedef float f32x4 __attribute__((ext_vector_type(4)));
typedef float f32x16 __attribute__((ext_vector_type(16)));
typedef unsigned u32x4 __attribute__((ext_vector_type(4)));
typedef unsigned u32x2 __attribute__((ext_vector_type(2)));
typedef float f32x2 __attribute__((ext_vector_type(2)));

#ifndef PROBE_DUP
#define PROBE_DUP -1
#endif
#ifndef PROBE_EXTRA_PHASE
#define PROBE_EXTRA_PHASE -1
#endif
#ifndef MK_PER_PHASE
#define MK_PER_PHASE 0
#endif

constexpr int NB = 2, SEQ = 4096, T = NB * SEQ, DM = 4096;
constexpr int AB_COLS = 8256, AB_MAIN = 8192, AB_PAD = 8448;
constexpr int CD_COLS = 11376, CD_MAIN = 11264, CD_PAD = 11520;
constexpr float ALPHA = 1.4142135623730951f;
constexpr float LN_EPS = 1e-5f, RMS_EPS = 1e-6f;
constexpr int NPHASE = 29;

constexpr size_t MiB = 1ull << 20;
constexpr size_t WS_CTL = 0, CTL_BYTES = 1 * MiB;
constexpr size_t WS_ROPE128 = 1 * MiB;
constexpr size_t WS_ROPE64 = 3 * MiB;
constexpr size_t WS_RSQ = 4 * MiB;
constexpr size_t WS_RSKV = 4 * MiB + 65536;
constexpr size_t WS_CUM = 5 * MiB;
constexpr size_t WS_LOGF = 5 * MiB + 524288;
constexpr size_t WS_KR = 6 * MiB;
constexpr size_t WS_KI = 7 * MiB;
constexpr size_t WS_WI = 8 * MiB;
constexpr size_t WS_KVM = 9 * MiB;
constexpr size_t WS_MEMB = 11 * MiB;
constexpr size_t WS_MASK = 15 * MiB;
constexpr size_t WS_PIDX = 19 * MiB;
constexpr size_t WS_PGATE = 23 * MiB;
constexpr size_t WS_MEMQ = 27 * MiB;
constexpr size_t WS_MEMO = 35 * MiB;
constexpr size_t WS_SMALL = 43 * MiB;
constexpr size_t WS_W_AB_IN = 64 * MiB;
constexpr size_t WS_W_UQ = 130 * MiB;
constexpr size_t WS_W_UKV = 139 * MiB;
constexpr size_t WS_W_AB_OUT = 143 * MiB;
constexpr size_t WS_W_CD_IN = 175 * MiB;
constexpr size_t WS_W_CD_OUT = 265 * MiB;
constexpr size_t WS_W_MEM_Q = 297 * MiB;
constexpr size_t WS_W_MEM_KV = 305 * MiB;
constexpr size_t WS_W_MEM_O = 321 * MiB;
constexpr size_t WS_W_PEER = 329 * MiB;
constexpr size_t WS_U8 = 361 * MiB;
constexpr size_t WS_V8 = 489 * MiB;
constexpr size_t WS_USC = 48 * MiB;
constexpr size_t WS_VSC = 48 * MiB + 262144;
constexpr size_t WS_XB = 873 * MiB;
constexpr size_t WS_HF = 937 * MiB;
constexpr size_t WS_RES = 1065 * MiB;
constexpr size_t WS_PROJ = 1193 * MiB;
constexpr size_t WS_PSCORE = WS_PROJ;
constexpr size_t WS_ATT = 1369 * MiB;
constexpr size_t WS_QB = 1433 * MiB;
constexpr size_t WS_KVB = 1481 * MiB;
constexpr size_t WS_SCORE = 1433 * MiB;
constexpr size_t WS_MQP = 1561 * MiB;
constexpr size_t WS_END = 1625 * MiB;

constexpr int LDS_BYTES = 147456;
constexpr int LDS_MISC = 140 * 1024;

#define LDS_WAIT() asm volatile("s_waitcnt lgkmcnt(0)" ::: "memory")
__device__ __forceinline__ float bf2f(bf16_t b) { return __uint_as_float(((unsigned)b) << 16); }
__device__ __forceinline__ unsigned f2bf(float f) { unsigned u = __float_as_uint(f); return (u + 0x7fffu + ((u >> 16) & 1u)) >> 16; }
__device__ __forceinline__ unsigned pk2(float lo, float hi) { return f2bf(lo) | (f2bf(hi) << 16); }
__device__ __forceinline__ float wave_sum(float v) {
#pragma unroll
    for (int o = 1; o < 64; o <<= 1) v += __shfl_xor(v, o);
    return v;
}
__device__ __forceinline__ float wave_max(float v) {
#pragma unroll
    for (int o = 1; o < 64; o <<= 1) v = fmaxf(v, __shfl_xor(v, o));
    return v;
}
__device__ __forceinline__ int wave_sum_i(int v) {
#pragma unroll
    for (int o = 1; o < 64; o <<= 1) v += __shfl_xor(v, o);
    return v;
}

#define XB_TMO      128
#define XB_XCNT(j)  (256  + 64 * (j))
#define XB_XSUB(j)  (1280 + 64 * (j))
#define XB_XGEN(j)  (2304 + 64 * (j))
#define XB_TOP      3328
#define XB_TOPGEN   3392
#define XCD_BAR_WORDS 3456
#define XB_SPIN_CAP (1u << 22)

__device__ __forceinline__ unsigned xb_ld(unsigned* p)              { return __hip_atomic_load(p, __ATOMIC_RELAXED, __HIP_MEMORY_SCOPE_AGENT); }
__device__ __forceinline__ unsigned xb_add(unsigned* p, unsigned v) { return __hip_atomic_fetch_add(p, v, __ATOMIC_RELAXED, __HIP_MEMORY_SCOPE_AGENT); }
__device__ __forceinline__ unsigned xb_xcc_id() { return (unsigned)__builtin_amdgcn_s_getreg((3 << 11) | 20) & 0xFu; }
#define XB_SPIN(cond, bar) do { unsigned _sp = 0; while (cond) { __builtin_amdgcn_s_sleep(1); \
    if ((++_sp & 255u) == 0u) { if (xb_ld(&(bar)[XB_TMO])) break; if (_sp > XB_SPIN_CAP) { atomicAdd(&(bar)[XB_TMO], 1u); break; } } } } while (0)

struct XcdBarrier { unsigned* bar; unsigned x; volatile LAS unsigned* st; };

__device__ __forceinline__ XcdBarrier xcd_barrier_post(unsigned* bar, volatile LAS unsigned* st) {
    XcdBarrier b; b.bar = bar; b.x = xb_xcc_id(); b.st = st;
    if (threadIdx.x == 0) (void)xb_add(&bar[XB_XCNT(b.x)], 1u);
    return b;
}
__device__ __forceinline__ void xcd_barrier_complete(unsigned* bar, unsigned x, unsigned& nloc, unsigned& nx) {
    const unsigned G = gridDim.x * gridDim.y * gridDim.z;
    unsigned sum, cnt, mine, sp = 0u;
    for (;;) {
        sum = 0u; cnt = 0u; mine = 0u;
#pragma unroll
        for (unsigned j = 0; j < 16; ++j) { const unsigned c = xb_ld(&bar[XB_XCNT(j)]); sum += c; cnt += (c > 0u) ? 1u : 0u; mine = (j == x) ? c : mine; }
        if (sum == G) break;
        __builtin_amdgcn_s_sleep(1);
        if ((++sp & 255u) == 0u) { if (xb_ld(&bar[XB_TMO])) break; if (sp > XB_SPIN_CAP) { atomicAdd(&bar[XB_TMO], 1u); break; } }
    }
    nloc = mine > 0u ? mine : 1u; nx = cnt > 0u ? cnt : 1u;
}
__device__ __forceinline__ void xcd_barrier(const XcdBarrier& b) {
    asm volatile("s_waitcnt vmcnt(0)" ::: "memory");
    __syncthreads();
    if (threadIdx.x == 0) {
        unsigned* bar = b.bar;
        __builtin_amdgcn_s_waitcnt(0);
        unsigned nloc = b.st[0], nx = b.st[1];
        if (nloc == 0u) { xcd_barrier_complete(bar, b.x, nloc, nx); b.st[0] = nloc; b.st[1] = nx; }
        const unsigned old = xb_add(&bar[XB_XSUB(b.x)], 1u);
        const unsigned gen = old / nloc;
        if (old + 1u == (gen + 1u) * nloc) {
            __builtin_amdgcn_fence(__ATOMIC_RELEASE, "agent");
            asm volatile("s_waitcnt vmcnt(0)" ::: "memory");
            const unsigned og = xb_add(&bar[XB_TOP], 1u);
            const unsigned tg = og / nx;
            if (og + 1u == (tg + 1u) * nx) xb_add(&bar[XB_TOPGEN], 1u);
            else XB_SPIN(xb_ld(&bar[XB_TOPGEN]) == tg, bar);
            __builtin_amdgcn_fence(__ATOMIC_ACQUIRE, "agent");
            xb_add(&bar[XB_XGEN(b.x)], 1u);
            asm volatile("s_waitcnt vmcnt(0)" ::: "memory");
        } else {
            XB_SPIN(xb_ld(&bar[XB_XGEN(b.x)]) == gen, bar);
            __builtin_amdgcn_fence(__ATOMIC_ACQUIRE, "agent");
            asm volatile("s_waitcnt vmcnt(0)" ::: "memory");
        }
    }
    __syncthreads();
}

namespace pg8 {
constexpr int BM = 256, BK = 64, HALF = 128, HTB = HALF * BK * 2, STAGE_BYTES = 8 * HTB, NXCD = 8, WGM = 8;
__host__ __device__ __forceinline__ int lds_byte(int r, int c) { const int st = (r >> 4) * 2 + (c >> 5), rr = r & 15, cc = c & 31, ob = rr * 64 + cc * 2; return st * 1024 + (ob ^ (((ob >> 9) & 1) << 5)); }
__host__ __device__ __forceinline__ void stage_rc(int b, int& R, int& C) { const int st = b / 1024, sb = b % 1024, swz = sb ^ (((sb >> 9) & 1) << 5); R = (st >> 1) * 16 + swz / 64; C = (st & 1) * 32 + (swz % 64) / 2; }
__host__ __device__ __forceinline__ int perm32(int rho) { const int n = rho >> 4, i = rho & 15; return 8 * (i >> 2) + 4 * n + (i & 3); }
struct Unit { int pm, pn, z; };
struct Gemm { const bf16_t* A; const bf16_t* Bt; int M, N, K, lda, ldb; long zA, zB; int nz; };
struct StaticOrder {
    int nM, nN, nZ, nwg, G, c;
    __device__ void init(int M, int N, int Z, int G_, int c_) { nM = M / BM; nN = N / BM; nZ = Z; nwg = nM * nN * nZ; G = G_; c = c_; }
    __device__ bool next(int i, Unit& u) const {
        const long L = (long)i * G + c; if (L >= nwg) return false;
        int wgid = (int)L; { const int q = nwg / NXCD, r = nwg % NXCD, xcd = wgid % NXCD, off = wgid / NXCD; wgid = (xcd < r ? xcd * (q + 1) : r * (q + 1) + (xcd - r) * q) + off; }
        const int per = nM * nN; u.z = wgid / per; wgid -= u.z * per;
        const int nig = WGM * nN, gid = wgid / nig, fm = gid * WGM, gsz = (nM - fm) < WGM ? (nM - fm) : WGM;
        u.pm = fm + ((wgid % nig) % gsz); u.pn = (wgid % nig) / gsz; return true;
    }
};
__device__ __forceinline__ unsigned cvt_pk_bf16(float lo, float hi) { unsigned r; asm volatile("v_cvt_pk_bf16_f32 %0, %1, %2" : "=v"(r) : "v"(lo), "v"(hi)); return r; }
struct EpiF32 {
    static constexpr bool PERM = false;
    float* C; int ldc; long zC; int nvalid;
    __device__ __forceinline__ void operator()(const f32x4 (&acc)[2][2][4][2], const Unit& u, int wr, int wc, int fr, int fq) const {
        const int row0 = u.pm * BM + wr * 64 + fr, col0 = u.pn * BM + wc * 32 + 4 * fq; float* Cz = C + (size_t)u.z * zC;
#pragma unroll
        for (int ai = 0; ai < 2; ++ai)
#pragma unroll
            for (int m = 0; m < 4; ++m) { float* rowp = Cz + (size_t)(row0 + ai * HALF + m * 16) * ldc + col0;
#pragma unroll
                for (int bj = 0; bj < 2; ++bj)
#pragma unroll
                    for (int n = 0; n < 2; ++n) if (col0 + bj * HALF + n * 16 < nvalid) *(f32x4*)(rowp + bj * HALF + n * 16) = acc[ai][bj][m][n]; }
    }
};
struct EpiResid {
    static constexpr bool PERM = true;
    const bf16_t* base; bf16_t* out; int ldc;
    __device__ __forceinline__ void operator()(const f32x4 (&acc)[2][2][4][2], const Unit& u, int wr, int wc, int fr, int fq) const {
        const int row0 = u.pm * BM + wr * 64 + fr, col0 = u.pn * BM + wc * 32 + 8 * fq;
#pragma unroll
        for (int ai = 0; ai < 2; ++ai)
#pragma unroll
            for (int m = 0; m < 4; ++m) { const size_t off = (size_t)(row0 + ai * HALF + m * 16) * ldc + col0;
#pragma unroll
                for (int bj = 0; bj < 2; ++bj) { const u32x4 bs = *(const u32x4*)(base + off + bj * HALF); const f32x4 v0 = acc[ai][bj][m][0], v1 = acc[ai][bj][m][1];
                    u32x4 wv;
                    wv.x = cvt_pk_bf16(fmaf(ALPHA, __uint_as_float(bs.x << 16), v0[0]), fmaf(ALPHA, __uint_as_float(bs.x & 0xffff0000u), v0[1]));
                    wv.y = cvt_pk_bf16(fmaf(ALPHA, __uint_as_float(bs.y << 16), v0[2]), fmaf(ALPHA, __uint_as_float(bs.y & 0xffff0000u), v0[3]));
                    wv.z = cvt_pk_bf16(fmaf(ALPHA, __uint_as_float(bs.z << 16), v1[0]), fmaf(ALPHA, __uint_as_float(bs.z & 0xffff0000u), v1[1]));
                    wv.w = cvt_pk_bf16(fmaf(ALPHA, __uint_as_float(bs.w << 16), v1[2]), fmaf(ALPHA, __uint_as_float(bs.w & 0xffff0000u), v1[3]));
                    *(u32x4*)(out + off + bj * HALF) = wv; }
                asm volatile("" ::: "memory"); }
    }
};
struct EpiBf16 {
    static constexpr bool PERM = true;
    bf16_t* O; int ldc; const float* rs;
    __device__ __forceinline__ void operator()(const f32x4 (&acc)[2][2][4][2], const Unit& u, int wr, int wc, int fr, int fq) const {
        const int row0 = u.pm * BM + wr * 64 + fr, col0 = u.pn * BM + wc * 32 + 8 * fq;
#pragma unroll
        for (int ai = 0; ai < 2; ++ai)
#pragma unroll
            for (int m = 0; m < 4; ++m) { const int row = row0 + ai * HALF + m * 16; bf16_t* rowp = O + (size_t)row * ldc + col0; const float sc = rs ? rs[row] : 1.f;
#pragma unroll
                for (int bj = 0; bj < 2; ++bj) { const f32x4 v0 = acc[ai][bj][m][0] * sc, v1 = acc[ai][bj][m][1] * sc;
                    u32x4 wv; wv.x = cvt_pk_bf16(v0[0], v0[1]); wv.y = cvt_pk_bf16(v0[2], v0[3]); wv.z = cvt_pk_bf16(v1[0], v1[1]); wv.w = cvt_pk_bf16(v1[2], v1[3]);
                    *(u32x4*)(rowp + bj * HALF) = wv; } }
    }
};
template <class Epi, class Sched>
__device__ __forceinline__ void gemm_phase(LAS unsigned char* lds, const Gemm g, const Sched& S, const Epi& E) {
    const int tid = threadIdx.x, wid = __builtin_amdgcn_readfirstlane(tid >> 6), lane = tid & 63, wr = wid >> 2, wc = wid & 3, fr = lane & 15, fq = lane >> 4;
    const int K = g.K, nt = K / BK;
    unsigned voffA[2], voffB[2];
#pragma unroll
    for (int i = 0; i < 2; ++i) { int R, C; stage_rc(tid * 16 + i * 8192, R, C); const int Rb = Epi::PERM ? ((R & ~31) + perm32(R & 31)) : R;
        voffA[i] = (unsigned)(R * g.lda + C) * 2u; voffB[i] = (unsigned)(Rb * g.ldb + C) * 2u; }
    const size_t kstep = (size_t)(BK * 2);
    const size_t hA = (size_t)HALF * g.lda * 2, hB = (size_t)HALF * g.ldb * 2;
    const size_t tA = 2 * hA, tB = 2 * hB;
    const unsigned ldsw = (unsigned)wid * 1024u;
    const int aoff = lds_byte(wr * 64 + fr, fq * 8), boff = lds_byte(wc * 32 + fr, fq * 8);
#define PG8_SA(b, h) (((b) * 2 + (h)) * HTB)
#define PG8_SB(b, h) ((4 + (b) * 2 + (h)) * HTB)
#define PG8_STAGE(bufoff, gbase, voff) do { _Pragma("unroll") for (int _i = 0; _i < 2; ++_i) \
        __builtin_amdgcn_global_load_lds((const unsigned*)((const char*)(gbase) + (voff)[_i]), (LAS unsigned*)(lds + (bufoff) + ldsw + _i * 8192), 16, 0, 0); } while (0)
#define PG8_LDA(dst, b, h) do { _Pragma("unroll") for (int m = 0; m < 4; ++m) _Pragma("unroll") for (int k = 0; k < 2; ++k) dst[m][k] = *(const LAS bf16x8*)(lds + PG8_SA(b, h) + aoff + m * 2048 + k * 1024); } while (0)
#define PG8_LDB(dst, b, h) do { _Pragma("unroll") for (int n = 0; n < 2; ++n) _Pragma("unroll") for (int k = 0; k < 2; ++k) dst[n][k] = *(const LAS bf16x8*)(lds + PG8_SB(b, h) + boff + n * 2048 + k * 1024); } while (0)
#define PG8_MMA(ai, bj, At, Bt) do { __builtin_amdgcn_s_setprio(1); _Pragma("unroll") for (int m = 0; m < 4; ++m) _Pragma("unroll") for (int n = 0; n < 2; ++n) _Pragma("unroll") for (int k = 0; k < 2; ++k) \
        acc[ai][bj][m][n] = __builtin_amdgcn_mfma_f32_16x16x32_bf16(Bt[n][k], At[m][k], acc[ai][bj][m][n], 0, 0, 0); __builtin_amdgcn_s_setprio(0); } while (0)
#define PG8_WAIT_V(n) asm volatile("s_waitcnt vmcnt(" #n ")" ::: "memory")
#define PG8_WAIT_L(n) asm volatile("s_waitcnt lgkmcnt(" #n ")" ::: "memory")
#define PG8_BAR __builtin_amdgcn_s_barrier()
#define PG8_SCHED __builtin_amdgcn_sched_barrier(0)
    Unit cur, nxt; int ui = 0;
    if (!S.next(0, cur)) return;
    f32x4 acc[2][2][4][2];
#pragma unroll
    for (int a = 0; a < 2; ++a)
#pragma unroll
        for (int b = 0; b < 2; ++b)
#pragma unroll
            for (int m = 0; m < 4; ++m)
#pragma unroll
                for (int n = 0; n < 2; ++n) acc[a][b][m][n] = (f32x4){0.f, 0.f, 0.f, 0.f};
    bf16x8 At[4][2], B0[2][2], B1[2][2];
    const char* cA = (const char*)g.A + (size_t)cur.pm * tA + (size_t)cur.z * g.zA * 2; const char* cB = (const char*)g.Bt + (size_t)cur.pn * tB + (size_t)cur.z * g.zB * 2;
    PG8_STAGE(PG8_SB(0, 0), cB, voffB); PG8_STAGE(PG8_SA(0, 0), cA, voffA); PG8_STAGE(PG8_SB(0, 1), cB + hB, voffB); PG8_STAGE(PG8_SA(0, 1), cA + hA, voffA);
    if (wr == 1) PG8_BAR;
    PG8_WAIT_V(4); PG8_BAR;
    PG8_STAGE(PG8_SB(1, 0), cB + kstep, voffB); PG8_STAGE(PG8_SA(1, 0), cA + kstep, voffA); PG8_STAGE(PG8_SB(1, 1), cB + hB + kstep, voffB);
    PG8_WAIT_V(6); PG8_BAR;
    for (;;) {
        const bool has_next = S.next(ui + 1, nxt);
        const char* nA = has_next ? (const char*)g.A + (size_t)nxt.pm * tA + (size_t)nxt.z * g.zA * 2 : cA; const char* nB = has_next ? (const char*)g.Bt + (size_t)nxt.pn * tB + (size_t)nxt.z * g.zB * 2 : cB;
        for (int t = 0; t < nt; t += 2) {
            const bool last = (t == nt - 2);
            const char* a1 = cA + (size_t)(t + 1) * kstep;
            const char* a2 = last ? nA : cA + (size_t)(t + 2) * kstep; const char* b2 = last ? nB : cB + (size_t)(t + 2) * kstep;
            const char* a3 = a2 + kstep; const char* b3 = b2 + kstep;
            PG8_LDB(B0, 0, 0); PG8_SCHED; PG8_LDA(At, 0, 0); PG8_STAGE(PG8_SA(1, 1), a1 + hA, voffA);
            PG8_WAIT_L(8); PG8_BAR; PG8_WAIT_L(0); PG8_MMA(0, 0, At, B0); PG8_BAR; PG8_SCHED;
            PG8_LDB(B1, 0, 1); PG8_STAGE(PG8_SB(0, 0), b2, voffB);
            PG8_BAR; PG8_WAIT_L(0); PG8_MMA(0, 1, At, B1); PG8_BAR;
            PG8_LDA(At, 0, 1); PG8_STAGE(PG8_SA(0, 0), a2, voffA);
            PG8_BAR; PG8_WAIT_L(0); PG8_MMA(1, 0, At, B0); PG8_BAR; PG8_SCHED;
            PG8_STAGE(PG8_SB(0, 1), b2 + hB, voffB);
            PG8_WAIT_V(6); PG8_BAR; PG8_MMA(1, 1, At, B1); PG8_BAR;
            PG8_LDB(B0, 1, 0); PG8_SCHED; PG8_LDA(At, 1, 0); PG8_STAGE(PG8_SA(0, 1), a2 + hA, voffA);
            PG8_WAIT_L(8); PG8_BAR; PG8_WAIT_L(0); PG8_MMA(0, 0, At, B0); PG8_BAR; PG8_SCHED;
            PG8_LDB(B1, 1, 1); PG8_STAGE(PG8_SB(1, 0), b3, voffB);
            PG8_BAR; PG8_WAIT_L(0); PG8_MMA(0, 1, At, B1); PG8_BAR;
            PG8_LDA(At, 1, 1); PG8_STAGE(PG8_SA(1, 0), a3, voffA);
            PG8_BAR; PG8_WAIT_L(0); PG8_MMA(1, 0, At, B0); PG8_BAR; PG8_SCHED;
            PG8_STAGE(PG8_SB(1, 1), b3 + hB, voffB);
            PG8_WAIT_V(6); PG8_BAR; PG8_MMA(1, 1, At, B1); PG8_BAR;
        }
        E(acc, cur, wr, wc, fr, fq);
        if (!has_next) break;
#pragma unroll
        for (int a = 0; a < 2; ++a)
#pragma unroll
            for (int b = 0; b < 2; ++b)
#pragma unroll
                for (int m = 0; m < 4; ++m)
#pragma unroll
                    for (int n = 0; n < 2; ++n) acc[a][b][m][n] = (f32x4){0.f, 0.f, 0.f, 0.f};
        cur = nxt; cA = nA; cB = nB; ++ui;
    }
    PG8_WAIT_V(0);
    if (wr == 0) PG8_BAR;
    PG8_BAR;
#undef PG8_SA
#undef PG8_SB
#undef PG8_STAGE
#undef PG8_LDA
#undef PG8_LDB
#undef PG8_MMA
#undef PG8_WAIT_V
#undef PG8_WAIT_L
#undef PG8_BAR
#undef PG8_SCHED
}
}

struct Args { const float* in[21]; float* out; unsigned char* ws; int ph_lo, ph_hi; };
enum { I_X = 0, I_MEM, I_AB_W_IN, I_A_REL_BIAS, I_B_Q_NORM, I_B_W_UQ, I_B_KV_NORM, I_B_W_UKV, I_AB_W_OUT, I_CD_W_IN, I_D_FORGET_BIAS, I_CD_W_OUT,
       I_MEM_W_Q, I_MEM_W_KV, I_MEM_W_O, I_PEER_W_Q, I_PEER_SUB_KEYS, I_PEER_U, I_PEER_V, I_LN_G, I_LN_B };

struct WI { int tid, lane, wave, gw, ngw, bid, nblk; };

__device__ __forceinline__ void tr_item(const float* W, int K, int ld, int c0, int nc, bf16_t* WT, int r0, const float* scale, LAS float* scr, int item, int lane) {
    const int nblk = (nc + 63) >> 6, kb = item / nblk, nb = item - kb * nblk, k0 = 64 * kb, n0 = 64 * nb;
    const int ln = (lane & 15) * 4, lk = lane >> 4; const bool ok = n0 + ln < nc;
    const float* src = W + (size_t)(k0 + lk) * ld + c0 + n0 + ln;
    f32x4 v[16];
#pragma unroll
    for (int i = 0; i < 16; ++i) v[i] = ok ? *(const f32x4*)(src + (size_t)(4 * i) * ld) : (f32x4){0.f, 0.f, 0.f, 0.f};
#pragma unroll
    for (int i = 0; i < 16; ++i) { const int kk = lk + 4 * i; const float s = scale ? scale[k0 + kk] : 1.f; LAS float* d = scr + kk * 65 + ln;
        d[0] = v[i].x * s; d[1] = v[i].y * s; d[2] = v[i].z * s; d[3] = v[i].w * s; }
    LDS_WAIT();
    const int c = lane & 7;
#pragma unroll
    for (int j = 0; j < 8; ++j) { const int n = (lane >> 3) + 8 * j; const LAS float* s = scr + (8 * c) * 65 + n;
        u32x4 o; o.x = pk2(s[0 * 65], s[1 * 65]); o.y = pk2(s[2 * 65], s[3 * 65]); o.z = pk2(s[4 * 65], s[5 * 65]); o.w = pk2(s[6 * 65], s[7 * 65]);
        if (n0 + n < nc) *(u32x4*)(WT + (size_t)(r0 + n0 + n) * K + k0 + 8 * c) = o; }
    LDS_WAIT();
}
__device__ __forceinline__ void cvt_rows(const float* src, bf16_t* dst, size_t n, size_t i0, size_t stride) {
    size_t i = i0 * 8;
    for (; i + 3 * stride * 8 < n; i += 4 * stride * 8) {
        f32x4 a[4], b[4];
#pragma unroll
        for (int q = 0; q < 4; ++q) { a[q] = *(const f32x4*)(src + i + q * stride * 8); b[q] = *(const f32x4*)(src + i + q * stride * 8 + 4); }
#pragma unroll
        for (int q = 0; q < 4; ++q) { u32x4 o; o.x = pk2(a[q].x, a[q].y); o.y = pk2(a[q].z, a[q].w); o.z = pk2(b[q].x, b[q].y); o.w = pk2(b[q].z, b[q].w); *(u32x4*)(dst + i + q * stride * 8) = o; }
    }
    for (; i < n; i += stride * 8) {
        const f32x4 a = *(const f32x4*)(src + i), b = *(const f32x4*)(src + i + 4);
        u32x4 o; o.x = pk2(a.x, a.y); o.y = pk2(a.z, a.w); o.z = pk2(b.x, b.y); o.w = pk2(b.z, b.w);
        *(u32x4*)(dst + i) = o;
    }
}
__device__ __forceinline__ void ph_convert(const Args& a, LAS unsigned char* lds, const WI& w) {
    unsigned char* ws = a.ws;
    LAS float* scr = (LAS float*)(lds + w.wave * 16640);
    constexpr int J1 = 64 * 129, J2 = 24 * 48, J3 = 8 * 64, J4 = 64 * 64, J5 = 64 * 80, J6 = 64 * 96, J7 = 64 * 2, J8 = 64 * 1, J9 = 64 * 64,
                  J10 = 64 * 8, J12 = 64 * 16, J14 = 8 * 64;
    constexpr int NJ = J1 + J2 + J3 + J4 + J5 + J6 + J7 + J8 + J9 + 2 * J10 + 2 * J12 + 2 * J14;
    for (int it = w.gw; it < NJ; it += w.ngw) {
        int r = it; const float* src; int K, ld, c0 = 0, nc, r0 = 0; bf16_t* dst; const float* sc = nullptr;
        if (r < J1) { src = a.in[I_AB_W_IN]; K = 4096; ld = AB_COLS; nc = AB_COLS; dst = (bf16_t*)(ws + WS_W_AB_IN); }
        else if ((r -= J1) < J2) { src = a.in[I_B_W_UQ]; K = 1536; ld = 3072; nc = 3072; dst = (bf16_t*)(ws + WS_W_UQ); sc = a.in[I_B_Q_NORM]; }
        else if ((r -= J2) < J3) { src = a.in[I_B_W_UKV]; K = 512; ld = 4096; nc = 4096; dst = (bf16_t*)(ws + WS_W_UKV); sc = a.in[I_B_KV_NORM]; }
        else if ((r -= J3) < J4) { src = a.in[I_AB_W_OUT]; K = 4096; ld = 4096; nc = 4096; dst = (bf16_t*)(ws + WS_W_AB_OUT); }
        else if ((r -= J4) < J5) { src = a.in[I_CD_W_IN]; K = 4096; ld = CD_COLS; c0 = 0; nc = 5120; r0 = 0; dst = (bf16_t*)(ws + WS_W_CD_IN); }
        else if ((r -= J5) < J6) { src = a.in[I_CD_W_IN]; K = 4096; ld = CD_COLS; c0 = 5216; nc = 6144; r0 = 5120; dst = (bf16_t*)(ws + WS_W_CD_IN); }
        else if ((r -= J6) < J7) { src = a.in[I_CD_W_IN]; K = 4096; ld = CD_COLS; c0 = 5120; nc = 96; r0 = 11264; dst = (bf16_t*)(ws + WS_W_CD_IN); }
        else if ((r -= J7) < J8) { src = a.in[I_CD_W_IN]; K = 4096; ld = CD_COLS; c0 = 11360; nc = 16; r0 = 11360; dst = (bf16_t*)(ws + WS_W_CD_IN); }
        else if ((r -= J8) < J9) { src = a.in[I_CD_W_OUT]; K = 4096; ld = 4096; nc = 4096; dst = (bf16_t*)(ws + WS_W_CD_OUT); }
        else if ((r -= J9) < 2 * J10) { const int l = r / J10; r -= l * J10; src = a.in[I_MEM_W_Q] + (size_t)l * 4096 * 512; K = 4096; ld = 512; nc = 512; dst = (bf16_t*)(ws + WS_W_MEM_Q) + (size_t)l * 512 * 4096; }
        else if ((r -= 2 * J10) < 2 * J12) { const int l = r / J12; r -= l * J12; src = a.in[I_MEM_W_KV] + (size_t)l * 4096 * 1024; K = 4096; ld = 1024; nc = 1024; dst = (bf16_t*)(ws + WS_W_MEM_KV) + (size_t)l * 1024 * 4096; }
        else { r -= 2 * J12; const int l = r / J14; r -= l * J14; src = a.in[I_MEM_W_O] + (size_t)l * 512 * 4096; K = 512; ld = 4096; nc = 4096; dst = (bf16_t*)(ws + WS_W_MEM_O) + (size_t)l * 4096 * 512; }
        tr_item(src, K, ld, c0, nc, dst, r0, sc, scr, r, w.lane);
    }
    { const size_t gt = (size_t)w.gw * 64 + w.lane, ng = (size_t)w.ngw * 64;
      bf16_t* p1 = (bf16_t*)(ws + WS_W_AB_IN) + (size_t)AB_COLS * 4096; const size_t n1 = (size_t)(AB_PAD - AB_COLS) * 4096;
      for (size_t i = gt * 8; i < n1; i += ng * 8) *(u32x4*)(p1 + i) = (u32x4){0u, 0u, 0u, 0u};
      bf16_t* p2 = (bf16_t*)(ws + WS_W_CD_IN) + (size_t)CD_COLS * 4096; const size_t n2 = (size_t)(CD_PAD - CD_COLS) * 4096;
      for (size_t i = gt * 8; i < n2; i += ng * 8) *(u32x4*)(p2 + i) = (u32x4){0u, 0u, 0u, 0u};
      cvt_rows(a.in[I_X], (bf16_t*)(ws + WS_XB), (size_t)T * DM, gt, ng);
      cvt_rows(a.in[I_MEM], (bf16_t*)(ws + WS_MEMB), (size_t)512 * DM, gt, ng);
      for (int r = w.gw; r < 65536; r += w.ngw) { const int tbl = r >> 15, rr = r & 32767;
          const float* srow = (tbl ? a.in[I_PEER_V] : a.in[I_PEER_U]) + (size_t)rr * DM + 32 * w.lane;
          unsigned char* dbase = ws + (tbl ? WS_V8 : WS_U8);
          f32x4 v[2][8];
#pragma unroll
          for (int i = 0; i < 2; ++i)
#pragma unroll
              for (int q = 0; q < 8; ++q) v[i][q] = *(const f32x4*)(srow + 2048 * i + 4 * q);
          unsigned scb = 0u;
#pragma unroll
          for (int i = 0; i < 2; ++i) { float bm = 0.f;
#pragma unroll
              for (int q = 0; q < 8; ++q) bm = fmaxf(bm, fmaxf(fmaxf(fabsf(v[i][q].x), fabsf(v[i][q].y)), fmaxf(fabsf(v[i][q].z), fabsf(v[i][q].w))));
              int b = 128; if (bm > 0.f) { b = (int)ceilf(8.f * __log2f(bm * (1.f / 6.f)) + 0.02f) + 128; b = b < 0 ? 0 : (b > 255 ? 255 : b); }
              const float inv = __builtin_amdgcn_exp2f((float)(128 - b) * 0.125f);
              u32x4 o;
#pragma unroll
              for (int d = 0; d < 4; ++d) { unsigned wv = 0u; const f32x4 p0 = v[i][2 * d] * inv, p1 = v[i][2 * d + 1] * inv;
                  wv = __builtin_amdgcn_cvt_scalef32_pk_fp4_f32(wv, p0.x, p0.y, 1.0f, 0); wv = __builtin_amdgcn_cvt_scalef32_pk_fp4_f32(wv, p0.z, p0.w, 1.0f, 1);
                  wv = __builtin_amdgcn_cvt_scalef32_pk_fp4_f32(wv, p1.x, p1.y, 1.0f, 2); wv = __builtin_amdgcn_cvt_scalef32_pk_fp4_f32(wv, p1.z, p1.w, 1.0f, 3); o[d] = wv; }
              *(u32x4*)(dbase + (size_t)rr * 2048 + 1024 * i + 16 * w.lane) = o;
              scb |= (unsigned)b << (8 * i); }
          ((unsigned short*)(dbase + 64 * MiB))[(size_t)rr * 64 + w.lane] = (unsigned short)scb; }
      float* r128 = (float*)(ws + WS_ROPE128); float* r64 = (float*)(ws + WS_ROPE64);
      for (size_t i = gt; i < (size_t)SEQ * 96; i += ng) {
          const int s = (int)(i / 96), j = (int)(i % 96); const bool big = j < 64; const int ii = big ? j : j - 64;
          const double rr = big ? 0.8659643233600653 : 0.7498942093324559; double inv = 1.0;
          for (int q = 0; q < ii; ++q) inv *= rr;
          const double rev = (double)s * inv * 0.15915494309189535; const float fr = (float)(rev - rint(rev));
          const float cs = __builtin_amdgcn_cosf(fr), sn = __builtin_amdgcn_sinf(fr);
          float* o = big ? (r128 + ((size_t)s * 64 + ii) * 2) : (r64 + ((size_t)s * 32 + ii) * 2);
          o[0] = cs; o[1] = sn; }
    }
    {
        LAS float* Ks = (LAS float*)lds; LAS float* Ws = Ks + 128 * 129;
        const int tk = w.tid & 31, tn = w.tid >> 5;
        for (int it = w.bid; it < 2 * 16 * 32; it += w.nblk) {
            const int l = it >> 9, hp = (it >> 5) & 15, kb = it & 31;
            __syncthreads();
            const float* keys = a.in[I_PEER_SUB_KEYS] + ((size_t)(l * 16 + hp) * 128) * 128;
            const float* wq = a.in[I_PEER_W_Q] + ((size_t)l * 4096 + (size_t)kb * 128) * 2048 + hp * 128;
            for (int e = w.tid; e < 128 * 128; e += 512) { const int rrow = e >> 7, d = e & 127; Ks[rrow * 129 + d] = keys[(size_t)rrow * 128 + d]; Ws[rrow * 129 + d] = wq[(size_t)rrow * 2048 + d]; }
            __syncthreads();
            float acc[8][4];
#pragma unroll
            for (int x = 0; x < 8; ++x)
#pragma unroll
                for (int y = 0; y < 4; ++y) acc[x][y] = 0.f;
            for (int d = 0; d < 128; ++d) {
                float kv[8], wv[4];
#pragma unroll
                for (int x = 0; x < 8; ++x) kv[x] = Ks[(tn + 16 * x) * 129 + d];
#pragma unroll
                for (int y = 0; y < 4; ++y) wv[y] = Ws[(tk + 32 * y) * 129 + d];
#pragma unroll
                for (int x = 0; x < 8; ++x)
#pragma unroll
                    for (int y = 0; y < 4; ++y) acc[x][y] += kv[x] * wv[y];
            }
            bf16_t* dst = (bf16_t*)(ws + WS_W_PEER) + ((size_t)l * 2048 + hp * 128) * 4096 + kb * 128;
#pragma unroll
            for (int x = 0; x < 8; ++x)
#pragma unroll
                for (int y = 0; y < 4; ++y) dst[(size_t)(tn + 16 * x) * 4096 + tk + 32 * y] = (bf16_t)f2bf(acc[x][y]);
        }
        __syncthreads();
    }
}

__device__ __forceinline__ int crow(int r, int hi) { return (r & 3) + 8 * (r >> 2) + 4 * hi; }
template <class F>
__device__ __forceinline__ void naive_gemm(const bf16_t* A, int lda, const bf16_t* Bt, int ldb, int M, int N, int K, const WI& w, F epi) {
    const int tm = M >> 5, tn = (N + 31) >> 5;
    const int i = w.lane & 31, g = w.lane >> 5;
    for (int tile = w.gw; tile < tm * tn; tile += w.ngw) {
        const int bn = tile / tm, bm = tile - bn * tm;
        const bf16_t* ap = A + (size_t)(bm * 32 + i) * lda + 8 * g;
        const int nrow = bn * 32 + i; const bool nv = nrow < N;
        const bf16_t* bp = Bt + (size_t)(nv ? nrow : 0) * ldb + 8 * g;
        f32x16 acc = {};
#pragma unroll 4
        for (int k = 0; k < K; k += 16) {
            const bf16x8 av = *(const bf16x8*)(ap + k);
            bf16x8 bv = *(const bf16x8*)(bp + k);
            if (!nv) bv = (bf16x8){0, 0, 0, 0, 0, 0, 0, 0};
            acc = __builtin_amdgcn_mfma_f32_32x32x16_bf16(av, bv, acc, 0, 0, 0);
        }
#pragma unroll
        for (int r = 0; r < 16; ++r) { const int row = bm * 32 + crow(r, g), col = bn * 32 + i; if (col < N) epi(row, col, acc[r]); }
    }
}

__device__ __forceinline__ void ln_rows(const bf16_t* src, const float* g, const float* b, bf16_t* dstb, const WI& w) {
    for (int m = w.gw; m < T; m += w.ngw) {
        const u32x4* xr = (const u32x4*)(src + (size_t)m * DM) + w.lane;
        float v[64]; float s = 0.f;
#pragma unroll
        for (int j = 0; j < 8; ++j) { const u32x4 x = xr[64 * j];
#pragma unroll
            for (int e = 0; e < 4; ++e) { v[8 * j + 2 * e] = __uint_as_float(x[e] << 16); v[8 * j + 2 * e + 1] = __uint_as_float(x[e] & 0xffff0000u); s += v[8 * j + 2 * e] + v[8 * j + 2 * e + 1]; } }
        const float mean = wave_sum(s) * (1.f / DM); float s2 = 0.f;
#pragma unroll
        for (int i = 0; i < 64; ++i) { v[i] -= mean; s2 += v[i] * v[i]; }
        const float rstd = 1.f / sqrtf(wave_sum(s2) * (1.f / DM) + LN_EPS);
#pragma unroll
        for (int j = 0; j < 8; ++j) { const int c = 8 * w.lane + 512 * j;
            const f32x4 g0 = *(const f32x4*)(g + c), g1 = *(const f32x4*)(g + c + 4), b0 = *(const f32x4*)(b + c), b1 = *(const f32x4*)(b + c + 4);
            u32x4 p;
            p.x = pk2(v[8 * j + 0] * rstd * g0.x + b0.x, v[8 * j + 1] * rstd * g0.y + b0.y); p.y = pk2(v[8 * j + 2] * rstd * g0.z + b0.z, v[8 * j + 3] * rstd * g0.w + b0.w);
            p.z = pk2(v[8 * j + 4] * rstd * g1.x + b1.x, v[8 * j + 5] * rstd * g1.y + b1.y); p.w = pk2(v[8 * j + 6] * rstd * g1.z + b1.z, v[8 * j + 7] * rstd * g1.w + b1.w);
            *(u32x4*)(dstb + (size_t)m * DM + c) = p; }
    }
}

template <int MODE>
__device__ __forceinline__ void attn_naive(const Args& a, int layer, LAS float* qs, const WI& w) {
    constexpr int H = (MODE == 4) ? 4 : 16, DK = (MODE == 1) ? 192 : 128;
    const float scale = (MODE == 1) ? 0.07216878364870322f : 0.08838834764831845f;
    unsigned char* ws = a.ws;
    const float NEG = -__builtin_inff();
    for (int it = w.gw; it < T * H; it += w.ngw) {
        const int h = it / T, t = it - h * T, b = t / SEQ, sp = t - b * SEQ, c = sp >> 6;
        const bf16_t* qp; const bf16_t* kbase; const bf16_t* vbase; int ldk, ldv; bf16_t* op;
        int s_lo = 0, s_hi;
        if (MODE == 0) { const bf16_t* P = (const bf16_t*)(ws + WS_PROJ); qp = P + (size_t)t * AB_MAIN + h * 128; kbase = P + (size_t)b * SEQ * AB_MAIN + 2048 + h * 128; vbase = kbase + 2048; ldk = ldv = AB_MAIN;
            op = (bf16_t*)(ws + WS_ATT) + (size_t)t * DM + h * 128; s_lo = (c - 8) * 64; if (s_lo < 0) s_lo = 0; s_hi = (c + 1) * 64; }
        else if (MODE == 1) { qp = (const bf16_t*)(ws + WS_QB) + (size_t)t * 3072 + h * 192; kbase = (const bf16_t*)(ws + WS_KVB) + (size_t)b * SEQ * 4096 + h * 256; vbase = kbase + 128; ldk = ldv = 4096;
            op = (bf16_t*)(ws + WS_ATT) + (size_t)t * DM + 2048 + h * 128; s_hi = (c + 1) * 64; }
        else if (MODE == 2) { const bf16_t* P = (const bf16_t*)(ws + WS_PROJ); qp = P + (size_t)t * CD_MAIN + h * 128; kbase = P + (size_t)b * SEQ * CD_MAIN + 2048 + (h >> 2) * 128; vbase = kbase + 512; ldk = ldv = CD_MAIN;
            op = (bf16_t*)(ws + WS_ATT) + (size_t)t * DM + h * 128; s_hi = (c + 1) * 64; }
        else if (MODE == 3) { const bf16_t* P = (const bf16_t*)(ws + WS_PROJ); qp = P + (size_t)t * CD_MAIN + 5120 + h * 128; kbase = P + (size_t)b * SEQ * CD_MAIN + 7168 + h * 128; vbase = kbase + 2048; ldk = ldv = CD_MAIN;
            op = (bf16_t*)(ws + WS_ATT) + (size_t)t * DM + 2048 + h * 128; s_hi = sp + 1; }
        else { qp = (const bf16_t*)(ws + WS_MEMQ) + (size_t)t * 512 + h * 128; kbase = (const bf16_t*)(ws + WS_KVM) + ((size_t)layer * 512 + b * 256) * 1024 + h * 128; vbase = kbase + 512; ldk = ldv = 1024;
            op = (bf16_t*)(ws + WS_MEMO) + (size_t)t * 512 + h * 128; s_hi = 256; }
        LDS_WAIT();
        if (MODE == 4) { const float* mq = (const float*)(ws + WS_MQP) + (size_t)t * 512 + h * 128;
            for (int d = w.lane; d < DK; d += 64) qs[d] = bf2f((bf16_t)f2bf((mq[d] + mq[d + (size_t)T * 512]) + (mq[d + (size_t)2 * T * 512] + mq[d + (size_t)3 * T * 512]))); }
        else for (int d = w.lane; d < DK; d += 64) qs[d] = bf2f(qp[d]);
        LDS_WAIT();
        const float* cum = (const float*)(ws + WS_CUM) + ((size_t)b * 16 + h) * SEQ;
        const float ct = (MODE == 3) ? cum[sp] : 0.f;
        const float* relb = a.in[I_A_REL_BIAS] + h * 513;
        const unsigned* mrow = (const unsigned*)(ws + WS_MASK) + (size_t)t * 128;
        float m = NEG, l = 0.f, o0 = 0.f, o1 = 0.f;
        for (int s0 = s_lo; s0 < s_hi; s0 += 64) {
            const int s = s0 + w.lane; bool valid = s < s_hi;
            if (MODE == 2) { if (valid) valid = (mrow[s >> 5] >> (s & 31)) & 1u; }
            float x = NEG;
            if (valid) {
                const bf16_t* kp = kbase + (size_t)s * ldk; float acc = 0.f;
#pragma unroll 4
                for (int d0 = 0; d0 < 128; d0 += 8) { const bf16x8 kv = *(const bf16x8*)(kp + d0);
#pragma unroll
                    for (int e = 0; e < 8; ++e) acc += qs[d0 + e] * bf2f((bf16_t)kv[e]); }
                if (MODE == 1) { const bf16_t* kr = (const bf16_t*)(ws + WS_KR) + ((size_t)b * SEQ + s) * 64;
#pragma unroll 4
                    for (int d0 = 0; d0 < 64; d0 += 8) { const bf16x8 kv = *(const bf16x8*)(kr + d0);
#pragma unroll
                        for (int e = 0; e < 8; ++e) acc += qs[128 + d0 + e] * bf2f((bf16_t)kv[e]); } }
                x = acc * scale;
                if (MODE == 0) { int rel = sp - s; rel = rel < -256 ? -256 : (rel > 256 ? 256 : rel); x += relb[rel + 256]; }
                if (MODE == 3) x += ct - cum[s];
            }
            const float mx = wave_max(x);
            if (mx == NEG) continue;
            const float mn = fmaxf(m, mx); const float p = valid ? __expf(x - mn) : 0.f; const float al = __expf(m - mn);
            l = l * al + wave_sum(p); o0 *= al; o1 *= al; m = mn;
            for (int j = 0; j < 64; ++j) { const float pj = __shfl(p, j);
                if (pj != 0.f) { const bf16_t* vp = vbase + (size_t)(s0 + j) * ldv; o0 += pj * bf2f(vp[w.lane]); o1 += pj * bf2f(vp[w.lane + 64]); } }
        }
        const float rl = 1.f / l;
        op[w.lane] = (bf16_t)f2bf(o0 * rl); op[w.lane + 64] = (bf16_t)f2bf(o1 * rl);
    }
}

__device__ __forceinline__ void rope8(u32x4& x1, u32x4& x2, const float* tab);
namespace fa {
constexpr int SHM_V = 64 * 128 * 2;
constexpr int LDS_V = 0, LDS_K = 2 * SHM_V, LDS_WS = LDS_K + 2 * 64 * 384, LDS_RELB = LDS_WS + 8 * 64 * 4, LDS_CS = LDS_RELB + 2304, LDS_END = LDS_CS + 512;
#define FA_KSWZ(row, colB, RS) ((row) * (RS) + ((colB) ^ (((row) & 7) << 4)))
__device__ __forceinline__ int v_st(int k, int c) { const int kk = (k & ~0xC) | ((k & 4) << 1) | ((k & 8) >> 1); return ((kk >> 3) * 4 + (c >> 5)) * 512 + ((kk & 7) * 32 + (c & 31)) * 2; }
__device__ __forceinline__ int v_rd_base(int lane) { return ((lane & 3) << 3) | (((lane >> 2) & 3) << 6) | (((lane >> 4) & 1) << 5) | (((lane >> 5) & 1) << 8); }
__device__ __forceinline__ unsigned cvtpk(float lo, float hi) { unsigned r; asm volatile("v_cvt_pk_bf16_f32 %0, %1, %2" : "=v"(r) : "v"(lo), "v"(hi)); return r; }
typedef short s16x4 __attribute__((ext_vector_type(4)));

template <int DK>
__device__ __forceinline__ void qkt(f32x16& p0, f32x16& p1, LAS const char* Kb, int r32, int hi, const bf16x8* qr) {
    constexpr int RS = DK * 2;
    p0 = f32x16{}; p1 = f32x16{};
    LAS const char* kb[4];
#pragma unroll
    for (int dd = 0; dd < 4; ++dd) kb[dd] = Kb + FA_KSWZ(r32, (dd * 16 + hi * 8) * 2, RS);
#pragma unroll
    for (int d0 = 0; d0 < DK / 16; ++d0) { LAS const char* ap = kb[d0 & 3] + (d0 >> 2) * 128;
        const bf16x8 b0 = *(LAS const bf16x8*)ap;
        const bf16x8 b1 = *(LAS const bf16x8*)(ap + 32 * RS);
        p0 = __builtin_amdgcn_mfma_f32_32x32x16_bf16(b0, qr[d0], p0, 0, 0, 0);
        p1 = __builtin_amdgcn_mfma_f32_32x32x16_bf16(b1, qr[d0], p1, 0, 0, 0); }
}
__device__ __forceinline__ void pv_tile(f32x16* o, int vb0, bf16x8 pa0, bf16x8 pa1, bf16x8 pa2, bf16x8 pa3) {
#define FA_TRRD(dst, off) asm volatile("ds_read_b64_tr_b16 %0, %1 offset:%2" : "=&v"(dst) : "v"(vb0), "i"(off) : "memory")
#define FA_PV_D0(d0) do { s16x4 l0, l1, l2, l3, h0, h1, h2, h3; constexpr int b_ = (d0) * 512; \
        FA_TRRD(l0, b_); FA_TRRD(h0, b_ + 2048); FA_TRRD(l1, b_ + 4096); FA_TRRD(h1, b_ + 6144); FA_TRRD(l2, b_ + 8192); FA_TRRD(h2, b_ + 10240); FA_TRRD(l3, b_ + 12288); FA_TRRD(h3, b_ + 14336); \
        asm volatile("s_waitcnt lgkmcnt(0)" ::: "memory"); __builtin_amdgcn_sched_barrier(0); \
        o[d0] = __builtin_amdgcn_mfma_f32_32x32x16_bf16(pa0, (bf16x8){l0[0], l0[1], l0[2], l0[3], h0[0], h0[1], h0[2], h0[3]}, o[d0], 0, 0, 0); \
        o[d0] = __builtin_amdgcn_mfma_f32_32x32x16_bf16(pa1, (bf16x8){l1[0], l1[1], l1[2], l1[3], h1[0], h1[1], h1[2], h1[3]}, o[d0], 0, 0, 0); \
        o[d0] = __builtin_amdgcn_mfma_f32_32x32x16_bf16(pa2, (bf16x8){l2[0], l2[1], l2[2], l2[3], h2[0], h2[1], h2[2], h2[3]}, o[d0], 0, 0, 0); \
        o[d0] = __builtin_amdgcn_mfma_f32_32x32x16_bf16(pa3, (bf16x8){l3[0], l3[1], l3[2], l3[3], h3[0], h3[1], h3[2], h3[3]}, o[d0], 0, 0, 0); } while (0)
    FA_PV_D0(0); FA_PV_D0(1); FA_PV_D0(2); FA_PV_D0(3);
#undef FA_PV_D0
#undef FA_TRRD
}
__device__ __forceinline__ void softmax_tile(f32x16& p0, f32x16& p1, float& m_reg, float& l_reg, float& alpha, bf16x8& pa0, bf16x8& pa1, bf16x8& pa2, bf16x8& pa3) {
    float pmax = p0[0];
#pragma unroll
    for (int r = 1; r < 16; ++r) pmax = fmaxf(pmax, p0[r]);
#pragma unroll
    for (int r = 0; r < 16; ++r) pmax = fmaxf(pmax, p1[r]);
    { auto rr = __builtin_amdgcn_permlane32_swap(__float_as_uint(pmax), __float_as_uint(pmax), false, false);
      pmax = fmaxf(__uint_as_float(rr[0]), __uint_as_float(rr[1])); }
    const float mn = fmaxf(m_reg, pmax); alpha = __builtin_amdgcn_exp2f(m_reg - mn); m_reg = mn;
#pragma unroll
    for (int r = 0; r < 16; ++r) { p0[r] = __builtin_amdgcn_exp2f(p0[r] - mn); p1[r] = __builtin_amdgcn_exp2f(p1[r] - mn); }
    float ps = 0.f;
#pragma unroll
    for (int r = 0; r < 16; ++r) ps += p0[r];
#pragma unroll
    for (int r = 0; r < 16; ++r) ps += p1[r];
    { auto rr = __builtin_amdgcn_permlane32_swap(__float_as_uint(ps), __float_as_uint(ps), false, false);
      ps = __uint_as_float(rr[0]) + __uint_as_float(rr[1]); }
    l_reg = l_reg * alpha + ps;
#define FA_PK4(P, B_, OUT) do { unsigned a0 = cvtpk(P[B_+0], P[B_+1]), a1 = cvtpk(P[B_+2], P[B_+3]); \
        unsigned b0 = cvtpk(P[B_+4], P[B_+5]), b1 = cvtpk(P[B_+6], P[B_+7]); \
        auto r0 = __builtin_amdgcn_permlane32_swap(a0, b0, false, false); auto r1 = __builtin_amdgcn_permlane32_swap(a1, b1, false, false); \
        u32x4 wv = {r0[0], r1[0], r0[1], r1[1]}; OUT = *reinterpret_cast<bf16x8*>(&wv); } while (0)
    FA_PK4(p0, 0, pa0); FA_PK4(p0, 8, pa1); FA_PK4(p1, 0, pa2); FA_PK4(p1, 8, pa3);
#undef FA_PK4
}

template <int MODE>
__device__ __forceinline__ void attn_unit(const Args& a, int layer, LAS unsigned char* lds, int b, int h, int qb) {
    constexpr int DK = (MODE == 1) ? 192 : 128, RS = DK * 2, SHM_K = 64 * RS, NQ = DK / 16;
    constexpr float C2 = (MODE == 1) ? 1.4426950408889634f * 0.07216878364870322f : 1.4426950408889634f * 0.08838834764831845f;
    constexpr float L2E = 1.4426950408889634f;
    unsigned char* ws = a.ws;
    const int tid = threadIdx.x, wid = __builtin_amdgcn_readfirstlane(tid >> 6), lane = tid & 63, r32 = lane & 31, hi = lane >> 5;
    const int P0 = qb * 256, qlo = P0 + wid * 32, row = qlo + r32, cw = qlo >> 6;
    const size_t tb = (size_t)b * SEQ;
    const float NEG = -__builtin_inff();
    const bf16_t* Kg; const bf16_t* Vg; int ldk, ldv; bf16_t* Og; int ldo; int j_lo = 0, j_hi;
    if (MODE == 0) { const bf16_t* P = (const bf16_t*)(ws + WS_PROJ); Kg = P + tb * AB_MAIN + 2048 + h * 128; Vg = Kg + 2048; ldk = ldv = AB_MAIN; Og = (bf16_t*)(ws + WS_ATT) + (tb + qlo) * DM + h * 128; ldo = DM;
        j_lo = (P0 >> 6) - 8; if (j_lo < 0) j_lo = 0; j_hi = (P0 >> 6) + 4; }
    else if (MODE == 1) { Kg = (const bf16_t*)(ws + WS_KVB) + tb * 4096 + h * 256; Vg = Kg + 128; ldk = ldv = 4096; Og = (bf16_t*)(ws + WS_ATT) + (tb + qlo) * DM + 2048 + h * 128; ldo = DM; j_hi = (P0 >> 6) + 4; }
    else if (MODE == 2) { const bf16_t* P = (const bf16_t*)(ws + WS_PROJ); Kg = P + tb * CD_MAIN + 2048 + (h >> 2) * 128; Vg = Kg + 512; ldk = ldv = CD_MAIN; Og = (bf16_t*)(ws + WS_ATT) + (tb + qlo) * DM + h * 128; ldo = DM; j_hi = (P0 >> 6) + 4; }
    else if (MODE == 3) { const bf16_t* P = (const bf16_t*)(ws + WS_PROJ); Kg = P + tb * CD_MAIN + 7168 + h * 128; Vg = Kg + 2048; ldk = ldv = CD_MAIN; Og = (bf16_t*)(ws + WS_ATT) + (tb + qlo) * DM + 2048 + h * 128; ldo = DM; j_hi = (P0 >> 6) + 4; }
    else { Kg = (const bf16_t*)(ws + WS_KVM) + ((size_t)layer * 512 + b * 256) * 1024 + h * 128; Vg = Kg + 512; ldk = ldv = 1024; Og = (bf16_t*)(ws + WS_MEMO) + (tb + qlo) * 512 + h * 128; ldo = 512; j_hi = 4; }
    if (MODE == 3) {
        const float* nrm = (const float*)(ws + WS_CTL + 32768); const float* cumh = (const float*)(ws + WS_CUM) + ((size_t)b * 16 + h) * SEQ;
        const float Bq = sqrtf(nrm[b * 16 + h] * nrm[32 + b * 16 + h]) * 0.08838834764831845f, thr = -(2.f * Bq + 110.f);
        const float c0 = cumh[P0]; const bool okj = (lane < j_hi) && (c0 - cumh[64 * (lane < j_hi ? lane : 0) + 63] >= thr);
        const unsigned long long bal = __ballot(okj); j_lo = bal ? (int)__builtin_ctzll(bal) : j_hi - 1; }
    const int NT = j_hi - j_lo;
    bf16x8 qr[NQ];
    if (MODE == 4) { const float* mq = (const float*)(ws + WS_MQP) + (tb + row) * 512 + h * 128;
#pragma unroll
        for (int d0 = 0; d0 < NQ; ++d0) { const float* p = mq + d0 * 16 + hi * 8; f32x4 s0 = {0.f, 0.f, 0.f, 0.f}, s1 = s0;
#pragma unroll
            for (int z = 0; z < 4; ++z) { s0 += *(const f32x4*)(p + (size_t)z * T * 512); s1 += *(const f32x4*)(p + (size_t)z * T * 512 + 4); }
            u32x4 wv = {cvtpk(s0[0], s0[1]), cvtpk(s0[2], s0[3]), cvtpk(s1[0], s1[1]), cvtpk(s1[2], s1[3])}; qr[d0] = *reinterpret_cast<bf16x8*>(&wv); } }
    else { const bf16_t* Qg;
        if (MODE == 0) Qg = (const bf16_t*)(ws + WS_PROJ) + (tb + row) * AB_MAIN + h * 128;
        else if (MODE == 1) Qg = (const bf16_t*)(ws + WS_QB) + (tb + row) * 3072 + h * 192;
        else if (MODE == 2) Qg = (const bf16_t*)(ws + WS_PROJ) + (tb + row) * CD_MAIN + h * 128;
        else Qg = (const bf16_t*)(ws + WS_PROJ) + (tb + row) * CD_MAIN + 5120 + h * 128;
#pragma unroll
        for (int d0 = 0; d0 < NQ; ++d0) qr[d0] = *(const bf16x8*)(Qg + d0 * 16 + hi * 8);
        if (MODE == 1) {
            const float* r64 = (const float*)(ws + WS_ROPE64) + ((size_t)row * 32 + hi * 8) * 2;
            u32x4 a8 = *reinterpret_cast<u32x4*>(&qr[NQ - 4]), a9 = *reinterpret_cast<u32x4*>(&qr[NQ - 3]), a10 = *reinterpret_cast<u32x4*>(&qr[NQ - 2]), a11 = *reinterpret_cast<u32x4*>(&qr[NQ - 1]);
            rope8(a8, a10, r64); rope8(a9, a11, r64 + 32);
            qr[NQ - 4] = *reinterpret_cast<bf16x8*>(&a8); qr[NQ - 3] = *reinterpret_cast<bf16x8*>(&a9); qr[NQ - 2] = *reinterpret_cast<bf16x8*>(&a10); qr[NQ - 1] = *reinterpret_cast<bf16x8*>(&a11); } }
    LAS char* V_lds = (LAS char*)lds + LDS_V; LAS char* K_lds = (LAS char*)lds + LDS_K;
    LAS float* wsc = (LAS float*)(lds + LDS_WS) + wid * 64; LAS float* relb = (LAS float*)(lds + LDS_RELB); LAS float* csl = (LAS float*)(lds + LDS_CS);
    const int vbase = (int)(unsigned)(uintptr_t)V_lds + v_rd_base(lane);
    const bf16_t* KRg = (const bf16_t*)(ws + WS_KR) + tb * 64;
    const float* cum = (const float*)(ws + WS_CUM) + ((size_t)b * 16 + h) * SEQ;
    const unsigned* mrow = (const unsigned*)(ws + WS_MASK) + (tb + row) * 128;
    float ctl = 0.f; if (MODE == 3) ctl = cum[row] * L2E;
    if (MODE == 0) { const float* rb = a.in[I_A_REL_BIAS] + h * 513; for (int i = tid; i < 513; i += 512) relb[i] = rb[i] * L2E; }
    float m_reg = -1e30f, l_reg = 0.f; f32x16 o[4] = {};
    unsigned mk0 = 0u, mk1 = 0u; float st_cs = 0.f;
    constexpr int NKI = (DK == 192) ? 3 : 2;
#define FA_DMA(j, bf) do { const int k0_ = (j) * 64; int ln_ = lane; asm volatile("" : "+v"(ln_)); \
        _Pragma("unroll") for (int i_ = 0; i_ < NKI; ++i_) { const int off_ = (wid * NKI + i_) * 1024 + ln_ * 16; const int rw_ = off_ / RS, sw_ = off_ - rw_ * RS, cb_ = sw_ ^ ((rw_ & 7) << 4); \
            const bool kr_ = (DK == 192) && (cb_ >= 256); const int ko_ = kr_ ? rw_ * 64 + ((cb_ - 256) >> 1) : rw_ * ldk + (cb_ >> 1); \
            const bf16_t* s_ = kr_ ? (KRg + (size_t)k0_ * 64 + ko_) : (Kg + (size_t)k0_ * ldk + ko_); \
            __builtin_amdgcn_global_load_lds((const unsigned*)s_, (LAS unsigned*)(K_lds + (bf) * SHM_K + (wid * NKI + i_) * 1024), 16, 0, 0); } \
        _Pragma("unroll") for (int i_ = 0; i_ < 2; ++i_) { const int off_ = (wid * 2 + i_) * 1024 + ln_ * 16; const int sub_ = off_ >> 9, within_ = off_ & 511, kk_ = ((sub_ >> 2) << 3) | (within_ >> 6); \
            const int kx_ = (kk_ & ~0xC) | ((kk_ & 4) << 1) | ((kk_ & 8) >> 1), cx_ = (sub_ & 3) * 32 + ((within_ & 63) >> 1); \
            __builtin_amdgcn_global_load_lds((const unsigned*)(Vg + (size_t)k0_ * ldv + kx_ * ldv + cx_), (LAS unsigned*)(V_lds + (bf) * SHM_V + (wid * 2 + i_) * 1024), 16, 0, 0); } \
        if (MODE == 3) { if (tid < 64) st_cs = cum[k0_ + tid] * L2E; } } while (0)
#define FA_CSW(bf) do { if (MODE == 3) { if (tid < 64) csl[(bf) * 64 + tid] = st_cs; } } while (0)
    __syncthreads();
    u32x2 mkn = {0u, 0u}; if (MODE == 2) mkn = *(const u32x2*)(mrow + 2 * j_lo);
    FA_DMA(j_lo, 0); asm volatile("s_waitcnt vmcnt(0)" ::: "memory"); FA_CSW(0);
    __syncthreads();
#pragma unroll 1
    for (int t = 0; t < NT; ++t) {
        const int buf = t & 1, j = j_lo + t, kbp = j * 64;
        if (t + 1 < NT) FA_DMA(j + 1, buf ^ 1);
        bool act;
        if (MODE == 0) act = (j >= cw - 8) && (j <= cw);
        else if (MODE == 1 || MODE == 2) act = (j <= cw);
        else if (MODE == 3) act = (kbp <= qlo + 31);
        else act = true;
        if (MODE == 2) { mk0 = mkn.x; mk1 = mkn.y; if (t + 1 < NT) mkn = *(const u32x2*)(mrow + 2 * (j + 1)); }
        if (act) {
            f32x16 p0, p1;
            qkt<DK>(p0, p1, K_lds + buf * SHM_K, r32, hi, qr);
            if (MODE == 0) {
                if (qlo - (kbp + 63) >= 256) { const float bf_ = relb[512];
#pragma unroll
                    for (int r = 0; r < 16; ++r) { p0[r] = fmaf(p0[r], C2, bf_); p1[r] = fmaf(p1[r], C2, bf_); } }
                else { const int dq = row - kbp - 4 * hi;
#pragma unroll
                    for (int r = 0; r < 16; ++r) { const int c = (r & 3) + 8 * (r >> 2);
                        int i0 = dq - c; i0 = i0 < -256 ? -256 : (i0 > 256 ? 256 : i0); int i1 = dq - c - 32; i1 = i1 < -256 ? -256 : (i1 > 256 ? 256 : i1);
                        p0[r] = fmaf(p0[r], C2, relb[i0 + 256]); p1[r] = fmaf(p1[r], C2, relb[i1 + 256]);
                        if ((r & 3) == 3) __builtin_amdgcn_sched_barrier(0); } }
            } else if (MODE == 3) {
                LAS const float* cs = csl + buf * 64 + 4 * hi;
#pragma unroll
                for (int q4 = 0; q4 < 4; ++q4) { const f32x4 c0 = *(LAS const f32x4*)(cs + 8 * q4), c1 = *(LAS const f32x4*)(cs + 32 + 8 * q4);
#pragma unroll
                    for (int e = 0; e < 4; ++e) { p0[4 * q4 + e] = fmaf(p0[4 * q4 + e], C2, ctl - c0[e]); p1[4 * q4 + e] = fmaf(p1[4 * q4 + e], C2, ctl - c1[e]); }
                    __builtin_amdgcn_sched_barrier(0); }
                if (kbp + 63 > qlo) { const int dq = row - kbp - 4 * hi;
#pragma unroll
                    for (int r = 0; r < 16; ++r) { const int c = (r & 3) + 8 * (r >> 2); if (dq - c < 0) p0[r] = NEG; if (dq - c - 32 < 0) p1[r] = NEG; } }
            } else {
#pragma unroll
                for (int r = 0; r < 16; ++r) { p0[r] *= C2; p1[r] *= C2; }
                if (MODE == 2) {
#pragma unroll
                    for (int r = 0; r < 16; ++r) { const int c = (r & 3) + 8 * (r >> 2) + 4 * hi; if (!((mk0 >> c) & 1u)) p0[r] = NEG; if (!((mk1 >> c) & 1u)) p1[r] = NEG; } }
            }
            float alpha; bf16x8 pa0, pa1, pa2, pa3;
            softmax_tile(p0, p1, m_reg, l_reg, alpha, pa0, pa1, pa2, pa3);
            if (__any(alpha < 1.f)) { if (hi == 0) wsc[r32] = alpha; LDS_WAIT();
#pragma unroll
                for (int r = 0; r < 16; ++r) { const float al = wsc[crow(r, hi)];
#pragma unroll
                    for (int d_ = 0; d_ < 4; ++d_) o[d_][r] *= al;
                    if ((r & 3) == 3) __builtin_amdgcn_sched_barrier(0); }
                LDS_WAIT(); }
            pv_tile(o, vbase + buf * SHM_V, pa0, pa1, pa2, pa3);
        }
        asm volatile("s_waitcnt vmcnt(0)" ::: "memory");
        if (t + 1 < NT) FA_CSW(buf ^ 1);
        __syncthreads();
    }
#undef FA_DMA
#undef FA_CSW
    if (hi == 0) wsc[32 + r32] = l_reg; LDS_WAIT();
#pragma unroll
    for (int r = 0; r < 16; ++r) { const int orow = crow(r, hi); const float rl = __builtin_amdgcn_rcpf(wsc[32 + orow]);
#pragma unroll
        for (int d0 = 0; d0 < 4; ++d0) { const float v = o[d0][r] * rl; const float vn = __shfl_xor(v, 1);
            if ((r32 & 1) == 0) *(unsigned*)(Og + (size_t)orow * ldo + d0 * 32 + r32) = cvtpk(v, vn); } }
    LDS_WAIT();
}
}

__device__ __forceinline__ void rope_pair(float& x1, float& x2, float cs, float sn) { const float a = x1 * cs - x2 * sn, b = x2 * cs + x1 * sn; x1 = a; x2 = b; }
__device__ __forceinline__ void rope8(u32x4& x1, u32x4& x2, const float* tab) {
    const f32x4 t0 = *(const f32x4*)tab, t1 = *(const f32x4*)(tab + 4), t2 = *(const f32x4*)(tab + 8), t3 = *(const f32x4*)(tab + 12);
    const float cs[8] = {t0.x, t0.z, t1.x, t1.z, t2.x, t2.z, t3.x, t3.z}, sn[8] = {t0.y, t0.w, t1.y, t1.w, t2.y, t2.w, t3.y, t3.w};
    float a[8], b[8];
#pragma unroll
    for (int e = 0; e < 4; ++e) { a[2 * e] = __uint_as_float(x1[e] << 16); a[2 * e + 1] = __uint_as_float(x1[e] & 0xffff0000u); b[2 * e] = __uint_as_float(x2[e] << 16); b[2 * e + 1] = __uint_as_float(x2[e] & 0xffff0000u); }
#pragma unroll
    for (int e = 0; e < 8; ++e) { const float p = a[e] * cs[e] - b[e] * sn[e], q = b[e] * cs[e] + a[e] * sn[e]; a[e] = p; b[e] = q; }
#pragma unroll
    for (int e = 0; e < 4; ++e) { x1[e] = pk2(a[2 * e], a[2 * e + 1]); x2[e] = pk2(b[2 * e], b[2 * e + 1]); }
}
__device__ __forceinline__ void ph_l0_stats(const Args& a, const WI& w) {
    unsigned char* ws = a.ws; const bf16_t* P = (const bf16_t*)(ws + WS_PROJ);
    const float* r64 = (const float*)(ws + WS_ROPE64);
    for (int t = w.gw; t < T; t += w.ngw) {
        const bf16_t* row = P + (size_t)t * AB_MAIN;
        float s = 0.f;
        for (int j = 0; j < 3; ++j) { const bf16x8 v = *(const bf16x8*)(row + 6144 + (j * 64 + w.lane) * 8);
#pragma unroll
            for (int e = 0; e < 8; ++e) { const float f = bf2f((bf16_t)v[e]); s += f * f; } }
        s = wave_sum(s);
        float s2 = 0.f; { const bf16x8 v = *(const bf16x8*)(row + 7680 + w.lane * 8);
#pragma unroll
            for (int e = 0; e < 8; ++e) { const float f = bf2f((bf16_t)v[e]); s2 += f * f; } }
        s2 = wave_sum(s2);
        if (w.lane == 0) { ((float*)(ws + WS_RSQ))[t] = 1.f / sqrtf(s * (1.f / 1536.f) + RMS_EPS); ((float*)(ws + WS_RSKV))[t] = 1.f / sqrtf(s2 * (1.f / 512.f) + RMS_EPS); }
        if (w.lane < 32) { const float* sm = (const float*)(ws + WS_MQP) + (size_t)t * 256; const int sp = t & (SEQ - 1);
            float x1 = 0.f, x2 = 0.f;
#pragma unroll
            for (int z = 0; z < 8; ++z) { x1 += sm[(size_t)z * T * 256 + w.lane]; x2 += sm[(size_t)z * T * 256 + w.lane + 32]; } const float cs = r64[((size_t)sp * 32 + w.lane) * 2], sn = r64[((size_t)sp * 32 + w.lane) * 2 + 1];
            rope_pair(x1, x2, cs, sn);
            bf16_t* kr = (bf16_t*)(ws + WS_KR) + (size_t)t * 64; kr[w.lane] = (bf16_t)f2bf(x1); kr[w.lane + 32] = (bf16_t)f2bf(x2); }
    }
}
__device__ __forceinline__ void ph_l0_qrope(const Args& a, const WI& w) {
    unsigned char* ws = a.ws; bf16_t* Q = (bf16_t*)(ws + WS_QB); const float* r64 = (const float*)(ws + WS_ROPE64);
    const int h = w.lane >> 2, ch = w.lane & 3;
    for (int t = w.gw; t < T; t += w.ngw) {
        const int sp = t & (SEQ - 1); bf16_t* q = Q + (size_t)t * 3072 + h * 192 + 128 + ch * 8;
        u32x4 x1 = *(const u32x4*)q, x2 = *(const u32x4*)(q + 32);
        rope8(x1, x2, r64 + ((size_t)sp * 32 + ch * 8) * 2);
        *(u32x4*)q = x1; *(u32x4*)(q + 32) = x2;
    }
}
__device__ __forceinline__ void ph_l1_elem(const Args& a, LAS float* sml  , const WI& w) {
    unsigned char* ws = a.ws; bf16_t* P = (bf16_t*)(ws + WS_PROJ);
    const float* r128 = (const float*)(ws + WS_ROPE128); const float* r64 = (const float*)(ws + WS_ROPE64);
    float nq0 = 0.f, nk0 = 0.f, nq1 = 0.f, nk1 = 0.f;
    for (int t = w.gw; t < T; t += w.ngw) {
        const int b = t / SEQ, sp = t - b * SEQ; bf16_t* row = P + (size_t)t * CD_MAIN;
        u32x4 xa[5], xb[5]; bf16_t* qp[5]; const float* tp[5]; bool on[5];
#pragma unroll
        for (int p = 0; p < 3; ++p) { const int e = w.lane + 64 * p; on[p] = e < 160; const int h = e >> 3, ch = e & 7; qp[p] = row + h * 128 + ch * 8; tp[p] = r128 + ((size_t)sp * 64 + ch * 8) * 2;
            if (on[p]) { xa[p] = *(const u32x4*)qp[p]; xb[p] = *(const u32x4*)(qp[p] + 64); } }
#pragma unroll
        for (int p = 3; p < 5; ++p) { const int e = w.lane + 64 * (p - 3); on[p] = true; const int h = e >> 2, ch = e & 3; qp[p] = row + 3072 + h * 64 + ch * 8; tp[p] = r64 + ((size_t)sp * 32 + ch * 8) * 2;
            xa[p] = *(const u32x4*)qp[p]; xb[p] = *(const u32x4*)(qp[p] + 32); }
#pragma unroll
        for (int p = 0; p < 5; ++p) if (on[p]) { rope8(xa[p], xb[p], tp[p]); *(u32x4*)qp[p] = xa[p]; *(u32x4*)(qp[p] + (p < 3 ? 64 : 32)) = xb[p]; }
        const float* smp = (const float*)(ws + WS_MQP) + (size_t)t * 256;
        float smv0 = 0.f, smv1 = 0.f;
#pragma unroll
        for (int z = 0; z < 8; ++z) { smv0 += smp[(size_t)z * T * 256 + w.lane]; smv1 += smp[(size_t)z * T * 256 + 64 + w.lane]; }
        LDS_WAIT(); sml[w.lane] = smv0; sml[64 + w.lane] = smv1; LDS_WAIT();
        LAS const float* sm = sml;
        if (w.lane < 32) { float x1 = sm[w.lane], x2 = sm[w.lane + 32]; rope_pair(x1, x2, r64[((size_t)sp * 32 + w.lane) * 2], r64[((size_t)sp * 32 + w.lane) * 2 + 1]);
            bf16_t* ki = (bf16_t*)(ws + WS_KI) + (size_t)t * 64; ki[w.lane] = (bf16_t)f2bf(x1); ki[w.lane + 32] = (bf16_t)f2bf(x2);
            ((float*)(ws + WS_WI))[(size_t)t * 32 + w.lane] = sm[64 + w.lane] * 0.17677669529663687f; }
        {
            float sq = 0.f, sk = 0.f;
#pragma unroll
            for (int q = 0; q < 4; ++q) { const u32x4 vq = *(const u32x4*)(row + 5120 + 32 * w.lane + 8 * q), vk = *(const u32x4*)(row + 7168 + 32 * w.lane + 8 * q);
#pragma unroll
                for (int e = 0; e < 4; ++e) { const float a0 = __uint_as_float(vq[e] << 16), a1 = __uint_as_float(vq[e] & 0xffff0000u), b0 = __uint_as_float(vk[e] << 16), b1 = __uint_as_float(vk[e] & 0xffff0000u);
                    sq += a0 * a0 + a1 * a1; sk += b0 * b0 + b1 * b1; } }
            sq += __shfl_xor(sq, 1); sq += __shfl_xor(sq, 2); sk += __shfl_xor(sk, 1); sk += __shfl_xor(sk, 2);
            if (b == 0) { nq0 = fmaxf(nq0, sq); nk0 = fmaxf(nk0, sk); } else { nq1 = fmaxf(nq1, sq); nk1 = fmaxf(nk1, sk); } }
        if (w.lane < 16) { const float z = sm[96 + w.lane] + a.in[I_D_FORGET_BIAS][w.lane];
            const float lf = fminf(z, 0.f) - log1pf(__expf(-fabsf(z)));
            ((float*)(ws + WS_LOGF))[((size_t)b * 16 + w.lane) * SEQ + sp] = lf; }
    }
    if ((w.lane & 3) == 0) { unsigned* nrm = (unsigned*)(ws + WS_CTL + 32768); const int h = w.lane >> 2;
        atomicMax(nrm + h, __float_as_uint(nq0)); atomicMax(nrm + 16 + h, __float_as_uint(nq1)); atomicMax(nrm + 32 + h, __float_as_uint(nk0)); atomicMax(nrm + 48 + h, __float_as_uint(nk1)); }
}
__device__ __forceinline__ void ph_l1_scan(const Args& a, LAS float* sh  , const WI& w) {
    unsigned char* ws = a.ws;
    for (int it = w.bid; it < NB * 16; it += w.nblk) {
        const float* src = (const float*)(ws + WS_LOGF) + (size_t)it * SEQ + w.tid * 8; float* dst = (float*)(ws + WS_CUM) + (size_t)it * SEQ + w.tid * 8;
        const f32x4 v0 = *(const f32x4*)src, v1 = *(const f32x4*)(src + 4);
        float c[8]; c[0] = v0.x; c[1] = c[0] + v0.y; c[2] = c[1] + v0.z; c[3] = c[2] + v0.w; c[4] = c[3] + v1.x; c[5] = c[4] + v1.y; c[6] = c[5] + v1.z; c[7] = c[6] + v1.w;
        float inc = c[7];
#pragma unroll
        for (int o = 1; o < 64; o <<= 1) { const float v = __shfl_up(inc, o); if (w.lane >= o) inc += v; }
        __syncthreads();
        if (w.lane == 63) sh[w.wave] = inc;
        __syncthreads();
        float base = inc - c[7];
        for (int q = 0; q < w.wave; ++q) base += sh[q];
        *(f32x4*)dst = (f32x4){c[0] + base, c[1] + base, c[2] + base, c[3] + base}; *(f32x4*)(dst + 4) = (f32x4){c[4] + base, c[5] + base, c[6] + base, c[7] + base};
    }
    __syncthreads();
}
__device__ __forceinline__ void ph_l1_index_naive(const Args& a, LAS float* qs  , const WI& w) {
    unsigned char* ws = a.ws; const bf16_t* P = (const bf16_t*)(ws + WS_PROJ); const bf16_t* KI = (const bf16_t*)(ws + WS_KI);
    const float* WIp = (const float*)(ws + WS_WI); float* SC = (float*)(ws + WS_SCORE);
    for (int t = w.gw; t < T; t += w.ngw) {
        const int b = t / SEQ, sp = t - b * SEQ, nadm = ((sp >> 6) + 1) * 64;
        LDS_WAIT();
        for (int e = w.lane; e < 2048; e += 64) qs[e] = bf2f(P[(size_t)t * CD_MAIN + 3072 + e]);
        if (w.lane < 32) qs[2048 + w.lane] = WIp[(size_t)t * 32 + w.lane];
        LDS_WAIT();
        for (int s0 = 0; s0 < nadm; s0 += 64) {
            const int s = s0 + w.lane; const bf16_t* kp = KI + ((size_t)b * SEQ + s) * 64;
            float k[64];
#pragma unroll
            for (int d0 = 0; d0 < 64; d0 += 8) { const bf16x8 kv = *(const bf16x8*)(kp + d0);
#pragma unroll
                for (int e = 0; e < 8; ++e) k[d0 + e] = bf2f((bf16_t)kv[e]); }
            float sc = 0.f;
            for (int h = 0; h < 32; ++h) { float dot = 0.f;
#pragma unroll
                for (int d = 0; d < 64; ++d) dot += qs[h * 64 + d] * k[d];
                sc += qs[2048 + h] * fmaxf(dot * 0.125f, 0.f); }
            SC[((size_t)b * SEQ + sp) * SEQ + s] = sc;
        }
    }
}
__device__ __forceinline__ void ph_l1_index(const Args& a, LAS unsigned char* lds, const WI& w) {
    unsigned char* ws = a.ws; const bf16_t* P = (const bf16_t*)(ws + WS_PROJ); const bf16_t* KI = (const bf16_t*)(ws + WS_KI);
    const float* WIp = (const float*)(ws + WS_WI); float* SC = (float*)(ws + WS_SCORE);
    LAS char* Qs = (LAS char*)lds; LAS float* Wt = (LAS float*)(lds + 131072);
    const int tid = w.tid, r32 = w.lane & 31, hi = w.lane >> 5;
    for (int u = w.bid; u < 256; u += w.nblk) {
        const int b = u >> 7, x = (u >> 1) & 63, half = u & 1;
        for (int pass = 0; pass < 2; ++pass) {
            const int qt = pass ? 127 - x : x; const int t0 = b * SEQ + qt * 32; const int nadm = ((qt * 32) >> 6) * 64 + 64, ngrp = (nadm + 127) >> 7;
            __syncthreads();
            for (int e = tid; e < 32 * 256; e += 512) { const int t = e >> 8, c = e & 255; const u32x4 v = *(const u32x4*)(P + (size_t)(t0 + t) * CD_MAIN + 3072 + c * 8);
                const int cs = (c & ~15) | ((c & 15) ^ (t & 15)); *(LAS u32x4*)(Qs + t * 4096 + cs * 16) = v; }
            for (int e = tid; e < 1024; e += 512) { const int t = e >> 5, h = e & 31; Wt[h * 32 + t] = WIp[(size_t)(t0 + t) * 32 + h] * 0.125f; }
            __syncthreads();
            for (int g = half + 2 * w.wave; g < ngrp; g += 16) {
                const int s0 = g * 128;
                bf16x8 kf[4][4];
#pragma unroll
                for (int j = 0; j < 4; ++j)
#pragma unroll
                    for (int dk = 0; dk < 4; ++dk) kf[j][dk] = *(const bf16x8*)(KI + ((size_t)b * SEQ + s0 + 32 * j + r32) * 64 + dk * 16 + hi * 8);
                f32x16 acc[4] = {};
#pragma unroll 2
                for (int h = 0; h < 32; ++h) {
                    bf16x8 qf[4];
#pragma unroll
                    for (int dk = 0; dk < 4; ++dk) qf[dk] = *(LAS const bf16x8*)(Qs + r32 * 4096 + ((((h >> 1) << 4) | ((((h & 1) << 3) | (dk << 1) | hi) ^ (r32 & 15))) << 4));
                    f32x4 wv[4];
#pragma unroll
                    for (int q4 = 0; q4 < 4; ++q4) wv[q4] = *(LAS const f32x4*)(Wt + h * 32 + 8 * q4 + 4 * hi);
#pragma unroll
                    for (int j = 0; j < 4; ++j) { f32x16 tmp = {};
#pragma unroll
                        for (int dk = 0; dk < 4; ++dk) tmp = __builtin_amdgcn_mfma_f32_32x32x16_bf16(qf[dk], kf[j][dk], tmp, 0, 0, 0);
#pragma unroll
                        for (int r = 0; r < 16; ++r) acc[j][r] = fmaf(wv[r >> 2][r & 3], fmaxf(tmp[r], 0.f), acc[j][r]); }
                }
#pragma unroll
                for (int j = 0; j < 4; ++j)
#pragma unroll
                    for (int r = 0; r < 16; ++r) SC[(size_t)(t0 + crow(r, hi)) * SEQ + s0 + 32 * j + r32] = acc[j][r];
            }
        }
    }
    __syncthreads();
}
__device__ __forceinline__ void ph_l1_select(const Args& a, const WI& w) {
    unsigned char* ws = a.ws; const float* SC = (const float*)(ws + WS_SCORE); unsigned* MK = (unsigned*)(ws + WS_MASK);
    for (int t = w.gw; t < T; t += w.ngw) {
        const int b = t / SEQ, sp = t - b * SEQ, nblk = (sp >> 6) + 1;
        const float* row = SC + ((size_t)b * SEQ + sp) * SEQ;
        unsigned key[64];
#pragma unroll
        for (int j = 0; j < 64; ++j) { unsigned u = 0u; if (j < nblk) { u = __float_as_uint(row[j * 64 + w.lane]); u ^= (u >> 31) ? 0xFFFFFFFFu : 0x80000000u; } key[j] = u; }
        unsigned thr = 0u;
        if (nblk > 4) {
            for (int bit = 31; bit >= 0; --bit) { const unsigned cand = thr | (1u << bit); int cnt = 0;
#pragma unroll
                for (int j = 0; j < 64; ++j) cnt += (key[j] >= cand) ? 1 : 0;
                cnt = wave_sum_i(cnt); if (cnt >= 256) thr = cand; if (cnt == 256) break; }
        }
        unsigned lo = 0u, hi = 0u;
#pragma unroll
        for (int j = 0; j < 64; ++j) { const bool sel = (j < nblk) && (key[j] >= thr); const unsigned long long bal = __ballot(sel); if (w.lane == j) { lo = (unsigned)bal; hi = (unsigned)(bal >> 32); } }
        *(u32x2*)(MK + (size_t)t * 128 + 2 * w.lane) = (u32x2){lo, hi};
    }
}

__device__ __forceinline__ unsigned tk_key(float v, unsigned payload, unsigned pmask) { const unsigned u = __float_as_uint(v); const unsigned m = (unsigned)((int)u >> 31) | 0x80000000u; return ((u ^ m) & ~pmask) | payload; }
__device__ __forceinline__ float tk_val(unsigned key, unsigned pmask) { const unsigned k = key & ~pmask; const unsigned m = ~(unsigned)((int)k >> 31) | 0x80000000u; return __uint_as_float(k ^ m); }
#define TK_INSERT(TOP, key_) do { unsigned k__ = (key_); \
        _Pragma("unroll") for (int q_ = 0; q_ < 16; ++q_) { const unsigned hi__ = TOP[q_] > k__ ? TOP[q_] : k__; k__ = TOP[q_] > k__ ? k__ : TOP[q_]; TOP[q_] = hi__; } } while (0)
__device__ __forceinline__ unsigned tk_sel16(const unsigned (&arr)[16], unsigned i) {
    unsigned x8[8], x4[4], x2[2];
    const unsigned m0 = 0u - (i & 1u), m1 = 0u - ((i >> 1) & 1u), m2 = 0u - ((i >> 2) & 1u), m3 = 0u - ((i >> 3) & 1u);
#pragma unroll
    for (int q = 0; q < 8; ++q) x8[q] = (arr[2 * q + 1] & m0) | (arr[2 * q] & ~m0);
#pragma unroll
    for (int q = 0; q < 4; ++q) x4[q] = (x8[2 * q + 1] & m1) | (x8[2 * q] & ~m1);
#pragma unroll
    for (int q = 0; q < 2; ++q) x2[q] = (x4[2 * q + 1] & m2) | (x4[2 * q] & ~m2);
    return (x2[1] & m3) | (x2[0] & ~m3); }
__device__ __forceinline__ void ph_peer_topk(const Args& a, const WI& w) {
    unsigned char* ws = a.ws; const float* PST = (const float*)(ws + WS_PSCORE); int* PIDX = (int*)(ws + WS_PIDX); float* PG = (float*)(ws + WS_PGATE);
    for (int task = w.gw; task < 128 * 8; task += w.ngw) {
        const int h = task & 7, t = (task >> 3) * 64 + w.lane;
        unsigned t0[16], t1[16];
#pragma unroll
        for (int k = 0; k < 16; ++k) { t0[k] = 0u; t1[k] = 0u; }
        { const float* col = PST + (size_t)(h * 256) * T + t;
#pragma unroll 8
          for (int i = 0; i < 128; ++i) { const float v = col[(size_t)i * T]; TK_INSERT(t0, tk_key(v, 127u - (unsigned)i, 127u)); } }
        { const float* col = PST + (size_t)(h * 256 + 128) * T + t;
#pragma unroll 8
          for (int i = 0; i < 128; ++i) { const float v = col[(size_t)i * T]; TK_INSERT(t1, tk_key(v, 127u - (unsigned)i, 127u)); } }
        float a0[16], a1[16];
#pragma unroll
        for (int k = 0; k < 16; ++k) { a0[k] = tk_val(t0[k], 127u); a1[k] = tk_val(t1[k], 127u); }
        unsigned bk[16];
#pragma unroll
        for (int k = 0; k < 16; ++k) bk[k] = 0u;
#pragma unroll
        for (int i = 0; i < 16; ++i)
#pragma unroll
            for (int j = 0; j < 16; ++j) if ((i + 1) * (j + 1) <= 16) TK_INSERT(bk, tk_key(a0[i] + a1[j], 255u - (unsigned)(i * 16 + j), 255u));
        const float top = tk_val(bk[0], 255u); float den = 0.f; float ex[16];
#pragma unroll
        for (int k = 0; k < 16; ++k) { ex[k] = __expf(tk_val(bk[k], 255u) - top); den += ex[k]; }
        const float rd = 1.f / den;
#pragma unroll
        for (int k = 0; k < 16; ++k) { const unsigned c = 255u - (bk[k] & 255u); const unsigned e0 = 127u - (tk_sel16(t0, c >> 4) & 127u), e1 = 127u - (tk_sel16(t1, c & 15u) & 127u);
            PIDX[(size_t)t * 128 + h * 16 + k] = (int)(e0 * 128u + e1); PG[(size_t)t * 128 + h * 16 + k] = ex[k] * rd; }
    }
}
__device__ __forceinline__ void ph_peer_experts(const Args& a, int layer, float* outf, bf16_t* outb, const float* g, const float* bta, LAS float* wsm  , const WI& w) {
    unsigned char* ws = a.ws; const bf16_t* XBh = (const bf16_t*)(ws + WS_XB);
    const unsigned char* U4 = ws + WS_U8 + (size_t)layer * 16384 * 2048; const unsigned char* V4 = ws + WS_V8 + (size_t)layer * 16384 * 2048;
    const unsigned short* US = (const unsigned short*)(ws + WS_U8 + 64 * MiB) + (size_t)layer * 16384 * 64; const unsigned short* VS = (const unsigned short*)(ws + WS_V8 + 64 * MiB) + (size_t)layer * 16384 * 64;
    const int* PIDX = (const int*)(ws + WS_PIDX); const float* PG = (const float*)(ws + WS_PGATE);
    const int lane = w.lane;
    for (int t = w.gw; t < T; t += w.ngw) {
        const bf16_t* hrow = XBh + (size_t)t * DM + 32 * lane;
        const int idx0 = PIDX[(size_t)t * 128 + lane], idx1 = PIDX[(size_t)t * 128 + 64 + lane];
        const float g0 = PG[(size_t)t * 128 + lane], g1 = PG[(size_t)t * 128 + 64 + lane];
        LDS_WAIT();
#define PE_LOAD(BUF, SB, TBL, STB, kb_) do { const int iv_ = ((kb_) & 64) ? idx1 : idx0; \
            _Pragma("unroll") for (int q_ = 0; q_ < 4; ++q_) { const int e_ = __builtin_amdgcn_readlane(iv_, ((kb_) + q_) & 63); const u32x4* r_ = (const u32x4*)(TBL + (size_t)e_ * 2048 + 16 * lane); \
                BUF[q_][0] = r_[0]; BUF[q_][1] = r_[64]; SB[q_] = STB[(size_t)e_ * 64 + lane]; } } while (0)
#define PE_SCALE(sb_, i_) __builtin_amdgcn_exp2f((float)((int)(((sb_) >> (8 * (i_))) & 255u) - 128) * 0.125f)
#define PE_DOT(BUF, SB, Z, zo_) do { _Pragma("unroll") for (int q_ = 0; q_ < 4; ++q_) { float zq_ = 0.f; \
            _Pragma("unroll") for (int i_ = 0; i_ < 2; ++i_) { f32x2 acc_ = {0.f, 0.f}; \
                _Pragma("unroll") for (int d_ = 0; d_ < 4; ++d_) { \
                    acc_ = __builtin_elementwise_fma(__builtin_amdgcn_cvt_scalef32_pk_f32_fp4(BUF[q_][i_][d_], 1.0f, 0), x[16 * i_ + 4 * d_ + 0], acc_); \
                    acc_ = __builtin_elementwise_fma(__builtin_amdgcn_cvt_scalef32_pk_f32_fp4(BUF[q_][i_][d_], 1.0f, 1), x[16 * i_ + 4 * d_ + 1], acc_); \
                    acc_ = __builtin_elementwise_fma(__builtin_amdgcn_cvt_scalef32_pk_f32_fp4(BUF[q_][i_][d_], 1.0f, 2), x[16 * i_ + 4 * d_ + 2], acc_); \
                    acc_ = __builtin_elementwise_fma(__builtin_amdgcn_cvt_scalef32_pk_f32_fp4(BUF[q_][i_][d_], 1.0f, 3), x[16 * i_ + 4 * d_ + 3], acc_); } \
                zq_ = fmaf(PE_SCALE((unsigned)SB[q_], i_), acc_.x + acc_.y, zq_); } \
            Z[(zo_) + q_] = zq_; } } while (0)
#define PE_AXPY(BUF, SB, kb_) do { _Pragma("unroll") for (int q_ = 0; q_ < 4; ++q_) { const float wt_ = wsm[(kb_) + q_]; \
            _Pragma("unroll") for (int i_ = 0; i_ < 2; ++i_) { const float ws_ = wt_ * PE_SCALE((unsigned)SB[q_], i_); const f32x2 wt2_ = {ws_, ws_}; \
                _Pragma("unroll") for (int d_ = 0; d_ < 4; ++d_) { \
                    y[16 * i_ + 4 * d_ + 0] = __builtin_elementwise_fma(__builtin_amdgcn_cvt_scalef32_pk_f32_fp4(BUF[q_][i_][d_], 1.0f, 0), wt2_, y[16 * i_ + 4 * d_ + 0]); \
                    y[16 * i_ + 4 * d_ + 1] = __builtin_elementwise_fma(__builtin_amdgcn_cvt_scalef32_pk_f32_fp4(BUF[q_][i_][d_], 1.0f, 1), wt2_, y[16 * i_ + 4 * d_ + 1]); \
                    y[16 * i_ + 4 * d_ + 2] = __builtin_elementwise_fma(__builtin_amdgcn_cvt_scalef32_pk_f32_fp4(BUF[q_][i_][d_], 1.0f, 2), wt2_, y[16 * i_ + 4 * d_ + 2]); \
                    y[16 * i_ + 4 * d_ + 3] = __builtin_elementwise_fma(__builtin_amdgcn_cvt_scalef32_pk_f32_fp4(BUF[q_][i_][d_], 1.0f, 3), wt2_, y[16 * i_ + 4 * d_ + 3]); } } \
            __builtin_amdgcn_sched_barrier(0); } } while (0)
#define PE_SB() __builtin_amdgcn_sched_barrier(0)
        u32x4 bA[4][2], bB[4][2]; unsigned short sA[4], sB[4];
        {
            f32x2 x[32];
#pragma unroll
            for (int i = 0; i < 2; ++i)
#pragma unroll
                for (int q = 0; q < 4; ++q) { const u32x4 v = *(const u32x4*)(hrow + 2048 * i + 8 * q);
#pragma unroll
                    for (int e = 0; e < 4; ++e) x[16 * i + 4 * q + e] = (f32x2){__uint_as_float(v[e] << 16), __uint_as_float(v[e] & 0xffff0000u)}; }
            PE_LOAD(bA, sA, U4, US, 0); PE_SB();
#pragma unroll 1
            for (int k0 = 0; k0 < 128; k0 += 8) {
                const int iv = (k0 & 64) ? idx1 : idx0; const float gv = (k0 & 64) ? g1 : g0;
                float z[8];
                PE_LOAD(bB, sB, U4, US, k0 + 4); PE_SB(); PE_DOT(bA, sA, z, 0); PE_SB();
                PE_LOAD(bA, sA, U4, US, (k0 + 8) & 127); PE_SB(); PE_DOT(bB, sB, z, 4); PE_SB();
                float r4[4], r2[2], r1;
#pragma unroll
                for (int i = 0; i < 4; ++i) { const float keep = (lane & 32) ? z[i + 4] : z[i], send = (lane & 32) ? z[i] : z[i + 4]; r4[i] = keep + __shfl_xor(send, 32); }
#pragma unroll
                for (int i = 0; i < 2; ++i) { const float keep = (lane & 16) ? r4[i + 2] : r4[i], send = (lane & 16) ? r4[i] : r4[i + 2]; r2[i] = keep + __shfl_xor(send, 16); }
                { const float keep = (lane & 8) ? r2[1] : r2[0], send = (lane & 8) ? r2[0] : r2[1]; r1 = keep + __shfl_xor(send, 8); }
                r1 += __shfl_xor(r1, 4); r1 += __shfl_xor(r1, 2); r1 += __shfl_xor(r1, 1);
                const int q = lane >> 3; const float gt_ = __shfl(gv, (k0 + q) & 63);
                if ((lane & 7) == 0) { const float zz = r1; const float act = 0.5f * zz * (1.f + erff(zz * 0.70710678118654752f)); wsm[k0 + q] = act * gt_; }
            }
        }
        LDS_WAIT();
        f32x2 y[32];
#pragma unroll
        for (int i = 0; i < 32; ++i) y[i] = (f32x2){0.f, 0.f};
        PE_LOAD(bA, sA, V4, VS, 0); PE_SB();
#pragma unroll 1
        for (int k0 = 0; k0 < 128; k0 += 8) {
            PE_LOAD(bB, sB, V4, VS, k0 + 4); PE_SB(); PE_AXPY(bA, sA, k0); PE_SB();
            PE_LOAD(bA, sA, V4, VS, (k0 + 8) & 127); PE_SB(); PE_AXPY(bB, sB, k0 + 4); PE_SB();
        }
#undef PE_LOAD
#undef PE_SCALE
#undef PE_DOT
#undef PE_AXPY
#undef PE_SB
        const bf16_t* hrow2 = hrow; asm volatile("" : "+v"(hrow2));
        float s = 0.f;
#pragma unroll
        for (int i = 0; i < 2; ++i)
#pragma unroll
            for (int q = 0; q < 4; ++q) { const u32x4 v = *(const u32x4*)(hrow2 + 2048 * i + 8 * q);
#pragma unroll
                for (int e = 0; e < 4; ++e) { y[16 * i + 4 * q + e].x += ALPHA * __uint_as_float(v[e] << 16); y[16 * i + 4 * q + e].y += ALPHA * __uint_as_float(v[e] & 0xffff0000u); } }
#pragma unroll
        for (int i = 0; i < 32; ++i) s += y[i].x + y[i].y;
        const float mean = wave_sum(s) * (1.f / DM); float s2 = 0.f;
#pragma unroll
        for (int i = 0; i < 32; ++i) { y[i].x -= mean; y[i].y -= mean; s2 += y[i].x * y[i].x + y[i].y * y[i].y; }
        const float rstd = 1.f / sqrtf(wave_sum(s2) * (1.f / DM) + LN_EPS);
#pragma unroll
        for (int i = 0; i < 2; ++i)
#pragma unroll
            for (int q = 0; q < 8; ++q) { const int c = 2048 * i + 32 * lane + 4 * q;
                const f32x4 gg = *(const f32x4*)(g + c), bb = *(const f32x4*)(bta + c); f32x4 o;
                o.x = y[16 * i + 2 * q].x * rstd * gg.x + bb.x; o.y = y[16 * i + 2 * q].y * rstd * gg.y + bb.y; o.z = y[16 * i + 2 * q + 1].x * rstd * gg.z + bb.z; o.w = y[16 * i + 2 * q + 1].y * rstd * gg.w + bb.w;
                if (outf) *(f32x4*)(outf + (size_t)t * DM + c) = o;
                if (outb) { u32x2 p; p.x = pk2(o.x, o.y); p.y = pk2(o.z, o.w); *(u32x2*)(outb + (size_t)t * DM + c) = p; }
                if (q & 1) __builtin_amdgcn_sched_barrier(0); }
    }
}

__device__ __forceinline__ void ph_attn_l0(const Args& a, LAS unsigned char* lds, const WI& w) {
    for (int pr = w.bid; pr < 256; pr += w.nblk) { const int bh = pr >> 3, x = pr & 7;
        for (int pass = 0; pass < 2; ++pass) fa::attn_unit<1>(a, 0, lds, bh >> 4, bh & 15, pass ? 15 - x : x); }
    for (int u = w.bid; u < 512; u += w.nblk) { const int bh = u >> 4; fa::attn_unit<0>(a, 0, lds, bh >> 4, bh & 15, u & 15); }
}
__device__ __forceinline__ void ph_attn_l1(const Args& a, LAS unsigned char* lds, const WI& w) {
    for (int pr = w.bid; pr < 256; pr += w.nblk) { const int bh = pr >> 3, x = pr & 7;
        for (int pass = 0; pass < 2; ++pass) fa::attn_unit<2>(a, 1, lds, bh >> 4, bh & 15, pass ? 15 - x : x); }
    for (int pr = w.bid; pr < 256; pr += w.nblk) { const int bh = pr >> 3, x = pr & 7;
        for (int pass = 0; pass < 2; ++pass) fa::attn_unit<3>(a, 1, lds, bh >> 4, bh & 15, pass ? 15 - x : x); }
}
__device__ __forceinline__ void ph_attn_mem(const Args& a, int layer, LAS unsigned char* lds, const WI& w) {
    for (int u = w.bid; u < 128; u += w.nblk) { const int bh = u >> 4; fa::attn_unit<4>(a, layer, lds, bh >> 2, bh & 3, u & 15); }
}

__global__ void __launch_bounds__(512, 2) mega(Args a) {
    extern __shared__ __attribute__((aligned(16))) unsigned char lds_raw[];
    LAS unsigned char* lds = (LAS unsigned char*)lds_raw;
    WI w; w.tid = threadIdx.x; w.lane = w.tid & 63; w.wave = __builtin_amdgcn_readfirstlane(w.tid >> 6);
    w.bid = blockIdx.x; w.nblk = gridDim.x; w.gw = w.bid * 8 + w.wave; w.ngw = w.nblk * 8;
    unsigned char* ws = a.ws;
    volatile LAS unsigned* misc = (volatile LAS unsigned*)(lds + LDS_MISC);
    if (w.tid < 4) misc[w.tid] = 0u;
    __syncthreads();
    XcdBarrier bar; bar.bar = (unsigned*)(ws + WS_CTL) + 4096; bar.x = 0; bar.st = misc;
#if !MK_PER_PHASE
    bar = xcd_barrier_post((unsigned*)(ws + WS_CTL) + 4096, misc);
#endif
    const int lo = a.ph_lo, hi = a.ph_hi;
#define IN(k) (lo <= (k) && (k) < hi)
#if MK_PER_PHASE
#define SEAM(k) do { } while (0)
#else
#define SEAM(k) do { if (IN(k) && IN((k) + 1)) xcd_barrier(bar); } while (0)
#endif
    LAS float* wlds = (LAS float*)(lds + w.wave * 16384);
    bf16_t* XB = (bf16_t*)(ws + WS_XB); bf16_t* RES = (bf16_t*)(ws + WS_RES); bf16_t* PROJ = (bf16_t*)(ws + WS_PROJ);
    bf16_t* ATT = (bf16_t*)(ws + WS_ATT); float* SMALL = (float*)(ws + WS_SMALL);

#define FAST_GEMM(EPI_T, Aptr, lda_, Btptr, ldb_, M_, N_, K_, nz_, zA_, zB_, EPI_OBJ) do { \
        pg8::Gemm g_{Aptr, Btptr, M_, N_, K_, lda_, ldb_, zA_, zB_, nz_}; pg8::StaticOrder S_; S_.init(M_, N_, nz_, w.nblk, w.bid); \
        pg8::gemm_phase<EPI_T, pg8::StaticOrder>(lds, g_, S_, EPI_OBJ); } while (0)
    if (IN(0)) { ph_convert(a, lds, w); if (PROBE_DUP == 0) ph_convert(a, lds, w); }
    SEAM(0);
    if (IN(1)) {
        FAST_GEMM(pg8::EpiBf16, XB, DM, (const bf16_t*)(ws + WS_W_AB_IN), DM, T, AB_MAIN, DM, 1, 0, 0, (pg8::EpiBf16{PROJ, AB_MAIN, nullptr}));
        FAST_GEMM(pg8::EpiF32, XB, DM, (const bf16_t*)(ws + WS_W_AB_IN) + (size_t)AB_MAIN * DM, DM, T, 256, 512, 8, 512, 512, (pg8::EpiF32{(float*)(ws + WS_MQP), 256, (long)T * 256, 64}));
        FAST_GEMM(pg8::EpiF32, (const bf16_t*)(ws + WS_MEMB), DM, (const bf16_t*)(ws + WS_W_MEM_KV), DM, 512, 2048, 256, 16, 256, 256, (pg8::EpiF32{(float*)(ws + WS_SCORE), 2048, (long)512 * 2048, 2048}));
    }
    SEAM(1);
    if (IN(2)) { ph_l0_stats(a, w);
        { const float* part = (const float*)(ws + WS_SCORE); bf16_t* KVM = (bf16_t*)(ws + WS_KVM);
          for (size_t i = ((size_t)w.gw * 64 + w.lane) * 4; i < (size_t)512 * 2048; i += (size_t)w.ngw * 64 * 4) { f32x4 s = {0.f, 0.f, 0.f, 0.f};
#pragma unroll
              for (int z = 0; z < 16; ++z) s += *(const f32x4*)(part + (size_t)z * 512 * 2048 + i);
              const int m = (int)(i >> 11), n = (int)(i & 2047); u32x2 p; p.x = pk2(s.x, s.y); p.y = pk2(s.z, s.w);
              *(u32x2*)(KVM + ((size_t)(n >> 10) * 512 + m) * 1024 + (n & 1023)) = p; } } }
    SEAM(2);
    if (IN(3)) {
        const float* rsq = (const float*)(ws + WS_RSQ); const float* rskv = (const float*)(ws + WS_RSKV);
        bf16_t* QB = (bf16_t*)(ws + WS_QB); bf16_t* KVB = (bf16_t*)(ws + WS_KVB);
        FAST_GEMM(pg8::EpiBf16, PROJ + 6144, AB_MAIN, (const bf16_t*)(ws + WS_W_UQ), 1536, T, 3072, 1536, 1, 0, 0, (pg8::EpiBf16{QB, 3072, rsq}));
        FAST_GEMM(pg8::EpiBf16, PROJ + 7680, AB_MAIN, (const bf16_t*)(ws + WS_W_UKV), 512, T, 4096, 512, 1, 0, 0, (pg8::EpiBf16{KVB, 4096, rskv}));
    }
    SEAM(3);
    if (IN(5)) { ph_attn_l0(a, lds, w); if (PROBE_DUP == 5) ph_attn_l0(a, lds, w); }
    SEAM(5);
    if (IN(6)) {
        FAST_GEMM(pg8::EpiResid, ATT, DM, (const bf16_t*)(ws + WS_W_AB_OUT), DM, T, DM, DM, 1, 0, 0, (pg8::EpiResid{XB, RES, DM})); }
    SEAM(6);
    if (IN(7)) ln_rows(RES, a.in[I_LN_G] + 0 * DM, a.in[I_LN_B] + 0 * DM, XB, w);
    SEAM(7);

#define MEM_PEER_PHASES(L, P0_, LAST)                                                                                                                         \
    if (IN(P0_)) { FAST_GEMM(pg8::EpiF32, XB, DM, (const bf16_t*)(ws + WS_W_MEM_Q) + (size_t)(L) * 512 * DM, DM, T, 512, 1024, 4, 1024, 1024,                    \
                             (pg8::EpiF32{(float*)(ws + WS_MQP), 512, (long)T * 512, 512})); }                                                                       \
    SEAM(P0_);                                                                                                                                                  \
    if (IN(P0_ + 1)) ph_attn_mem(a, (L), lds, w);                                                                                                               \
    SEAM(P0_ + 1);                                                                                                                                              \
    if (IN(P0_ + 2)) { FAST_GEMM(pg8::EpiResid, (const bf16_t*)(ws + WS_MEMO), 512, (const bf16_t*)(ws + WS_W_MEM_O) + (size_t)(L) * DM * 512, 512, T, DM, 512, 1, 0, 0, \
                                 (pg8::EpiResid{XB, RES, DM})); }                                                                                               \
    SEAM(P0_ + 2);                                                                                                                                              \
    if (IN(P0_ + 3)) ln_rows(RES, a.in[I_LN_G] + ((L) * 3 + 1) * DM, a.in[I_LN_B] + ((L) * 3 + 1) * DM, XB, w);                                             \
    SEAM(P0_ + 3);                                                                                                                                              \
    if (IN(P0_ + 4)) { FAST_GEMM(pg8::EpiF32, (const bf16_t*)(ws + WS_W_PEER) + (size_t)(L) * 2048 * DM, DM, XB, DM, 2048, T, DM, 1, 0, 0,                     \
                                 (pg8::EpiF32{(float*)(ws + WS_PSCORE), T, 0, T})); }                                                                              \
    SEAM(P0_ + 4);                                                                                                                                              \
    if (IN(P0_ + 5)) { ph_peer_topk(a, w); if (PROBE_DUP == 27 && (LAST)) ph_peer_topk(a, w); }                                                                 \
    SEAM(P0_ + 5);                                                                                                                                              \
    if (IN(P0_ + 6)) { ph_peer_experts(a, (L), (LAST) ? a.out : (float*)nullptr, (LAST) ? (bf16_t*)nullptr : XB, a.in[I_LN_G] + ((L) * 3 + 2) * DM, a.in[I_LN_B] + ((L) * 3 + 2) * DM, wlds, w); \
        if (PROBE_DUP == 28 && (LAST)) ph_peer_experts(a, (L), a.out, (bf16_t*)nullptr, a.in[I_LN_G] + ((L) * 3 + 2) * DM, a.in[I_LN_B] + ((L) * 3 + 2) * DM, wlds, w); } \
    if (!(LAST)) SEAM(P0_ + 6);

    MEM_PEER_PHASES(0, 8, false)

    if (IN(15)) {
        FAST_GEMM(pg8::EpiBf16, XB, DM, (const bf16_t*)(ws + WS_W_CD_IN), DM, T, CD_MAIN, DM, 1, 0, 0, (pg8::EpiBf16{PROJ, CD_MAIN, nullptr}));
        FAST_GEMM(pg8::EpiF32, XB, DM, (const bf16_t*)(ws + WS_W_CD_IN) + (size_t)CD_MAIN * DM, DM, T, 256, 512, 8, 512, 512, (pg8::EpiF32{(float*)(ws + WS_MQP), 256, (long)T * 256, 112}));
    }
    SEAM(15);
    if (IN(16)) ph_l1_elem(a, wlds, w);
    SEAM(16);
    if (IN(17)) { ph_l1_scan(a, (LAS float*)(lds + LDS_MISC + 64), w); ph_l1_index(a, lds, w); if (PROBE_DUP == 17) ph_l1_index(a, lds, w); }
    SEAM(17);
    if (IN(18)) { ph_l1_select(a, w); if (PROBE_DUP == 18) ph_l1_select(a, w); }
    SEAM(18);
    if (IN(19)) { ph_attn_l1(a, lds, w); if (PROBE_DUP == 19) ph_attn_l1(a, lds, w); }
    SEAM(19);
    if (IN(20)) { FAST_GEMM(pg8::EpiResid, ATT, DM, (const bf16_t*)(ws + WS_W_CD_OUT), DM, T, DM, DM, 1, 0, 0, (pg8::EpiResid{XB, RES, DM})); }
    SEAM(20);
    if (IN(21)) ln_rows(RES, a.in[I_LN_G] + 3 * DM, a.in[I_LN_B] + 3 * DM, XB, w);
    SEAM(21);
    MEM_PEER_PHASES(1, 22, true)
#undef IN
#undef SEAM
}

extern "C" void kernel_launch(void* const* d_in, const int* in_sizes, int n_in, void* d_out, int out_size, void* d_ws, size_t ws_size, hipStream_t stream) {
    static int grid = 0;
    if (grid == 0) {
        if (n_in != 21 || out_size != T * DM || ws_size < WS_END) { fprintf(stderr, "kernel_launch: unexpected shapes (n_in %d out %d ws %zu need %zu)\n", n_in, out_size, ws_size, (size_t)WS_END); grid = -1; return; }
        int dev = 0, cus = 0, per_cu = 0;
        if (hipGetDevice(&dev) != hipSuccess || hipDeviceGetAttribute(&cus, hipDeviceAttributeMultiprocessorCount, dev) != hipSuccess) { grid = -1; return; }
        if (hipFuncSetAttribute((const void*)mega, hipFuncAttributeMaxDynamicSharedMemorySize, LDS_BYTES) != hipSuccess) { fprintf(stderr, "kernel_launch: hipFuncSetAttribute failed\n"); grid = -1; return; }
        if (hipOccupancyMaxActiveBlocksPerMultiprocessor(&per_cu, (const void*)mega, 512, LDS_BYTES) != hipSuccess || per_cu < 1) { fprintf(stderr, "kernel_launch: occupancy query says %d\n", per_cu); }
        (void)hipGetLastError();
        grid = cus;
    }
    if (grid < 0) return;
    (void)hipMemsetAsync((char*)d_ws + WS_CTL, 0, CTL_BYTES, stream);
    Args a{};
    for (int i = 0; i < 21; ++i) a.in[i] = (const float*)d_in[i];
    a.out = (float*)d_out; a.ws = (unsigned char*)d_ws;
#if MK_PER_PHASE
    for (int p = 0; p < NPHASE; ++p) { a.ph_lo = p; a.ph_hi = p + 1; hipLaunchKernelGGL(mega, dim3(grid), dim3(512), LDS_BYTES, stream, a);
        if (p == PROBE_EXTRA_PHASE) hipLaunchKernelGGL(mega, dim3(grid), dim3(512), LDS_BYTES, stream, a); }
#else
    a.ph_lo = 0; a.ph_hi = NPHASE;
    hipLaunchKernelGGL(mega, dim3(grid), dim3(512), LDS_BYTES, stream, a);
#endif
}
```
